# Optimizing an MI355X kernel written in HIP

```python
import jax, jax.numpy as jnp
from jax import lax
import numpy as np

D_MODEL = 1024
BATCH = 8
SEQ = 4096
DEPTH = 1

CHUNK = 64
HG_HEADS = 8
HG_DK = 64
HG_DV = 64
HG_WIDTH = HG_HEADS * HG_DK
CONV_WIDTH = 512
CONV_K = 3
N_BRANCH = 2
PEER_HEADS = 8
PEER_NKEYS = 128
PEER_N = PEER_NKEYS * PEER_NKEYS
PEER_QDIM = 256
PEER_HALF = PEER_QDIM // 2
PEER_TOPK = 16
PEER_BLOCK = 128
EPS = 1e-6
IN_SPLITS = [HG_WIDTH] * 4 + [CONV_WIDTH] * 3 + [N_BRANCH * D_MODEL]
IN_COLS = sum(IN_SPLITS)

kernel_name = "hybrid_hgrn2_shortconv_peer_block"


def rmsnorm(x, g):
    xf = x.astype(jnp.float32)
    y = xf * lax.rsqrt(jnp.mean(xf * xf, axis=-1, keepdims=True) + EPS)
    return (y * g.astype(jnp.float32)).astype(x.dtype)


def hgrn2_chunkwise(q, k, log_f, v):
    b_, s_, h_, dk = q.shape
    dv = v.shape[-1]
    nc = s_ // CHUNK

    def to_chunks(t):
        return t.astype(jnp.float32).reshape(b_, nc, CHUNK, h_, t.shape[-1]).transpose(1, 0, 3, 2, 4)

    qc, kc, fc, vc = to_chunks(q), to_chunks(k), to_chunks(log_f), to_chunks(v)
    causal = jnp.tril(jnp.ones((CHUNK, CHUNK), dtype=bool))

    def step(state, inp):
        q_, k_, lf, v_ = inp
        b = jnp.cumsum(lf, axis=-2)
        b_last = b[..., -1:, :]
        o_inter = jnp.einsum('bhtd,bhde->bhte', q_ * jnp.exp(b), state)
        rel = jnp.where(causal[:, :, None], b[..., :, None, :] - b[..., None, :, :], -jnp.inf)
        scores = jnp.einsum('bhtd,bhsd,bhtsd->bhts', q_, k_, jnp.exp(rel))
        o = o_inter + jnp.einsum('bhts,bhse->bhte', scores, v_)
        new_state = (jnp.exp(b_last[..., 0, :])[..., None] * state
                     + jnp.einsum('bhsd,bhse->bhde', k_ * jnp.exp(b_last - b), v_))
        return new_state, o

    s0 = jnp.zeros((b_, h_, dk, dv), jnp.float32)
    _, o = lax.scan(step, s0, (qc, kc, fc, vc))
    return o.transpose(1, 0, 3, 2, 4).reshape(b_, s_, h_, dv)


def causal_depthwise_conv(u, w):
    c = u.shape[-1]
    return lax.conv_general_dilated(
        u, w[:, None, :].astype(u.dtype), window_strides=(1,), padding=[(CONV_K - 1, 0)],
        dimension_numbers=('NWC', 'WIO', 'NWC'), feature_group_count=c)


def peer_ffn(h, w_query, keys1, keys2, expert_u, expert_v):
    b_, s_, d = h.shape
    t = b_ * s_
    hf = h.reshape(t, d)
    q = (hf @ w_query).reshape(t, PEER_HEADS, 2, PEER_HALF)
    s1 = jnp.einsum('thc,hnc->thn', q[:, :, 0], keys1)
    s2 = jnp.einsum('thc,hnc->thn', q[:, :, 1], keys2)
    v1, i1 = lax.top_k(s1, PEER_TOPK)
    v2, i2 = lax.top_k(s2, PEER_TOPK)
    cand_s = (v1[..., :, None] + v2[..., None, :]).reshape(t, PEER_HEADS, PEER_TOPK * PEER_TOPK)
    cand_i = (i1[..., :, None] * PEER_NKEYS + i2[..., None, :]).reshape(t, PEER_HEADS, PEER_TOPK * PEER_TOPK)
    top_s, top_pos = lax.top_k(cand_s, PEER_TOPK)
    idx = jnp.take_along_axis(cand_i, top_pos, axis=-1)
    gate = jax.nn.softmax(top_s.astype(jnp.float32), axis=-1).astype(h.dtype)
    nb = t // PEER_BLOCK

    def block(args):
        hb, ib, gb = args
        act = jax.nn.gelu(jnp.einsum('thkd,td->thk', expert_u[ib], hb), approximate=False)
        return jnp.einsum('thk,thkd->td', gb * act, expert_v[ib])

    out = lax.map(block, (hf.reshape(nb, PEER_BLOCK, d),
                          idx.reshape(nb, PEER_BLOCK, PEER_HEADS, PEER_TOPK),
                          gate.reshape(nb, PEER_BLOCK, PEER_HEADS, PEER_TOPK)))
    return out.reshape(b_, s_, d)


def setup_inputs(seed: int = 0) -> dict:
    key = jax.random.key(seed)
    ks = jax.random.split(key, 18)
    f32 = jnp.float32
    nrm = lambda k, shape, scale: jax.random.normal(k, shape, f32) * scale
    gain = lambda k, shape: 1.0 + 0.02 * jax.random.normal(k, shape, f32)
    return {
        "x": jax.random.normal(ks[0], (BATCH, SEQ, D_MODEL), f32),
        "norm_mix_g": gain(ks[1], (DEPTH, D_MODEL)),
        "w_in": nrm(ks[2], (DEPTH, D_MODEL, IN_COLS), D_MODEL ** -0.5),
        "hg_lb_logits": nrm(ks[3], (DEPTH + 1, HG_WIDTH), 0.1),
        "hg_out_norm_g": gain(ks[4], (DEPTH, HG_WIDTH)),
        "conv_w": nrm(ks[5], (DEPTH, CONV_K, CONV_WIDTH), CONV_K ** -0.5),
        "w_branch_hg": nrm(ks[6], (DEPTH, HG_WIDTH, D_MODEL), HG_WIDTH ** -0.5),
        "w_branch_conv": nrm(ks[7], (DEPTH, CONV_WIDTH, D_MODEL), CONV_WIDTH ** -0.5),
        "w_out": nrm(ks[8], (DEPTH, D_MODEL, D_MODEL), D_MODEL ** -0.5),
        "norm_ffn_g": gain(ks[9], (DEPTH, D_MODEL)),
        "peer_w_query": nrm(ks[10], (DEPTH, D_MODEL, PEER_HEADS * PEER_QDIM), D_MODEL ** -0.5),
        "peer_keys1": nrm(ks[11], (DEPTH, PEER_HEADS, PEER_NKEYS, PEER_HALF), PEER_HALF ** -0.5),
        "peer_keys2": nrm(ks[12], (DEPTH, PEER_HEADS, PEER_NKEYS, PEER_HALF), PEER_HALF ** -0.5),
        "peer_u": nrm(ks[13], (DEPTH, PEER_N, D_MODEL), D_MODEL ** -0.5),
        "peer_v": nrm(ks[14], (DEPTH, PEER_N, D_MODEL), PEER_HEADS ** -0.5),
        "norm_final_g": gain(ks[15], (D_MODEL,)),
    }


def reference(x, norm_mix_g, w_in, hg_lb_logits, hg_out_norm_g, conv_w, w_branch_hg,
              w_branch_conv, w_out, norm_ffn_g, peer_w_query, peer_keys1, peer_keys2,
              peer_u, peer_v, norm_final_g):
    b_, s_, _ = x.shape
    lb_all = jnp.cumsum(jax.nn.softmax(hg_lb_logits.astype(jnp.float32), axis=0), axis=0)
    split_at = list(np.cumsum(IN_SPLITS)[:-1])
    for l in range(DEPTH):
        h = rmsnorm(x, norm_mix_g[l])
        proj = h @ w_in[l]
        hq, hf, hi, hg, cb, cc, ch, gates = jnp.split(proj, split_at, axis=-1)

        lb = lb_all[l]
        q = jax.nn.silu(hq.astype(jnp.float32)) * (HG_DK ** -0.5)
        sig = jax.nn.sigmoid(hf.astype(jnp.float32))
        forget = lb + (1.0 - lb) * sig
        k = 1.0 - forget
        log_f = jnp.log(forget)
        rs = lambda t: t.reshape(b_, s_, HG_HEADS, -1)
        o = hgrn2_chunkwise(rs(q), rs(k), rs(log_f), rs(hi))
        o = o * lax.rsqrt(jnp.mean(o * o, axis=-1, keepdims=True) + EPS)
        o = o * hg_out_norm_g[l].astype(jnp.float32).reshape(HG_HEADS, HG_DV)
        y_a = (o.reshape(b_, s_, HG_WIDTH) * jax.nn.silu(hg.astype(jnp.float32))).astype(x.dtype)

        y_b = cb * causal_depthwise_conv(cc * ch, conv_w[l])

        g_a, g_b = jnp.split(jax.nn.sigmoid(gates), 2, axis=-1)
        merged = g_a * (y_a @ w_branch_hg[l]) + g_b * (y_b @ w_branch_conv[l])
        x = x + merged @ w_out[l]

        x = x + peer_ffn(rmsnorm(x, norm_ffn_g[l]), peer_w_query[l], peer_keys1[l],
                         peer_keys2[l], peer_u[l], peer_v[l])
    return rmsnorm(x, norm_final_g)
```

```cpp
#include <hip/hip_runtime.h>
#include <cstdio>
#include <cstdint>


#define DBG_ZYA 1.0f
#define DBG_ZYB 1.0f


#ifdef DBG_SWAPG
#define CHK_GA_ROW 4608
#define CHK_GB_ROW 3584
#else
#define CHK_GA_ROW 3584
#define CHK_GB_ROW 4608
#endif

#ifndef MK_N_LAUNCHES
#define MK_N_LAUNCHES 1
#endif
namespace pg8 {
#define PG8_LAS __attribute__((address_space(3)))
typedef unsigned short bf16_t;
typedef short bf16x8 __attribute__((ext_vector_type(8)));
typedef float f32x4 __attribute__((ext_vector_type(4)));
typedef int v4i_ __attribute__((ext_vector_type(4)));
typedef int v8i_ __attribute__((ext_vector_type(8)));
typedef unsigned u32x4 __attribute__((ext_vector_type(4)));
constexpr int BM = 256, BK = 64, HALF = 128, HTB = HALF * BK * 2  , STAGE_BYTES = 8 * HTB, NXCD = 8, WGM = 8;

__host__ __device__ __forceinline__ int lds_byte(int r, int c) { const int st = (r >> 4) * 2 + (c >> 5), rr = r & 15, cc = c & 31, ob = rr * 64 + cc * 2; return st * 1024 + (ob ^ (((ob >> 9) & 1) << 5)); }
__host__ __device__ __forceinline__ void stage_rc(int b, int& R, int& C) { const int st = b / 1024, sb = b % 1024, swz = sb ^ (((sb >> 9) & 1) << 5); R = (st >> 1) * 16 + swz / 64; C = (st & 1) * 32 + (swz % 64) / 2; }
__host__ __device__ __forceinline__ int perm32(int rho) { const int n = rho >> 4, i = rho & 15; return 8 * (i >> 2) + 4 * n + (i & 3); }

struct Unit { int pm, pn; };
struct Gemm { const bf16_t* A; const bf16_t* Bt; int M, N, K; };

struct StaticOrder {
    int nM, nN, nwg, G, c;
    __host__ __device__ void init(int M, int N, int G_, int c_) { nM = M / BM; nN = N / BM; nwg = nM * nN; G = G_; c = c_; }
    __host__ __device__ bool next(int i, Unit& u) const {
        if ((long)i * G + c >= nwg) return false;
#ifdef DBG_REV
        const int nr = (nwg - 1 - c) / G; const long L = (long)(nr - i) * G + c;
#else
        const long L = (long)i * G + c;
#endif
        int wgid = (int)L; { const int q = nwg / NXCD, r = nwg % NXCD, xcd = wgid % NXCD, off = wgid / NXCD; wgid = (xcd < r ? xcd * (q + 1) : r * (q + 1) + (xcd - r) * q) + off; }
        const int nig = WGM * nN, gid = wgid / nig, fm = gid * WGM, gsz = (nM - fm) < WGM ? (nM - fm) : WGM;
        u.pm = fm + ((wgid % nig) % gsz); u.pn = (wgid % nig) / gsz; return true;
    }
    __device__ __forceinline__ void a_ready(const Unit&) const {}
    __device__ __forceinline__ void done(const Unit&) const {}
};

__device__ __forceinline__ int fresh_lane() { int l; asm volatile("v_mbcnt_lo_u32_b32 %0, -1, 0\n\tv_mbcnt_hi_u32_b32 %0, -1, %0" : "=v"(l)); return l; }
__device__ __forceinline__ unsigned cvt_pk_bf16(float lo, float hi) { unsigned r; asm volatile("v_cvt_pk_bf16_f32 %0, %1, %2" : "=v"(r) : "v"(lo), "v"(hi)); return r; }
__device__ __forceinline__ float fexp(float x) { return __builtin_amdgcn_exp2f(x * 1.44269504089f); }
__device__ __forceinline__ float fsig(float x) { return __builtin_amdgcn_rcpf(1.0f + fexp(-x)); }
__device__ __forceinline__ float bflo(unsigned w) { return __builtin_bit_cast(float, w << 16); }
__device__ __forceinline__ float bfhi(unsigned w) { return __builtin_bit_cast(float, w & 0xffff0000u); }
__device__ __forceinline__ void st8(bf16_t* p, const float (&v)[8]) {
    u32x4 w; w.x = cvt_pk_bf16(v[0], v[1]); w.y = cvt_pk_bf16(v[2], v[3]); w.z = cvt_pk_bf16(v[4], v[5]); w.w = cvt_pk_bf16(v[6], v[7]); *(u32x4*)p = w; }
__device__ __forceinline__ void ld8(const bf16_t* p, float (&v)[8]) {
    const u32x4 w = *(const u32x4*)p; v[0] = bflo(w.x); v[1] = bfhi(w.x); v[2] = bflo(w.y); v[3] = bfhi(w.y); v[4] = bflo(w.z); v[5] = bfhi(w.z); v[6] = bflo(w.w); v[7] = bfhi(w.w); }

__device__ __forceinline__ float sum16(const float* p) {
    const f32x4 a = *(const f32x4*)p, b = *(const f32x4*)(p + 4), c = *(const f32x4*)(p + 8), d = *(const f32x4*)(p + 12);
    return (((a[0] + a[1]) + (a[2] + a[3])) + ((b[0] + b[1]) + (b[2] + b[3]))) + (((c[0] + c[1]) + (c[2] + c[3])) + ((d[0] + d[1]) + (d[2] + d[3]))); }
struct EpiInProj {
    static constexpr bool PERM = true, AFTER_DRAIN = false, MID = false;
    const float* rstd; const float* lb;
    bf16_t *Q, *LF, *KK, *V, *SG, *CB, *U, *GA;
    int pn_off;
    __device__ __forceinline__ void mid(f32x4 (&)[2][2][4][2], const Unit&, int, int, int, int) const {}
    template <int MODE> __device__ __forceinline__ void run(const f32x4 (&acc)[2][2][4][2], bf16_t* O, bf16_t* O2, int ldo, int cbase, int row0, int cl) const {
        float lbv[2][8];
#pragma unroll
        for (int bj = 0; bj < 2; ++bj)
#pragma unroll
            for (int i = 0; i < 8; ++i) lbv[bj][i] = (MODE == 1) ? lb[cbase + bj * HALF + cl + i] : 0.f;
#pragma unroll
        for (int ai = 0; ai < 2; ++ai)
#pragma unroll
            for (int m = 0; m < 4; ++m) { const int r = row0 + ai * HALF + m * 16; const float rs = rstd[r];
#pragma unroll
                for (int bj = 0; bj < 2; ++bj) { float v[8];
#pragma unroll
                    for (int i = 0; i < 8; ++i) { float x = acc[ai][bj][m][i >> 2][i & 3] * rs;
                        if (MODE == 0) { v[i] = x * fsig(x) * 0.125f; }
                        else if (MODE == 1) { x = fminf(fmaxf(x, -30.f), 30.f); const float ex = fexp(-x), sg = __builtin_amdgcn_rcpf(1.0f + ex), om = ex * sg;
                            v[i] = (1.0f - lbv[bj][i]) * om; }
                        else if (MODE == 2) { v[i] = x; }
                        else if (MODE == 3) { v[i] = x * fsig(x); }
                        else { v[i] = fsig(x); } }
                    const size_t off = (size_t)r * ldo + cbase + bj * HALF + cl;
                    st8(O + off, v); } }
    }
    __device__ __forceinline__ void operator()(const f32x4 (&acc)[2][2][4][2], const Unit& u, int wr, int wc, int fr, int fq) const {
        const int pn = (pn_off == 0) ? u.pn + 2 : (u.pn < 2 ? u.pn : u.pn + 12); int row0 = u.pm * BM + wr * 64 + fr, cl = wc * 32 + 8 * fq;
        asm volatile("" : "+v"(row0), "+v"(cl));
        if (pn < 2) run<0>(acc, Q, nullptr, 512, pn * 256, row0, cl);
        else if (pn < 4) run<1>(acc, KK, nullptr, 512, (pn - 2) * 256, row0, cl);
        else if (pn < 6) run<2>(acc, V, nullptr, 512, (pn - 4) * 256, row0, cl);
        else if (pn < 8) run<3>(acc, SG, nullptr, 512, (pn - 6) * 256, row0, cl);
        else if (pn < 10) run<2>(acc, CB, nullptr, 512, (pn - 8) * 256, row0, cl);
        else if (pn < 14) {
#pragma unroll
            for (int ai = 0; ai < 2; ++ai)
#pragma unroll
                for (int m = 0; m < 4; ++m) { const int r = row0 + ai * HALF + m * 16; const float rs = rstd[r], rs2 = rs * rs; float v[8];
#pragma unroll
                    for (int i = 0; i < 8; ++i) v[i] = acc[ai][0][m][i >> 2][i & 3] * acc[ai][1][m][i >> 2][i & 3] * rs2;
                    st8(U + (size_t)r * 512 + (pn - 10) * 128 + cl, v); }
        }
        else {
            unsigned char* G8 = (unsigned char*)GA + (size_t)(u.pm * 8 + (pn - 14)) * 65536 + (size_t)((wr * 4 + wc) * 64 + fq * 16 + fr) * 16;
#pragma unroll
            for (int ai = 0; ai < 2; ++ai)
#pragma unroll
                for (int m = 0; m < 4; ++m) { const int r = row0 + ai * HALF + m * 16; const float rs = rstd[r]; unsigned w[4] = {0u, 0u, 0u, 0u};
#pragma unroll
                    for (int bj = 0; bj < 2; ++bj)
#pragma unroll
                        for (int i = 0; i < 8; ++i) { const float gq = fmaxf(fsig(acc[ai][bj][m][i >> 2][i & 3] * rs) * 255.0f + 0.5f, 1.0f); w[2 * bj + (i >> 2)] = __builtin_amdgcn_cvt_pk_u8_f32(gq, i & 3, w[2 * bj + (i >> 2)]); }
                    u32x4 o; o.x = w[0]; o.y = w[1]; o.z = w[2]; o.w = w[3]; *(u32x4*)(G8 + (ai * 4 + m) * 8192) = o; }
        }
    }
};
struct EpiMerged {
    static constexpr bool PERM = true, AFTER_DRAIN = false, MID = true;
    const bf16_t *GAB; bf16_t* MG;
    static __device__ __forceinline__ float ub(unsigned w, int k) { return (float)((w >> (8 * k)) & 0xffu); }
    __device__ __forceinline__ void mid(f32x4 (&acc)[2][2][4][2], const Unit& u, int wr, int wc, int fr, int fq) const {
        int lt = (wr * 4 + wc) * 64 + fq * 16 + fr; asm volatile("" : "+v"(lt));
        const unsigned char* Ga = (const unsigned char*)GAB + (size_t)(u.pm * 8 + u.pn) * 65536 + (size_t)lt * 16; const unsigned char* Gb = Ga + (size_t)4 * 65536;
#pragma unroll
        for (int ai = 0; ai < 2; ++ai)
#pragma unroll
            for (int m = 0; m < 4; ++m) { const u32x4 a = *(const u32x4*)(Ga + (ai * 4 + m) * 8192), b = *(const u32x4*)(Gb + (ai * 4 + m) * 8192);
                const unsigned aw[4] = {a.x, a.y, a.z, a.w}, bw[4] = {b.x, b.y, b.z, b.w};
#pragma unroll
                for (int bj = 0; bj < 2; ++bj)
#pragma unroll
                    for (int i = 0; i < 8; ++i) acc[ai][bj][m][i >> 2][i & 3] *= ub(aw[2 * bj + (i >> 2)], i & 3) * __builtin_amdgcn_rcpf(ub(bw[2 * bj + (i >> 2)], i & 3)); }
        asm volatile("" ::: "memory");
    }
    __device__ __forceinline__ void operator()(const f32x4 (&acc)[2][2][4][2], const Unit& u, int wr, int wc, int fr, int fq) const {
        int row0 = u.pm * BM + wr * 64 + fr, c0 = u.pn * BM + wc * 32 + 8 * fq;
        asm volatile("" : "+v"(row0), "+v"(c0));
        int lt = (wr * 4 + wc) * 64 + fq * 16 + fr; asm volatile("" : "+v"(lt));
        const unsigned char* Gb = (const unsigned char*)GAB + (size_t)(u.pm * 8 + 4 + u.pn) * 65536 + (size_t)lt * 16;
        u32x4 gbw[2][4];
#pragma unroll
        for (int ai = 0; ai < 2; ++ai)
#pragma unroll
            for (int m = 0; m < 4; ++m) gbw[ai][m] = *(const u32x4*)(Gb + (ai * 4 + m) * 8192);
#pragma unroll
        for (int ai = 0; ai < 2; ++ai)
#pragma unroll
            for (int m = 0; m < 4; ++m) { const size_t rr = (size_t)(row0 + ai * HALF + m * 16); const unsigned bw[4] = {gbw[ai][m].x, gbw[ai][m].y, gbw[ai][m].z, gbw[ai][m].w};
#pragma unroll
                for (int bj = 0; bj < 2; ++bj) { float v[8];
#pragma unroll
                    for (int i = 0; i < 8; ++i) v[i] = acc[ai][bj][m][i >> 2][i & 3] * (ub(bw[2 * bj + (i >> 2)], i & 3) * (1.0f / 255.0f));
                    st8(MG + rr * 1024 + c0 + bj * HALF, v); } }
    }
};
struct EpiOut {
    static constexpr bool PERM = true, AFTER_DRAIN = false, MID = false;
    const bf16_t* x; float* x1; bf16_t* x1b; float* rowss;
    __device__ __forceinline__ void mid(f32x4 (&)[2][2][4][2], const Unit&, int, int, int, int) const {}
    __device__ __forceinline__ void operator()(const f32x4 (&acc)[2][2][4][2], const Unit& u, int wr, int wc, int fr, int fq) const {
        int row0 = u.pm * BM + wr * 64 + fr, c0 = u.pn * BM + wc * 32 + 8 * fq;
        asm volatile("" : "+v"(row0), "+v"(c0));
#pragma unroll
        for (int ai = 0; ai < 2; ++ai)
#pragma unroll
            for (int m = 0; m < 4; ++m) { const int r = row0 + ai * HALF + m * 16; const size_t ro = (size_t)r * 1024 + c0; float ss = 0.f;
#pragma unroll
                for (int bj = 0; bj < 2; ++bj) { float xv[8]; ld8(x + ro + bj * HALF, xv);
                    const f32x4 x0 = {xv[0], xv[1], xv[2], xv[3]}, x1v = {xv[4], xv[5], xv[6], xv[7]};
                    const f32x4 o0 = acc[ai][bj][m][0] + x0, o1 = acc[ai][bj][m][1] + x1v;
                    float v[8] = {o0[0], o0[1], o0[2], o0[3], o1[0], o1[1], o1[2], o1[3]};
#pragma unroll
                    for (int i = 0; i < 8; ++i) ss += v[i] * v[i];
                    st8(x1b + ro + bj * HALF, v); }
                ss += __shfl_xor(ss, 16); ss += __shfl_xor(ss, 32);
                if (fq == 0) rowss[(size_t)r * 16 + u.pn * 4 + wc] = ss; }
    }
};
struct EpiQuery {
    static constexpr bool PERM = true, AFTER_DRAIN = false, MID = false;
    const float* rowss; bf16_t* QQ; float eps;
    __device__ __forceinline__ void mid(f32x4 (&)[2][2][4][2], const Unit&, int, int, int, int) const {}
    __device__ __forceinline__ void operator()(const f32x4 (&acc)[2][2][4][2], const Unit& u, int wr, int wc, int fr, int fq) const {
        int row0 = u.pm * BM + wr * 64 + fr, c0 = u.pn * BM + wc * 32 + 8 * fq;
        asm volatile("" : "+v"(row0), "+v"(c0));
#pragma unroll
        for (int ai = 0; ai < 2; ++ai)
#pragma unroll
            for (int m = 0; m < 4; ++m) { const int r = row0 + ai * HALF + m * 16; const float rs = __builtin_amdgcn_rsqf(sum16(rowss + (size_t)r * 16) * (1.0f / 1024.0f) + eps);
#pragma unroll
                for (int bj = 0; bj < 2; ++bj) { float v[8];
#pragma unroll
                    for (int i = 0; i < 8; ++i) v[i] = acc[ai][bj][m][i >> 2][i & 3] * rs;
                    st8(QQ + (size_t)r * 2048 + c0 + bj * HALF, v); } }
    }
};

template <class Epi, class Sched, bool ALIGN_EPI = false, bool SP2 = false, bool FP8 = false>
__device__ __forceinline__ void gemm_phase(PG8_LAS unsigned char* lds, const Gemm g, const Sched& S, const Epi& E, const int wid) {
    const int lane = fresh_lane(), tid = wid * 64 + lane, wr = wid >> 2, wc = wid & 3, fr = lane & 15, fq = lane >> 4;
    const int K = g.K, nt = K / BK;
    unsigned voffA[2], voffB[2];
#pragma unroll
    for (int i = 0; i < 2; ++i) { int R, C; stage_rc(tid * 16 + i * 8192, R, C); const int Rb = Epi::PERM ? ((R & ~31) + perm32(R & 31)) : R;
        voffA[i] = (unsigned)(R * K + C) * 2u; voffB[i] = (unsigned)(Rb * K + C) * 2u; }
    const size_t kstep = (size_t)(BK * 2);
    const size_t hstep = (size_t)HALF * K * 2;
    const size_t tstep = 2 * hstep;
    const unsigned ldsw = (unsigned)wid * 1024u;
    const int aoff = lds_byte(wr * 64 + fr, fq * 8), boff = lds_byte(wc * 32 + fr, fq * 8);
#define PG8_SA(b, h) (((b) * 2 + (h)) * HTB)
#define PG8_SB(b, h) ((4 + (b) * 2 + (h)) * HTB)
#define PG8_STAGE(bufoff, gbase, voff) do { _Pragma("unroll") for (int _i = 0; _i < 2; ++_i) \
        __builtin_amdgcn_global_load_lds((const unsigned*)((const char*)(gbase) + (voff)[_i]), (PG8_LAS unsigned*)(lds + (bufoff) + ldsw + _i * 8192), 16, 0, 0); } while (0)
#define PG8_LDA(dst, b, h) do { _Pragma("unroll") for (int m = 0; m < 4; ++m) _Pragma("unroll") for (int k = 0; k < 2; ++k) dst[m][k] = *(const PG8_LAS bf16x8*)(lds + PG8_SA(b, h) + aoff + m * 2048 + k * 1024); } while (0)
#define PG8_LDB(dst, b, h) do { _Pragma("unroll") for (int n = 0; n < 2; ++n) _Pragma("unroll") for (int k = 0; k < 2; ++k) dst[n][k] = *(const PG8_LAS bf16x8*)(lds + PG8_SB(b, h) + boff + n * 2048 + k * 1024); } while (0)
#define PG8_MMA(ai, bj, At, Bt) do { __builtin_amdgcn_s_setprio(1); \
        if constexpr (FP8) { _Pragma("unroll") for (int m = 0; m < 4; ++m) _Pragma("unroll") for (int n = 0; n < 2; ++n) { \
            const v4i_ b0_ = __builtin_bit_cast(v4i_, Bt[n][0]), b1_ = __builtin_bit_cast(v4i_, Bt[n][1]), a0_ = __builtin_bit_cast(v4i_, At[m][0]), a1_ = __builtin_bit_cast(v4i_, At[m][1]); \
            const v8i_ bb_ = {b0_[0], b0_[1], b0_[2], b0_[3], b1_[0], b1_[1], b1_[2], b1_[3]}, aa_ = {a0_[0], a0_[1], a0_[2], a0_[3], a1_[0], a1_[1], a1_[2], a1_[3]}; \
            asm("v_mfma_scale_f32_16x16x128_f8f6f4 %0, %1, %2, %0, %3, %4 op_sel_hi:[0,0,0]" : "+v"(acc[ai][bj][m][n]) : "v"(bb_), "v"(aa_), "v"(scw_), "v"(sca_)); } } \
        else { _Pragma("unroll") for (int m = 0; m < 4; ++m) _Pragma("unroll") for (int n = 0; n < 2; ++n) _Pragma("unroll") for (int k = 0; k < 2; ++k) \
            acc[ai][bj][m][n] = __builtin_amdgcn_mfma_f32_16x16x32_bf16(Bt[n][k], At[m][k], acc[ai][bj][m][n], 0, 0, 0); } \
        __builtin_amdgcn_s_setprio(0); } while (0)
#define PG8_WAIT_V(n) asm volatile("s_waitcnt vmcnt(" #n ")" ::: "memory")
#define PG8_WAIT_L(n) asm volatile("s_waitcnt lgkmcnt(" #n ")" ::: "memory")
#define PG8_BAR __builtin_amdgcn_s_barrier()
#define PG8_SCHED __builtin_amdgcn_sched_barrier(0)
    Unit cur, nxt; int ui = 0;
    if (!S.next(0, cur)) return;
    int scw_ = 0x79797979, sca_ = 0x7f7f7f7f; if constexpr (FP8) asm volatile("" : "+v"(scw_), "+v"(sca_));
    f32x4 acc[2][2][4][2];
#pragma unroll
    for (int a = 0; a < 2; ++a)
#pragma unroll
        for (int b = 0; b < 2; ++b)
#pragma unroll
            for (int m = 0; m < 4; ++m)
#pragma unroll
                for (int n = 0; n < 2; ++n) acc[a][b][m][n] = (f32x4){0.f, 0.f, 0.f, 0.f};
    bf16x8 At[4][2], B0[2][2], B1[2][2];
    const char* cA = (const char*)g.A + (size_t)cur.pm * tstep; const char* cB = (const char*)g.Bt + (size_t)cur.pn * tstep;
    S.a_ready(cur);
    if constexpr (SP2) {
        PG8_STAGE(PG8_SB(0, 0), cB, voffB); PG8_STAGE(PG8_SB(0, 1), cB + hstep, voffB); PG8_STAGE(PG8_SA(0, 0), cA, voffA); PG8_STAGE(PG8_SA(0, 1), cA + hstep, voffA);
        if (wr == 1) PG8_BAR;
        PG8_WAIT_V(2); PG8_BAR;
        PG8_STAGE(PG8_SB(1, 0), cB + kstep, voffB); PG8_STAGE(PG8_SA(1, 0), cA + kstep, voffA); PG8_STAGE(PG8_SB(1, 1), cB + hstep + kstep, voffB);
        PG8_WAIT_V(6); PG8_BAR;
    } else {
        PG8_STAGE(PG8_SB(0, 0), cB, voffB); PG8_STAGE(PG8_SA(0, 0), cA, voffA); PG8_STAGE(PG8_SB(0, 1), cB + hstep, voffB); PG8_STAGE(PG8_SA(0, 1), cA + hstep, voffA);
        if (wr == 1) PG8_BAR;
        PG8_WAIT_V(4); PG8_BAR;
        PG8_STAGE(PG8_SB(1, 0), cB + kstep, voffB); PG8_STAGE(PG8_SA(1, 0), cA + kstep, voffA); PG8_STAGE(PG8_SB(1, 1), cB + hstep + kstep, voffB);
        PG8_WAIT_V(6); PG8_BAR;
    }
    for (;;) {
        const bool has_next = S.next(ui + 1, nxt);
        const char* nA = has_next ? (const char*)g.A + (size_t)nxt.pm * tstep : cA; const char* nB = has_next ? (const char*)g.Bt + (size_t)nxt.pn * tstep : cB;
#pragma unroll 1
        for (int t = 0; t < nt; t += 2) {
            if constexpr (Epi::MID) { if (t == (nt >> 1)) E.mid(acc, cur, wr, wc, fr, fq); }
            const bool last = (t == nt - 2);
            const char* a1 = cA + (size_t)(t + 1) * kstep;
            const char* a2 = last ? nA : cA + (size_t)(t + 2) * kstep; const char* b2 = last ? nB : cB + (size_t)(t + 2) * kstep;
            const char* a3 = a2 + kstep; const char* b3 = b2 + kstep;
            if (last && has_next) S.a_ready(nxt);
            if constexpr (SP2) {
            PG8_LDB(B0, 0, 0); PG8_LDB(B1, 0, 1); PG8_SCHED; PG8_LDA(At, 0, 0); PG8_STAGE(PG8_SA(1, 1), a1 + hstep, voffA);
            PG8_WAIT_V(8); PG8_WAIT_L(0); PG8_BAR; PG8_MMA(0, 0, At, B0); PG8_MMA(0, 1, At, B1); PG8_BAR; PG8_SCHED;
            PG8_LDA(At, 0, 1); PG8_STAGE(PG8_SB(0, 0), b2, voffB); PG8_STAGE(PG8_SB(0, 1), b2 + hstep, voffB); PG8_STAGE(PG8_SA(0, 0), a2, voffA);
            PG8_WAIT_V(8); PG8_WAIT_L(0); PG8_BAR; PG8_MMA(1, 0, At, B0); PG8_MMA(1, 1, At, B1); PG8_BAR; PG8_SCHED;
            PG8_LDB(B0, 1, 0); PG8_LDB(B1, 1, 1); PG8_SCHED; PG8_LDA(At, 1, 0); PG8_STAGE(PG8_SA(0, 1), a2 + hstep, voffA);
            PG8_WAIT_V(8); PG8_WAIT_L(0); PG8_BAR; PG8_MMA(0, 0, At, B0); PG8_MMA(0, 1, At, B1); PG8_BAR; PG8_SCHED;
            PG8_LDA(At, 1, 1); PG8_STAGE(PG8_SB(1, 0), b3, voffB); PG8_STAGE(PG8_SB(1, 1), b3 + hstep, voffB); PG8_STAGE(PG8_SA(1, 0), a3, voffA);
            PG8_WAIT_V(8); PG8_WAIT_L(0); PG8_BAR; PG8_MMA(1, 0, At, B0); PG8_MMA(1, 1, At, B1); PG8_BAR; PG8_SCHED;
            } else {
            PG8_LDB(B0, 0, 0); PG8_SCHED; PG8_LDA(At, 0, 0); PG8_STAGE(PG8_SA(1, 1), a1 + hstep, voffA);
            PG8_WAIT_L(8); PG8_BAR; PG8_WAIT_L(0); PG8_MMA(0, 0, At, B0); PG8_BAR; PG8_SCHED;
            PG8_LDB(B1, 0, 1); PG8_STAGE(PG8_SB(0, 0), b2, voffB);
            PG8_BAR; PG8_WAIT_L(0); PG8_MMA(0, 1, At, B1); PG8_BAR;
            PG8_LDA(At, 0, 1); PG8_STAGE(PG8_SA(0, 0), a2, voffA);
            PG8_BAR; PG8_WAIT_L(0); PG8_MMA(1, 0, At, B0); PG8_BAR; PG8_SCHED;
            PG8_STAGE(PG8_SB(0, 1), b2 + hstep, voffB);
            PG8_WAIT_V(6); PG8_BAR; PG8_MMA(1, 1, At, B1); PG8_BAR;
            PG8_LDB(B0, 1, 0); PG8_SCHED; PG8_LDA(At, 1, 0); PG8_STAGE(PG8_SA(0, 1), a2 + hstep, voffA);
            PG8_WAIT_L(8); PG8_BAR; PG8_WAIT_L(0); PG8_MMA(0, 0, At, B0); PG8_BAR; PG8_SCHED;
            PG8_LDB(B1, 1, 1); PG8_STAGE(PG8_SB(1, 0), b3, voffB);
            PG8_BAR; PG8_WAIT_L(0); PG8_MMA(0, 1, At, B1); PG8_BAR;
            PG8_LDA(At, 1, 1); PG8_STAGE(PG8_SA(1, 0), a3, voffA);
            PG8_BAR; PG8_WAIT_L(0); PG8_MMA(1, 0, At, B0); PG8_BAR; PG8_SCHED;
            PG8_STAGE(PG8_SB(1, 1), b3 + hstep, voffB);
            PG8_WAIT_V(6); PG8_BAR; PG8_MMA(1, 1, At, B1); PG8_BAR;
            }
        }
        if constexpr (FP8) asm volatile("s_nop 15\n\ts_nop 15\n\ts_nop 15" ::: "memory");
        if constexpr (ALIGN_EPI) { if (wr == 0) PG8_BAR; }
        if constexpr (!Epi::AFTER_DRAIN) { E(acc, cur, wr, wc, fr, fq); S.done(cur); }
        if (!has_next) break;
#pragma unroll
        for (int a = 0; a < 2; ++a)
#pragma unroll
            for (int b = 0; b < 2; ++b)
#pragma unroll
                for (int m = 0; m < 4; ++m)
#pragma unroll
                    for (int n = 0; n < 2; ++n) acc[a][b][m][n] = (f32x4){0.f, 0.f, 0.f, 0.f};
        cur = nxt; cA = nA; cB = nB; ++ui;
        if constexpr (ALIGN_EPI) { if (wr == 1) PG8_BAR; }
    }
    PG8_WAIT_V(0);
    if constexpr (!ALIGN_EPI) { if (wr == 0) PG8_BAR; }
    PG8_BAR;
    if constexpr (Epi::AFTER_DRAIN) { E.fused(acc, cur, wr, wc, fr, fq, lds, wid, lane); S.done(cur); }
#undef PG8_SA
#undef PG8_SB
#undef PG8_STAGE
#undef PG8_LDA
#undef PG8_LDB
#undef PG8_MMA
#undef PG8_WAIT_V
#undef PG8_WAIT_L
#undef PG8_BAR
#undef PG8_SCHED
}
}

constexpr int NWAVES = 8;
constexpr int N_LAUNCHES = MK_N_LAUNCHES;
constexpr int PER_PHASE = 10;
constexpr int T = 32768, D = 1024, SEQ = 4096, NIN = 5632, NUNIT = 4096;
constexpr float EPS = 1e-6f;
constexpr size_t MiB = 1u << 20;
constexpr size_t WS_CTL = 0, CTL_ZERO_BYTES = 1 * MiB;
constexpr size_t WS_ROWSS = 4 * MiB;
constexpr size_t WS_RSTD1 = 1 * MiB;
constexpr size_t WS_LB = 1 * MiB + 256 * 1024;
constexpr size_t WS_DEC = 2 * MiB;
constexpr size_t WS_WIN = 8 * MiB, WS_PAB = 19 * MiB, WS_WO = 21 * MiB, WS_WQ = 23 * MiB, WS_KEYS = 27 * MiB;
constexpr size_t WS_GA = 32 * MiB, WS_GB = 96 * MiB;
constexpr size_t WS_Q = 160 * MiB, WS_LF = 192 * MiB, WS_KK = 224 * MiB, WS_V = 256 * MiB, WS_SG = 288 * MiB, WS_CB = 320 * MiB, WS_U = 352 * MiB;
constexpr size_t WS_XB = 384 * MiB;
constexpr size_t WS_LOC = 448 * MiB;
constexpr size_t WS_SPREV = 320 * MiB;
constexpr size_t WS_X1 = 32 * MiB;
constexpr size_t WS_MG = 160 * MiB;
constexpr size_t WS_X1B = 224 * MiB;
constexpr size_t WS_QQ = 288 * MiB;
constexpr size_t WS_IDX = 416 * MiB, WS_GATE = 432 * MiB;
constexpr size_t WS_EU = 160 * MiB, WS_EV = 176 * MiB;
constexpr size_t WS_ESC = 192 * MiB;
constexpr size_t WS_X8 = 448 * MiB;
constexpr size_t WS_W8G = 28 * MiB;
constexpr size_t WS_END = 480 * MiB;
constexpr int CW_BAR = 4096;
constexpr int RING_BYTES = 131072, WAVE_LDS = 18688, MISC_OFF = NWAVES * WAVE_LDS, LDS_BYTES = MISC_OFF + 1024;
static_assert(MISC_OFF >= RING_BYTES && LDS_BYTES <= 160 * 1024, "LDS map");

#define GAS __attribute__((address_space(1)))
#define LAS __attribute__((address_space(3)))
typedef unsigned short bf16;
typedef unsigned v4u __attribute__((ext_vector_type(4)));
typedef unsigned v2u __attribute__((ext_vector_type(2)));
typedef float f32x4 __attribute__((ext_vector_type(4)));
typedef float f32x16 __attribute__((ext_vector_type(16)));
typedef short bf16x8 __attribute__((ext_vector_type(8)));
typedef __bf16 bf16x2_t __attribute__((ext_vector_type(2)));
typedef GAS unsigned gu32;
#define RLX_AGENT __ATOMIC_RELAXED, __HIP_MEMORY_SCOPE_AGENT
#define LDS_WAIT() asm volatile("s_waitcnt lgkmcnt(0)" ::: "memory")
#define VM_WAIT() asm volatile("s_waitcnt vmcnt(0)" ::: "memory")
#define MFMA32(a, b, c) __builtin_amdgcn_mfma_f32_32x32x16_bf16((a), (b), (c), 0, 0, 0)
using pg8::cvt_pk_bf16; using pg8::fexp; using pg8::fsig; using pg8::bflo; using pg8::bfhi;
__device__ __forceinline__ int crow(int reg, int h) { return (reg & 3) + 8 * (reg >> 2) + 4 * h; }

#define XB_TMO      128
#define XB_XCNT(j)  (256  + 64 * (j))
#define XB_XSUB(j)  (1280 + 64 * (j))
#define XB_XGEN(j)  (2304 + 64 * (j))
#define XB_TOP      3328
#define XB_TOPGEN   3392
#define XCD_BAR_WORDS 3456
#define XB_SPIN_CAP (1u << 18)
__device__ __forceinline__ unsigned xb_ld(unsigned* p)              { return __hip_atomic_load(p, __ATOMIC_RELAXED, __HIP_MEMORY_SCOPE_AGENT); }
__device__ __forceinline__ unsigned xb_add(unsigned* p, unsigned v) { return __hip_atomic_fetch_add(p, v, __ATOMIC_RELAXED, __HIP_MEMORY_SCOPE_AGENT); }
__device__ __forceinline__ unsigned xb_xcc_id() { return (unsigned)__builtin_amdgcn_s_getreg((3 << 11) | 20) & 0xFu; }
#define XB_SPIN(cond, bar) do { unsigned _sp = 0; while (cond) { __builtin_amdgcn_s_sleep(1); \
    if ((++_sp & 255u) == 0u) { if (xb_ld(&(bar)[XB_TMO])) break; if (_sp > XB_SPIN_CAP) { atomicAdd(&(bar)[XB_TMO], 1u); break; } } } } while (0)
struct XcdBarrier { unsigned* bar; unsigned x; volatile LAS unsigned* st; };
__device__ __forceinline__ XcdBarrier xcd_barrier_post(unsigned* bar, volatile LAS unsigned* st) {
    XcdBarrier b; b.bar = bar; b.x = xb_xcc_id(); b.st = st;
    if (threadIdx.x == 0) (void)xb_add(&bar[XB_XCNT(b.x)], 1u);
    return b;
}
__device__ __forceinline__ void xcd_barrier_complete(unsigned* bar, unsigned x, unsigned& nloc, unsigned& nx) {
    const unsigned G = gridDim.x * gridDim.y * gridDim.z;
    unsigned sum, cnt, mine, sp = 0u;
    for (;;) {
        sum = 0u; cnt = 0u; mine = 0u;
#pragma unroll
        for (unsigned j = 0; j < 16; ++j) { const unsigned c = xb_ld(&bar[XB_XCNT(j)]); sum += c; cnt += (c > 0u) ? 1u : 0u; mine = (j == x) ? c : mine; }
        if (sum == G) break;
        __builtin_amdgcn_s_sleep(1);
        if ((++sp & 255u) == 0u) { if (xb_ld(&bar[XB_TMO])) break; if (sp > XB_SPIN_CAP) { atomicAdd(&bar[XB_TMO], 1u); break; } }
    }
    nloc = mine > 0u ? mine : 1u; nx = cnt > 0u ? cnt : 1u;
}
__device__ __forceinline__ void xcd_barrier(const XcdBarrier& b) {
    asm volatile("s_waitcnt vmcnt(0)" ::: "memory");
    __syncthreads();
    if (threadIdx.x == 0) {
        unsigned* bar = b.bar;
        __builtin_amdgcn_s_waitcnt(0);
        unsigned nloc = b.st[0], nx = b.st[1];
        if (nloc == 0u) { xcd_barrier_complete(bar, b.x, nloc, nx); b.st[0] = nloc; b.st[1] = nx; }
        const unsigned old = xb_add(&bar[XB_XSUB(b.x)], 1u);
        const unsigned gen = old / nloc;
        if (old + 1u == (gen + 1u) * nloc) {
            __builtin_amdgcn_fence(__ATOMIC_RELEASE, "agent");
            asm volatile("s_waitcnt vmcnt(0)" ::: "memory");
            const unsigned og = xb_add(&bar[XB_TOP], 1u);
            const unsigned tg = og / nx;
            if (og + 1u == (tg + 1u) * nx) xb_add(&bar[XB_TOPGEN], 1u);
            else XB_SPIN(xb_ld(&bar[XB_TOPGEN]) == tg, bar);
            __builtin_amdgcn_fence(__ATOMIC_ACQUIRE, "agent");
            xb_add(&bar[XB_XGEN(b.x)], 1u);
            asm volatile("s_waitcnt vmcnt(0)" ::: "memory");
        } else {
            XB_SPIN(xb_ld(&bar[XB_XGEN(b.x)]) == gen, bar);
            __builtin_amdgcn_fence(__ATOMIC_ACQUIRE, "agent");
            asm volatile("s_waitcnt vmcnt(0)" ::: "memory");
        }
    }
    __syncthreads();
}

struct Args { const float* in[16]; float* out; unsigned char* ws; int ph_lo, ph_hi, li, pad; };
struct Frame {
    LAS unsigned char* lds;
    int wave;
    int vcu, G;
    int gw, ngw;
    float* out; unsigned char* ws;
};
__device__ __forceinline__ float wave_sum(float v) {
#pragma unroll
    for (int o = 1; o < 64; o <<= 1) v += __shfl_xor(v, o);
    return v;
}
__device__ __forceinline__ unsigned f2bf(float f) { unsigned u = __builtin_bit_cast(unsigned, f); return (u + 0x7fffu + ((u >> 16) & 1u)) >> 16; }
__device__ __forceinline__ unsigned pk2(float lo, float hi) { return cvt_pk_bf16(lo, hi); }
__device__ __forceinline__ float bf2f(bf16 h) { return __builtin_bit_cast(float, (unsigned)h << 16); }

__device__ __forceinline__ int win_dst_row(int n) {
    if (n >= 2560 && n < 3072) { const int j = (n - 2560) >> 7, r = (n - 2560) & 127; return 2560 + 256 * j + r; }
    if (n >= 3072 && n < 3584) { const int j = (n - 3072) >> 7, r = (n - 3072) & 127; return 2560 + 256 * j + 128 + r; }
#ifdef DBG_SWAPG
    if (n >= 3584 && n < 4608) return n + 1024;
    if (n >= 4608) return n - 1024;
#endif
    return n;
}
__device__ __forceinline__ void p0_transpose_item(const float* W, int K, int N, const float* gain, bf16* WT, int ldwt, int koff, bool perm, LAS float* scr, int item, int lane, unsigned char* W8 = nullptr) {
    const int nblk = N / 32, kb = item / nblk, nb = item % nblk, k0 = 64 * kb, n0 = 32 * nb;
    { float wv[32];
#pragma unroll
      for (int i = 0; i < 32; ++i) wv[i] = W[(size_t)(k0 + 2 * i + (lane >> 5)) * N + n0 + (lane & 31)];
#pragma unroll
      for (int i = 0; i < 32; ++i) { const int kk = 2 * i + (lane >> 5); float v = wv[i]; if (gain) v *= gain[k0 + kk]; scr[kk * 33 + (lane & 31)] = v; } }
    LDS_WAIT(); asm volatile("" ::: "memory");
    const int c = lane & 7, d0 = perm ? win_dst_row(n0) : n0;
    if (W8 != nullptr && (n0 >= 3584 || n0 < 512)) {
#pragma unroll
        for (int j = 0; j < 4; ++j) { const int n = (lane >> 3) + 8 * j; const LAS float* s = scr + (8 * c) * 33 + n;
            int lo = __builtin_amdgcn_cvt_pk_fp8_f32(s[0 * 33] * 64.f, s[1 * 33] * 64.f, 0, false); lo = __builtin_amdgcn_cvt_pk_fp8_f32(s[2 * 33] * 64.f, s[3 * 33] * 64.f, lo, true);
            int hi = __builtin_amdgcn_cvt_pk_fp8_f32(s[4 * 33] * 64.f, s[5 * 33] * 64.f, 0, false); hi = __builtin_amdgcn_cvt_pk_fp8_f32(s[6 * 33] * 64.f, s[7 * 33] * 64.f, hi, true);
            v2u o; o.x = (unsigned)lo; o.y = (unsigned)hi; *(GAS v2u*)(W8 + (size_t)((n0 < 512 ? n0 : n0 - 3072) + n) * 1024 + k0 + 8 * c) = o; }
        LDS_WAIT(); asm volatile("" ::: "memory");
        return;
    }
#pragma unroll
    for (int j = 0; j < 4; ++j) { const int n = (lane >> 3) + 8 * j; const LAS float* s = scr + (8 * c) * 33 + n;
        v4u o; o.x = pk2(s[0 * 33], s[1 * 33]); o.y = pk2(s[2 * 33], s[3 * 33]); o.z = pk2(s[4 * 33], s[5 * 33]); o.w = pk2(s[6 * 33], s[7 * 33]);
        *(GAS v4u*)(WT + (size_t)(d0 + n) * ldwt + koff + k0 + 8 * c) = o; }
    LDS_WAIT(); asm volatile("" ::: "memory");
}
__device__ __forceinline__ void cvt512(const float* src, bf16* dst, size_t item, int lane) {
    const f32x4 a = *(const f32x4*)(src + item * 512 + lane * 8), b = *(const f32x4*)(src + item * 512 + lane * 8 + 4);
    v4u o; o.x = pk2(a[0], a[1]); o.y = pk2(a[2], a[3]); o.z = pk2(b[0], b[1]); o.w = pk2(b[2], b[3]);
    *(v4u*)(dst + item * 512 + lane * 8) = o;
}
__device__ __forceinline__ void p0_prologue(Frame& F, const Args& A) {
    const float *x = A.in[0], *g_mix = A.in[1], *w_in = A.in[2], *lb_log = A.in[3], *w_pa = A.in[6], *w_pb = A.in[7], *w_o = A.in[8], *g_ffn = A.in[9], *w_q = A.in[10],
                *k1 = A.in[11], *k2 = A.in[12];
    unsigned char* ws = F.ws; const int lane_ = pg8::fresh_lane();
    LAS float* scr = (LAS float*)(F.lds + F.wave * 16384);
    constexpr int I_IN = 16 * 176, I_P = 8 * 32, I_O = 16 * 32, I_Q = 16 * 64, NITEMS = I_IN + 2 * I_P + I_O + I_Q;
    for (int it = F.gw; it < NITEMS; it += F.ngw) {
        int r = it;
        if (r < I_IN) { p0_transpose_item(w_in, 1024, NIN, g_mix, (bf16*)(ws + WS_WIN), 1024, 0, true, scr, r, lane_, ws + WS_W8G); continue; } r -= I_IN;
        if (r < I_P) { p0_transpose_item(w_pa, 512, 1024, nullptr, (bf16*)(ws + WS_PAB), 1024, 0, false, scr, r, lane_); continue; } r -= I_P;
        if (r < I_P) { p0_transpose_item(w_pb, 512, 1024, nullptr, (bf16*)(ws + WS_PAB), 1024, 512, false, scr, r, lane_); continue; } r -= I_P;
        if (r < I_O) { p0_transpose_item(w_o, 1024, 1024, nullptr, (bf16*)(ws + WS_WO), 1024, 0, false, scr, r, lane_); continue; } r -= I_O;
        p0_transpose_item(w_q, 1024, 2048, g_ffn, (bf16*)(ws + WS_WQ), 1024, 0, false, scr, r, lane_);
    }
    for (int it = F.gw; it < 512; it += F.ngw) { if (it < 256) cvt512(k1, (bf16*)(ws + WS_KEYS), it, lane_); else cvt512(k2, (bf16*)(ws + WS_KEYS) + 131072, it - 256, lane_); }
    float* rstd1 = (float*)(ws + WS_RSTD1); bf16* xb = (bf16*)(ws + WS_XB);
    for (int m = F.gw; m < T; m += F.ngw) {
        const f32x4* xr = (const f32x4*)(x + (size_t)m * D) + lane_; f32x4 v[4]; float s = 0.f;
#pragma unroll
        for (int j = 0; j < 4; ++j) { v[j] = xr[64 * j]; s += (v[j][0] * v[j][0] + v[j][1] * v[j][1]) + (v[j][2] * v[j][2] + v[j][3] * v[j][3]); }
        s = wave_sum(s);
        if (lane_ == 0) rstd1[m] = __builtin_amdgcn_rsqf(s * (1.0f / D) + EPS);
        v2u* o8 = (v2u*)(xb + (size_t)m * D) + lane_; unsigned* q8 = (unsigned*)(ws + WS_X8 + (size_t)m * D) + lane_;
#pragma unroll
        for (int j = 0; j < 4; ++j) { v2u o; o.x = pk2(v[j][0], v[j][1]); o.y = pk2(v[j][2], v[j][3]); o8[64 * j] = o;
            int w = __builtin_amdgcn_cvt_pk_fp8_f32(v[j][0], v[j][1], 0, false); w = __builtin_amdgcn_cvt_pk_fp8_f32(v[j][2], v[j][3], w, true); q8[64 * j] = (unsigned)w; }
    }
    if (F.gw == 0) { float* lb = (float*)(ws + WS_LB);
        for (int j = lane_; j < 512; j += 64) { const float a = lb_log[j], b = lb_log[512 + j]; lb[j] = 1.0f / (1.0f + expf(b - a)); } }
}

#define P2_SCATTER(REG, SRC) { _Pragma("unroll") for (int p = 0; p < 8; ++p) { LAS unsigned char* dst_ = (REG) + (8 * cc) * 144 + cc * 16 + 2 * (rr + 8 * p); const unsigned w_[4] = {SRC[p].x, SRC[p].y, SRC[p].z, SRC[p].w}; \
        _Pragma("unroll") for (int i = 0; i < 4; ++i) { *(LAS bf16*)(dst_ + (2 * i) * 144) = (bf16)(w_[i] & 0xffffu); *(LAS bf16*)(dst_ + (2 * i + 1) * 144) = (bf16)(w_[i] >> 16); } } }
#define P2_ROWLOAD(REG, W) { _Pragma("unroll") for (int j = 0; j < 8; ++j) { const v4u o_ = *(LAS v4u*)((REG) + lane * 144 + rr * 16 + j * 16); W[4 * j] = o_.x; W[4 * j + 1] = o_.y; W[4 * j + 2] = o_.z; W[4 * j + 3] = o_.w; } }
#define P2_ROWSTORE(REG, W) { _Pragma("unroll") for (int j = 0; j < 8; ++j) { v4u o_; o_.x = W[4 * j]; o_.y = W[4 * j + 1]; o_.z = W[4 * j + 2]; o_.w = W[4 * j + 3]; *(LAS v4u*)((REG) + lane * 144 + rr * 16 + j * 16) = o_; } }
#define P2_GATHER_STORE(REG, GP) { int ro_ = rr; asm volatile("" : "+v"(ro_));     \
    _Pragma("unroll") for (int p = 0; p < 8; ++p) { const LAS unsigned char* src_ = (REG) + (8 * cc) * 144 + cc * 16 + 2 * (ro_ + 8 * p); unsigned e_[8]; \
        _Pragma("unroll") for (int i = 0; i < 8; ++i) e_[i] = (unsigned)*(const LAS bf16*)(src_ + i * 144); \
        v4u o_; o_.x = e_[0] | (e_[1] << 16); o_.y = e_[2] | (e_[3] << 16); o_.z = e_[4] | (e_[5] << 16); o_.w = e_[6] | (e_[7] << 16); *(v4u*)((GP) + (size_t)(ro_ + 8 * p) * 512) = o_; if (p & 1) asm volatile("" ::: "memory"); } }
__device__ __forceinline__ void p2_unit(Frame& F, int unit) {
    unsigned char* ws = F.ws; const int lane = pg8::fresh_lane(), rr = lane >> 3, cc = lane & 7;
    const int bh = unit >> 6, c = unit & 63, bb = bh >> 3, h = bh & 7; const size_t t0 = (size_t)bb * SEQ + c * 64; const int cb0 = h * 64;
    bf16* Qg = (bf16*)(ws + WS_Q) + t0 * 512 + cb0 + 8 * cc; bf16* Kg = (bf16*)(ws + WS_KK) + t0 * 512 + cb0 + 8 * cc; const bf16* Vg = (const bf16*)(ws + WS_V) + t0 * 512 + cb0 + 8 * cc;
    LAS unsigned char* wl = F.lds + F.wave * WAVE_LDS; LAS unsigned char* KH = wl; LAS unsigned char* VT = wl + 9344;
    v4u kw[8], qw[8];
#pragma unroll
    for (int p = 0; p < 8; ++p) { kw[p] = *(const v4u*)(Kg + (size_t)(rr + 8 * p) * 512); qw[p] = *(const v4u*)(Qg + (size_t)(rr + 8 * p) * 512); }
    P2_SCATTER(KH, kw) P2_SCATTER(VT, qw)
    LDS_WAIT(); asm volatile("" ::: "memory");
    unsigned kr[32]; P2_ROWLOAD(KH, kr)
    LDS_WAIT(); asm volatile("" ::: "memory");
    float b[64];
    { float run = 0.f;
#pragma unroll
      for (int t = 0; t < 64; ++t) { const float kt = (t & 1) ? bfhi(kr[t >> 1]) : bflo(kr[t >> 1]); run += __builtin_amdgcn_logf(1.0f - kt) * 0.69314718056f; b[t] = run; } }
    const float blast = b[63];
    ((float*)(ws + WS_DEC))[unit * 64 + lane] = fexp(blast);
    { unsigned w[32];
#pragma unroll
      for (int t = 0; t < 64; t += 2) w[t >> 1] = pk2(bflo(kr[t >> 1]) * fexp(-b[t]), bfhi(kr[t >> 1]) * fexp(-b[t + 1]));
      P2_ROWSTORE(KH, w) }
    LDS_WAIT(); asm volatile("" ::: "memory");
    P2_GATHER_STORE(KH, Kg)
    LDS_WAIT(); asm volatile("" ::: "memory");
    { unsigned w[32];
#pragma unroll
      for (int t = 0; t < 64; t += 2) w[t >> 1] = pk2(bflo(kr[t >> 1]) * fexp(blast - b[t]), bfhi(kr[t >> 1]) * fexp(blast - b[t + 1]));
      P2_ROWSTORE(KH, w) }
    { unsigned w[32]; P2_ROWLOAD(VT, w)
      LDS_WAIT(); asm volatile("" ::: "memory");
#pragma unroll
      for (int t = 0; t < 64; t += 2) w[t >> 1] = pk2(bflo(w[t >> 1]) * fexp(b[t]), bfhi(w[t >> 1]) * fexp(b[t + 1]));
      P2_ROWSTORE(VT, w) }
    LDS_WAIT(); asm volatile("" ::: "memory");
    P2_GATHER_STORE(VT, Qg)
    LDS_WAIT(); asm volatile("" ::: "memory");
    { v4u vw[8]; int ro = rr; asm volatile("" : "+v"(ro));
#pragma unroll
      for (int p = 0; p < 8; ++p) vw[p] = *(const v4u*)(Vg + (size_t)(ro + 8 * p) * 512);
      P2_SCATTER(VT, vw) }
    LDS_WAIT(); asm volatile("" ::: "memory");
    const int r = lane & 31, hh = lane >> 5;
    f32x16 acc[2][2];
#pragma unroll
    for (int i = 0; i < 2; ++i)
#pragma unroll
        for (int j = 0; j < 2; ++j)
#pragma unroll
            for (int k = 0; k < 16; ++k) acc[i][j][k] = 0.f;
#pragma unroll
    for (int ks = 0; ks < 4; ++ks) {
        bf16x8 a[2], bq[2];
#pragma unroll
        for (int i = 0; i < 2; ++i) { const int ra = (32 * i + r) * 144 + (4 * i + (r >> 3)) * 16 + (16 * ks + 8 * hh) * 2; a[i] = *(const LAS bf16x8*)(VT + ra); bq[i] = *(const LAS bf16x8*)(KH + ra); }
#pragma unroll
        for (int i = 0; i < 2; ++i)
#pragma unroll
            for (int j = 0; j < 2; ++j) acc[i][j] = MFMA32(a[i], bq[j], acc[i][j]);
    }
    LDS_WAIT(); asm volatile("" ::: "memory");
    { LAS float* OL = (LAS float*)wl;
#pragma unroll
      for (int i = 0; i < 2; ++i)
#pragma unroll
          for (int j = 0; j < 2; ++j)
#pragma unroll
              for (int k = 0; k < 16; ++k) OL[(32 * i + crow(k, hh)) * 68 + 32 * j + r] = acc[i][j][k];
      LDS_WAIT(); asm volatile("" ::: "memory");
      bf16* LOC = (bf16*)(ws + WS_LOC) + (size_t)unit * 4096 + 8 * cc; int ro = rr; asm volatile("" : "+v"(ro));
#pragma unroll
      for (int p = 0; p < 8; ++p) { const int e = ro + 8 * p; const f32x4 v0 = *(LAS f32x4*)(OL + e * 68 + 8 * cc), v1 = *(LAS f32x4*)(OL + e * 68 + 8 * cc + 4);
          v4u o; o.x = pk2(v0[0], v0[1]); o.y = pk2(v0[2], v0[3]); o.z = pk2(v1[0], v1[1]); o.w = pk2(v1[2], v1[3]); *(v4u*)(LOC + e * 64) = o; } }
    LDS_WAIT(); asm volatile("" ::: "memory");
}
__device__ __forceinline__ void p2_phase(Frame& F, const float* cw) {
    for (int u = F.gw; u < NUNIT; u += F.ngw) p2_unit(F, u);
    unsigned char* ws = F.ws;
    const bf16* CB = (const bf16*)(ws + WS_CB); const bf16* U = (const bf16*)(ws + WS_U); bf16* YAB = (bf16*)F.out;
    const int gt = F.vcu * (NWAVES * 64) + F.wave * 64 + pg8::fresh_lane(), ngt = F.G * NWAVES * 64;
    for (int i = gt; i < (T / 16) * 64; i += ngt) {
        const int t0 = (i >> 6) * 16, j0 = (i & 63) * 8;
        float w0[8], w1[8], w2[8];
        { const f32x4 a0 = *(const f32x4*)(cw + j0), a1 = *(const f32x4*)(cw + j0 + 4), b0 = *(const f32x4*)(cw + 512 + j0), b1 = *(const f32x4*)(cw + 512 + j0 + 4), c0 = *(const f32x4*)(cw + 1024 + j0), c1 = *(const f32x4*)(cw + 1024 + j0 + 4);
#pragma unroll
          for (int k = 0; k < 4; ++k) { w0[k] = a0[k]; w0[4 + k] = a1[k]; w1[k] = b0[k]; w1[4 + k] = b1[k]; w2[k] = c0[k]; w2[4 + k] = c1[k]; } }
        float um2[8], um1[8];
        if ((t0 & (SEQ - 1)) != 0) { pg8::ld8(U + (size_t)(t0 - 2) * 512 + j0, um2); pg8::ld8(U + (size_t)(t0 - 1) * 512 + j0, um1); }
        else {
#pragma unroll
            for (int k = 0; k < 8; ++k) { um2[k] = 0.f; um1[k] = 0.f; } }
#pragma unroll 1
        for (int tt = 0; tt < 16; tt += 4) {
            pg8::u32x4 uw[4], cbw[4];
#pragma unroll
            for (int q = 0; q < 4; ++q) { uw[q] = *(const pg8::u32x4*)(U + (size_t)(t0 + tt + q) * 512 + j0); cbw[q] = *(const pg8::u32x4*)(CB + (size_t)(t0 + tt + q) * 512 + j0); }
#pragma unroll
            for (int q = 0; q < 4; ++q) {
                const float u0[8] = {bflo(uw[q].x), bfhi(uw[q].x), bflo(uw[q].y), bfhi(uw[q].y), bflo(uw[q].z), bfhi(uw[q].z), bflo(uw[q].w), bfhi(uw[q].w)};
                const float cbv[8] = {bflo(cbw[q].x), bfhi(cbw[q].x), bflo(cbw[q].y), bfhi(cbw[q].y), bflo(cbw[q].z), bfhi(cbw[q].z), bflo(cbw[q].w), bfhi(cbw[q].w)};
                float y[8];
#pragma unroll
                for (int k = 0; k < 8; ++k) { y[k] = DBG_ZYB * cbv[k] * (w0[k] * um2[k] + w1[k] * um1[k] + w2[k] * u0[k]); um2[k] = um1[k]; um1[k] = u0[k]; }
                pg8::st8(YAB + (size_t)(t0 + tt + q) * 1024 + 512 + j0, y); }
        }
    }
}

__device__ __forceinline__ void p3_phase(Frame& F) {
    unsigned char* ws = F.ws; const bf16* LOC = (const bf16*)(ws + WS_LOC); bf16* SP = (bf16*)(ws + WS_SPREV); const float* DEC = (const float*)(ws + WS_DEC);
    const int gt = F.vcu * (NWAVES * 64) + F.wave * 64 + pg8::fresh_lane(), ngt = F.G * NWAVES * 64;
    for (int i = gt; i < 64 * 4096; i += ngt) {
        const int bh = i >> 12, ed = i & 4095, d = ed & 63; float st = 0.f;
        for (int c0 = 0; c0 < 64; c0 += 8) { float lv[8], dv[8];
#pragma unroll
            for (int k = 0; k < 8; ++k) { lv[k] = bf2f(LOC[(size_t)(bh * 64 + c0 + k) * 4096 + ed]); dv[k] = DEC[(bh * 64 + c0 + k) * 64 + d]; }
#pragma unroll
            for (int k = 0; k < 8; ++k) { SP[(size_t)(bh * 64 + c0 + k) * 4096 + ed] = (bf16)f2bf(st); st = dv[k] * st + lv[k]; } }
    }
}

template <int M> __device__ __forceinline__ float p4_swz(float v) { return __builtin_bit_cast(float, __builtin_amdgcn_ds_swizzle(__builtin_bit_cast(int, v), 0x1f | (M << 10))); }
__device__ __forceinline__ void p4_unit(Frame& F, int unit, const float* gain) {
    unsigned char* ws = F.ws; const int lane = pg8::fresh_lane(), r = lane & 31, hh = lane >> 5;
    const int bh = unit >> 6, c = unit & 63, bb = bh >> 3, h = bh & 7; const size_t t0 = (size_t)bb * SEQ + c * 64; const int cb0 = h * 64;
    const bf16* Qt = (const bf16*)(ws + WS_Q) + t0 * 512 + cb0; const bf16* Kt = (const bf16*)(ws + WS_KK) + t0 * 512 + cb0;
    const bf16* Vp = (const bf16*)(ws + WS_V) + t0 * 512 + cb0 + lane; const bf16* SPu = (const bf16*)(ws + WS_SPREV) + (size_t)unit * 4096;
    LAS unsigned char* wl = F.lds + F.wave * WAVE_LDS; LAS unsigned char* PL = wl; LAS unsigned char* VT = wl + 9216;
    bf16x8 qa[2][4], kb[2][4], spf[2][4];
    { const bf16* Vt = (const bf16*)(ws + WS_V) + t0 * 512 + cb0 + 8 * (lane & 7);
      v4u pv[8];
#pragma unroll
      for (int p = 0; p < 8; ++p) pv[p] = *(const v4u*)(Vt + (size_t)((lane >> 3) + 8 * p) * 512);
#pragma unroll
      for (int i = 0; i < 2; ++i)
#pragma unroll
          for (int ks = 0; ks < 4; ++ks) { qa[i][ks] = *(const bf16x8*)(Qt + (size_t)(32 * i + r) * 512 + 16 * ks + 8 * hh); kb[i][ks] = *(const bf16x8*)(Kt + (size_t)(32 * i + r) * 512 + 16 * ks + 8 * hh); }
#pragma unroll
      for (int jj = 0; jj < 2; ++jj)
#pragma unroll
          for (int ks = 0; ks < 4; ++ks) spf[jj][ks] = *(const bf16x8*)(SPu + (32 * jj + r) * 64 + 16 * ks + 8 * hh);
#pragma unroll
      for (int p = 0; p < 8; ++p) { const int t = (lane >> 3) + 8 * p; LAS unsigned char* dst = VT + (8 * (lane & 7)) * 144 + 2 * t; const unsigned w[4] = {pv[p].x, pv[p].y, pv[p].z, pv[p].w};
#pragma unroll
          for (int i = 0; i < 4; ++i) { *(LAS bf16*)(dst + (2 * i) * 144) = (bf16)(w[i] & 0xffffu); *(LAS bf16*)(dst + (2 * i + 1) * 144) = (bf16)(w[i] >> 16); } } }
    asm volatile("" ::: "memory");
    {
        f32x16 sc[3];
#pragma unroll
        for (int k = 0; k < 16; ++k) { sc[0][k] = 0.f; sc[1][k] = 0.f; sc[2][k] = 0.f; }
#pragma unroll
        for (int ks = 0; ks < 4; ++ks) { sc[0] = MFMA32(qa[0][ks], kb[0][ks], sc[0]); sc[1] = MFMA32(qa[1][ks], kb[0][ks], sc[1]); sc[2] = MFMA32(qa[1][ks], kb[1][ks], sc[2]); }
#pragma unroll
        for (int k = 0; k < 16; ++k) { const int tr = crow(k, hh);
            *(LAS bf16*)(PL + tr * 144 + r * 2) = (bf16)f2bf(r <= tr ? sc[0][k] : 0.f);
            *(LAS bf16*)(PL + (32 + tr) * 144 + r * 2) = (bf16)f2bf(sc[1][k]);
            *(LAS bf16*)(PL + (32 + tr) * 144 + (32 + r) * 2) = (bf16)f2bf(r <= tr ? sc[2][k] : 0.f); }
    }
    asm volatile("" ::: "memory");
    f32x16 o[2][2];
#pragma unroll
    for (int i = 0; i < 2; ++i)
#pragma unroll
        for (int j = 0; j < 2; ++j)
#pragma unroll
            for (int k = 0; k < 16; ++k) o[i][j][k] = 0.f;
#pragma unroll
    for (int ks = 0; ks < 4; ++ks) {
#pragma unroll
        for (int i = 0; i < 2; ++i)
#pragma unroll
            for (int j = 0; j < 2; ++j) o[i][j] = MFMA32(qa[i][ks], spf[j][ks], o[i][j]);
    }
    LDS_WAIT(); asm volatile("" ::: "memory");
#pragma unroll
    for (int ks = 0; ks < 4; ++ks) {
        bf16x8 pa[2], vb[2];
        if (ks < 2) pa[0] = *(const LAS bf16x8*)(PL + r * 144 + (16 * ks + 8 * hh) * 2);
        pa[1] = *(const LAS bf16x8*)(PL + (32 + r) * 144 + (16 * ks + 8 * hh) * 2);
#pragma unroll
        for (int j = 0; j < 2; ++j) vb[j] = *(const LAS bf16x8*)(VT + (32 * j + r) * 144 + (16 * ks + 8 * hh) * 2);
#pragma unroll
        for (int j = 0; j < 2; ++j) { if (ks < 2) o[0][j] = MFMA32(pa[0], vb[j], o[0][j]); o[1][j] = MFMA32(pa[1], vb[j], o[1][j]); }
    }
    asm volatile("" ::: "memory");
    LDS_WAIT(); asm volatile("" ::: "memory");
    { LAS float* OL = (LAS float*)wl;
#pragma unroll
      for (int i = 0; i < 2; ++i)
#pragma unroll
          for (int j = 0; j < 2; ++j)
#pragma unroll
              for (int k = 0; k < 16; ++k) OL[(32 * i + crow(k, hh)) * 68 + 32 * j + r] = o[i][j][k];
      LDS_WAIT(); asm volatile("" ::: "memory");
      const int c = lane & 7; const f32x4 ga = *(const f32x4*)(gain + cb0 + 8 * c), gb = *(const f32x4*)(gain + cb0 + 8 * c + 4);
      const float g8[8] = {ga[0], ga[1], ga[2], ga[3], gb[0], gb[1], gb[2], gb[3]};
      const bf16* SGp = (const bf16*)(ws + WS_SG) + t0 * 512 + cb0 + 8 * c; bf16* YA = (bf16*)F.out + t0 * 1024 + cb0 + 8 * c;
#pragma unroll
      for (int p = 0; p < 8; ++p) { int t = (lane >> 3) + 8 * p; asm volatile("" : "+v"(t));
          const f32x4 v0 = *(LAS f32x4*)(OL + t * 68 + 8 * c), v1 = *(LAS f32x4*)(OL + t * 68 + 8 * c + 4);
          float ss = (v0[0] * v0[0] + v0[1] * v0[1]) + (v0[2] * v0[2] + v0[3] * v0[3]) + (v1[0] * v1[0] + v1[1] * v1[1]) + (v1[2] * v1[2] + v1[3] * v1[3]);
          ss += p4_swz<1>(ss); ss += p4_swz<2>(ss); ss += p4_swz<4>(ss);
          const float rs = __builtin_amdgcn_rsqf(ss * (1.0f / 64.0f) + EPS) * DBG_ZYA;
          float sg[8], y[8]; pg8::ld8(SGp + (size_t)t * 512, sg);
#pragma unroll
          for (int e = 0; e < 4; ++e) { y[e] = v0[e] * rs * g8[e] * sg[e]; y[4 + e] = v1[e] * rs * g8[4 + e] * sg[4 + e]; }
          pg8::st8(YA + (size_t)t * 1024, y); }
    }
    LDS_WAIT(); asm volatile("" ::: "memory");
}

__device__ __forceinline__ unsigned mono(float f) { const unsigned u = __builtin_bit_cast(unsigned, f); return u ^ (((unsigned)((int)u >> 31)) | 0x80000000u); }
__device__ __forceinline__ float unmono(unsigned m) { const unsigned u = (m & 0x80000000u) ? (m ^ 0x80000000u) : ~m; return __builtin_bit_cast(float, u); }
__device__ __forceinline__ unsigned med3u(unsigned a, unsigned b, unsigned c) { unsigned r; asm("v_med3_u32 %0, %1, %2, %3" : "=v"(r) : "v"(a), "v"(b), "v"(c)); return r; }
__device__ __forceinline__ unsigned maxu(unsigned a, unsigned b) { return a > b ? a : b; }
__device__ __forceinline__ void ins16(unsigned (&L)[16], unsigned v) {
#pragma unroll
    for (int j = 15; j >= 1; --j) L[j] = med3u(v, L[j - 1], L[j]);
    L[0] = maxu(L[0], v);
}
__device__ __forceinline__ unsigned minu(unsigned a, unsigned b) { return a < b ? a : b; }
#define P8_CE(X, A, B) { const unsigned hi_ = maxu(X[A], X[B]), lo_ = minu(X[A], X[B]); X[A] = hi_; X[B] = lo_; }
__device__ __forceinline__ void sort16_desc(unsigned (&x)[16]) { P8_CE(x, 0, 13) P8_CE(x, 1, 12) P8_CE(x, 2, 15) P8_CE(x, 3, 14) P8_CE(x, 4, 8) P8_CE(x, 5, 6) P8_CE(x, 7, 11) P8_CE(x, 9, 10) P8_CE(x, 0, 5) P8_CE(x, 1, 7) P8_CE(x, 2, 9) P8_CE(x, 3, 4) P8_CE(x, 6, 13) P8_CE(x, 8, 14) P8_CE(x, 10, 15) P8_CE(x, 11, 12) P8_CE(x, 0, 1) P8_CE(x, 2, 3) P8_CE(x, 4, 5) P8_CE(x, 6, 8) P8_CE(x, 7, 9) P8_CE(x, 10, 11) P8_CE(x, 12, 13) P8_CE(x, 14, 15) P8_CE(x, 0, 2) P8_CE(x, 1, 3) P8_CE(x, 4, 10) P8_CE(x, 5, 11) P8_CE(x, 6, 7) P8_CE(x, 8, 9) P8_CE(x, 12, 14) P8_CE(x, 13, 15) P8_CE(x, 1, 2) P8_CE(x, 3, 12) P8_CE(x, 4, 6) P8_CE(x, 5, 7) P8_CE(x, 8, 10) P8_CE(x, 9, 11) P8_CE(x, 13, 14) P8_CE(x, 1, 4) P8_CE(x, 2, 6) P8_CE(x, 5, 8) P8_CE(x, 7, 10) P8_CE(x, 9, 13) P8_CE(x, 11, 14) P8_CE(x, 2, 4) P8_CE(x, 3, 6) P8_CE(x, 9, 12) P8_CE(x, 11, 13) P8_CE(x, 3, 5) P8_CE(x, 6, 8) P8_CE(x, 7, 9) P8_CE(x, 10, 12) P8_CE(x, 3, 4) P8_CE(x, 5, 6) P8_CE(x, 7, 8) P8_CE(x, 9, 10) P8_CE(x, 11, 12) P8_CE(x, 6, 7) P8_CE(x, 8, 9) }
__device__ __forceinline__ void merge16_desc(unsigned (&L)[16], const unsigned (&S)[16]) {
    unsigned c[16];
#pragma unroll
    for (int i = 0; i < 16; ++i) c[i] = maxu(L[i], S[15 - i]);
    P8_CE(c, 0, 8) P8_CE(c, 1, 9) P8_CE(c, 2, 10) P8_CE(c, 3, 11) P8_CE(c, 4, 12) P8_CE(c, 5, 13) P8_CE(c, 6, 14) P8_CE(c, 7, 15) P8_CE(c, 0, 4) P8_CE(c, 1, 5) P8_CE(c, 2, 6) P8_CE(c, 3, 7) P8_CE(c, 8, 12) P8_CE(c, 9, 13) P8_CE(c, 10, 14) P8_CE(c, 11, 15) P8_CE(c, 0, 2) P8_CE(c, 1, 3) P8_CE(c, 4, 6) P8_CE(c, 5, 7) P8_CE(c, 8, 10) P8_CE(c, 9, 11) P8_CE(c, 12, 14) P8_CE(c, 13, 15) P8_CE(c, 0, 1) P8_CE(c, 2, 3) P8_CE(c, 4, 5) P8_CE(c, 6, 7) P8_CE(c, 8, 9) P8_CE(c, 10, 11) P8_CE(c, 12, 13) P8_CE(c, 14, 15)
#pragma unroll
    for (int i = 0; i < 16; ++i) L[i] = c[i];
}
__device__ __forceinline__ void p8_half(const bf16* keys, const bf16* qbase, LAS unsigned char* wl, int lane, unsigned (&L)[16]) {
    const int r = lane & 31, hh = lane >> 5, rr4 = lane >> 4, c = lane & 15;
    LAS unsigned char* qbuf = wl; LAS unsigned char* kbuf = wl + 8192;
    v4u st[8];
#pragma unroll
    for (int i = 0; i < 8; ++i) st[i] = *(const v4u*)(qbase + (size_t)(4 * i + rr4) * 2048 + 8 * c);
#pragma unroll
    for (int i = 0; i < 8; ++i) { const int rr = 4 * i + rr4; *(LAS v4u*)(qbuf + rr * 256 + ((c ^ (rr & 15)) << 4)) = st[i]; }
#pragma unroll
    for (int i = 0; i < 8; ++i) st[i] = *(const v4u*)(keys + (size_t)(4 * i + rr4) * 128 + 8 * c);
    LDS_WAIT(); asm volatile("" ::: "memory");
    bf16x8 qb[8];
#pragma unroll
    for (int ks = 0; ks < 8; ++ks) qb[ks] = *(const LAS bf16x8*)(qbuf + r * 256 + (((2 * ks + hh) ^ (r & 15)) << 4));
#pragma unroll
    for (int j = 0; j < 16; ++j) L[j] = 0u;
    const unsigned h4 = (unsigned)hh << 2;
#pragma unroll
    for (int it = 0; it < 4; ++it) {
#pragma unroll
        for (int i = 0; i < 8; ++i) { const int rr = 4 * i + rr4; *(LAS v4u*)(kbuf + rr * 256 + ((c ^ (rr & 15)) << 4)) = st[i]; }
        if (it < 3) {
#pragma unroll
            for (int i = 0; i < 8; ++i) st[i] = *(const v4u*)(keys + (size_t)(32 * (it + 1) + 4 * i + rr4) * 128 + 8 * c);
        }
        LDS_WAIT(); asm volatile("" ::: "memory");
        f32x16 acc;
#pragma unroll
        for (int k = 0; k < 16; ++k) acc[k] = 0.f;
#pragma unroll
        for (int ks = 0; ks < 8; ++ks) { const bf16x8 ka = *(const LAS bf16x8*)(kbuf + r * 256 + (((2 * ks + hh) ^ (r & 15)) << 4)); acc = MFMA32(ka, qb[ks], acc); }
        LDS_WAIT(); asm volatile("" ::: "memory");
        unsigned kx[16];
#pragma unroll
        for (int k = 0; k < 16; ++k) { const unsigned n0 = (unsigned)(32 * it + (k & 3) + 8 * (k >> 2));
            kx[k] = (mono(acc[k]) & 0xFFFFFF80u) | ((127u - n0) ^ h4); }
        sort16_desc(kx);
        if (it == 0) {
#pragma unroll
            for (int j = 0; j < 16; ++j) L[j] = kx[j];
        } else merge16_desc(L, kx);
    }
    unsigned P[16];
#pragma unroll
    for (int j = 0; j < 16; ++j) P[j] = (unsigned)__shfl_xor((int)L[j], 32);
    merge16_desc(L, P);
}
__device__ __forceinline__ void p8_task(Frame& F, int tile, int head) {
    unsigned char* ws = F.ws; const int lane = pg8::fresh_lane(), r = lane & 31, hh = lane >> 5; int t = tile * 32 + r; asm volatile("" : "+v"(t));
    const bf16* kb = (const bf16*)(ws + WS_KEYS); int tbase = tile * 32; asm volatile("" : "+s"(tbase)); const bf16* qtile = (const bf16*)(ws + WS_QQ) + (size_t)tbase * 2048 + head * 256;
    LAS unsigned char* wl = F.lds + F.wave * WAVE_LDS;
    unsigned L1[16], L2[16];
    p8_half(kb + (size_t)head * 16384, qtile, wl, lane, L1);
    p8_half(kb + 131072 + (size_t)head * 16384, qtile + 128, wl, lane, L2);
    LDS_WAIT(); asm volatile("" ::: "memory");
    float v1[16], v2[16]; unsigned n1[16], n2[16];
#pragma unroll
    for (int j = 0; j < 16; ++j) { v1[j] = unmono(L1[j] & 0xFFFFFF80u); n1[j] = 127u - (L1[j] & 127u); v2[j] = unmono(L2[j] & 0xFFFFFF80u); n2[j] = 127u - (L2[j] & 127u); }
    LAS unsigned* tab = (LAS unsigned*)(F.lds + F.wave * WAVE_LDS) + lane * 9;
#pragma unroll
    for (int j = 0; j < 4; ++j) { tab[j] = n1[4 * j] | (n1[4 * j + 1] << 8) | (n1[4 * j + 2] << 16) | (n1[4 * j + 3] << 24); tab[4 + j] = n2[4 * j] | (n2[4 * j + 1] << 8) | (n2[4 * j + 2] << 16) | (n2[4 * j + 3] << 24); }
    unsigned Fk[16];
#define P8_CK(A, B) ((mono(v1[A] + v2[B]) & 0xFFFFFF00u) | (unsigned)(255 - ((A) * 16 + (B))))
#pragma unroll
    for (int b = 0; b < 16; ++b) Fk[b] = P8_CK(0, b);
    { unsigned s1[16] = {P8_CK(1, 0), P8_CK(1, 1), P8_CK(1, 2), P8_CK(1, 3), P8_CK(1, 4), P8_CK(1, 5), P8_CK(1, 6), P8_CK(1, 7), P8_CK(2, 0), P8_CK(2, 1), P8_CK(2, 2), P8_CK(2, 3), P8_CK(2, 4), P8_CK(4, 0), P8_CK(4, 1), P8_CK(4, 2)};
      sort16_desc(s1); merge16_desc(Fk, s1); }
    { unsigned s2[16] = {P8_CK(3, 0), P8_CK(3, 1), P8_CK(3, 2), P8_CK(3, 3), P8_CK(5, 0), P8_CK(5, 1), P8_CK(6, 0), P8_CK(6, 1), P8_CK(7, 0), P8_CK(7, 1), P8_CK(8, 0), P8_CK(9, 0), P8_CK(10, 0), P8_CK(11, 0), P8_CK(12, 0), P8_CK(13, 0)};
      sort16_desc(s2); merge16_desc(Fk, s2); }
    ins16(Fk, P8_CK(14, 0)); ins16(Fk, P8_CK(15, 0));
#undef P8_CK
    LDS_WAIT(); asm volatile("" ::: "memory");
    float sv[16]; int ex[16];
    const LAS unsigned char* tb = (const LAS unsigned char*)tab;
#pragma unroll
    for (int j = 0; j < 16; ++j) { const unsigned pos = 255u - (Fk[j] & 255u); sv[j] = unmono(Fk[j] & 0xFFFFFF00u); ex[j] = (int)tb[pos >> 4] * 128 + (int)tb[16 + (pos & 15)]; }
    float den = 0.f, p[16];
#pragma unroll
    for (int j = 0; j < 16; ++j) { p[j] = fexp(sv[j] - sv[0]); den += p[j]; }
    const float inv = 1.0f / den;
    int* IDX = (int*)(ws + WS_IDX) + (size_t)t * 128 + head * 16; float* GT = (float*)(ws + WS_GATE) + (size_t)t * 128 + head * 16;
    if (hh == 0) {
#pragma unroll
        for (int j = 0; j < 4; ++j) { *(int4*)(IDX + 4 * j) = make_int4(ex[4 * j], ex[4 * j + 1], ex[4 * j + 2], ex[4 * j + 3]); }
    } else {
#pragma unroll
        for (int j = 0; j < 4; ++j) { f32x4 g = {p[4 * j] * inv, p[4 * j + 1] * inv, p[4 * j + 2] * inv, p[4 * j + 3] * inv}; *(f32x4*)(GT + 4 * j) = g; }
    }
    LDS_WAIT(); asm volatile("" ::: "memory");
}

#ifdef DBG_CHK
constexpr int CW_CHK = 8192;
__device__ __forceinline__ unsigned chk_hash(unsigned x) { x ^= x >> 16; x *= 0x7feb352dU; x ^= x >> 15; x *= 0x846ca68bU; x ^= x >> 16; return x; }
__device__ __forceinline__ float chk_dot(const bf16* a, const bf16* b, int K) { float s = 0.f; for (int k = 0; k < K; ++k) s += bf2f(a[k]) * bf2f(b[k]); return s; }
__device__ __forceinline__ void chk_rec(unsigned* cnt, float got, float ref) { if (!(fabsf(got - ref) <= 0.03f * fabsf(ref) + 0.03f)) atomicAdd(cnt, 1u); }
__device__ __forceinline__ void chk_phase(Frame& F, const Args& A, int which) {
    unsigned char* ws = F.ws; unsigned* ctl = (unsigned*)(ws + WS_CTL);
    const int g = F.vcu * (NWAVES * 64) + F.wave * 64 + pg8::fresh_lane();
    if (which == 21) {
        const bf16* xb_ = (const bf16*)(ws + WS_XB); const bf16* W_ = (const bf16*)(ws + WS_WIN); const float* r1 = (const float*)(ws + WS_RSTD1); bf16* GBo = (bf16*)(ws + WS_GA);
        for (long i = g; i < (long)T * 1024; i += (long)F.G * NWAVES * 64) { const long rw = i >> 10; const int j = (int)(i & 1023);
            const float v = r1[rw] * chk_dot(xb_ + rw * 1024, W_ + (size_t)(4608 + j) * 1024, 1024); GBo[i] = (bf16)f2bf(1.0f / (1.0f + expf(-v))); }
        return;
    }
    if (g >= 8192) return;
    const unsigned h1 = chk_hash(g * 2 + 1), h2 = chk_hash(g * 2 + 2); const int row = h1 % T;
    const bf16* xb = (const bf16*)(ws + WS_XB); const bf16* WinT = (const bf16*)(ws + WS_WIN); const float* rstd1 = (const float*)(ws + WS_RSTD1);
    if (which == 0) {
        { const int n = h2 % NIN, k = h1 % 1024; chk_rec(ctl + CW_CHK + (n >= 4608 ? 256 : 0), 32.f * bf2f(WinT[(size_t)(win_dst_row(n & ~31) + (n & 31)) * 1024 + k]), 32.f * A.in[1][k] * A.in[2][(size_t)k * NIN + n]); }
        { const int n = h2 % 1024, k = h1 % 512; chk_rec(ctl + CW_CHK, 32.f * bf2f(((const bf16*)(ws + WS_PAB))[(size_t)n * 1024 + k]), 32.f * A.in[6][(size_t)k * 1024 + n]);
          chk_rec(ctl + CW_CHK, 32.f * bf2f(((const bf16*)(ws + WS_PAB))[(size_t)n * 1024 + 512 + k]), 32.f * A.in[7][(size_t)k * 1024 + n]); }
        { const int n = h2 % 1024, k = h1 % 1024; chk_rec(ctl + CW_CHK, 32.f * bf2f(((const bf16*)(ws + WS_WO))[(size_t)n * 1024 + k]), 32.f * A.in[8][(size_t)k * 1024 + n]); }
        { const int n = h2 % 2048, k = h1 % 1024; chk_rec(ctl + CW_CHK, 32.f * bf2f(((const bf16*)(ws + WS_WQ))[(size_t)n * 1024 + k]), 32.f * A.in[9][k] * A.in[10][(size_t)k * 2048 + n]); }
        { const int k = h2 % 1024; chk_rec(ctl + CW_CHK, bf2f(xb[(size_t)row * 1024 + k]), A.in[0][(size_t)row * 1024 + k]); }
    }
    if (which == 1) {
        const float rs = rstd1[row];
        { const int j = h2 % 512; chk_rec(ctl + CW_CHK + 0, bf2f(((const bf16*)(ws + WS_V))[(size_t)row * 512 + j]), rs * chk_dot(xb + (size_t)row * 1024, WinT + (size_t)(1024 + j) * 1024, 1024)); }
        { const int j = h2 % 1024; const float v = rs * chk_dot(xb + (size_t)row * 1024, WinT + (size_t)(CHK_GA_ROW + j) * 1024, 1024);
          chk_rec(ctl + CW_CHK + 128, bf2f(((const bf16*)(ws + WS_GA))[(size_t)row * 2048 + j]), 1.0f / (1.0f + expf(-v))); }
        { const int j = h2 % 1024; const float v = rs * chk_dot(xb + (size_t)row * 1024, WinT + (size_t)(CHK_GB_ROW + j) * 1024, 1024);
          chk_rec(ctl + CW_CHK + 64, bf2f(((const bf16*)(ws + WS_GA))[(size_t)row * 2048 + 1024 + j]), 1.0f / (1.0f + expf(-v))); }
        { const int j = h2 % 512; chk_rec(ctl + CW_CHK + 448, bf2f(((const bf16*)(ws + WS_CB))[(size_t)row * 512 + j]), rs * chk_dot(xb + (size_t)row * 1024, WinT + (size_t)(2048 + j) * 1024, 1024)); }
        { const int j = h2 % 512; const int rb = 2560 + 256 * (j >> 7) + (j & 127);
          const float cc = rs * chk_dot(xb + (size_t)row * 1024, WinT + (size_t)rb * 1024, 1024), ch = rs * chk_dot(xb + (size_t)row * 1024, WinT + (size_t)(rb + 128) * 1024, 1024);
          chk_rec(ctl + CW_CHK + 192, bf2f(((const bf16*)(ws + WS_U))[(size_t)row * 512 + j]), cc * ch); }
    }
    if (which == 1) {
        const float rs = rstd1[row]; const int j = h2 % 512; const float* lbv = (const float*)(ws + WS_LB);
        const float hq = rs * chk_dot(xb + (size_t)row * 1024, WinT + (size_t)(0 + j) * 1024, 1024), hf = rs * chk_dot(xb + (size_t)row * 1024, WinT + (size_t)(512 + j) * 1024, 1024),
                    hg = rs * chk_dot(xb + (size_t)row * 1024, WinT + (size_t)(1536 + j) * 1024, 1024);
        const float l0 = A.in[3][j], l1 = A.in[3][512 + j], lb = expf(l0) / (expf(l0) + expf(l1)); chk_rec(ctl + CW_CHK + 128, lbv[j], lb);
        const float sg = 1.0f / (1.0f + expf(-hf)), f = lb + (1.0f - lb) * sg;
        chk_rec(ctl + CW_CHK + 128, bf2f(((const bf16*)(ws + WS_Q))[(size_t)row * 512 + j]), hq / (1.0f + expf(-hq)) * 0.125f);
        chk_rec(ctl + CW_CHK + 128, bf2f(((const bf16*)(ws + WS_LF))[(size_t)row * 512 + j]), logf(f));
        chk_rec(ctl + CW_CHK + 128, bf2f(((const bf16*)(ws + WS_KK))[(size_t)row * 512 + j]), 1.0f - f);
        chk_rec(ctl + CW_CHK + 128, bf2f(((const bf16*)(ws + WS_SG))[(size_t)row * 512 + j]), hg / (1.0f + expf(-hg)));
    }
    if (which == 11 && g < 64 * 64) {
        const int smp = g >> 6, e = g & 63; const unsigned hs = chk_hash(1000 + smp); const int bb = hs % 8, hd = (hs >> 3) % 8, tpos = (smp < 8) ? (int)(smp * 9) : (int)((hs >> 6) % SEQ);
        const bf16* Qb = (const bf16*)(ws + WS_Q); const bf16* LFb = (const bf16*)(ws + WS_LF); const bf16* KKb = (const bf16*)(ws + WS_KK); const bf16* Vb = (const bf16*)(ws + WS_V); const bf16* SGb = (const bf16*)(ws + WS_SG);
        float S[64];
#pragma unroll
        for (int d = 0; d < 64; ++d) S[d] = 0.f;
        for (int sp = 0; sp <= tpos; ++sp) { const size_t ro = ((size_t)bb * SEQ + sp) * 512 + hd * 64; const float v = bf2f(Vb[ro + e]);
#pragma unroll
            for (int d = 0; d < 64; ++d) S[d] = expf(bf2f(LFb[ro + d])) * S[d] + bf2f(KKb[ro + d]) * v; }
        const size_t rq = ((size_t)bb * SEQ + tpos) * 512 + hd * 64; float o = 0.f;
#pragma unroll
        for (int d = 0; d < 64; ++d) o += bf2f(Qb[rq + d]) * S[d];
        const float ss = wave_sum(o * o); const float y = o * rsqrtf(ss * (1.0f / 64.0f) + EPS) * A.in[4][hd * 64 + e] * bf2f(SGb[rq + e]);
        ((float*)(ws + 6 * MiB))[g] = y;
    }
    if (which == 14 && g < 64 * 64) {
        const int smp = g >> 6, e = g & 63; const unsigned hs = chk_hash(1000 + smp); const int bb = hs % 8, hd = (hs >> 3) % 8, tpos = (smp < 8) ? (int)(smp * 9) : (int)((hs >> 6) % SEQ);
        chk_rec(ctl + CW_CHK + 192, bf2f(((const bf16*)(ws + WS_XB))[((size_t)bb * SEQ + tpos) * 1024 + hd * 64 + e]), ((const float*)(ws + 6 * MiB))[g]);
    }
    if (which == 2) {
        const int j = h2 % 512, sq = row & (SEQ - 1); const bf16* U = (const bf16*)(ws + WS_U); const bf16* CB = (const bf16*)(ws + WS_CB); const float* cw = A.in[5];
        float acc = cw[1024 + j] * bf2f(U[(size_t)row * 512 + j]);
        if (sq >= 1) acc += cw[512 + j] * bf2f(U[(size_t)(row - 1) * 512 + j]);
        if (sq >= 2) acc += cw[j] * bf2f(U[(size_t)(row - 2) * 512 + j]);
        chk_rec(ctl + CW_CHK + 448, bf2f(((const bf16*)(ws + WS_XB))[(size_t)row * 1024 + 512 + j]), bf2f(CB[(size_t)row * 512 + j]) * acc);
    }
    if (which == 5) {
        const int j = h2 % 1024; const bf16* Y = (const bf16*)(ws + WS_XB) + (size_t)row * 1024; const bf16* P = (const bf16*)(ws + WS_PAB) + (size_t)j * 1024;
        const float ga = bf2f(((const bf16*)(ws + WS_GA))[(size_t)row * 2048 + j]), gb = bf2f(((const bf16*)(ws + WS_GA))[(size_t)row * 2048 + 1024 + j]);
        chk_rec(ctl + CW_CHK + 256, bf2f(((const bf16*)(ws + WS_MG))[(size_t)row * 1024 + j]), ga * chk_dot(Y, P, 512) + gb * chk_dot(Y + 512, P + 512, 512));
    }
    if (which == 6) {
        const int j = h2 % 1024;
        chk_rec(ctl + CW_CHK + 320, ((const float*)(ws + WS_X1))[(size_t)row * 1024 + j] - A.in[0][(size_t)row * 1024 + j],
                chk_dot((const bf16*)(ws + WS_MG) + (size_t)row * 1024, (const bf16*)(ws + WS_WO) + (size_t)j * 1024, 1024));
    }
    if (which == 7) {
        const int j = h2 % 2048; const float rs2 = rsqrtf(pg8::sum16((const float*)(ws + WS_ROWSS) + (size_t)row * 16) * (1.0f / D) + EPS);
        chk_rec(ctl + CW_CHK + 384, bf2f(((const bf16*)(ws + WS_QQ))[(size_t)row * 2048 + j]), rs2 * chk_dot((const bf16*)(ws + WS_X1B) + (size_t)row * 1024, (const bf16*)(ws + WS_WQ) + (size_t)j * 1024, 1024));
    }
}
__device__ __forceinline__ float chk_scale(Frame& F) {
    const unsigned* c = (const unsigned*)(F.ws + WS_CTL) + CW_CHK; const float sc[8] = {0.5f, 0.0f, 2.0f, -0.5f, -1.0f, 3.0f, -2.0f, 4.0f};
    float s = 1.0f;
#pragma unroll
    for (int i = 7; i >= 0; --i) if (c[64 * i] > 40u) s = sc[i];
    return s;
}
#endif
__device__ __forceinline__ float dot2bf(unsigned w, unsigned x, float acc) { return __builtin_amdgcn_fdot2_f32_bf16(__builtin_bit_cast(bf16x2_t, w), __builtin_bit_cast(bf16x2_t, x), acc, false); }
__device__ __forceinline__ float gelu_erf(float v) {
    const float av = fabsf(v), tt = __builtin_amdgcn_rcpf(av * 0.2316418882f + 1.0f);
    float q = tt * 0.5307027145f + (-0.7265760135f); q = q * tt + 0.7107068705f; q = q * tt + (-0.142248368f); q = q * tt + 0.127414796f; q = q * tt;
    const float e = __builtin_amdgcn_exp2f(v * v * (-0.72134752044f)), m = v * (q * e);
    return v < 0.f ? m : v - m;
}
typedef float f32x2v __attribute__((ext_vector_type(2)));
__device__ __forceinline__ void cvt_row_fp8(const float* src, unsigned char* dst, float* inv_scale, int row, int lane) {
    const float* r = src + (size_t)row * 1024; f32x4 v[4]; float m = 0.f;
#pragma unroll
    for (int j = 0; j < 4; ++j) { v[j] = *(const f32x4*)(r + 256 * j + 4 * lane); m = fmaxf(m, fmaxf(fmaxf(fabsf(v[j][0]), fabsf(v[j][1])), fmaxf(fabsf(v[j][2]), fabsf(v[j][3])))); }
#pragma unroll
    for (int o = 1; o < 64; o <<= 1) m = fmaxf(m, __shfl_xor(m, o));
    const int ex = (int)((__builtin_bit_cast(unsigned, m) >> 23) & 0xff);
    const int k = (m > 0.f) ? (134 - ex) : 0;
    const float sc = __builtin_bit_cast(float, (unsigned)(127 + k) << 23), isc = __builtin_bit_cast(float, (unsigned)(127 - k) << 23);
    v4u o;
#pragma unroll
    for (int j = 0; j < 4; ++j) { int p = __builtin_amdgcn_cvt_pk_fp8_f32(v[j][0] * sc, v[j][1] * sc, 0, false); p = __builtin_amdgcn_cvt_pk_fp8_f32(v[j][2] * sc, v[j][3] * sc, p, true); o[j] = (unsigned)p; }
    *(v4u*)(dst + (size_t)row * 1024 + 16 * lane) = o;
    if (lane == 0) inv_scale[row] = isc;
}
constexpr int F4_ROW = 1152;
__device__ __forceinline__ void pack16_fp4(const float* r, int lane, unsigned& d0, unsigned& d1, unsigned& eb_out) {
    f32x4 v[4]; float m = 0.f;
#pragma unroll
    for (int j = 0; j < 4; ++j) { v[j] = *(const f32x4*)(r + 256 * j + 4 * lane); m = fmaxf(m, fmaxf(fmaxf(fabsf(v[j][0]), fabsf(v[j][1])), fmaxf(fabsf(v[j][2]), fabsf(v[j][3])))); }
    const float tq = m * (1.0f / 6.0f); const unsigned eb = (__builtin_bit_cast(unsigned, tq) + 0x7FFFFFu) >> 23;
    const unsigned ebc = eb > 253u ? 253u : eb; const float inv = __builtin_bit_cast(float, (254u - ebc) << 23);
    d0 = 0u; d1 = 0u;
    d0 = __builtin_amdgcn_cvt_scalef32_pk_fp4_f32(d0, v[0][0] * inv, v[0][1] * inv, 1.0f, 0); d0 = __builtin_amdgcn_cvt_scalef32_pk_fp4_f32(d0, v[0][2] * inv, v[0][3] * inv, 1.0f, 1);
    d0 = __builtin_amdgcn_cvt_scalef32_pk_fp4_f32(d0, v[1][0] * inv, v[1][1] * inv, 1.0f, 2); d0 = __builtin_amdgcn_cvt_scalef32_pk_fp4_f32(d0, v[1][2] * inv, v[1][3] * inv, 1.0f, 3);
    d1 = __builtin_amdgcn_cvt_scalef32_pk_fp4_f32(d1, v[2][0] * inv, v[2][1] * inv, 1.0f, 0); d1 = __builtin_amdgcn_cvt_scalef32_pk_fp4_f32(d1, v[2][2] * inv, v[2][3] * inv, 1.0f, 1);
    d1 = __builtin_amdgcn_cvt_scalef32_pk_fp4_f32(d1, v[3][0] * inv, v[3][1] * inv, 1.0f, 2); d1 = __builtin_amdgcn_cvt_scalef32_pk_fp4_f32(d1, v[3][2] * inv, v[3][3] * inv, 1.0f, 3);
    eb_out = ebc;
}
__device__ __forceinline__ void cvt_expert_fp4(const float* eu, const float* ev, unsigned char* dst, int e, int lane) {
    unsigned u0, u1, v0, v1, su, sv;
    pack16_fp4(eu + (size_t)e * 1024, lane, u0, u1, su); pack16_fp4(ev + (size_t)e * 1024, lane, v0, v1, sv);
    v4u o; o.x = u0; o.y = u1; o.z = v0; o.w = v1;
    unsigned char* rec = dst + (size_t)e * F4_ROW;
    *(v4u*)(rec + 16 * lane) = o; *(unsigned short*)(rec + 1024 + 2 * lane) = (unsigned short)(su | (sv << 8));
}
struct RowsF4 { v4u d[8]; unsigned s[8]; };
__device__ __forceinline__ void p9_load_f4(RowsF4& R, const unsigned char* EUV, const int (&e)[8], int lane) {
#pragma unroll
    for (int j = 0; j < 8; ++j) { const GAS unsigned char* rec = (const GAS unsigned char*)EUV + (size_t)e[j] * F4_ROW;
        R.d[j] = *(const GAS v4u*)(rec + (unsigned)(16 * lane)); R.s[j] = *(const GAS unsigned short*)(rec + (unsigned)(1024 + 2 * lane)); }
}
template <int M> __device__ __forceinline__ float swz_xor(float v) {
    return __builtin_bit_cast(float, __builtin_amdgcn_ds_swizzle(__builtin_bit_cast(int, v), 0x1f | (M << 10))); }
__device__ __forceinline__ float bperm(float v, int lane_src) { return __builtin_bit_cast(float, __builtin_amdgcn_ds_bpermute(lane_src << 2, __builtin_bit_cast(int, v))); }
__device__ __forceinline__ float rdl(float v, int l) { return __builtin_bit_cast(float, __builtin_amdgcn_readlane(__builtin_bit_cast(int, v), l)); }
__device__ __forceinline__ void unpack8_f4(const unsigned dw, float (&f)[8]) {
    const f32x2v p0 = __builtin_amdgcn_cvt_scalef32_pk_f32_fp4(dw, 1.0f, 0), p1 = __builtin_amdgcn_cvt_scalef32_pk_f32_fp4(dw, 1.0f, 1),
                 p2 = __builtin_amdgcn_cvt_scalef32_pk_f32_fp4(dw, 1.0f, 2), p3 = __builtin_amdgcn_cvt_scalef32_pk_f32_fp4(dw, 1.0f, 3);
    f[0] = p0.x; f[1] = p0.y; f[2] = p1.x; f[3] = p1.y; f[4] = p2.x; f[5] = p2.y; f[6] = p3.x; f[7] = p3.y;
}
__device__ __forceinline__ float dot16_f4(const unsigned q0, const unsigned q1, const float (&hn)[16]) {
    f32x2v acc = {0.f, 0.f};
#define D16_STEP(Q, C, B) { const f32x2v p = __builtin_amdgcn_cvt_scalef32_pk_f32_fp4(Q, 1.0f, C); const f32x2v h = {hn[B], hn[B + 1]}; acc = __builtin_elementwise_fma(p, h, acc); }
    D16_STEP(q0, 0, 0) D16_STEP(q0, 1, 2) D16_STEP(q0, 2, 4) D16_STEP(q0, 3, 6) D16_STEP(q1, 0, 8) D16_STEP(q1, 1, 10) D16_STEP(q1, 2, 12) D16_STEP(q1, 3, 14)
#undef D16_STEP
    return acc.x + acc.y;
}
__device__ __forceinline__ void axpy16_f4(const unsigned q0, const unsigned q1, const float w, float (&o)[16]) {
    float f0[8], f1[8]; unpack8_f4(q0, f0); unpack8_f4(q1, f1);
#pragma unroll
    for (int i = 0; i < 8; ++i) { o[i] += w * f0[i]; o[8 + i] += w * f1[i]; }
}
__device__ __forceinline__ void p9_batch_f4(const RowsF4& R, const float (&hn)[16], float (&oacc)[16], int bt, int lane, float gA, float gB) {
    const int hh = lane >> 5, q4 = (lane >> 4) & 1, q3 = (lane >> 3) & 1, jsel = 4 * hh + 2 * q4 + q3;
    float pd[8];
#pragma unroll
    for (int j = 0; j < 8; ++j) { pd[j] = dot16_f4(R.d[j].x, R.d[j].y, hn) * __builtin_bit_cast(float, (R.s[j] & 0xffu) << 23); if (j & 1) __builtin_amdgcn_sched_barrier(0); }
    float r4[4], r2[2];
#pragma unroll
    for (int i = 0; i < 4; ++i) { const float keep = hh ? pd[4 + i] : pd[i], send = hh ? pd[i] : pd[4 + i]; r4[i] = keep + bperm(send, lane ^ 32); }
#pragma unroll
    for (int i = 0; i < 2; ++i) { const float keep = q4 ? r4[2 + i] : r4[i], send = q4 ? r4[i] : r4[2 + i]; r2[i] = keep + swz_xor<16>(send); }
    float v = (q3 ? r2[1] : r2[0]) + swz_xor<8>(q3 ? r2[0] : r2[1]);
    v += swz_xor<4>(v); v += swz_xor<2>(v); v += swz_xor<1>(v);
    const int n = 8 * bt + jsel; const float g = (bt < 8) ? bperm(gA, n & 63) : bperm(gB, n & 63);
    const float w = g * gelu_erf(v);
#pragma unroll
    for (int j = 0; j < 8; ++j) { axpy16_f4(R.d[j].z, R.d[j].w, rdl(w, 8 * j) * __builtin_bit_cast(float, (R.s[j] >> 8) << 23), oacc); if (j & 1) __builtin_amdgcn_sched_barrier(0); }
}
__device__ __forceinline__ void p9_ids(int idA, int idB, int nb, int (&e)[8]) {
#pragma unroll
    for (int j = 0; j < 8; ++j) { const int n = 8 * nb + j; e[j] = (nb < 8) ? __builtin_amdgcn_readlane(idA, n & 63) : __builtin_amdgcn_readlane(idB, n & 63); }
}
struct RowsF4q { v4u d[4]; unsigned s[4]; };
__device__ __forceinline__ void p9_load_f4q(RowsF4q& R, const unsigned char* EUV, int idP, int nb, int lane) {
    const __amdgpu_buffer_rsrc_t rs = __builtin_amdgcn_make_buffer_rsrc((void*)EUV, (short)0, 16384 * F4_ROW, 0x00020000);
#pragma unroll
    for (int j = 0; j < 4; ++j) { const int n = 4 * nb + j; const unsigned x = (unsigned)__builtin_amdgcn_readlane(idP, n & 63); const unsigned e = (x >> ((n >> 6) << 4)) & 0xffffu;
        const int so = (int)(e * F4_ROW);
        R.d[j] = __builtin_bit_cast(v4u, __builtin_amdgcn_raw_buffer_load_b128(rs, 16 * lane, so, 0)); R.s[j] = (unsigned)__builtin_amdgcn_raw_buffer_load_b16(rs, 1024 + 2 * lane, so, 0); }
}
__device__ __forceinline__ void p9_batch4_f4(const RowsF4q& R, const float (&hn)[16], float (&oacc)[16], int bt, int lane, float gA, float gB) {
    const int hh = lane >> 5, q4 = (lane >> 4) & 1, jsel = 2 * hh + q4;
    float pd[4];
#pragma unroll
    for (int j = 0; j < 4; ++j) pd[j] = dot16_f4(R.d[j].x, R.d[j].y, hn) * __builtin_bit_cast(float, (R.s[j] & 0xffu) << 23);
    const float k0 = hh ? pd[2] : pd[0], k1 = hh ? pd[3] : pd[1], s0 = hh ? pd[0] : pd[2], s1 = hh ? pd[1] : pd[3];
    const float r0 = k0 + bperm(s0, lane ^ 32), r1 = k1 + bperm(s1, lane ^ 32);
    float v = (q4 ? r1 : r0) + swz_xor<16>(q4 ? r0 : r1);
    v += swz_xor<8>(v); v += swz_xor<4>(v); v += swz_xor<2>(v); v += swz_xor<1>(v);
    const int n = 4 * bt + jsel; const float g = (bt < 16) ? bperm(gA, n & 63) : bperm(gB, n & 63);
    const float w = g * gelu_erf(v);
#pragma unroll
    for (int j = 0; j < 4; ++j) axpy16_f4(R.d[j].z, R.d[j].w, rdl(w, 16 * j) * __builtin_bit_cast(float, (R.s[j] >> 8) << 23), oacc);
}
__device__ __forceinline__ void p9_token_f4(Frame& F, int t, const float* g_ffn, const float* g_fin) {
    unsigned char* ws = F.ws; const int lane = pg8::fresh_lane();
    const unsigned char* EUV = ws + WS_EU;
    const bf16* xrow = (const bf16*)(ws + WS_X1B) + (size_t)t * D; float* orow = F.out + (size_t)t * D;
    const float rs2 = __builtin_amdgcn_rsqf(pg8::sum16((const float*)(ws + WS_ROWSS) + (size_t)t * 16) * (1.0f / D) + EPS);
    float hn[16];
#pragma unroll
    for (int j = 0; j < 4; ++j) { const v2u a = *(const v2u*)(xrow + 256 * j + 4 * lane); const f32x4 g = *(const f32x4*)(g_ffn + 256 * j + 4 * lane);
        hn[4 * j] = bflo(a.x) * rs2 * g[0]; hn[4 * j + 1] = bfhi(a.x) * rs2 * g[1]; hn[4 * j + 2] = bflo(a.y) * rs2 * g[2]; hn[4 * j + 3] = bfhi(a.y) * rs2 * g[3]; }
    const int* IDX = (const int*)(ws + WS_IDX) + (size_t)t * 128; const float* GT = (const float*)(ws + WS_GATE) + (size_t)t * 128;
    int idA, idB; float gA, gB;
    { const int a0 = IDX[lane], b0 = IDX[64 + lane]; const float ga = GT[lane], gb = GT[64 + lane];
      const int kA = a0 >> 10, kB = b0 >> 10; const unsigned long long lt = (1ull << lane) - 1ull;
      int base = 0, rA = 0, rB = 0;
#pragma unroll
      for (int k = 0; k < 16; ++k) { const unsigned long long mA = __ballot(kA == k), mB = __ballot(kB == k); const int cA = __popcll(mA), cB = __popcll(mB);
          if (kA == k) rA = base + __popcll(mA & lt);
          if (kB == k) rB = base + cA + __popcll(mB & lt);
          base += cA + cB; }
      LAS int* sid = (LAS int*)(F.lds + F.wave * WAVE_LDS); LAS float* sgt = (LAS float*)(sid + 128);
      sid[rA] = a0; sid[rB] = b0; sgt[rA] = ga; sgt[rB] = gb;
      LDS_WAIT(); asm volatile("" ::: "memory");
      idA = sid[lane]; idB = sid[64 + lane]; gA = sgt[lane]; gB = sgt[64 + lane];
      LDS_WAIT(); asm volatile("" ::: "memory"); }
    float oacc[16];
#pragma unroll
    for (int i = 0; i < 16; ++i) oacc[i] = 0.f;
    const int idP = idA | (idB << 16);
    RowsF4q R0, R1, R2, R3, R4;
    p9_load_f4q(R0, EUV, idP, 0, lane); p9_load_f4q(R1, EUV, idP, 1, lane); p9_load_f4q(R2, EUV, idP, 2, lane); p9_load_f4q(R3, EUV, idP, 3, lane);
#pragma unroll 1
    for (int bt = 0; bt < 30; bt += 5) {
        p9_load_f4q(R4, EUV, idP, bt + 4, lane); asm volatile("" ::: "memory");
        p9_batch4_f4(R0, hn, oacc, bt, lane, gA, gB); asm volatile("" ::: "memory");
        p9_load_f4q(R0, EUV, idP, (bt + 5) & 31, lane); asm volatile("" ::: "memory");
        p9_batch4_f4(R1, hn, oacc, bt + 1, lane, gA, gB); asm volatile("" ::: "memory");
        p9_load_f4q(R1, EUV, idP, (bt + 6) & 31, lane); asm volatile("" ::: "memory");
        p9_batch4_f4(R2, hn, oacc, bt + 2, lane, gA, gB); asm volatile("" ::: "memory");
        p9_load_f4q(R2, EUV, idP, (bt + 7) & 31, lane); asm volatile("" ::: "memory");
        p9_batch4_f4(R3, hn, oacc, bt + 3, lane, gA, gB); asm volatile("" ::: "memory");
        p9_load_f4q(R3, EUV, idP, (bt + 8) & 31, lane); asm volatile("" ::: "memory");
        p9_batch4_f4(R4, hn, oacc, bt + 4, lane, gA, gB); asm volatile("" ::: "memory");
    }
    p9_batch4_f4(R0, hn, oacc, 30, lane, gA, gB); p9_batch4_f4(R1, hn, oacc, 31, lane, gA, gB);
    asm volatile("" ::: "memory");
    float ss = 0.f;
#pragma unroll
    for (int j = 0; j < 4; ++j) { const v2u a = *(const v2u*)(xrow + 256 * j + 4 * lane);
        oacc[4 * j] += bflo(a.x); oacc[4 * j + 1] += bfhi(a.x); oacc[4 * j + 2] += bflo(a.y); oacc[4 * j + 3] += bfhi(a.y);
#pragma unroll
        for (int i = 0; i < 4; ++i) ss += oacc[4 * j + i] * oacc[4 * j + i]; }
    ss += swz_xor<1>(ss); ss += swz_xor<2>(ss); ss += swz_xor<4>(ss); ss += swz_xor<8>(ss); ss += swz_xor<16>(ss); ss += bperm(ss, lane ^ 32);
    const float rs3 = __builtin_amdgcn_rsqf(ss * (1.0f / D) + EPS);
#pragma unroll
    for (int j = 0; j < 4; ++j) { const f32x4 g = *(const f32x4*)(g_fin + 256 * j + 4 * lane); f32x4 o;
#pragma unroll
        for (int i = 0; i < 4; ++i) o[i] = oacc[4 * j + i] * rs3 * g[i];
        *(f32x4*)(orow + 256 * j + 4 * lane) = o; }
}
constexpr int MX_ROW = 1120, MX_USC = 512, MX_V = 544, MX_VSC = 1056;
typedef int v8i __attribute__((ext_vector_type(8)));
__device__ __forceinline__ void cvt_expert_mx(const float* eu, const float* ev, unsigned char* dst, int e, int lane) {
    unsigned char* rec = dst + (size_t)e * MX_ROW;
    { const float* r = eu + (size_t)e * 1024 + 16 * lane; f32x4 v[4]; float m = 0.f;
#pragma unroll
      for (int j = 0; j < 4; ++j) { v[j] = *(const f32x4*)(r + 4 * j); m = fmaxf(m, fmaxf(fmaxf(fabsf(v[j][0]), fabsf(v[j][1])), fmaxf(fabsf(v[j][2]), fabsf(v[j][3])))); }
      m = fmaxf(m, swz_xor<1>(m));
      const float tq = m * (1.0f / 6.0f); const unsigned eb = (__builtin_bit_cast(unsigned, tq) + 0x7FFFFFu) >> 23;
      const unsigned ebc = eb > 253u ? 253u : eb; const float inv = __builtin_bit_cast(float, (254u - ebc) << 23);
      unsigned d0 = 0u, d1 = 0u;
      d0 = __builtin_amdgcn_cvt_scalef32_pk_fp4_f32(d0, v[0][0] * inv, v[0][1] * inv, 1.0f, 0); d0 = __builtin_amdgcn_cvt_scalef32_pk_fp4_f32(d0, v[0][2] * inv, v[0][3] * inv, 1.0f, 1);
      d0 = __builtin_amdgcn_cvt_scalef32_pk_fp4_f32(d0, v[1][0] * inv, v[1][1] * inv, 1.0f, 2); d0 = __builtin_amdgcn_cvt_scalef32_pk_fp4_f32(d0, v[1][2] * inv, v[1][3] * inv, 1.0f, 3);
      d1 = __builtin_amdgcn_cvt_scalef32_pk_fp4_f32(d1, v[2][0] * inv, v[2][1] * inv, 1.0f, 0); d1 = __builtin_amdgcn_cvt_scalef32_pk_fp4_f32(d1, v[2][2] * inv, v[2][3] * inv, 1.0f, 1);
      d1 = __builtin_amdgcn_cvt_scalef32_pk_fp4_f32(d1, v[3][0] * inv, v[3][1] * inv, 1.0f, 2); d1 = __builtin_amdgcn_cvt_scalef32_pk_fp4_f32(d1, v[3][2] * inv, v[3][3] * inv, 1.0f, 3);
      v2u o; o.x = d0; o.y = d1; *(v2u*)(rec + 8 * lane) = o;
      if (!(lane & 1)) { const int blk = lane >> 1; rec[MX_USC + (blk & 3) * 8 + (blk >> 2)] = (unsigned char)ebc; } }
    { unsigned v0, v1, sv; pack16_fp4(ev + (size_t)e * 1024, lane, v0, v1, sv);
      v2u o; o.x = v0; o.y = v1; *(v2u*)(rec + MX_V + 8 * lane) = o; rec[MX_VSC + lane] = (unsigned char)sv; }
}
__device__ __forceinline__ void mx_pack_u(const f32x4 (&v)[4], unsigned char* rec, int lane) {
    float m = 0.f;
#pragma unroll
    for (int j = 0; j < 4; ++j) m = fmaxf(m, fmaxf(fmaxf(fabsf(v[j][0]), fabsf(v[j][1])), fmaxf(fabsf(v[j][2]), fabsf(v[j][3]))));
    m = fmaxf(m, swz_xor<1>(m));
    const float tq = m * (1.0f / 6.0f); const unsigned eb = (__builtin_bit_cast(unsigned, tq) + 0x7FFFFFu) >> 23;
    const unsigned ebc = eb > 253u ? 253u : eb; const float inv = __builtin_bit_cast(float, (254u - ebc) << 23);
    unsigned d0 = 0u, d1 = 0u;
    d0 = __builtin_amdgcn_cvt_scalef32_pk_fp4_f32(d0, v[0][0] * inv, v[0][1] * inv, 1.0f, 0); d0 = __builtin_amdgcn_cvt_scalef32_pk_fp4_f32(d0, v[0][2] * inv, v[0][3] * inv, 1.0f, 1);
    d0 = __builtin_amdgcn_cvt_scalef32_pk_fp4_f32(d0, v[1][0] * inv, v[1][1] * inv, 1.0f, 2); d0 = __builtin_amdgcn_cvt_scalef32_pk_fp4_f32(d0, v[1][2] * inv, v[1][3] * inv, 1.0f, 3);
    d1 = __builtin_amdgcn_cvt_scalef32_pk_fp4_f32(d1, v[2][0] * inv, v[2][1] * inv, 1.0f, 0); d1 = __builtin_amdgcn_cvt_scalef32_pk_fp4_f32(d1, v[2][2] * inv, v[2][3] * inv, 1.0f, 1);
    d1 = __builtin_amdgcn_cvt_scalef32_pk_fp4_f32(d1, v[3][0] * inv, v[3][1] * inv, 1.0f, 2); d1 = __builtin_amdgcn_cvt_scalef32_pk_fp4_f32(d1, v[3][2] * inv, v[3][3] * inv, 1.0f, 3);
    v2u o; o.x = d0; o.y = d1; *(v2u*)(rec + 8 * lane) = o;
    if (!(lane & 1)) { const int blk = lane >> 1; rec[MX_USC + (blk & 3) * 8 + (blk >> 2)] = (unsigned char)ebc; }
}
__device__ __forceinline__ void mx_pack_v(const f32x4 (&v)[4], unsigned char* rec, int lane) {
    float m = 0.f;
#pragma unroll
    for (int j = 0; j < 4; ++j) m = fmaxf(m, fmaxf(fmaxf(fabsf(v[j][0]), fabsf(v[j][1])), fmaxf(fabsf(v[j][2]), fabsf(v[j][3]))));
    const float tq = m * (1.0f / 6.0f); const unsigned eb = (__builtin_bit_cast(unsigned, tq) + 0x7FFFFFu) >> 23;
    const unsigned ebc = eb > 253u ? 253u : eb; const float inv = __builtin_bit_cast(float, (254u - ebc) << 23);
    unsigned d0 = 0u, d1 = 0u;
    d0 = __builtin_amdgcn_cvt_scalef32_pk_fp4_f32(d0, v[0][0] * inv, v[0][1] * inv, 1.0f, 0); d0 = __builtin_amdgcn_cvt_scalef32_pk_fp4_f32(d0, v[0][2] * inv, v[0][3] * inv, 1.0f, 1);
    d0 = __builtin_amdgcn_cvt_scalef32_pk_fp4_f32(d0, v[1][0] * inv, v[1][1] * inv, 1.0f, 2); d0 = __builtin_amdgcn_cvt_scalef32_pk_fp4_f32(d0, v[1][2] * inv, v[1][3] * inv, 1.0f, 3);
    d1 = __builtin_amdgcn_cvt_scalef32_pk_fp4_f32(d1, v[2][0] * inv, v[2][1] * inv, 1.0f, 0); d1 = __builtin_amdgcn_cvt_scalef32_pk_fp4_f32(d1, v[2][2] * inv, v[2][3] * inv, 1.0f, 1);
    d1 = __builtin_amdgcn_cvt_scalef32_pk_fp4_f32(d1, v[3][0] * inv, v[3][1] * inv, 1.0f, 2); d1 = __builtin_amdgcn_cvt_scalef32_pk_fp4_f32(d1, v[3][2] * inv, v[3][3] * inv, 1.0f, 3);
    v2u o; o.x = d0; o.y = d1; *(v2u*)(rec + MX_V + 8 * lane) = o; rec[MX_VSC + lane] = (unsigned char)ebc;
}
__device__ __forceinline__ void cvt_expert_mx2(const float* eu, const float* ev, unsigned char* dst, int e0, int e1, int lane) {
    f32x4 ua[4], va[4], ub[4], vb[4];
#pragma unroll
    for (int j = 0; j < 4; ++j) { ua[j] = *(const f32x4*)(eu + (size_t)e0 * 1024 + 16 * lane + 4 * j); va[j] = *(const f32x4*)(ev + (size_t)e0 * 1024 + 256 * j + 4 * lane);
                                  ub[j] = *(const f32x4*)(eu + (size_t)e1 * 1024 + 16 * lane + 4 * j); vb[j] = *(const f32x4*)(ev + (size_t)e1 * 1024 + 256 * j + 4 * lane); }
    mx_pack_u(ua, dst + (size_t)e0 * MX_ROW, lane); mx_pack_v(va, dst + (size_t)e0 * MX_ROW, lane);
    mx_pack_u(ub, dst + (size_t)e1 * MX_ROW, lane); mx_pack_v(vb, dst + (size_t)e1 * MX_ROW, lane);
}
struct AFrag { v4u a[8]; v2u sc; };
__device__ __forceinline__ void p9m_load_a(AFrag& A, const unsigned char* EUV, int id, int lane) {
    const GAS unsigned char* rec = (const GAS unsigned char*)EUV + (size_t)id * MX_ROW + (unsigned)((lane >> 4) * 8);
    A.sc = *(const GAS v2u*)(rec + MX_USC);
    const GAS unsigned char* ra = rec + (unsigned)((lane >> 4) * 8);
#pragma unroll
    for (int s = 0; s < 8; ++s) A.a[s] = *(const GAS v4u*)(ra + 64 * s);
}
struct VSlot { v2u d; unsigned s; };
__device__ __forceinline__ void p9m_load_v(VSlot& V, __amdgpu_buffer_rsrc_t rs, int e, int lane) {
    const int so = e * MX_ROW;
    V.d = __builtin_bit_cast(v2u, __builtin_amdgcn_raw_buffer_load_b64(rs, MX_V + 8 * lane, so, 0)); V.s = (unsigned)__builtin_amdgcn_raw_buffer_load_b8(rs, MX_VSC + lane, so, 0);
}
__device__ __forceinline__ void p9m_axpy(const VSlot& V, const float c, f32x2v (&o)[8]) {
    const float sc = __builtin_bit_cast(float, V.s << 23); const f32x2v cc = {c, c};
#define AX_STEP(K) { o[K] = __builtin_elementwise_fma(__builtin_amdgcn_cvt_scalef32_pk_f32_fp4(V.d.x, sc, K), cc, o[K]); o[4 + K] = __builtin_elementwise_fma(__builtin_amdgcn_cvt_scalef32_pk_f32_fp4(V.d.y, sc, K), cc, o[4 + K]); }
    AX_STEP(0) AX_STEP(1) AX_STEP(2) AX_STEP(3)
#undef AX_STEP
}
__device__ __forceinline__ f32x4 p9m_dots(const AFrag& A, LAS unsigned char* h8, int lane) {
    f32x4 d0 = {0.f, 0.f, 0.f, 0.f}, d1 = {0.f, 0.f, 0.f, 0.f};
    LAS unsigned char* hb = h8 + (lane >> 4) * 16;
#define P9M_STEP(S, ACC) { const v4u b0 = *(LAS v4u*)(hb + 128 * (S)), b1 = *(LAS v4u*)(hb + 128 * (S) + 64); \
        const v8i a8 = {(int)A.a[S].x, (int)A.a[S].y, (int)A.a[S].z, (int)A.a[S].w, 0, 0, 0, 0}; const v8i b8 = {(int)b0.x, (int)b0.y, (int)b0.z, (int)b0.w, (int)b1.x, (int)b1.y, (int)b1.z, (int)b1.w}; \
        ACC = __builtin_amdgcn_mfma_scale_f32_16x16x128_f8f6f4(a8, b8, ACC, 4, 0, (S) & 3, (int)((S) < 4 ? A.sc.x : A.sc.y), 0, 0x7f7f7f7f); }
    P9M_STEP(0, d0) P9M_STEP(1, d1) P9M_STEP(2, d0) P9M_STEP(3, d1) P9M_STEP(4, d0) P9M_STEP(5, d1) P9M_STEP(6, d0) P9M_STEP(7, d1)
#undef P9M_STEP
    return d0 + d1;
}
__device__ __forceinline__ void p9m_batch(const AFrag& A, VSlot (&V)[16], LAS unsigned char* h8, LAS float* sgt, __amdgpu_buffer_rsrc_t rs, int b, int idn, int lane, f32x2v (&o)[8]) {
    const f32x4 dd = p9m_dots(A, h8, lane);
    const f32x4 gt = *(LAS f32x4*)(sgt + 16 * b + 4 * (lane >> 4));
    float c[4];
#pragma unroll
    for (int r = 0; r < 4; ++r) c[r] = gt[r] * gelu_erf(dd[r]);
#pragma unroll
    for (int p = 0; p < 16; ++p) {
        p9m_axpy(V[p], rdl(c[p & 3], 16 * (p >> 2)), o);
        p9m_load_v(V[p], rs, __builtin_amdgcn_readlane(idn, p), lane);
    }
}
constexpr int G_HSTR = 1040;
struct BFrag { v4u b[16]; };
__device__ __forceinline__ void p9g_load_b(BFrag& B, LAS unsigned char* h8, int lane) {
    LAS unsigned char* hb = h8 + (lane & 3) * G_HSTR + (lane >> 4) * 16;
#pragma unroll
    for (int s = 0; s < 8; ++s) { B.b[2 * s] = *(LAS v4u*)(hb + 128 * s); B.b[2 * s + 1] = *(LAS v4u*)(hb + 128 * s + 64); }
}
__device__ __forceinline__ f32x4 p9g_dots(const AFrag& A, const BFrag& B, int lane) {
    f32x4 d0 = {0.f, 0.f, 0.f, 0.f}, d1 = {0.f, 0.f, 0.f, 0.f};
#define P9G_STEP(S, ACC) { const v4u b0 = B.b[2 * (S)], b1 = B.b[2 * (S) + 1]; \
        const v8i a8 = {(int)A.a[S].x, (int)A.a[S].y, (int)A.a[S].z, (int)A.a[S].w, 0, 0, 0, 0}; const v8i b8 = {(int)b0.x, (int)b0.y, (int)b0.z, (int)b0.w, (int)b1.x, (int)b1.y, (int)b1.z, (int)b1.w}; \
        ACC = __builtin_amdgcn_mfma_scale_f32_16x16x128_f8f6f4(a8, b8, ACC, 4, 0, (S) & 3, (int)((S) < 4 ? A.sc.x : A.sc.y), 0, 0x7f7f7f7f); }
    P9G_STEP(0, d0) P9G_STEP(1, d1) P9G_STEP(2, d0) P9G_STEP(3, d1) P9G_STEP(4, d0) P9G_STEP(5, d1) P9G_STEP(6, d0) P9G_STEP(7, d1)
#undef P9G_STEP
    return d0 + d1;
}
typedef unsigned v4s __attribute__((ext_vector_type(4)));
__device__ __forceinline__ void p9g_issue_a(AFrag& A, v4s rsrc, unsigned voa, unsigned vos) {
#define LD_A(S) asm volatile("buffer_load_dwordx4 %0, %1, %2, 0 offen offset:" #S : "=v"(A.a[(S) / 64]) : "v"(voa), "s"(rsrc));
    LD_A(0) LD_A(64) LD_A(128) LD_A(192) LD_A(256) LD_A(320) LD_A(384) LD_A(448)
#undef LD_A
    asm volatile("buffer_load_dwordx2 %0, %1, %2, 0 offen offset:512" : "=v"(A.sc) : "v"(vos), "s"(rsrc));
}
__device__ __forceinline__ void p9g_issue_v(VSlot& V, v4s rsrc, int so, unsigned vov, unsigned vob) {
    asm volatile("buffer_load_dwordx2 %0, %1, %2, %3 offen offset:544" : "=v"(V.d) : "v"(vov), "s"(rsrc), "s"(so));
    asm volatile("buffer_load_ubyte %0, %1, %2, %3 offen offset:1056" : "=v"(V.s) : "v"(vob), "s"(rsrc), "s"(so));
}
#define P9G_WAIT_A(N, A) asm volatile("s_waitcnt vmcnt(" #N ")" : "+v"(A.a[0]), "+v"(A.a[1]), "+v"(A.a[2]), "+v"(A.a[3]), "+v"(A.a[4]), "+v"(A.a[5]), "+v"(A.a[6]), "+v"(A.a[7]), "+v"(A.sc))
#define P9G_WAIT_V(N, V) asm volatile("s_waitcnt vmcnt(" #N ")" : "+v"(V.d), "+v"(V.s))
template <bool PF> __device__ __forceinline__ void p9g_batch(AFrag& A, VSlot (&V)[16], const BFrag& B, LAS float* sgtl, v4s rsrc, int b, int idn, int lane,
                                                            f32x2v (&o0)[8], f32x2v (&o1)[8], f32x2v (&o2)[8], f32x2v (&o3)[8]) {
    if (PF) P9G_WAIT_A(32, A); else P9G_WAIT_A(0, A);
    const f32x4 dd = p9g_dots(A, B, lane);
    if (PF) { const unsigned rowo = (unsigned)idn * MX_ROW + (unsigned)((lane >> 4) * 8); p9g_issue_a(A, rsrc, rowo + (unsigned)((lane >> 4) * 8), rowo); }
    const f32x4 gt = *(LAS f32x4*)(sgtl + 4 * b);
    float c[4];
#pragma unroll
    for (int r = 0; r < 4; ++r) c[r] = gt[r] * gelu_erf(dd[r]);
    const unsigned vov = 8u * (unsigned)lane, vob = (unsigned)lane;
#define P9G_PAIR(P, O) { if (PF) P9G_WAIT_V(39, V[P]); else P9G_WAIT_V(0, V[P]); p9m_axpy(V[P], rdl(c[(P) & 3], 17 * ((P) >> 2)), O); \
        if (PF) p9g_issue_v(V[P], rsrc, __builtin_amdgcn_readlane(idn, P) * MX_ROW, vov, vob); }
    P9G_PAIR(0, o0) P9G_PAIR(1, o0) P9G_PAIR(2, o0) P9G_PAIR(3, o0) P9G_PAIR(4, o1) P9G_PAIR(5, o1) P9G_PAIR(6, o1) P9G_PAIR(7, o1)
    P9G_PAIR(8, o2) P9G_PAIR(9, o2) P9G_PAIR(10, o2) P9G_PAIR(11, o2) P9G_PAIR(12, o3) P9G_PAIR(13, o3) P9G_PAIR(14, o3) P9G_PAIR(15, o3)
#undef P9G_PAIR
}
__device__ __forceinline__ void p9_group_mx(Frame& F, int g, const float* g_ffn, const float* g_fin) {
    unsigned char* ws = F.ws; const int lane = pg8::fresh_lane();
    const unsigned char* EUV = ws + WS_EU;
    const __amdgpu_buffer_rsrc_t rs = __builtin_amdgcn_make_buffer_rsrc((void*)EUV, (short)0, 16384 * MX_ROW, 0x00020000);
    LAS unsigned char* wl = F.lds + F.wave * WAVE_LDS;
    LAS int* sid = (LAS int*)wl; LAS float* sgt = (LAS float*)(wl + 2048); LAS unsigned char* h8 = wl + 4096;
#pragma unroll 1
    for (int tk = 0; tk < 4; ++tk) {
        const int t = 4 * g + tk;
        const bf16* xrow = (const bf16*)(ws + WS_X1B) + (size_t)t * D;
        const float rs2 = __builtin_amdgcn_rsqf(pg8::sum16((const float*)(ws + WS_ROWSS) + (size_t)t * 16) * (1.0f / D) + EPS);
        { const v4u a0 = *(const v4u*)(xrow + 16 * lane), a1 = *(const v4u*)(xrow + 16 * lane + 8); v4u o;
          const unsigned xs[8] = {a0.x, a0.y, a0.z, a0.w, a1.x, a1.y, a1.z, a1.w};
#pragma unroll
          for (int j = 0; j < 4; ++j) { const f32x4 gg = *(const f32x4*)(g_ffn + 16 * lane + 4 * j);
              int p = __builtin_amdgcn_cvt_pk_fp8_f32(bflo(xs[2 * j]) * rs2 * gg[0], bfhi(xs[2 * j]) * rs2 * gg[1], 0, false);
              p = __builtin_amdgcn_cvt_pk_fp8_f32(bflo(xs[2 * j + 1]) * rs2 * gg[2], bfhi(xs[2 * j + 1]) * rs2 * gg[3], p, true); o[j] = (unsigned)p; }
          *(LAS v4u*)(h8 + tk * G_HSTR + 16 * lane) = o; }
        const int* IDX = (const int*)(ws + WS_IDX) + (size_t)t * 128; const float* GT = (const float*)(ws + WS_GATE) + (size_t)t * 128;
        { const int a0 = IDX[lane], b0 = IDX[64 + lane]; const float ga = GT[lane], gb = GT[64 + lane];
            const int kA = (int)(((unsigned)a0 * 2654435761u) >> 27), kB = (int)(((unsigned)b0 * 2654435761u) >> 27); const unsigned long long lt = (1ull << lane) - 1ull;
          int base = 0, rA = 0, rB = 0;
#pragma unroll 4
          for (int k = 0; k < 32; ++k) { const unsigned long long mA = __ballot(kA == k), mB = __ballot(kB == k); const int cA = __popcll(mA), cB = __popcll(mB);
              if (kA == k) rA = base + __popcll(mA & lt);
              if (kB == k) rB = base + cA + __popcll(mB & lt);
              base += cA + cB; }
          sid[tk * 128 + rA] = a0; sid[tk * 128 + rB] = b0; sgt[tk * 128 + rA] = ga; sgt[tk * 128 + rB] = gb; }
    }
    LDS_WAIT(); asm volatile("" ::: "memory");
    f32x2v o0[8], o1[8], o2[8], o3[8];
#pragma unroll
    for (int i = 0; i < 8; ++i) { o0[i] = (f32x2v){0.f, 0.f}; o1[i] = o0[i]; o2[i] = o0[i]; o3[i] = o0[i]; }
    AFrag A; VSlot V[16]; BFrag B; p9g_load_b(B, h8, lane);
    LAS int* sidl = sid + ((lane & 15) >> 2) * 128 + (lane & 3);
    LAS float* sgtl = sgt + (lane >> 4) * 128;
    v4s rsrc; { const unsigned long long ba = (unsigned long long)EUV; rsrc.x = (unsigned)__builtin_amdgcn_readfirstlane((int)(unsigned)ba); rsrc.y = (unsigned)__builtin_amdgcn_readfirstlane((int)(unsigned)(ba >> 32)) & 0xffffu; rsrc.z = 16384u * MX_ROW; rsrc.w = 0x00020000u; }
    { const int idc = sidl[0];
      const unsigned rowo = (unsigned)idc * MX_ROW + (unsigned)((lane >> 4) * 8); p9g_issue_a(A, rsrc, rowo + (unsigned)((lane >> 4) * 8), rowo);
#pragma unroll
      for (int p = 0; p < 16; ++p) p9g_issue_v(V[p], rsrc, __builtin_amdgcn_readlane(idc, p) * MX_ROW, 8u * (unsigned)lane, (unsigned)lane); }
#pragma unroll 1
    for (int b = 0; b < 31; ++b) {
        const int idn = sidl[4 * (b + 1)];
        p9g_batch<true>(A, V, B, sgtl, rsrc, b, idn, lane, o0, o1, o2, o3);
    }
    p9g_batch<false>(A, V, B, sgtl, rsrc, 31, 0, lane, o0, o1, o2, o3);
    LDS_WAIT(); asm volatile("" ::: "memory");
#define P9G_EPI(TK, O) { const int t = 4 * g + (TK); const bf16* xrow = (const bf16*)(ws + WS_X1B) + (size_t)t * D; float* orow = F.out + (size_t)t * D; \
        float oacc[16]; _Pragma("unroll") for (int k = 0; k < 8; ++k) { oacc[2 * k] = O[k].x; oacc[2 * k + 1] = O[k].y; } \
        float ss = 0.f; \
        _Pragma("unroll") for (int j = 0; j < 4; ++j) { const v2u a = *(const v2u*)(xrow + 256 * j + 4 * lane); \
            oacc[4 * j] += bflo(a.x); oacc[4 * j + 1] += bfhi(a.x); oacc[4 * j + 2] += bflo(a.y); oacc[4 * j + 3] += bfhi(a.y); \
            _Pragma("unroll") for (int i = 0; i < 4; ++i) ss += oacc[4 * j + i] * oacc[4 * j + i]; } \
        ss += swz_xor<1>(ss); ss += swz_xor<2>(ss); ss += swz_xor<4>(ss); ss += swz_xor<8>(ss); ss += swz_xor<16>(ss); ss += bperm(ss, lane ^ 32); \
        const float rs3 = __builtin_amdgcn_rsqf(ss * (1.0f / D) + EPS); \
        _Pragma("unroll") for (int j = 0; j < 4; ++j) { const f32x4 gg = *(const f32x4*)(g_fin + 256 * j + 4 * lane); f32x4 ov; \
            _Pragma("unroll") for (int i = 0; i < 4; ++i) ov[i] = oacc[4 * j + i] * rs3 * gg[i]; \
            *(f32x4*)(orow + 256 * j + 4 * lane) = ov; } }
    P9G_EPI(0, o0) P9G_EPI(1, o1) P9G_EPI(2, o2) P9G_EPI(3, o3)
#undef P9G_EPI
}
#ifdef DBG_P9
__device__ __forceinline__ void p9_token_dbg(Frame& F, int t, const float* g_ffn, const float* g_fin) {
    unsigned char* ws = F.ws; const int lane = pg8::fresh_lane();
    const unsigned char* EUV = ws + WS_EU;
    const __amdgpu_buffer_rsrc_t rs = __builtin_amdgcn_make_buffer_rsrc((void*)EUV, (short)0, 16384 * MX_ROW, 0x00020000);
    const bf16* xrow = (const bf16*)(ws + WS_X1B) + (size_t)t * D; float* orow = F.out + (size_t)t * D;
    const float rs2 = __builtin_amdgcn_rsqf(pg8::sum16((const float*)(ws + WS_ROWSS) + (size_t)t * 16) * (1.0f / D) + EPS);
    LAS unsigned char* wl = F.lds + F.wave * WAVE_LDS;
    LAS int* sid = (LAS int*)wl; LAS float* sgt = (LAS float*)(sid + 128); LAS unsigned char* h8 = wl + 1024;
    { const v4u a0 = *(const v4u*)(xrow + 16 * lane), a1 = *(const v4u*)(xrow + 16 * lane + 8); v4u o;
      const unsigned xs[8] = {a0.x, a0.y, a0.z, a0.w, a1.x, a1.y, a1.z, a1.w};
#pragma unroll
      for (int j = 0; j < 4; ++j) { const f32x4 g = *(const f32x4*)(g_ffn + 16 * lane + 4 * j);
          int p = __builtin_amdgcn_cvt_pk_fp8_f32(bflo(xs[2 * j]) * rs2 * g[0], bfhi(xs[2 * j]) * rs2 * g[1], 0, false);
          p = __builtin_amdgcn_cvt_pk_fp8_f32(bflo(xs[2 * j + 1]) * rs2 * g[2], bfhi(xs[2 * j + 1]) * rs2 * g[3], p, true); o[j] = (unsigned)p; }
      *(LAS v4u*)(h8 + 16 * lane) = o; }
    const int* IDX = (const int*)(ws + WS_IDX) + (size_t)t * 128; const float* GT = (const float*)(ws + WS_GATE) + (size_t)t * 128;
    sid[lane] = IDX[lane]; sid[64 + lane] = IDX[64 + lane]; sgt[lane] = GT[lane]; sgt[64 + lane] = GT[64 + lane];
    LDS_WAIT(); asm volatile("" ::: "memory");
    f32x2v o[8];
#pragma unroll
    for (int i = 0; i < 8; ++i) o[i] = (f32x2v){0.f, 0.f};
#pragma unroll 1
    for (int b = 0; b < 8; ++b) {
        const int idc = sid[16 * b + (lane & 15)];
        f32x4 dd = {0.f, 0.f, 0.f, 0.f};
#if DBG_P9 == 2
        { AFrag A; p9m_load_a(A, EUV, idc, lane); dd = p9m_dots(A, h8, lane); }
#else
#pragma unroll 1
        for (int i = 0; i < 16; ++i) { const int e = __builtin_amdgcn_readlane(idc, i); const unsigned char* rec = EUV + (size_t)e * MX_ROW;
            const v2u uu = *(const v2u*)(rec + 8 * lane); const int blk = lane >> 1; const unsigned sb = rec[MX_USC + (blk & 3) * 8 + (blk >> 2)];
            const v4u hh = *(LAS v4u*)(h8 + 16 * lane);
            float f0[8], f1[8]; unpack8_f4(uu.x, f0); unpack8_f4(uu.y, f1); float acc = 0.f;
#define DBG_ACC(HW, F, O4) { const f32x2v lo = __builtin_amdgcn_cvt_pk_f32_fp8((int)(HW), false), hi = __builtin_amdgcn_cvt_pk_f32_fp8((int)(HW), true); acc += F[O4] * lo.x + F[O4 + 1] * lo.y + F[O4 + 2] * hi.x + F[O4 + 3] * hi.y; }
            DBG_ACC(hh.x, f0, 0) DBG_ACC(hh.y, f0, 4) DBG_ACC(hh.z, f1, 0) DBG_ACC(hh.w, f1, 4)
#undef DBG_ACC
            acc *= __builtin_bit_cast(float, sb << 23);
            acc += swz_xor<1>(acc); acc += swz_xor<2>(acc); acc += swz_xor<4>(acc); acc += swz_xor<8>(acc); acc += swz_xor<16>(acc); acc += bperm(acc, lane ^ 32);
            if ((lane >> 4) == (i >> 2)) { if ((i & 3) == 0) dd[0] = acc; if ((i & 3) == 1) dd[1] = acc; if ((i & 3) == 2) dd[2] = acc; if ((i & 3) == 3) dd[3] = acc; } }
#endif
        const f32x4 gt = *(LAS f32x4*)(sgt + 16 * b + 4 * (lane >> 4));
        float c[4];
#pragma unroll
        for (int r = 0; r < 4; ++r) c[r] = gt[r] * gelu_erf(dd[r]);
#pragma unroll 1
        for (int p = 0; p < 16; ++p) { VSlot V; p9m_load_v(V, rs, __builtin_amdgcn_readlane(idc, p), lane);
            const float cs = (p & 3) == 0 ? c[0] : (p & 3) == 1 ? c[1] : (p & 3) == 2 ? c[2] : c[3];
            p9m_axpy(V, rdl(cs, 16 * (p >> 2)), o); }
    }
    LDS_WAIT(); asm volatile("" ::: "memory");
    float oacc[16];
#pragma unroll
    for (int k = 0; k < 8; ++k) { oacc[2 * k] = o[k].x; oacc[2 * k + 1] = o[k].y; }
    float ss = 0.f;
#pragma unroll
    for (int j = 0; j < 4; ++j) { const v2u a = *(const v2u*)(xrow + 256 * j + 4 * lane);
        oacc[4 * j] += bflo(a.x); oacc[4 * j + 1] += bfhi(a.x); oacc[4 * j + 2] += bflo(a.y); oacc[4 * j + 3] += bfhi(a.y);
#pragma unroll
        for (int i = 0; i < 4; ++i) ss += oacc[4 * j + i] * oacc[4 * j + i]; }
    ss += swz_xor<1>(ss); ss += swz_xor<2>(ss); ss += swz_xor<4>(ss); ss += swz_xor<8>(ss); ss += swz_xor<16>(ss); ss += bperm(ss, lane ^ 32);
    const float rs3 = __builtin_amdgcn_rsqf(ss * (1.0f / D) + EPS);
#pragma unroll
    for (int j = 0; j < 4; ++j) { const f32x4 g = *(const f32x4*)(g_fin + 256 * j + 4 * lane); f32x4 ov;
#pragma unroll
        for (int i = 0; i < 4; ++i) ov[i] = oacc[4 * j + i] * rs3 * g[i];
        *(f32x4*)(orow + 256 * j + 4 * lane) = ov; }
}
#endif
__device__ __forceinline__ void p9_token_mx(Frame& F, int t, const float* g_ffn, const float* g_fin) {
    unsigned char* ws = F.ws; const int lane = pg8::fresh_lane();
    const unsigned char* EUV = ws + WS_EU;
    const __amdgpu_buffer_rsrc_t rs = __builtin_amdgcn_make_buffer_rsrc((void*)EUV, (short)0, 16384 * MX_ROW, 0x00020000);
    const bf16* xrow = (const bf16*)(ws + WS_X1B) + (size_t)t * D; float* orow = F.out + (size_t)t * D;
    const float rs2 = __builtin_amdgcn_rsqf(pg8::sum16((const float*)(ws + WS_ROWSS) + (size_t)t * 16) * (1.0f / D) + EPS);
    LAS unsigned char* wl = F.lds + F.wave * WAVE_LDS;
    LAS int* sid = (LAS int*)wl; LAS float* sgt = (LAS float*)(sid + 128); LAS unsigned char* h8 = wl + 1024;
    { const v4u a0 = *(const v4u*)(xrow + 16 * lane), a1 = *(const v4u*)(xrow + 16 * lane + 8); v4u o;
      const unsigned xs[8] = {a0.x, a0.y, a0.z, a0.w, a1.x, a1.y, a1.z, a1.w};
#pragma unroll
      for (int j = 0; j < 4; ++j) { const f32x4 g = *(const f32x4*)(g_ffn + 16 * lane + 4 * j);
          int p = __builtin_amdgcn_cvt_pk_fp8_f32(bflo(xs[2 * j]) * rs2 * g[0], bfhi(xs[2 * j]) * rs2 * g[1], 0, false);
          p = __builtin_amdgcn_cvt_pk_fp8_f32(bflo(xs[2 * j + 1]) * rs2 * g[2], bfhi(xs[2 * j + 1]) * rs2 * g[3], p, true); o[j] = (unsigned)p; }
      *(LAS v4u*)(h8 + 16 * lane) = o; }
    const int* IDX = (const int*)(ws + WS_IDX) + (size_t)t * 128; const float* GT = (const float*)(ws + WS_GATE) + (size_t)t * 128;
    { const int a0 = IDX[lane], b0 = IDX[64 + lane]; const float ga = GT[lane], gb = GT[64 + lane];
      const int kA = a0 >> 10, kB = b0 >> 10; const unsigned long long lt = (1ull << lane) - 1ull;
      int base = 0, rA = 0, rB = 0;
#pragma unroll
      for (int k = 0; k < 16; ++k) { const unsigned long long mA = __ballot(kA == k), mB = __ballot(kB == k); const int cA = __popcll(mA), cB = __popcll(mB);
          if (kA == k) rA = base + __popcll(mA & lt);
          if (kB == k) rB = base + cA + __popcll(mB & lt);
          base += cA + cB; }
      sid[rA] = a0; sid[rB] = b0; sgt[rA] = ga; sgt[rB] = gb;
      LDS_WAIT(); asm volatile("" ::: "memory"); }
    f32x2v o[8];
#pragma unroll
    for (int i = 0; i < 8; ++i) o[i] = (f32x2v){0.f, 0.f};
    AFrag A0, A1; VSlot V[16];
    int idc = sid[lane & 15];
    p9m_load_a(A0, EUV, idc, lane);
#pragma unroll
    for (int p = 0; p < 16; ++p) p9m_load_v(V[p], rs, __builtin_amdgcn_readlane(idc, p), lane);
#pragma unroll 1
    for (int b = 0; b < 8; b += 2) {
        const int id1 = sid[16 * (b + 1) + (lane & 15)];
        p9m_load_a(A1, EUV, id1, lane); asm volatile("" ::: "memory");
        p9m_batch(A0, V, h8, sgt, rs, b, id1, lane, o); asm volatile("" ::: "memory");
        const int b2 = (b + 2 < 8) ? b + 2 : 7;
        const int id2 = sid[16 * b2 + (lane & 15)];
        p9m_load_a(A0, EUV, id2, lane); asm volatile("" ::: "memory");
        p9m_batch(A1, V, h8, sgt, rs, b + 1, id2, lane, o); asm volatile("" ::: "memory");
    }
    LDS_WAIT(); asm volatile("" ::: "memory");
    float oacc[16];
#pragma unroll
    for (int k = 0; k < 8; ++k) { oacc[2 * k] = o[k].x; oacc[2 * k + 1] = o[k].y; }
    float ss = 0.f;
#pragma unroll
    for (int j = 0; j < 4; ++j) { const v2u a = *(const v2u*)(xrow + 256 * j + 4 * lane);
        oacc[4 * j] += bflo(a.x); oacc[4 * j + 1] += bfhi(a.x); oacc[4 * j + 2] += bflo(a.y); oacc[4 * j + 3] += bfhi(a.y);
#pragma unroll
        for (int i = 0; i < 4; ++i) ss += oacc[4 * j + i] * oacc[4 * j + i]; }
    ss += swz_xor<1>(ss); ss += swz_xor<2>(ss); ss += swz_xor<4>(ss); ss += swz_xor<8>(ss); ss += swz_xor<16>(ss); ss += bperm(ss, lane ^ 32);
    const float rs3 = __builtin_amdgcn_rsqf(ss * (1.0f / D) + EPS);
#pragma unroll
    for (int j = 0; j < 4; ++j) { const f32x4 g = *(const f32x4*)(g_fin + 256 * j + 4 * lane); f32x4 ov;
#pragma unroll
        for (int i = 0; i < 4; ++i) ov[i] = oacc[4 * j + i] * rs3 * g[i];
        *(f32x4*)(orow + 256 * j + 4 * lane) = ov; }
}
struct Rows8 { v4u u[8], v[8]; };
__device__ __forceinline__ void p9_load8(Rows8& R, const unsigned char* EU, const unsigned char* EV, const int (&e)[8], int lane) {
#pragma unroll
    for (int j = 0; j < 8; ++j) { R.u[j] = *(const v4u*)(EU + (size_t)e[j] * 1024 + 16 * lane); R.v[j] = *(const v4u*)(EV + (size_t)e[j] * 1024 + 16 * lane); }
}
__device__ __forceinline__ void p9_token_f8(Frame& F, int t, const float* g_ffn, const float* g_fin) {
    unsigned char* ws = F.ws; const int lane = pg8::fresh_lane(), hh = lane >> 5, q4 = (lane >> 4) & 1, q3 = (lane >> 3) & 1;
    const unsigned char* EU = ws + WS_EU; const unsigned char* EV = ws + WS_EV; const float* ISU = (const float*)(ws + WS_ESC); const float* ISV = ISU + 16384;
    const bf16* xrow = (const bf16*)(ws + WS_X1B) + (size_t)t * D; float* orow = F.out + (size_t)t * D;
    const float rs2 = __builtin_amdgcn_rsqf(pg8::sum16((const float*)(ws + WS_ROWSS) + (size_t)t * 16) * (1.0f / D) + EPS);
    float hn[16];
#pragma unroll
    for (int j = 0; j < 4; ++j) { const v2u a = *(const v2u*)(xrow + 256 * j + 4 * lane); const f32x4 g = *(const f32x4*)(g_ffn + 256 * j + 4 * lane);
        hn[4 * j] = bflo(a.x) * rs2 * g[0]; hn[4 * j + 1] = bfhi(a.x) * rs2 * g[1]; hn[4 * j + 2] = bflo(a.y) * rs2 * g[2]; hn[4 * j + 3] = bfhi(a.y) * rs2 * g[3]; }
    const int* IDX = (const int*)(ws + WS_IDX) + (size_t)t * 128; const float* GT = (const float*)(ws + WS_GATE) + (size_t)t * 128;
    int idA, idB; float suA, suB, gvA, gvB;
    { const int a0 = IDX[lane], b0 = IDX[64 + lane];
      const float sa = ISU[a0], sb = ISU[b0], ga = GT[lane] * ISV[a0], gb = GT[64 + lane] * ISV[b0];
      const int kA = a0 >> 10, kB = b0 >> 10; const unsigned long long lt = (1ull << lane) - 1ull;
      int base = 0, rA = 0, rB = 0;
#pragma unroll
      for (int k = 0; k < 16; ++k) { const unsigned long long mA = __ballot(kA == k), mB = __ballot(kB == k); const int cA = __popcll(mA), cB = __popcll(mB);
          if (kA == k) rA = base + __popcll(mA & lt);
          if (kB == k) rB = base + cA + __popcll(mB & lt);
          base += cA + cB; }
      LAS int* sid = (LAS int*)(F.lds + F.wave * WAVE_LDS); LAS float* ssu = (LAS float*)(sid + 128); LAS float* sgv = ssu + 128;
      sid[rA] = a0; sid[rB] = b0; ssu[rA] = sa; ssu[rB] = sb; sgv[rA] = ga; sgv[rB] = gb;
      LDS_WAIT(); asm volatile("" ::: "memory");
      idA = sid[lane]; idB = sid[64 + lane]; suA = ssu[lane]; suB = ssu[64 + lane]; gvA = sgv[lane]; gvB = sgv[64 + lane];
      LDS_WAIT(); asm volatile("" ::: "memory"); }
    float oacc[16];
#pragma unroll
    for (int i = 0; i < 16; ++i) oacc[i] = 0.f;
    const int jsel = 4 * hh + 2 * q4 + q3;
    Rows8 R;
    { int e[8];
#pragma unroll
      for (int j = 0; j < 8; ++j) e[j] = __builtin_amdgcn_readlane(idA, j);
      p9_load8(R, EU, EV, e, lane); }
    for (int bt = 0; bt < 16; ++bt) {
        Rows8 Rn;
        { const int nb = (bt + 1) & 15; int e[8];
#pragma unroll
          for (int j = 0; j < 8; ++j) { const int n = 8 * nb + j; e[j] = (nb < 8) ? __builtin_amdgcn_readlane(idA, n & 63) : __builtin_amdgcn_readlane(idB, n & 63); }
          p9_load8(Rn, EU, EV, e, lane); }
        float pd[8];
#pragma unroll
        for (int j = 0; j < 8; ++j) { float a = 0.f, b = 0.f;
#pragma unroll
            for (int d = 0; d < 4; ++d) { const f32x2v lo = __builtin_amdgcn_cvt_pk_f32_fp8((int)R.u[j][d], false), hi = __builtin_amdgcn_cvt_pk_f32_fp8((int)R.u[j][d], true);
                a += lo.x * hn[4 * d] + hi.x * hn[4 * d + 2]; b += lo.y * hn[4 * d + 1] + hi.y * hn[4 * d + 3]; }
            pd[j] = a + b; }
        float r4[4], r2[2];
#pragma unroll
        for (int i = 0; i < 4; ++i) { const float keep = hh ? pd[4 + i] : pd[i], send = hh ? pd[i] : pd[4 + i]; r4[i] = keep + __shfl_xor(send, 32); }
#pragma unroll
        for (int i = 0; i < 2; ++i) { const float keep = q4 ? r4[2 + i] : r4[i], send = q4 ? r4[i] : r4[2 + i]; r2[i] = keep + __shfl_xor(send, 16); }
        float v = (q3 ? r2[1] : r2[0]) + __shfl_xor(q3 ? r2[0] : r2[1], 8);
        v += __shfl_xor(v, 4); v += __shfl_xor(v, 2); v += __shfl_xor(v, 1);
        const int n = 8 * bt + jsel;
        const float su = (bt < 8) ? __shfl(suA, n & 63) : __shfl(suB, n & 63), gv = (bt < 8) ? __shfl(gvA, n & 63) : __shfl(gvB, n & 63);
        const float w = gv * gelu_erf(v * su);
#pragma unroll
        for (int j = 0; j < 8; ++j) { const float wj = rdl(w, 8 * j);
#pragma unroll
            for (int d = 0; d < 4; ++d) { const f32x2v lo = __builtin_amdgcn_cvt_pk_f32_fp8((int)R.v[j][d], false), hi = __builtin_amdgcn_cvt_pk_f32_fp8((int)R.v[j][d], true);
                oacc[4 * d] += wj * lo.x; oacc[4 * d + 1] += wj * lo.y; oacc[4 * d + 2] += wj * hi.x; oacc[4 * d + 3] += wj * hi.y; } }
        R = Rn;
    }
    asm volatile("" ::: "memory");
    float ss = 0.f;
#pragma unroll
    for (int j = 0; j < 4; ++j) { const v2u a = *(const v2u*)(xrow + 256 * j + 4 * lane);
        oacc[4 * j] += bflo(a.x); oacc[4 * j + 1] += bfhi(a.x); oacc[4 * j + 2] += bflo(a.y); oacc[4 * j + 3] += bfhi(a.y);
#pragma unroll
        for (int i = 0; i < 4; ++i) ss += oacc[4 * j + i] * oacc[4 * j + i]; }
    ss = wave_sum(ss);
    const float rs3 = __builtin_amdgcn_rsqf(ss * (1.0f / D) + EPS);
#pragma unroll
    for (int j = 0; j < 4; ++j) { const f32x4 g = *(const f32x4*)(g_fin + 256 * j + 4 * lane); f32x4 o;
#pragma unroll
        for (int i = 0; i < 4; ++i) o[i] = oacc[4 * j + i] * rs3 * g[i];
        *(f32x4*)(orow + 256 * j + 4 * lane) = o; }
}
struct Rows4 { v4u ua[4], ub[4], va[4], vb[4]; };
__device__ __forceinline__ void p9_load(Rows4& R, const bf16* EU, const bf16* EV, const int (&e)[4], int lane) {
#pragma unroll
    for (int j = 0; j < 4; ++j) { const bf16* up = EU + (size_t)e[j] * 1024 + lane * 8; const bf16* vp = EV + (size_t)e[j] * 1024 + lane * 8;
        R.ua[j] = *(const v4u*)up; R.ub[j] = *(const v4u*)(up + 512); R.va[j] = *(const v4u*)vp; R.vb[j] = *(const v4u*)(vp + 512); }
}
__device__ __forceinline__ void p9_token(Frame& F, int t, const float* g_ffn, const float* g_fin) {
    unsigned char* ws = F.ws; const int lane = pg8::fresh_lane(), hh = lane >> 5, q4 = (lane >> 4) & 1;
    const bf16* EU = (const bf16*)(ws + WS_EU); const bf16* EV = (const bf16*)(ws + WS_EV);
    const float* xrow = (const float*)(ws + WS_X1) + (size_t)t * D; float* orow = F.out + (size_t)t * D;
    const float rs2 = __builtin_amdgcn_rsqf(pg8::sum16((const float*)(ws + WS_ROWSS) + (size_t)t * 16) * (1.0f / D) + EPS);
    float x1[16];
    { const f32x4 a0 = *(const f32x4*)(xrow + lane * 8), a1 = *(const f32x4*)(xrow + lane * 8 + 4), b0 = *(const f32x4*)(xrow + 512 + lane * 8), b1 = *(const f32x4*)(xrow + 512 + lane * 8 + 4);
#pragma unroll
      for (int i = 0; i < 4; ++i) { x1[i] = a0[i]; x1[4 + i] = a1[i]; x1[8 + i] = b0[i]; x1[12 + i] = b1[i]; } }
    unsigned hn[8];
    { const f32x4 a0 = *(const f32x4*)(g_ffn + lane * 8), a1 = *(const f32x4*)(g_ffn + lane * 8 + 4), b0 = *(const f32x4*)(g_ffn + 512 + lane * 8), b1 = *(const f32x4*)(g_ffn + 512 + lane * 8 + 4);
      float g[16];
#pragma unroll
      for (int i = 0; i < 4; ++i) { g[i] = a0[i]; g[4 + i] = a1[i]; g[8 + i] = b0[i]; g[12 + i] = b1[i]; }
#pragma unroll
      for (int i = 0; i < 8; ++i) hn[i] = pk2(x1[2 * i] * rs2 * g[2 * i], x1[2 * i + 1] * rs2 * g[2 * i + 1]); }
    const int* IDX = (const int*)(ws + WS_IDX) + (size_t)t * 128; const float* GT = (const float*)(ws + WS_GATE) + (size_t)t * 128;
    const int idA = IDX[lane], idB = IDX[64 + lane]; const float gtA = GT[lane], gtB = GT[64 + lane];
    float oacc[16];
#pragma unroll
    for (int i = 0; i < 16; ++i) oacc[i] = 0.f;
    const int jsel = 2 * hh + q4;
    Rows4 R;
    { int e[4];
#pragma unroll
      for (int j = 0; j < 4; ++j) e[j] = __builtin_amdgcn_readlane(idA, j);
      p9_load(R, EU, EV, e, lane); }
#ifndef DBG_NBATCH
#define DBG_NBATCH 32
#endif
    for (int bt = 0; bt < DBG_NBATCH; ++bt) {
        Rows4 Rn;
        { const int nb = (bt + 1) & 31; int e[4];
#pragma unroll
          for (int j = 0; j < 4; ++j) { const int n = 4 * nb + j; e[j] = (nb < 16) ? __builtin_amdgcn_readlane(idA, n & 63) : __builtin_amdgcn_readlane(idB, n & 63); }
          p9_load(Rn, EU, EV, e, lane); }
        float pd[4];
#pragma unroll
        for (int j = 0; j < 4; ++j) { float a = 0.f, b = 0.f;
            a = dot2bf(R.ua[j].x, hn[0], a); b = dot2bf(R.ua[j].y, hn[1], b); a = dot2bf(R.ua[j].z, hn[2], a); b = dot2bf(R.ua[j].w, hn[3], b);
            a = dot2bf(R.ub[j].x, hn[4], a); b = dot2bf(R.ub[j].y, hn[5], b); a = dot2bf(R.ub[j].z, hn[6], a); b = dot2bf(R.ub[j].w, hn[7], b); pd[j] = a + b; }
        const float k0 = hh ? pd[2] : pd[0], k1 = hh ? pd[3] : pd[1], s0 = hh ? pd[0] : pd[2], s1 = hh ? pd[1] : pd[3];
        const float r0 = k0 + __shfl_xor(s0, 32), r1 = k1 + __shfl_xor(s1, 32);
        float v = (q4 ? r1 : r0) + __shfl_xor(q4 ? r0 : r1, 16);
        v += __shfl_xor(v, 8); v += __shfl_xor(v, 4); v += __shfl_xor(v, 2); v += __shfl_xor(v, 1);
        const int n = 4 * bt + jsel; const float gsel = (bt < 16) ? __shfl(gtA, n & 63) : __shfl(gtB, n & 63);
        const float w = gsel * gelu_erf(v);
        const float w0 = __builtin_bit_cast(float, __builtin_amdgcn_readlane(__builtin_bit_cast(int, w), 0)), w1 = __builtin_bit_cast(float, __builtin_amdgcn_readlane(__builtin_bit_cast(int, w), 16)),
                    w2 = __builtin_bit_cast(float, __builtin_amdgcn_readlane(__builtin_bit_cast(int, w), 32)), w3 = __builtin_bit_cast(float, __builtin_amdgcn_readlane(__builtin_bit_cast(int, w), 48));
        const float wj[4] = {w0, w1, w2, w3};
#pragma unroll
        for (int j = 0; j < 4; ++j) {
            const unsigned va[4] = {R.va[j].x, R.va[j].y, R.va[j].z, R.va[j].w}, vb[4] = {R.vb[j].x, R.vb[j].y, R.vb[j].z, R.vb[j].w};
#pragma unroll
            for (int i = 0; i < 4; ++i) { oacc[2 * i] += wj[j] * bflo(va[i]); oacc[2 * i + 1] += wj[j] * bfhi(va[i]); oacc[8 + 2 * i] += wj[j] * bflo(vb[i]); oacc[8 + 2 * i + 1] += wj[j] * bfhi(vb[i]); }
        }
        R = Rn;
    }
    float ss = 0.f;
#pragma unroll
    for (int i = 0; i < 16; ++i) { x1[i] += oacc[i]; ss += x1[i] * x1[i]; }
    ss = wave_sum(ss);
#ifdef DBG_CHK
    const float rs3 = __builtin_amdgcn_rsqf(ss * (1.0f / D) + EPS) * chk_scale(F);
#else
    const float rs3 = __builtin_amdgcn_rsqf(ss * (1.0f / D) + EPS);
#endif
    { const f32x4 a0 = *(const f32x4*)(g_fin + lane * 8), a1 = *(const f32x4*)(g_fin + lane * 8 + 4), b0 = *(const f32x4*)(g_fin + 512 + lane * 8), b1 = *(const f32x4*)(g_fin + 512 + lane * 8 + 4);
      f32x4 o0, o1, o2, o3;
#pragma unroll
      for (int i = 0; i < 4; ++i) { o0[i] = x1[i] * rs3 * a0[i]; o1[i] = x1[4 + i] * rs3 * a1[i]; o2[i] = x1[8 + i] * rs3 * b0[i]; o3[i] = x1[12 + i] * rs3 * b1[i]; }
      *(f32x4*)(orow + lane * 8) = o0; *(f32x4*)(orow + lane * 8 + 4) = o1; *(f32x4*)(orow + 512 + lane * 8) = o2; *(f32x4*)(orow + 512 + lane * 8 + 4) = o3; }
}

__device__ __forceinline__ void dbg_dump_bf16(Frame& F, const bf16* src, int ld, int c0, int n) {
    const int gt = F.vcu * (NWAVES * 64) + F.wave * 64 + pg8::fresh_lane(), ngt = F.G * NWAVES * 64;
    for (long i = gt; i < (long)T * n; i += ngt) { const long t = i / n; const int c = (int)(i % n); F.out[t * 1024 + c0 + c] = bf2f(src[t * ld + c]); }
}
__device__ __forceinline__ void dbg_dump_f32(Frame& F, const float* src, long n, long o0) {
    const int gt = F.vcu * (NWAVES * 64) + F.wave * 64 + pg8::fresh_lane(), ngt = F.G * NWAVES * 64;
    for (long i = gt; i < n; i += ngt) F.out[o0 + i] = src[i];
}
__global__ void __launch_bounds__(NWAVES * 64, 2) fwd_kernel(Args args) {
    extern __shared__ __attribute__((aligned(16))) unsigned char lds[];
    Frame F;
    F.lds = (LAS unsigned char*)lds;
    F.wave = __builtin_amdgcn_readfirstlane((int)threadIdx.x >> 6);
    F.G = gridDim.x; { const int bx = blockIdx.x; F.vcu = (F.G % 8 == 0) ? (bx % 8) * (F.G / 8) + bx / 8 : bx; }
    F.gw = F.vcu * NWAVES + F.wave; F.ngw = F.G * NWAVES;
    F.out = args.out; F.ws = args.ws;
    unsigned char* ws = args.ws;
    volatile LAS unsigned* MISC = (volatile LAS unsigned*)(F.lds + MISC_OFF);
    for (int u = threadIdx.x; u < 256; u += NWAVES * 64) MISC[u] = 0u;
    __syncthreads();
    gu32* ctl = (gu32*)(ws + WS_CTL);
    XcdBarrier bar; bar.bar = (unsigned*)(ctl + CW_BAR); bar.x = 0; bar.st = nullptr;
    if (N_LAUNCHES != PER_PHASE) bar = xcd_barrier_post((unsigned*)(ctl + CW_BAR), MISC + 8);
#ifdef PROBE_DUP
#define DUPN(k) (((PROBE_DUP >> (k)) & 1) ? 2 : 1)
#else
#define DUPN(k) 1
#endif
#define GRID_BAR() do { if (N_LAUNCHES != PER_PHASE) xcd_barrier(bar); } while (0)
    const int lo = args.ph_lo, hi = args.ph_hi;
#ifdef ONLY_PH
#define IN(k) ((k) == ONLY_PH)
#else
#define IN(k) (lo <= (k) && (k) < hi)
#endif
#define BOTH(k) (IN(k) && IN((k) + 1))
    bf16* const XB = (bf16*)(ws + WS_XB);
    float* const rowss = (float*)(ws + WS_ROWSS);

    if (IN(0)) { for (int rep = 0; rep < DUPN(0); ++rep) p0_prologue(F, args); if (BOTH(0)) GRID_BAR(); }
    if (IN(1)) for (int rep = 0; rep < DUPN(1); ++rep) {
        { pg8::Gemm g{XB, (const bf16*)(ws + WS_WIN) + (size_t)512 * D, T, 3072, D}; pg8::StaticOrder S; S.init(T, 3072, F.G, (int)blockIdx.x);
          pg8::EpiInProj E{(const float*)(ws + WS_RSTD1), (const float*)(ws + WS_LB), (bf16*)(ws + WS_Q), (bf16*)(ws + WS_LF), (bf16*)(ws + WS_KK), (bf16*)(ws + WS_V), (bf16*)(ws + WS_SG),
                           (bf16*)(ws + WS_CB), (bf16*)(ws + WS_U), (bf16*)(ws + WS_GA), 0};
          pg8::gemm_phase<pg8::EpiInProj, pg8::StaticOrder, true, true>(F.lds, g, S, E, F.wave); }
        { pg8::Gemm g{(const bf16*)(ws + WS_X8), (const bf16*)(ws + WS_W8G), T, 2560, D / 2}; pg8::StaticOrder S; S.init(T, 2560, F.G, (int)blockIdx.x);
          pg8::EpiInProj E{(const float*)(ws + WS_RSTD1), (const float*)(ws + WS_LB), (bf16*)(ws + WS_Q), (bf16*)(ws + WS_LF), (bf16*)(ws + WS_KK), (bf16*)(ws + WS_V), (bf16*)(ws + WS_SG),
                           (bf16*)(ws + WS_CB), (bf16*)(ws + WS_U), (bf16*)(ws + WS_GA), 14};
          pg8::gemm_phase<pg8::EpiInProj, pg8::StaticOrder, true, true, true>(F.lds, g, S, E, F.wave); }
        if (BOTH(1)) GRID_BAR();
    }
    if (IN(2)) { p2_phase(F, args.in[5]); if (BOTH(2)) GRID_BAR(); }
    if (IN(3)) { for (int rep = 0; rep < DUPN(3); ++rep) p3_phase(F); if (BOTH(3)) GRID_BAR(); }
    if (IN(4)) { const float* gain = args.in[4]; for (int rep = 0; rep < DUPN(4); ++rep) for (int u = F.gw; u < NUNIT; u += F.ngw) p4_unit(F, u, gain); if (BOTH(4)) GRID_BAR(); }
    if (IN(5)) for (int rep = 0; rep < DUPN(5); ++rep) {
        pg8::Gemm g{(const bf16*)F.out, (const bf16*)(ws + WS_PAB), T, D, D}; pg8::StaticOrder S; S.init(T, D, F.G, (int)blockIdx.x);
        pg8::EpiMerged E{(const bf16*)(ws + WS_GA), (bf16*)(ws + WS_MG)};
        pg8::gemm_phase<pg8::EpiMerged, pg8::StaticOrder, true, true>(F.lds, g, S, E, F.wave);
        if (BOTH(5)) GRID_BAR();
    }
    if (IN(6)) for (int rep = 0; rep < DUPN(6); ++rep) {
        pg8::Gemm g{(const bf16*)(ws + WS_MG), (const bf16*)(ws + WS_WO), T, D, D}; pg8::StaticOrder S; S.init(T, D, F.G, (int)blockIdx.x);
        pg8::EpiOut E{XB, (float*)(ws + WS_X1), (bf16*)(ws + WS_X1B), rowss};
        pg8::gemm_phase<pg8::EpiOut, pg8::StaticOrder, true, true>(F.lds, g, S, E, F.wave);
        if (BOTH(6)) GRID_BAR();
    }
    if (IN(7)) for (int rep = 0; rep < DUPN(7); ++rep) {
        pg8::Gemm g{(const bf16*)(ws + WS_X1B), (const bf16*)(ws + WS_WQ), T, 2048, D}; pg8::StaticOrder S; S.init(T, 2048, F.G, (int)blockIdx.x);
        pg8::EpiQuery E{rowss, (bf16*)(ws + WS_QQ), EPS};
        pg8::gemm_phase<pg8::EpiQuery, pg8::StaticOrder, true, true>(F.lds, g, S, E, F.wave);
        if (BOTH(7)) GRID_BAR();
    }
    if (IN(8)) {
        const float* eu = args.in[13]; const float* ev = args.in[14]; const int ln = pg8::fresh_lane();
        int it = F.gw;
        for (int rep = 0; rep < DUPN(8); ++rep)
        for (int tile = F.vcu; tile < T / 32; tile += F.G) {
            p8_task(F, tile, F.wave);
            if (it + F.ngw < 16384) { cvt_expert_mx2(eu, ev, ws + WS_EU, it, it + F.ngw, ln); it += 2 * F.ngw; }
            else if (it < 16384) { cvt_expert_mx(eu, ev, ws + WS_EU, it, ln); it += F.ngw; }
        }
#pragma unroll 1
        for (; it < 16384; it += F.ngw) cvt_expert_mx(eu, ev, ws + WS_EU, it, ln);
        if (BOTH(8)) GRID_BAR();
    }
    if (IN(9)) { const float* g_ffn = args.in[9]; const float* g_fin = args.in[15];
        for (int rep = 0; rep < DUPN(9); ++rep)
#pragma unroll 1
        for (int g = F.gw; g < T / 4; g += F.ngw) p9_group_mx(F, g, g_ffn, g_fin);
    }
#undef IN
#undef BOTH
}

extern "C" void kernel_launch(void* const* d_in, const int* in_sizes, int n_in, void* d_out, int out_size, void* d_ws, size_t ws_size, hipStream_t stream) {
    static int grid = 0;
    if (grid == 0) {
        if (n_in != 16 || in_sizes[0] != T * D || out_size != T * D || ws_size < WS_END) { fprintf(stderr, "kernel_launch: unexpected shapes (n_in %d, in0 %d, out %d, ws %zu); nothing launched\n", n_in, n_in > 0 ? in_sizes[0] : -1, out_size, ws_size); grid = -1; return; }
        int dev = 0, cus = 0, per_cu = 0;
        if (hipGetDevice(&dev) != hipSuccess || hipDeviceGetAttribute(&cus, hipDeviceAttributeMultiprocessorCount, dev) != hipSuccess) { fprintf(stderr, "kernel_launch: device query failed\n"); grid = -1; return; }
        if (hipFuncSetAttribute((const void*)fwd_kernel, hipFuncAttributeMaxDynamicSharedMemorySize, LDS_BYTES) != hipSuccess) { fprintf(stderr, "kernel_launch: hipFuncSetAttribute failed\n"); grid = -1; return; }
        if (hipOccupancyMaxActiveBlocksPerMultiprocessor(&per_cu, (const void*)fwd_kernel, NWAVES * 64, LDS_BYTES) != hipSuccess || per_cu < 1)
            fprintf(stderr, "kernel_launch: note: occupancy query reports %d workgroups per CU\n", per_cu);
        (void)hipGetLastError();
        grid = cus;
    }
    if (grid < 0) return;
    if (hipMemsetAsync((char*)d_ws + WS_CTL, 0, CTL_ZERO_BYTES, stream) != hipSuccess) { fprintf(stderr, "kernel_launch: hipMemsetAsync failed\n"); return; }
    Args a{};
    for (int i = 0; i < 16; ++i) a.in[i] = (const float*)d_in[i];
    a.out = (float*)d_out; a.ws = (unsigned char*)d_ws;
    for (int li = 0; li < N_LAUNCHES; ++li) {
        a.ph_lo = (N_LAUNCHES == PER_PHASE) ? li : 0; a.ph_hi = (N_LAUNCHES == PER_PHASE) ? li + 1 : PER_PHASE; a.li = li;
#ifdef DBG_STOP
        if (li == DBG_STOP + 1) { a.ph_lo = 100; a.ph_hi = 101; }
        if (li > DBG_STOP + 1) break;
#endif
        hipLaunchKernelGGL(fwd_kernel, dim3(grid), dim3(NWAVES * 64), LDS_BYTES, stream, a);
#ifdef DBG_CHK
        if (N_LAUNCHES == PER_PHASE && (li == 1 || li == 4)) { Args c = a; c.ph_lo = 210 + li; c.ph_hi = 211 + li; hipLaunchKernelGGL(fwd_kernel, dim3(grid), dim3(NWAVES * 64), LDS_BYTES, stream, c); }
        if (N_LAUNCHES == PER_PHASE && (li == 0 || li == 1 || li == 2 || li == 5 || li == 6 || li == 7)) { Args c = a; c.ph_lo = 200 + li; c.ph_hi = 201 + li; hipLaunchKernelGGL(fwd_kernel, dim3(grid), dim3(NWAVES * 64), LDS_BYTES, stream, c); }
#endif
        const hipError_t le = hipPeekAtLastError();
        if (le != hipSuccess) { fprintf(stderr, "kernel_launch: launch %d failed: %s\n", li, hipGetErrorName(le)); break; }
    }
}
```

```cpp
#include <hip/hip_runtime.h>
#include <cstdio>
#include <cstdint>


#define DBG_ZYA 1.0f
#define DBG_ZYB 1.0f


#ifdef DBG_SWAPG
#define CHK_GA_ROW 4608
#define CHK_GB_ROW 3584
#else
#define CHK_GA_ROW 3584
#define CHK_GB_ROW 4608
#endif

#ifndef MK_N_LAUNCHES
#define MK_N_LAUNCHES 1
#endif
namespace pg8 {
#define PG8_LAS __attribute__((address_space(3)))
typedef unsigned short bf16_t;
typedef short bf16x8 __attribute__((ext_vector_type(8)));
typedef float f32x4 __attribute__((ext_vector_type(4)));
typedef int v4i_ __attribute__((ext_vector_type(4)));
typedef int v8i_ __attribute__((ext_vector_type(8)));
typedef unsigned u32x4 __attribute__((ext_vector_type(4)));
constexpr int BM = 256, BK = 64, HALF = 128, HTB = HALF * BK * 2  , STAGE_BYTES = 8 * HTB, NXCD = 8, WGM = 2;

__host__ __device__ __forceinline__ int lds_byte(int r, int c) { const int st = (r >> 4) * 2 + (c >> 5), rr = r & 15, cc = c & 31, ob = rr * 64 + cc * 2; return st * 1024 + (ob ^ (((ob >> 9) & 1) << 5)); }
__host__ __device__ __forceinline__ void stage_rc(int b, int& R, int& C) { const int st = b / 1024, sb = b % 1024, swz = sb ^ (((sb >> 9) & 1) << 5); R = (st >> 1) * 16 + swz / 64; C = (st & 1) * 32 + (swz % 64) / 2; }
__host__ __device__ __forceinline__ int perm32(int rho) { const int n = rho >> 4, i = rho & 15; return 8 * (i >> 2) + 4 * n + (i & 3); }

struct Unit { int pm, pn; };
struct Gemm { const bf16_t* A; const bf16_t* Bt; int M, N, K; };

struct StaticOrder {
    int nM, nN, nwg, G, c;
    __host__ __device__ void init(int M, int N, int G_, int c_) { nM = M / BM; nN = N / BM; nwg = nM * nN; G = G_; c = c_; }
    __host__ __device__ bool next(int i, Unit& u) const {
        if ((long)i * G + c >= nwg) return false;
#ifdef DBG_REV
        const int nr = (nwg - 1 - c) / G; const long L = (long)(nr - i) * G + c;
#else
        const long L = (long)i * G + c;
#endif
        int wgid = (int)L; { const int q = nwg / NXCD, r = nwg % NXCD, xcd = wgid % NXCD, off = wgid / NXCD; wgid = (xcd < r ? xcd * (q + 1) : r * (q + 1) + (xcd - r) * q) + off; }
        const int nig = WGM * nN, gid = wgid / nig, fm = gid * WGM, gsz = (nM - fm) < WGM ? (nM - fm) : WGM;
        u.pm = fm + ((wgid % nig) % gsz); u.pn = (wgid % nig) / gsz; return true;
    }
    __device__ __forceinline__ void a_ready(const Unit&) const {}
    __device__ __forceinline__ void done(const Unit&) const {}
};

__device__ __forceinline__ int fresh_lane() { int l; asm volatile("v_mbcnt_lo_u32_b32 %0, -1, 0\n\tv_mbcnt_hi_u32_b32 %0, -1, %0" : "=v"(l)); return l; }
__device__ __forceinline__ unsigned cvt_pk_bf16(float lo, float hi) { unsigned r; asm volatile("v_cvt_pk_bf16_f32 %0, %1, %2" : "=v"(r) : "v"(lo), "v"(hi)); return r; }
__device__ __forceinline__ float fexp(float x) { return __builtin_amdgcn_exp2f(x * 1.44269504089f); }
__device__ __forceinline__ float fsig(float x) { return __builtin_amdgcn_rcpf(1.0f + fexp(-x)); }
__device__ __forceinline__ float bflo(unsigned w) { return __builtin_bit_cast(float, w << 16); }
__device__ __forceinline__ float bfhi(unsigned w) { return __builtin_bit_cast(float, w & 0xffff0000u); }
__device__ __forceinline__ void st8(bf16_t* p, const float (&v)[8]) {
    u32x4 w; w.x = cvt_pk_bf16(v[0], v[1]); w.y = cvt_pk_bf16(v[2], v[3]); w.z = cvt_pk_bf16(v[4], v[5]); w.w = cvt_pk_bf16(v[6], v[7]); *(u32x4*)p = w; }
__device__ __forceinline__ void ld8(const bf16_t* p, float (&v)[8]) {
    const u32x4 w = *(const u32x4*)p; v[0] = bflo(w.x); v[1] = bfhi(w.x); v[2] = bflo(w.y); v[3] = bfhi(w.y); v[4] = bflo(w.z); v[5] = bfhi(w.z); v[6] = bflo(w.w); v[7] = bfhi(w.w); }

__device__ __forceinline__ float sum16(const float* p) {
    const f32x4 a = *(const f32x4*)p, b = *(const f32x4*)(p + 4), c = *(const f32x4*)(p + 8), d = *(const f32x4*)(p + 12);
    return (((a[0] + a[1]) + (a[2] + a[3])) + ((b[0] + b[1]) + (b[2] + b[3]))) + (((c[0] + c[1]) + (c[2] + c[3])) + ((d[0] + d[1]) + (d[2] + d[3]))); }
struct EpiInProj {
    static constexpr bool PERM = true, AFTER_DRAIN = false, MID = false;
    const float* rstd; const float* lb;
    bf16_t *Q, *LF, *KK, *V, *SG, *CB, *U, *GA;
    int pn_off;
    __device__ __forceinline__ void mid(f32x4 (&)[2][2][4][2], const Unit&, int, int, int, int) const {}
    template <int MODE> __device__ __forceinline__ void run(const f32x4 (&acc)[2][2][4][2], bf16_t* O, bf16_t* O2, int ldo, int cbase, int row0, int cl) const {
        float lbv[2][8];
#pragma unroll
        for (int bj = 0; bj < 2; ++bj)
#pragma unroll
            for (int i = 0; i < 8; ++i) lbv[bj][i] = (MODE == 1) ? lb[cbase + bj * HALF + cl + i] : 0.f;
#pragma unroll
        for (int ai = 0; ai < 2; ++ai)
#pragma unroll
            for (int m = 0; m < 4; ++m) { const int r = row0 + ai * HALF + m * 16; const float rs = rstd[r];
#pragma unroll
                for (int bj = 0; bj < 2; ++bj) { float v[8];
#pragma unroll
                    for (int i = 0; i < 8; ++i) { float x = acc[ai][bj][m][i >> 2][i & 3] * rs;
                        if (MODE == 0) { v[i] = x * fsig(x) * 0.125f; }
                        else if (MODE == 1) { x = fminf(fmaxf(x, -30.f), 30.f); const float ex = fexp(-x), sg = __builtin_amdgcn_rcpf(1.0f + ex), om = ex * sg;
                            v[i] = (1.0f - lbv[bj][i]) * om; }
                        else if (MODE == 2) { v[i] = x; }
                        else if (MODE == 3) { v[i] = x * fsig(x); }
                        else { v[i] = fsig(x); } }
                    const size_t off = (size_t)r * ldo + cbase + bj * HALF + cl;
                    st8(O + off, v); } }
    }
    __device__ __forceinline__ void operator()(const f32x4 (&acc)[2][2][4][2], const Unit& u, int wr, int wc, int fr, int fq) const {
        const int pn = (pn_off == 0) ? u.pn + 2 : (u.pn < 2 ? u.pn : u.pn + 12); int row0 = u.pm * BM + wr * 64 + fr, cl = wc * 32 + 8 * fq;
        asm volatile("" : "+v"(row0), "+v"(cl));
        if (pn < 2) run<0>(acc, Q, nullptr, 512, pn * 256, row0, cl);
        else if (pn < 4) run<1>(acc, KK, nullptr, 512, (pn - 2) * 256, row0, cl);
        else if (pn < 6) run<2>(acc, V, nullptr, 512, (pn - 4) * 256, row0, cl);
        else if (pn < 8) run<3>(acc, SG, nullptr, 512, (pn - 6) * 256, row0, cl);
        else if (pn < 10) run<2>(acc, CB, nullptr, 512, (pn - 8) * 256, row0, cl);
        else if (pn < 14) {
#pragma unroll
            for (int ai = 0; ai < 2; ++ai)
#pragma unroll
                for (int m = 0; m < 4; ++m) { const int r = row0 + ai * HALF + m * 16; const float rs = rstd[r], rs2 = rs * rs; float v[8];
#pragma unroll
                    for (int i = 0; i < 8; ++i) v[i] = acc[ai][0][m][i >> 2][i & 3] * acc[ai][1][m][i >> 2][i & 3] * rs2;
                    st8(U + (size_t)r * 512 + (pn - 10) * 128 + cl, v); }
        }
        else {
            unsigned char* G8 = (unsigned char*)GA + (size_t)(u.pm * 8 + (pn - 14)) * 65536 + (size_t)((wr * 4 + wc) * 64 + fq * 16 + fr) * 16;
#pragma unroll
            for (int ai = 0; ai < 2; ++ai)
#pragma unroll
                for (int m = 0; m < 4; ++m) { const int r = row0 + ai * HALF + m * 16; const float rs = rstd[r]; unsigned w[4] = {0u, 0u, 0u, 0u};
#pragma unroll
                    for (int bj = 0; bj < 2; ++bj)
#pragma unroll
                        for (int i = 0; i < 8; ++i) { const float gq = fmaxf(fsig(acc[ai][bj][m][i >> 2][i & 3] * rs) * 255.0f + 0.5f, 1.0f); w[2 * bj + (i >> 2)] = __builtin_amdgcn_cvt_pk_u8_f32(gq, i & 3, w[2 * bj + (i >> 2)]); }
                    u32x4 o; o.x = w[0]; o.y = w[1]; o.z = w[2]; o.w = w[3]; *(u32x4*)(G8 + (ai * 4 + m) * 8192) = o; }
        }
    }
};
struct EpiMerged {
    static constexpr bool PERM = true, AFTER_DRAIN = false, MID = true;
    const bf16_t *GAB; bf16_t* MG;
    static __device__ __forceinline__ float ub(unsigned w, int k) { return (float)((w >> (8 * k)) & 0xffu); }
    __device__ __forceinline__ void mid(f32x4 (&acc)[2][2][4][2], const Unit& u, int wr, int wc, int fr, int fq) const {
        int lt = (wr * 4 + wc) * 64 + fq * 16 + fr; asm volatile("" : "+v"(lt));
        const unsigned char* Ga = (const unsigned char*)GAB + (size_t)(u.pm * 8 + u.pn) * 65536 + (size_t)lt * 16; const unsigned char* Gb = Ga + (size_t)4 * 65536;
#pragma unroll
        for (int ai = 0; ai < 2; ++ai)
#pragma unroll
            for (int m = 0; m < 4; ++m) { const u32x4 a = *(const u32x4*)(Ga + (ai * 4 + m) * 8192), b = *(const u32x4*)(Gb + (ai * 4 + m) * 8192);
                const unsigned aw[4] = {a.x, a.y, a.z, a.w}, bw[4] = {b.x, b.y, b.z, b.w};
#pragma unroll
                for (int bj = 0; bj < 2; ++bj)
#pragma unroll
                    for (int i = 0; i < 8; ++i) acc[ai][bj][m][i >> 2][i & 3] *= ub(aw[2 * bj + (i >> 2)], i & 3) * __builtin_amdgcn_rcpf(ub(bw[2 * bj + (i >> 2)], i & 3)); }
        asm volatile("" ::: "memory");
    }
    __device__ __forceinline__ void operator()(const f32x4 (&acc)[2][2][4][2], const Unit& u, int wr, int wc, int fr, int fq) const {
        int row0 = u.pm * BM + wr * 64 + fr, c0 = u.pn * BM + wc * 32 + 8 * fq;
        asm volatile("" : "+v"(row0), "+v"(c0));
        int lt = (wr * 4 + wc) * 64 + fq * 16 + fr; asm volatile("" : "+v"(lt));
        const unsigned char* Gb = (const unsigned char*)GAB + (size_t)(u.pm * 8 + 4 + u.pn) * 65536 + (size_t)lt * 16;
        u32x4 gbw[2][4];
#pragma unroll
        for (int ai = 0; ai < 2; ++ai)
#pragma unroll
            for (int m = 0; m < 4; ++m) gbw[ai][m] = *(const u32x4*)(Gb + (ai * 4 + m) * 8192);
#pragma unroll
        for (int ai = 0; ai < 2; ++ai)
#pragma unroll
            for (int m = 0; m < 4; ++m) { const size_t rr = (size_t)(row0 + ai * HALF + m * 16); const unsigned bw[4] = {gbw[ai][m].x, gbw[ai][m].y, gbw[ai][m].z, gbw[ai][m].w};
#pragma unroll
                for (int bj = 0; bj < 2; ++bj) { float v[8];
#pragma unroll
                    for (int i = 0; i < 8; ++i) v[i] = acc[ai][bj][m][i >> 2][i & 3] * (ub(bw[2 * bj + (i >> 2)], i & 3) * (1.0f / 255.0f));
                    st8(MG + rr * 1024 + c0 + bj * HALF, v); } }
    }
};
struct EpiOut {
    static constexpr bool PERM = true, AFTER_DRAIN = false, MID = false;
    const bf16_t* x; float* x1; bf16_t* x1b; float* rowss;
    __device__ __forceinline__ void mid(f32x4 (&)[2][2][4][2], const Unit&, int, int, int, int) const {}
    __device__ __forceinline__ void operator()(const f32x4 (&acc)[2][2][4][2], const Unit& u, int wr, int wc, int fr, int fq) const {
        int row0 = u.pm * BM + wr * 64 + fr, c0 = u.pn * BM + wc * 32 + 8 * fq;
        asm volatile("" : "+v"(row0), "+v"(c0));
#pragma unroll
        for (int ai = 0; ai < 2; ++ai)
#pragma unroll
            for (int m = 0; m < 4; ++m) { const int r = row0 + ai * HALF + m * 16; const size_t ro = (size_t)r * 1024 + c0; float ss = 0.f;
#pragma unroll
                for (int bj = 0; bj < 2; ++bj) { float xv[8]; ld8(x + ro + bj * HALF, xv);
                    const f32x4 x0 = {xv[0], xv[1], xv[2], xv[3]}, x1v = {xv[4], xv[5], xv[6], xv[7]};
                    const f32x4 o0 = acc[ai][bj][m][0] + x0, o1 = acc[ai][bj][m][1] + x1v;
                    float v[8] = {o0[0], o0[1], o0[2], o0[3], o1[0], o1[1], o1[2], o1[3]};
#pragma unroll
                    for (int i = 0; i < 8; ++i) ss += v[i] * v[i];
                    st8(x1b + ro + bj * HALF, v); }
                ss += __shfl_xor(ss, 16); ss += __shfl_xor(ss, 32);
                if (fq == 0) rowss[(size_t)r * 16 + u.pn * 4 + wc] = ss; }
    }
};
struct EpiQuery {
    static constexpr bool PERM = true, AFTER_DRAIN = false, MID = false;
    const float* rowss; bf16_t* QQ; float eps;
    __device__ __forceinline__ void mid(f32x4 (&)[2][2][4][2], const Unit&, int, int, int, int) const {}
    __device__ __forceinline__ void operator()(const f32x4 (&acc)[2][2][4][2], const Unit& u, int wr, int wc, int fr, int fq) const {
        int row0 = u.pm * BM + wr * 64 + fr, c0 = u.pn * BM + wc * 32 + 8 * fq;
        asm volatile("" : "+v"(row0), "+v"(c0));
#pragma unroll
        for (int ai = 0; ai < 2; ++ai)
#pragma unroll
            for (int m = 0; m < 4; ++m) { const int r = row0 + ai * HALF + m * 16; const float rs = __builtin_amdgcn_rsqf(sum16(rowss + (size_t)r * 16) * (1.0f / 1024.0f) + eps);
#pragma unroll
                for (int bj = 0; bj < 2; ++bj) { float v[8];
#pragma unroll
                    for (int i = 0; i < 8; ++i) v[i] = acc[ai][bj][m][i >> 2][i & 3] * rs;
                    st8(QQ + (size_t)r * 2048 + c0 + bj * HALF, v); } }
    }
};

template <class Epi, class Sched, bool ALIGN_EPI = false, bool SP2 = false, bool FP8 = false>
__device__ __forceinline__ void gemm_phase(PG8_LAS unsigned char* lds, const Gemm g, const Sched& S, const Epi& E, const int wid) {
    const int lane = fresh_lane(), tid = wid * 64 + lane, wr = wid >> 2, wc = wid & 3, fr = lane & 15, fq = lane >> 4;
    const int K = g.K, nt = K / BK;
    unsigned voffA[2], voffB[2];
#pragma unroll
    for (int i = 0; i < 2; ++i) { int R, C; stage_rc(tid * 16 + i * 8192, R, C); const int Rb = Epi::PERM ? ((R & ~31) + perm32(R & 31)) : R;
        voffA[i] = (unsigned)(R * K + C) * 2u; voffB[i] = (unsigned)(Rb * K + C) * 2u; }
    const size_t kstep = (size_t)(BK * 2);
    const size_t hstep = (size_t)HALF * K * 2;
    const size_t tstep = 2 * hstep;
    const unsigned ldsw = (unsigned)wid * 1024u;
    const int aoff = lds_byte(wr * 64 + fr, fq * 8), boff = lds_byte(wc * 32 + fr, fq * 8);
#define PG8_SA(b, h) (((b) * 2 + (h)) * HTB)
#define PG8_SB(b, h) ((4 + (b) * 2 + (h)) * HTB)
#define PG8_STAGE(bufoff, gbase, voff) do { _Pragma("unroll") for (int _i = 0; _i < 2; ++_i) \
        __builtin_amdgcn_global_load_lds((const unsigned*)((const char*)(gbase) + (voff)[_i]), (PG8_LAS unsigned*)(lds + (bufoff) + ldsw + _i * 8192), 16, 0, 0); } while (0)
#define PG8_LDA(dst, b, h) do { _Pragma("unroll") for (int m = 0; m < 4; ++m) _Pragma("unroll") for (int k = 0; k < 2; ++k) dst[m][k] = *(const PG8_LAS bf16x8*)(lds + PG8_SA(b, h) + aoff + m * 2048 + k * 1024); } while (0)
#define PG8_LDB(dst, b, h) do { _Pragma("unroll") for (int n = 0; n < 2; ++n) _Pragma("unroll") for (int k = 0; k < 2; ++k) dst[n][k] = *(const PG8_LAS bf16x8*)(lds + PG8_SB(b, h) + boff + n * 2048 + k * 1024); } while (0)
#define PG8_MMA(ai, bj, At, Bt) do { __builtin_amdgcn_s_setprio(1); \
        if constexpr (FP8) { _Pragma("unroll") for (int m = 0; m < 4; ++m) _Pragma("unroll") for (int n = 0; n < 2; ++n) { \
            const v4i_ b0_ = __builtin_bit_cast(v4i_, Bt[n][0]), b1_ = __builtin_bit_cast(v4i_, Bt[n][1]), a0_ = __builtin_bit_cast(v4i_, At[m][0]), a1_ = __builtin_bit_cast(v4i_, At[m][1]); \
            const v8i_ bb_ = {b0_[0], b0_[1], b0_[2], b0_[3], b1_[0], b1_[1], b1_[2], b1_[3]}, aa_ = {a0_[0], a0_[1], a0_[2], a0_[3], a1_[0], a1_[1], a1_[2], a1_[3]}; \
            asm("v_mfma_scale_f32_16x16x128_f8f6f4 %0, %1, %2, %0, %3, %4 op_sel_hi:[0,0,0]" : "+v"(acc[ai][bj][m][n]) : "v"(bb_), "v"(aa_), "v"(scw_), "v"(sca_)); } } \
        else { _Pragma("unroll") for (int m = 0; m < 4; ++m) _Pragma("unroll") for (int n = 0; n < 2; ++n) _Pragma("unroll") for (int k = 0; k < 2; ++k) \
            acc[ai][bj][m][n] = __builtin_amdgcn_mfma_f32_16x16x32_bf16(Bt[n][k], At[m][k], acc[ai][bj][m][n], 0, 0, 0); } \
        __builtin_amdgcn_s_setprio(0); } while (0)
#define PG8_WAIT_V(n) asm volatile("s_waitcnt vmcnt(" #n ")" ::: "memory")
#define PG8_WAIT_L(n) asm volatile("s_waitcnt lgkmcnt(" #n ")" ::: "memory")
#define PG8_BAR __builtin_amdgcn_s_barrier()
#define PG8_SCHED __builtin_amdgcn_sched_barrier(0)
    Unit cur, nxt; int ui = 0;
    if (!S.next(0, cur)) return;
    int scw_ = 0x79797979, sca_ = 0x7f7f7f7f; if constexpr (FP8) asm volatile("" : "+v"(scw_), "+v"(sca_));
    f32x4 acc[2][2][4][2];
#pragma unroll
    for (int a = 0; a < 2; ++a)
#pragma unroll
        for (int b = 0; b < 2; ++b)
#pragma unroll
            for (int m = 0; m < 4; ++m)
#pragma unroll
                for (int n = 0; n < 2; ++n) acc[a][b][m][n] = (f32x4){0.f, 0.f, 0.f, 0.f};
    bf16x8 At[4][2], B0[2][2], B1[2][2];
    const char* cA = (const char*)g.A + (size_t)cur.pm * tstep; const char* cB = (const char*)g.Bt + (size_t)cur.pn * tstep;
    S.a_ready(cur);
    if constexpr (SP2) {
        PG8_STAGE(PG8_SB(0, 0), cB, voffB); PG8_STAGE(PG8_SB(0, 1), cB + hstep, voffB); PG8_STAGE(PG8_SA(0, 0), cA, voffA); PG8_STAGE(PG8_SA(0, 1), cA + hstep, voffA);
        if (wr == 1) PG8_BAR;
        PG8_WAIT_V(2); PG8_BAR;
        PG8_STAGE(PG8_SB(1, 0), cB + kstep, voffB); PG8_STAGE(PG8_SA(1, 0), cA + kstep, voffA); PG8_STAGE(PG8_SB(1, 1), cB + hstep + kstep, voffB);
        PG8_WAIT_V(6); PG8_BAR;
    } else {
        PG8_STAGE(PG8_SB(0, 0), cB, voffB); PG8_STAGE(PG8_SA(0, 0), cA, voffA); PG8_STAGE(PG8_SB(0, 1), cB + hstep, voffB); PG8_STAGE(PG8_SA(0, 1), cA + hstep, voffA);
        if (wr == 1) PG8_BAR;
        PG8_WAIT_V(4); PG8_BAR;
        PG8_STAGE(PG8_SB(1, 0), cB + kstep, voffB); PG8_STAGE(PG8_SA(1, 0), cA + kstep, voffA); PG8_STAGE(PG8_SB(1, 1), cB + hstep + kstep, voffB);
        PG8_WAIT_V(6); PG8_BAR;
    }
    for (;;) {
        const bool has_next = S.next(ui + 1, nxt);
        const char* nA = has_next ? (const char*)g.A + (size_t)nxt.pm * tstep : cA; const char* nB = has_next ? (const char*)g.Bt + (size_t)nxt.pn * tstep : cB;
#pragma unroll 1
        for (int t = 0; t < nt; t += 2) {
            if constexpr (Epi::MID) { if (t == (nt >> 1)) E.mid(acc, cur, wr, wc, fr, fq); }
            const bool last = (t == nt - 2);
            const char* a1 = cA + (size_t)(t + 1) * kstep;
            const char* a2 = last ? nA : cA + (size_t)(t + 2) * kstep; const char* b2 = last ? nB : cB + (size_t)(t + 2) * kstep;
            const char* a3 = a2 + kstep; const char* b3 = b2 + kstep;
            if (last && has_next) S.a_ready(nxt);
            if constexpr (SP2) {
            PG8_LDB(B0, 0, 0); PG8_LDB(B1, 0, 1); PG8_SCHED; PG8_LDA(At, 0, 0); PG8_STAGE(PG8_SA(1, 1), a1 + hstep, voffA);
            PG8_WAIT_V(8); PG8_WAIT_L(0); PG8_BAR; PG8_MMA(0, 0, At, B0); PG8_MMA(0, 1, At, B1); PG8_BAR; PG8_SCHED;
            PG8_LDA(At, 0, 1); PG8_STAGE(PG8_SB(0, 0), b2, voffB); PG8_STAGE(PG8_SB(0, 1), b2 + hstep, voffB); PG8_STAGE(PG8_SA(0, 0), a2, voffA);
            PG8_WAIT_V(8); PG8_WAIT_L(0); PG8_BAR; PG8_MMA(1, 0, At, B0); PG8_MMA(1, 1, At, B1); PG8_BAR; PG8_SCHED;
            PG8_LDB(B0, 1, 0); PG8_LDB(B1, 1, 1); PG8_SCHED; PG8_LDA(At, 1, 0); PG8_STAGE(PG8_SA(0, 1), a2 + hstep, voffA);
            PG8_WAIT_V(8); PG8_WAIT_L(0); PG8_BAR; PG8_MMA(0, 0, At, B0); PG8_MMA(0, 1, At, B1); PG8_BAR; PG8_SCHED;
            PG8_LDA(At, 1, 1); PG8_STAGE(PG8_SB(1, 0), b3, voffB); PG8_STAGE(PG8_SB(1, 1), b3 + hstep, voffB); PG8_STAGE(PG8_SA(1, 0), a3, voffA);
            PG8_WAIT_V(8); PG8_WAIT_L(0); PG8_BAR; PG8_MMA(1, 0, At, B0); PG8_MMA(1, 1, At, B1); PG8_BAR; PG8_SCHED;
            } else {
            PG8_LDB(B0, 0, 0); PG8_SCHED; PG8_LDA(At, 0, 0); PG8_STAGE(PG8_SA(1, 1), a1 + hstep, voffA);
            PG8_WAIT_L(8); PG8_BAR; PG8_WAIT_L(0); PG8_MMA(0, 0, At, B0); PG8_BAR; PG8_SCHED;
            PG8_LDB(B1, 0, 1); PG8_STAGE(PG8_SB(0, 0), b2, voffB);
            PG8_BAR; PG8_WAIT_L(0); PG8_MMA(0, 1, At, B1); PG8_BAR;
            PG8_LDA(At, 0, 1); PG8_STAGE(PG8_SA(0, 0), a2, voffA);
            PG8_BAR; PG8_WAIT_L(0); PG8_MMA(1, 0, At, B0); PG8_BAR; PG8_SCHED;
            PG8_STAGE(PG8_SB(0, 1), b2 + hstep, voffB);
            PG8_WAIT_V(6); PG8_BAR; PG8_MMA(1, 1, At, B1); PG8_BAR;
            PG8_LDB(B0, 1, 0); PG8_SCHED; PG8_LDA(At, 1, 0); PG8_STAGE(PG8_SA(0, 1), a2 + hstep, voffA);
            PG8_WAIT_L(8); PG8_BAR; PG8_WAIT_L(0); PG8_MMA(0, 0, At, B0); PG8_BAR; PG8_SCHED;
            PG8_LDB(B1, 1, 1); PG8_STAGE(PG8_SB(1, 0), b3, voffB);
            PG8_BAR; PG8_WAIT_L(0); PG8_MMA(0, 1, At, B1); PG8_BAR;
            PG8_LDA(At, 1, 1); PG8_STAGE(PG8_SA(1, 0), a3, voffA);
            PG8_BAR; PG8_WAIT_L(0); PG8_MMA(1, 0, At, B0); PG8_BAR; PG8_SCHED;
            PG8_STAGE(PG8_SB(1, 1), b3 + hstep, voffB);
            PG8_WAIT_V(6); PG8_BAR; PG8_MMA(1, 1, At, B1); PG8_BAR;
            }
        }
        if constexpr (FP8) asm volatile("s_nop 15\n\ts_nop 15\n\ts_nop 15" ::: "memory");
        if constexpr (ALIGN_EPI) { if (wr == 0) PG8_BAR; }
        if constexpr (!Epi::AFTER_DRAIN) { E(acc, cur, wr, wc, fr, fq); S.done(cur); }
        if (!has_next) break;
#pragma unroll
        for (int a = 0; a < 2; ++a)
#pragma unroll
            for (int b = 0; b < 2; ++b)
#pragma unroll
                for (int m = 0; m < 4; ++m)
#pragma unroll
                    for (int n = 0; n < 2; ++n) acc[a][b][m][n] = (f32x4){0.f, 0.f, 0.f, 0.f};
        cur = nxt; cA = nA; cB = nB; ++ui;
        if constexpr (ALIGN_EPI) { if (wr == 1) PG8_BAR; }
    }
    PG8_WAIT_V(0);
    if constexpr (!ALIGN_EPI) { if (wr == 0) PG8_BAR; }
    PG8_BAR;
    if constexpr (Epi::AFTER_DRAIN) { E.fused(acc, cur, wr, wc, fr, fq, lds, wid, lane); S.done(cur); }
#undef PG8_SA
#undef PG8_SB
#undef PG8_STAGE
#undef PG8_LDA
#undef PG8_LDB
#undef PG8_MMA
#undef PG8_WAIT_V
#undef PG8_WAIT_L
#undef PG8_BAR
#undef PG8_SCHED
}
}

constexpr int NWAVES = 8;
constexpr int N_LAUNCHES = MK_N_LAUNCHES;
constexpr int PER_PHASE = 10;
constexpr int T = 32768, D = 1024, SEQ = 4096, NIN = 5632, NUNIT = 4096;
constexpr float EPS = 1e-6f;
constexpr size_t MiB = 1u << 20;
constexpr size_t WS_CTL = 0, CTL_ZERO_BYTES = 1 * MiB;
constexpr size_t WS_ROWSS = 4 * MiB;
constexpr size_t WS_RSTD1 = 1 * MiB;
constexpr size_t WS_LB = 1 * MiB + 256 * 1024;
constexpr size_t WS_DEC = 2 * MiB;
constexpr size_t WS_WIN = 8 * MiB, WS_PAB = 19 * MiB, WS_WO = 21 * MiB, WS_WQ = 23 * MiB, WS_KEYS = 27 * MiB;
constexpr size_t WS_GA = 32 * MiB, WS_GB = 96 * MiB;
constexpr size_t WS_Q = 160 * MiB, WS_LF = 192 * MiB, WS_KK = 224 * MiB, WS_V = 256 * MiB, WS_SG = 288 * MiB, WS_CB = 320 * MiB, WS_U = 352 * MiB;
constexpr size_t WS_XB = 384 * MiB;
constexpr size_t WS_LOC = 448 * MiB;
constexpr size_t WS_SPREV = 320 * MiB;
constexpr size_t WS_X1 = 32 * MiB;
constexpr size_t WS_MG = 160 * MiB;
constexpr size_t WS_X1B = 224 * MiB;
constexpr size_t WS_QQ = 288 * MiB;
constexpr size_t WS_IDX = 416 * MiB, WS_GATE = 432 * MiB;
constexpr size_t WS_EU = 160 * MiB, WS_EV = 176 * MiB;
constexpr size_t WS_ESC = 192 * MiB;
constexpr size_t WS_X8 = 448 * MiB;
constexpr size_t WS_W8G = 28 * MiB;
constexpr size_t WS_END = 480 * MiB;
constexpr int CW_BAR = 4096;
constexpr int RING_BYTES = 131072, WAVE_LDS = 18688, MISC_OFF = NWAVES * WAVE_LDS, LDS_BYTES = MISC_OFF + 1024;
static_assert(MISC_OFF >= RING_BYTES && LDS_BYTES <= 160 * 1024, "LDS map");

#define GAS __attribute__((address_space(1)))
#define LAS __attribute__((address_space(3)))
typedef unsigned short bf16;
typedef unsigned v4u __attribute__((ext_vector_type(4)));
typedef unsigned v2u __attribute__((ext_vector_type(2)));
typedef float f32x4 __attribute__((ext_vector_type(4)));
typedef float f32x16 __attribute__((ext_vector_type(16)));
typedef short bf16x8 __attribute__((ext_vector_type(8)));
typedef __bf16 bf16x2_t __attribute__((ext_vector_type(2)));
typedef GAS unsigned gu32;
#define RLX_AGENT __ATOMIC_RELAXED, __HIP_MEMORY_SCOPE_AGENT
#define LDS_WAIT() asm volatile("s_waitcnt lgkmcnt(0)" ::: "memory")
#define VM_WAIT() asm volatile("s_waitcnt vmcnt(0)" ::: "memory")
#define MFMA32(a, b, c) __builtin_amdgcn_mfma_f32_32x32x16_bf16((a), (b), (c), 0, 0, 0)
using pg8::cvt_pk_bf16; using pg8::fexp; using pg8::fsig; using pg8::bflo; using pg8::bfhi;
__device__ __forceinline__ int crow(int reg, int h) { return (reg & 3) + 8 * (reg >> 2) + 4 * h; }

#define XB_TMO      128
#define XB_XCNT(j)  (256  + 64 * (j))
#define XB_XSUB(j)  (1280 + 64 * (j))
#define XB_XGEN(j)  (2304 + 64 * (j))
#define XB_TOP      3328
#define XB_TOPGEN   3392
#define XCD_BAR_WORDS 3456
#define XB_SPIN_CAP (1u << 18)
__device__ __forceinline__ unsigned xb_ld(unsigned* p)              { return __hip_atomic_load(p, __ATOMIC_RELAXED, __HIP_MEMORY_SCOPE_AGENT); }
__device__ __forceinline__ unsigned xb_add(unsigned* p, unsigned v) { return __hip_atomic_fetch_add(p, v, __ATOMIC_RELAXED, __HIP_MEMORY_SCOPE_AGENT); }
__device__ __forceinline__ unsigned xb_xcc_id() { return (unsigned)__builtin_amdgcn_s_getreg((3 << 11) | 20) & 0xFu; }
#define XB_SPIN(cond, bar) do { unsigned _sp = 0; while (cond) { __builtin_amdgcn_s_sleep(1); \
    if ((++_sp & 255u) == 0u) { if (xb_ld(&(bar)[XB_TMO])) break; if (_sp > XB_SPIN_CAP) { atomicAdd(&(bar)[XB_TMO], 1u); break; } } } } while (0)
struct XcdBarrier { unsigned* bar; unsigned x; volatile LAS unsigned* st; };
__device__ __forceinline__ XcdBarrier xcd_barrier_post(unsigned* bar, volatile LAS unsigned* st) {
    XcdBarrier b; b.bar = bar; b.x = xb_xcc_id(); b.st = st;
    if (threadIdx.x == 0) (void)xb_add(&bar[XB_XCNT(b.x)], 1u);
    return b;
}
__device__ __forceinline__ void xcd_barrier_complete(unsigned* bar, unsigned x, unsigned& nloc, unsigned& nx) {
    const unsigned G = gridDim.x * gridDim.y * gridDim.z;
    unsigned sum, cnt, mine, sp = 0u;
    for (;;) {
        sum = 0u; cnt = 0u; mine = 0u;
#pragma unroll
        for (unsigned j = 0; j < 16; ++j) { const unsigned c = xb_ld(&bar[XB_XCNT(j)]); sum += c; cnt += (c > 0u) ? 1u : 0u; mine = (j == x) ? c : mine; }
        if (sum == G) break;
        __builtin_amdgcn_s_sleep(1);
        if ((++sp & 255u) == 0u) { if (xb_ld(&bar[XB_TMO])) break; if (sp > XB_SPIN_CAP) { atomicAdd(&bar[XB_TMO], 1u); break; } }
    }
    nloc = mine > 0u ? mine : 1u; nx = cnt > 0u ? cnt : 1u;
}
__device__ __forceinline__ void xcd_barrier(const XcdBarrier& b) {
    asm volatile("s_waitcnt vmcnt(0)" ::: "memory");
    __syncthreads();
    if (threadIdx.x == 0) {
        unsigned* bar = b.bar;
        __builtin_amdgcn_s_waitcnt(0);
        unsigned nloc = b.st[0], nx = b.st[1];
        if (nloc == 0u) { xcd_barrier_complete(bar, b.x, nloc, nx); b.st[0] = nloc; b.st[1] = nx; }
        const unsigned old = xb_add(&bar[XB_XSUB(b.x)], 1u);
        const unsigned gen = old / nloc;
        if (old + 1u == (gen + 1u) * nloc) {
            __builtin_amdgcn_fence(__ATOMIC_RELEASE, "agent");
            asm volatile("s_waitcnt vmcnt(0)" ::: "memory");
            const unsigned og = xb_add(&bar[XB_TOP], 1u);
            const unsigned tg = og / nx;
            if (og + 1u == (tg + 1u) * nx) xb_add(&bar[XB_TOPGEN], 1u);
            else XB_SPIN(xb_ld(&bar[XB_TOPGEN]) == tg, bar);
            __builtin_amdgcn_fence(__ATOMIC_ACQUIRE, "agent");
            xb_add(&bar[XB_XGEN(b.x)], 1u);
            asm volatile("s_waitcnt vmcnt(0)" ::: "memory");
        } else {
            XB_SPIN(xb_ld(&bar[XB_XGEN(b.x)]) == gen, bar);
            __builtin_amdgcn_fence(__ATOMIC_ACQUIRE, "agent");
            asm volatile("s_waitcnt vmcnt(0)" ::: "memory");
        }
    }
    __syncthreads();
}

struct Args { const float* in[16]; float* out; unsigned char* ws; int ph_lo, ph_hi, li, pad; };
struct Frame {
    LAS unsigned char* lds;
    int wave;
    int vcu, G;
    int gw, ngw;
    float* out; unsigned char* ws;
};
__device__ __forceinline__ float wave_sum(float v) {
#pragma unroll
    for (int o = 1; o < 64; o <<= 1) v += __shfl_xor(v, o);
    return v;
}
__device__ __forceinline__ unsigned f2bf(float f) { unsigned u = __builtin_bit_cast(unsigned, f); return (u + 0x7fffu + ((u >> 16) & 1u)) >> 16; }
__device__ __forceinline__ unsigned pk2(float lo, float hi) { return cvt_pk_bf16(lo, hi); }
__device__ __forceinline__ float bf2f(bf16 h) { return __builtin_bit_cast(float, (unsigned)h << 16); }

__device__ __forceinline__ int win_dst_row(int n) {
    if (n >= 2560 && n < 3072) { const int j = (n - 2560) >> 7, r = (n - 2560) & 127; return 2560 + 256 * j + r; }
    if (n >= 3072 && n < 3584) { const int j = (n - 3072) >> 7, r = (n - 3072) & 127; return 2560 + 256 * j + 128 + r; }
#ifdef DBG_SWAPG
    if (n >= 3584 && n < 4608) return n + 1024;
    if (n >= 4608) return n - 1024;
#endif
    return n;
}
__device__ __forceinline__ void p0_transpose_item(const float* W, int K, int N, const float* gain, bf16* WT, int ldwt, int koff, bool perm, LAS float* scr, int item, int lane, unsigned char* W8 = nullptr) {
    const int nblk = N / 32, kb = item / nblk, nb = item % nblk, k0 = 64 * kb, n0 = 32 * nb;
    { float wv[32];
#pragma unroll
      for (int i = 0; i < 32; ++i) wv[i] = W[(size_t)(k0 + 2 * i + (lane >> 5)) * N + n0 + (lane & 31)];
#pragma unroll
      for (int i = 0; i < 32; ++i) { const int kk = 2 * i + (lane >> 5); float v = wv[i]; if (gain) v *= gain[k0 + kk]; scr[kk * 33 + (lane & 31)] = v; } }
    LDS_WAIT(); asm volatile("" ::: "memory");
    const int c = lane & 7, d0 = perm ? win_dst_row(n0) : n0;
    if (W8 != nullptr && (n0 >= 3584 || n0 < 512)) {
#pragma unroll
        for (int j = 0; j < 4; ++j) { const int n = (lane >> 3) + 8 * j; const LAS float* s = scr + (8 * c) * 33 + n;
            int lo = __builtin_amdgcn_cvt_pk_fp8_f32(s[0 * 33] * 64.f, s[1 * 33] * 64.f, 0, false); lo = __builtin_amdgcn_cvt_pk_fp8_f32(s[2 * 33] * 64.f, s[3 * 33] * 64.f, lo, true);
            int hi = __builtin_amdgcn_cvt_pk_fp8_f32(s[4 * 33] * 64.f, s[5 * 33] * 64.f, 0, false); hi = __builtin_amdgcn_cvt_pk_fp8_f32(s[6 * 33] * 64.f, s[7 * 33] * 64.f, hi, true);
            v2u o; o.x = (unsigned)lo; o.y = (unsigned)hi; *(GAS v2u*)(W8 + (size_t)((n0 < 512 ? n0 : n0 - 3072) + n) * 1024 + k0 + 8 * c) = o; }
        LDS_WAIT(); asm volatile("" ::: "memory");
        return;
    }
#pragma unroll
    for (int j = 0; j < 4; ++j) { const int n = (lane >> 3) + 8 * j; const LAS float* s = scr + (8 * c) * 33 + n;
        v4u o; o.x = pk2(s[0 * 33], s[1 * 33]); o.y = pk2(s[2 * 33], s[3 * 33]); o.z = pk2(s[4 * 33], s[5 * 33]); o.w = pk2(s[6 * 33], s[7 * 33]);
        *(GAS v4u*)(WT + (size_t)(d0 + n) * ldwt + koff + k0 + 8 * c) = o; }
    LDS_WAIT(); asm volatile("" ::: "memory");
}
__device__ __forceinline__ void cvt512(const float* src, bf16* dst, size_t item, int lane) {
    const f32x4 a = *(const f32x4*)(src + item * 512 + lane * 8), b = *(const f32x4*)(src + item * 512 + lane * 8 + 4);
    v4u o; o.x = pk2(a[0], a[1]); o.y = pk2(a[2], a[3]); o.z = pk2(b[0], b[1]); o.w = pk2(b[2], b[3]);
    *(v4u*)(dst + item * 512 + lane * 8) = o;
}
__device__ __forceinline__ void p0_prologue(Frame& F, const Args& A) {
    const float *x = A.in[0], *g_mix = A.in[1], *w_in = A.in[2], *lb_log = A.in[3], *w_pa = A.in[6], *w_pb = A.in[7], *w_o = A.in[8], *g_ffn = A.in[9], *w_q = A.in[10],
                *k1 = A.in[11], *k2 = A.in[12];
    unsigned char* ws = F.ws; const int lane_ = pg8::fresh_lane();
    LAS float* scr = (LAS float*)(F.lds + F.wave * 16384);
    constexpr int I_IN = 16 * 176, I_P = 8 * 32, I_O = 16 * 32, I_Q = 16 * 64, NITEMS = I_IN + 2 * I_P + I_O + I_Q;
    for (int it = F.gw; it < NITEMS; it += F.ngw) {
        int r = it;
        if (r < I_IN) { p0_transpose_item(w_in, 1024, NIN, g_mix, (bf16*)(ws + WS_WIN), 1024, 0, true, scr, r, lane_, ws + WS_W8G); continue; } r -= I_IN;
        if (r < I_P) { p0_transpose_item(w_pa, 512, 1024, nullptr, (bf16*)(ws + WS_PAB), 1024, 0, false, scr, r, lane_); continue; } r -= I_P;
        if (r < I_P) { p0_transpose_item(w_pb, 512, 1024, nullptr, (bf16*)(ws + WS_PAB), 1024, 512, false, scr, r, lane_); continue; } r -= I_P;
        if (r < I_O) { p0_transpose_item(w_o, 1024, 1024, nullptr, (bf16*)(ws + WS_WO), 1024, 0, false, scr, r, lane_); continue; } r -= I_O;
        p0_transpose_item(w_q, 1024, 2048, g_ffn, (bf16*)(ws + WS_WQ), 1024, 0, false, scr, r, lane_);
    }
    for (int it = F.gw; it < 512; it += F.ngw) { if (it < 256) cvt512(k1, (bf16*)(ws + WS_KEYS), it, lane_); else cvt512(k2, (bf16*)(ws + WS_KEYS) + 131072, it - 256, lane_); }
    float* rstd1 = (float*)(ws + WS_RSTD1); bf16* xb = (bf16*)(ws + WS_XB);
    for (int m = F.gw; m < T; m += F.ngw) {
        const f32x4* xr = (const f32x4*)(x + (size_t)m * D) + lane_; f32x4 v[4]; float s = 0.f;
#pragma unroll
        for (int j = 0; j < 4; ++j) { v[j] = xr[64 * j]; s += (v[j][0] * v[j][0] + v[j][1] * v[j][1]) + (v[j][2] * v[j][2] + v[j][3] * v[j][3]); }
        s = wave_sum(s);
        if (lane_ == 0) rstd1[m] = __builtin_amdgcn_rsqf(s * (1.0f / D) + EPS);
        v2u* o8 = (v2u*)(xb + (size_t)m * D) + lane_; unsigned* q8 = (unsigned*)(ws + WS_X8 + (size_t)m * D) + lane_;
#pragma unroll
        for (int j = 0; j < 4; ++j) { v2u o; o.x = pk2(v[j][0], v[j][1]); o.y = pk2(v[j][2], v[j][3]); o8[64 * j] = o;
            int w = __builtin_amdgcn_cvt_pk_fp8_f32(v[j][0], v[j][1], 0, false); w = __builtin_amdgcn_cvt_pk_fp8_f32(v[j][2], v[j][3], w, true); q8[64 * j] = (unsigned)w; }
    }
    if (F.gw == 0) { float* lb = (float*)(ws + WS_LB);
        for (int j = lane_; j < 512; j += 64) { const float a = lb_log[j], b = lb_log[512 + j]; lb[j] = 1.0f / (1.0f + expf(b - a)); } }
}

#define P2_SCATTER(REG, SRC) { _Pragma("unroll") for (int p = 0; p < 8; ++p) { LAS unsigned char* dst_ = (REG) + (8 * cc) * 144 + cc * 16 + 2 * (rr + 8 * p); const unsigned w_[4] = {SRC[p].x, SRC[p].y, SRC[p].z, SRC[p].w}; \
        _Pragma("unroll") for (int i = 0; i < 4; ++i) { *(LAS bf16*)(dst_ + (2 * i) * 144) = (bf16)(w_[i] & 0xffffu); *(LAS bf16*)(dst_ + (2 * i + 1) * 144) = (bf16)(w_[i] >> 16); } } }
#define P2_ROWLOAD(REG, W) { _Pragma("unroll") for (int j = 0; j < 8; ++j) { const v4u o_ = *(LAS v4u*)((REG) + lane * 144 + rr * 16 + j * 16); W[4 * j] = o_.x; W[4 * j + 1] = o_.y; W[4 * j + 2] = o_.z; W[4 * j + 3] = o_.w; } }
#define P2_ROWSTORE(REG, W) { _Pragma("unroll") for (int j = 0; j < 8; ++j) { v4u o_; o_.x = W[4 * j]; o_.y = W[4 * j + 1]; o_.z = W[4 * j + 2]; o_.w = W[4 * j + 3]; *(LAS v4u*)((REG) + lane * 144 + rr * 16 + j * 16) = o_; } }
#define P2_GATHER_STORE(REG, GP) { int ro_ = rr; asm volatile("" : "+v"(ro_));     \
    _Pragma("unroll") for (int p = 0; p < 8; ++p) { const LAS unsigned char* src_ = (REG) + (8 * cc) * 144 + cc * 16 + 2 * (ro_ + 8 * p); unsigned e_[8]; \
        _Pragma("unroll") for (int i = 0; i < 8; ++i) e_[i] = (unsigned)*(const LAS bf16*)(src_ + i * 144); \
        v4u o_; o_.x = e_[0] | (e_[1] << 16); o_.y = e_[2] | (e_[3] << 16); o_.z = e_[4] | (e_[5] << 16); o_.w = e_[6] | (e_[7] << 16); *(v4u*)((GP) + (size_t)(ro_ + 8 * p) * 512) = o_; if (p & 1) asm volatile("" ::: "memory"); } }
__device__ __forceinline__ void p2_unit(Frame& F, int unit) {
    unsigned char* ws = F.ws; const int lane = pg8::fresh_lane(), rr = lane >> 3, cc = lane & 7;
    const int bh = unit >> 6, c = unit & 63, bb = bh >> 3, h = bh & 7; const size_t t0 = (size_t)bb * SEQ + c * 64; const int cb0 = h * 64;
    bf16* Qg = (bf16*)(ws + WS_Q) + t0 * 512 + cb0 + 8 * cc; bf16* Kg = (bf16*)(ws + WS_KK) + t0 * 512 + cb0 + 8 * cc; const bf16* Vg = (const bf16*)(ws + WS_V) + t0 * 512 + cb0 + 8 * cc;
    LAS unsigned char* wl = F.lds + F.wave * WAVE_LDS; LAS unsigned char* KH = wl; LAS unsigned char* VT = wl + 9344;
    v4u kw[8], qw[8];
#pragma unroll
    for (int p = 0; p < 8; ++p) { kw[p] = *(const v4u*)(Kg + (size_t)(rr + 8 * p) * 512); qw[p] = *(const v4u*)(Qg + (size_t)(rr + 8 * p) * 512); }
    P2_SCATTER(KH, kw) P2_SCATTER(VT, qw)
    LDS_WAIT(); asm volatile("" ::: "memory");
    unsigned kr[32]; P2_ROWLOAD(KH, kr)
    LDS_WAIT(); asm volatile("" ::: "memory");
    float b[64];
    { float run = 0.f;
#pragma unroll
      for (int t = 0; t < 64; ++t) { const float kt = (t & 1) ? bfhi(kr[t >> 1]) : bflo(kr[t >> 1]); run += __builtin_amdgcn_logf(1.0f - kt) * 0.69314718056f; b[t] = run; } }
    const float blast = b[63];
    ((float*)(ws + WS_DEC))[unit * 64 + lane] = fexp(blast);
    { unsigned w[32];
#pragma unroll
      for (int t = 0; t < 64; t += 2) w[t >> 1] = pk2(bflo(kr[t >> 1]) * fexp(-b[t]), bfhi(kr[t >> 1]) * fexp(-b[t + 1]));
      P2_ROWSTORE(KH, w) }
    LDS_WAIT(); asm volatile("" ::: "memory");
    P2_GATHER_STORE(KH, Kg)
    LDS_WAIT(); asm volatile("" ::: "memory");
    { unsigned w[32];
#pragma unroll
      for (int t = 0; t < 64; t += 2) w[t >> 1] = pk2(bflo(kr[t >> 1]) * fexp(blast - b[t]), bfhi(kr[t >> 1]) * fexp(blast - b[t + 1]));
      P2_ROWSTORE(KH, w) }
    { unsigned w[32]; P2_ROWLOAD(VT, w)
      LDS_WAIT(); asm volatile("" ::: "memory");
#pragma unroll
      for (int t = 0; t < 64; t += 2) w[t >> 1] = pk2(bflo(w[t >> 1]) * fexp(b[t]), bfhi(w[t >> 1]) * fexp(b[t + 1]));
      P2_ROWSTORE(VT, w) }
    LDS_WAIT(); asm volatile("" ::: "memory");
    P2_GATHER_STORE(VT, Qg)
    LDS_WAIT(); asm volatile("" ::: "memory");
    { v4u vw[8]; int ro = rr; asm volatile("" : "+v"(ro));
#pragma unroll
      for (int p = 0; p < 8; ++p) vw[p] = *(const v4u*)(Vg + (size_t)(ro + 8 * p) * 512);
      P2_SCATTER(VT, vw) }
    LDS_WAIT(); asm volatile("" ::: "memory");
    const int r = lane & 31, hh = lane >> 5;
    f32x16 acc[2][2];
#pragma unroll
    for (int i = 0; i < 2; ++i)
#pragma unroll
        for (int j = 0; j < 2; ++j)
#pragma unroll
            for (int k = 0; k < 16; ++k) acc[i][j][k] = 0.f;
#pragma unroll
    for (int ks = 0; ks < 4; ++ks) {
        bf16x8 a[2], bq[2];
#pragma unroll
        for (int i = 0; i < 2; ++i) { const int ra = (32 * i + r) * 144 + (4 * i + (r >> 3)) * 16 + (16 * ks + 8 * hh) * 2; a[i] = *(const LAS bf16x8*)(VT + ra); bq[i] = *(const LAS bf16x8*)(KH + ra); }
#pragma unroll
        for (int i = 0; i < 2; ++i)
#pragma unroll
            for (int j = 0; j < 2; ++j) acc[i][j] = MFMA32(a[i], bq[j], acc[i][j]);
    }
    LDS_WAIT(); asm volatile("" ::: "memory");
    { LAS float* OL = (LAS float*)wl;
#pragma unroll
      for (int i = 0; i < 2; ++i)
#pragma unroll
          for (int j = 0; j < 2; ++j)
#pragma unroll
              for (int k = 0; k < 16; ++k) OL[(32 * i + crow(k, hh)) * 68 + 32 * j + r] = acc[i][j][k];
      LDS_WAIT(); asm volatile("" ::: "memory");
      bf16* LOC = (bf16*)(ws + WS_LOC) + (size_t)unit * 4096 + 8 * cc; int ro = rr; asm volatile("" : "+v"(ro));
#pragma unroll
      for (int p = 0; p < 8; ++p) { const int e = ro + 8 * p; const f32x4 v0 = *(LAS f32x4*)(OL + e * 68 + 8 * cc), v1 = *(LAS f32x4*)(OL + e * 68 + 8 * cc + 4);
          v4u o; o.x = pk2(v0[0], v0[1]); o.y = pk2(v0[2], v0[3]); o.z = pk2(v1[0], v1[1]); o.w = pk2(v1[2], v1[3]); *(v4u*)(LOC + e * 64) = o; } }
    LDS_WAIT(); asm volatile("" ::: "memory");
}
__device__ __forceinline__ void p2_phase(Frame& F, const float* cw) {
    for (int u = F.gw; u < NUNIT; u += F.ngw) p2_unit(F, u);
    unsigned char* ws = F.ws;
    const bf16* CB = (const bf16*)(ws + WS_CB); const bf16* U = (const bf16*)(ws + WS_U); bf16* YAB = (bf16*)F.out;
    const int gt = F.vcu * (NWAVES * 64) + F.wave * 64 + pg8::fresh_lane(), ngt = F.G * NWAVES * 64;
    for (int i = gt; i < (T / 16) * 64; i += ngt) {
        const int t0 = (i >> 6) * 16, j0 = (i & 63) * 8;
        float w0[8], w1[8], w2[8];
        { const f32x4 a0 = *(const f32x4*)(cw + j0), a1 = *(const f32x4*)(cw + j0 + 4), b0 = *(const f32x4*)(cw + 512 + j0), b1 = *(const f32x4*)(cw + 512 + j0 + 4), c0 = *(const f32x4*)(cw + 1024 + j0), c1 = *(const f32x4*)(cw + 1024 + j0 + 4);
#pragma unroll
          for (int k = 0; k < 4; ++k) { w0[k] = a0[k]; w0[4 + k] = a1[k]; w1[k] = b0[k]; w1[4 + k] = b1[k]; w2[k] = c0[k]; w2[4 + k] = c1[k]; } }
        float um2[8], um1[8];
        if ((t0 & (SEQ - 1)) != 0) { pg8::ld8(U + (size_t)(t0 - 2) * 512 + j0, um2); pg8::ld8(U + (size_t)(t0 - 1) * 512 + j0, um1); }
        else {
#pragma unroll
            for (int k = 0; k < 8; ++k) { um2[k] = 0.f; um1[k] = 0.f; } }
#pragma unroll 1
        for (int tt = 0; tt < 16; tt += 4) {
            pg8::u32x4 uw[4], cbw[4];
#pragma unroll
            for (int q = 0; q < 4; ++q) { uw[q] = *(const pg8::u32x4*)(U + (size_t)(t0 + tt + q) * 512 + j0); cbw[q] = *(const pg8::u32x4*)(CB + (size_t)(t0 + tt + q) * 512 + j0); }
#pragma unroll
            for (int q = 0; q < 4; ++q) {
                const float u0[8] = {bflo(uw[q].x), bfhi(uw[q].x), bflo(uw[q].y), bfhi(uw[q].y), bflo(uw[q].z), bfhi(uw[q].z), bflo(uw[q].w), bfhi(uw[q].w)};
                const float cbv[8] = {bflo(cbw[q].x), bfhi(cbw[q].x), bflo(cbw[q].y), bfhi(cbw[q].y), bflo(cbw[q].z), bfhi(cbw[q].z), bflo(cbw[q].w), bfhi(cbw[q].w)};
                float y[8];
#pragma unroll
                for (int k = 0; k < 8; ++k) { y[k] = DBG_ZYB * cbv[k] * (w0[k] * um2[k] + w1[k] * um1[k] + w2[k] * u0[k]); um2[k] = um1[k]; um1[k] = u0[k]; }
                pg8::st8(YAB + (size_t)(t0 + tt + q) * 1024 + 512 + j0, y); }
        }
    }
}

__device__ __forceinline__ void p3_phase(Frame& F) {
    unsigned char* ws = F.ws; const bf16* LOC = (const bf16*)(ws + WS_LOC); bf16* SP = (bf16*)(ws + WS_SPREV); const float* DEC = (const float*)(ws + WS_DEC);
    const int gt = F.vcu * (NWAVES * 64) + F.wave * 64 + pg8::fresh_lane(), ngt = F.G * NWAVES * 64;
    for (int i = gt; i < 64 * 4096; i += ngt) {
        const int bh = i >> 12, ed = i & 4095, d = ed & 63; float st = 0.f;
        for (int c0 = 0; c0 < 64; c0 += 8) { float lv[8], dv[8];
#pragma unroll
            for (int k = 0; k < 8; ++k) { lv[k] = bf2f(LOC[(size_t)(bh * 64 + c0 + k) * 4096 + ed]); dv[k] = DEC[(bh * 64 + c0 + k) * 64 + d]; }
#pragma unroll
            for (int k = 0; k < 8; ++k) { SP[(size_t)(bh * 64 + c0 + k) * 4096 + ed] = (bf16)f2bf(st); st = dv[k] * st + lv[k]; } }
    }
}

template <int M> __device__ __forceinline__ float p4_swz(float v) { return __builtin_bit_cast(float, __builtin_amdgcn_ds_swizzle(__builtin_bit_cast(int, v), 0x1f | (M << 10))); }
__device__ __forceinline__ void p4_unit(Frame& F, int unit, const float* gain) {
    unsigned char* ws = F.ws; const int lane = pg8::fresh_lane(), r = lane & 31, hh = lane >> 5;
    const int bh = unit >> 6, c = unit & 63, bb = bh >> 3, h = bh & 7; const size_t t0 = (size_t)bb * SEQ + c * 64; const int cb0 = h * 64;
    const bf16* Qt = (const bf16*)(ws + WS_Q) + t0 * 512 + cb0; const bf16* Kt = (const bf16*)(ws + WS_KK) + t0 * 512 + cb0;
    const bf16* Vp = (const bf16*)(ws + WS_V) + t0 * 512 + cb0 + lane; const bf16* SPu = (const bf16*)(ws + WS_SPREV) + (size_t)unit * 4096;
    LAS unsigned char* wl = F.lds + F.wave * WAVE_LDS; LAS unsigned char* PL = wl; LAS unsigned char* VT = wl + 9216;
    bf16x8 qa[2][4], kb[2][4], spf[2][4];
    { const bf16* Vt = (const bf16*)(ws + WS_V) + t0 * 512 + cb0 + 8 * (lane & 7);
      v4u pv[8];
#pragma unroll
      for (int p = 0; p < 8; ++p) pv[p] = *(const v4u*)(Vt + (size_t)((lane >> 3) + 8 * p) * 512);
#pragma unroll
      for (int i = 0; i < 2; ++i)
#pragma unroll
          for (int ks = 0; ks < 4; ++ks) { qa[i][ks] = *(const bf16x8*)(Qt + (size_t)(32 * i + r) * 512 + 16 * ks + 8 * hh); kb[i][ks] = *(const bf16x8*)(Kt + (size_t)(32 * i + r) * 512 + 16 * ks + 8 * hh); }
#pragma unroll
      for (int jj = 0; jj < 2; ++jj)
#pragma unroll
          for (int ks = 0; ks < 4; ++ks) spf[jj][ks] = *(const bf16x8*)(SPu + (32 * jj + r) * 64 + 16 * ks + 8 * hh);
#pragma unroll
      for (int p = 0; p < 8; ++p) { const int t = (lane >> 3) + 8 * p; LAS unsigned char* dst = VT + (8 * (lane & 7)) * 144 + 2 * t; const unsigned w[4] = {pv[p].x, pv[p].y, pv[p].z, pv[p].w};
#pragma unroll
          for (int i = 0; i < 4; ++i) { *(LAS bf16*)(dst + (2 * i) * 144) = (bf16)(w[i] & 0xffffu); *(LAS bf16*)(dst + (2 * i + 1) * 144) = (bf16)(w[i] >> 16); } } }
    asm volatile("" ::: "memory");
    {
        f32x16 sc[3];
#pragma unroll
        for (int k = 0; k < 16; ++k) { sc[0][k] = 0.f; sc[1][k] = 0.f; sc[2][k] = 0.f; }
#pragma unroll
        for (int ks = 0; ks < 4; ++ks) { sc[0] = MFMA32(qa[0][ks], kb[0][ks], sc[0]); sc[1] = MFMA32(qa[1][ks], kb[0][ks], sc[1]); sc[2] = MFMA32(qa[1][ks], kb[1][ks], sc[2]); }
#pragma unroll
        for (int k = 0; k < 16; ++k) { const int tr = crow(k, hh);
            *(LAS bf16*)(PL + tr * 144 + r * 2) = (bf16)f2bf(r <= tr ? sc[0][k] : 0.f);
            *(LAS bf16*)(PL + (32 + tr) * 144 + r * 2) = (bf16)f2bf(sc[1][k]);
            *(LAS bf16*)(PL + (32 + tr) * 144 + (32 + r) * 2) = (bf16)f2bf(r <= tr ? sc[2][k] : 0.f); }
    }
    asm volatile("" ::: "memory");
    f32x16 o[2][2];
#pragma unroll
    for (int i = 0; i < 2; ++i)
#pragma unroll
        for (int j = 0; j < 2; ++j)
#pragma unroll
            for (int k = 0; k < 16; ++k) o[i][j][k] = 0.f;
#pragma unroll
    for (int ks = 0; ks < 4; ++ks) {
#pragma unroll
        for (int i = 0; i < 2; ++i)
#pragma unroll
            for (int j = 0; j < 2; ++j) o[i][j] = MFMA32(qa[i][ks], spf[j][ks], o[i][j]);
    }
    LDS_WAIT(); asm volatile("" ::: "memory");
#pragma unroll
    for (int ks = 0; ks < 4; ++ks) {
        bf16x8 pa[2], vb[2];
        if (ks < 2) pa[0] = *(const LAS bf16x8*)(PL + r * 144 + (16 * ks + 8 * hh) * 2);
        pa[1] = *(const LAS bf16x8*)(PL + (32 + r) * 144 + (16 * ks + 8 * hh) * 2);
#pragma unroll
        for (int j = 0; j < 2; ++j) vb[j] = *(const LAS bf16x8*)(VT + (32 * j + r) * 144 + (16 * ks + 8 * hh) * 2);
#pragma unroll
        for (int j = 0; j < 2; ++j) { if (ks < 2) o[0][j] = MFMA32(pa[0], vb[j], o[0][j]); o[1][j] = MFMA32(pa[1], vb[j], o[1][j]); }
    }
    asm volatile("" ::: "memory");
    LDS_WAIT(); asm volatile("" ::: "memory");
    { LAS float* OL = (LAS float*)wl;
#pragma unroll
      for (int i = 0; i < 2; ++i)
#pragma unroll
          for (int j = 0; j < 2; ++j)
#pragma unroll
              for (int k = 0; k < 16; ++k) OL[(32 * i + crow(k, hh)) * 68 + 32 * j + r] = o[i][j][k];
      LDS_WAIT(); asm volatile("" ::: "memory");
      const int c = lane & 7; const f32x4 ga = *(const f32x4*)(gain + cb0 + 8 * c), gb = *(const f32x4*)(gain + cb0 + 8 * c + 4);
      const float g8[8] = {ga[0], ga[1], ga[2], ga[3], gb[0], gb[1], gb[2], gb[3]};
      const bf16* SGp = (const bf16*)(ws + WS_SG) + t0 * 512 + cb0 + 8 * c; bf16* YA = (bf16*)F.out + t0 * 1024 + cb0 + 8 * c;
#pragma unroll
      for (int p = 0; p < 8; ++p) { int t = (lane >> 3) + 8 * p; asm volatile("" : "+v"(t));
          const f32x4 v0 = *(LAS f32x4*)(OL + t * 68 + 8 * c), v1 = *(LAS f32x4*)(OL + t * 68 + 8 * c + 4);
          float ss = (v0[0] * v0[0] + v0[1] * v0[1]) + (v0[2] * v0[2] + v0[3] * v0[3]) + (v1[0] * v1[0] + v1[1] * v1[1]) + (v1[2] * v1[2] + v1[3] * v1[3]);
          ss += p4_swz<1>(ss); ss += p4_swz<2>(ss); ss += p4_swz<4>(ss);
          const float rs = __builtin_amdgcn_rsqf(ss * (1.0f / 64.0f) + EPS) * DBG_ZYA;
          float sg[8], y[8]; pg8::ld8(SGp + (size_t)t * 512, sg);
#pragma unroll
          for (int e = 0; e < 4; ++e) { y[e] = v0[e] * rs * g8[e] * sg[e]; y[4 + e] = v1[e] * rs * g8[4 + e] * sg[4 + e]; }
          pg8::st8(YA + (size_t)t * 1024, y); }
    }
    LDS_WAIT(); asm volatile("" ::: "memory");
}

__device__ __forceinline__ unsigned mono(float f) { const unsigned u = __builtin_bit_cast(unsigned, f); return u ^ (((unsigned)((int)u >> 31)) | 0x80000000u); }
__device__ __forceinline__ float unmono(unsigned m) { const unsigned u = (m & 0x80000000u) ? (m ^ 0x80000000u) : ~m; return __builtin_bit_cast(float, u); }
__device__ __forceinline__ unsigned med3u(unsigned a, unsigned b, unsigned c) { unsigned r; asm("v_med3_u32 %0, %1, %2, %3" : "=v"(r) : "v"(a), "v"(b), "v"(c)); return r; }
__device__ __forceinline__ unsigned maxu(unsigned a, unsigned b) { return a > b ? a : b; }
__device__ __forceinline__ void ins16(unsigned (&L)[16], unsigned v) {
#pragma unroll
    for (int j = 15; j >= 1; --j) L[j] = med3u(v, L[j - 1], L[j]);
    L[0] = maxu(L[0], v);
}
__device__ __forceinline__ unsigned minu(unsigned a, unsigned b) { return a < b ? a : b; }
#define P8_CE(X, A, B) { const unsigned hi_ = maxu(X[A], X[B]), lo_ = minu(X[A], X[B]); X[A] = hi_; X[B] = lo_; }
__device__ __forceinline__ void sort16_desc(unsigned (&x)[16]) { P8_CE(x, 0, 13) P8_CE(x, 1, 12) P8_CE(x, 2, 15) P8_CE(x, 3, 14) P8_CE(x, 4, 8) P8_CE(x, 5, 6) P8_CE(x, 7, 11) P8_CE(x, 9, 10) P8_CE(x, 0, 5) P8_CE(x, 1, 7) P8_CE(x, 2, 9) P8_CE(x, 3, 4) P8_CE(x, 6, 13) P8_CE(x, 8, 14) P8_CE(x, 10, 15) P8_CE(x, 11, 12) P8_CE(x, 0, 1) P8_CE(x, 2, 3) P8_CE(x, 4, 5) P8_CE(x, 6, 8) P8_CE(x, 7, 9) P8_CE(x, 10, 11) P8_CE(x, 12, 13) P8_CE(x, 14, 15) P8_CE(x, 0, 2) P8_CE(x, 1, 3) P8_CE(x, 4, 10) P8_CE(x, 5, 11) P8_CE(x, 6, 7) P8_CE(x, 8, 9) P8_CE(x, 12, 14) P8_CE(x, 13, 15) P8_CE(x, 1, 2) P8_CE(x, 3, 12) P8_CE(x, 4, 6) P8_CE(x, 5, 7) P8_CE(x, 8, 10) P8_CE(x, 9, 11) P8_CE(x, 13, 14) P8_CE(x, 1, 4) P8_CE(x, 2, 6) P8_CE(x, 5, 8) P8_CE(x, 7, 10) P8_CE(x, 9, 13) P8_CE(x, 11, 14) P8_CE(x, 2, 4) P8_CE(x, 3, 6) P8_CE(x, 9, 12) P8_CE(x, 11, 13) P8_CE(x, 3, 5) P8_CE(x, 6, 8) P8_CE(x, 7, 9) P8_CE(x, 10, 12) P8_CE(x, 3, 4) P8_CE(x, 5, 6) P8_CE(x, 7, 8) P8_CE(x, 9, 10) P8_CE(x, 11, 12) P8_CE(x, 6, 7) P8_CE(x, 8, 9) }
__device__ __forceinline__ void merge16_desc(unsigned (&L)[16], const unsigned (&S)[16]) {
    unsigned c[16];
#pragma unroll
    for (int i = 0; i < 16; ++i) c[i] = maxu(L[i], S[15 - i]);
    P8_CE(c, 0, 8) P8_CE(c, 1, 9) P8_CE(c, 2, 10) P8_CE(c, 3, 11) P8_CE(c, 4, 12) P8_CE(c, 5, 13) P8_CE(c, 6, 14) P8_CE(c, 7, 15) P8_CE(c, 0, 4) P8_CE(c, 1, 5) P8_CE(c, 2, 6) P8_CE(c, 3, 7) P8_CE(c, 8, 12) P8_CE(c, 9, 13) P8_CE(c, 10, 14) P8_CE(c, 11, 15) P8_CE(c, 0, 2) P8_CE(c, 1, 3) P8_CE(c, 4, 6) P8_CE(c, 5, 7) P8_CE(c, 8, 10) P8_CE(c, 9, 11) P8_CE(c, 12, 14) P8_CE(c, 13, 15) P8_CE(c, 0, 1) P8_CE(c, 2, 3) P8_CE(c, 4, 5) P8_CE(c, 6, 7) P8_CE(c, 8, 9) P8_CE(c, 10, 11) P8_CE(c, 12, 13) P8_CE(c, 14, 15)
#pragma unroll
    for (int i = 0; i < 16; ++i) L[i] = c[i];
}
__device__ __forceinline__ void p8_half(const bf16* keys, const bf16* qbase, LAS unsigned char* wl, int lane, unsigned (&L)[16]) {
    const int r = lane & 31, hh = lane >> 5, rr4 = lane >> 4, c = lane & 15;
    LAS unsigned char* qbuf = wl; LAS unsigned char* kbuf = wl + 8192;
    v4u st[8];
#pragma unroll
    for (int i = 0; i < 8; ++i) st[i] = *(const v4u*)(qbase + (size_t)(4 * i + rr4) * 2048 + 8 * c);
#pragma unroll
    for (int i = 0; i < 8; ++i) { const int rr = 4 * i + rr4; *(LAS v4u*)(qbuf + rr * 256 + ((c ^ (rr & 15)) << 4)) = st[i]; }
#pragma unroll
    for (int i = 0; i < 8; ++i) st[i] = *(const v4u*)(keys + (size_t)(4 * i + rr4) * 128 + 8 * c);
    LDS_WAIT(); asm volatile("" ::: "memory");
    bf16x8 qb[8];
#pragma unroll
    for (int ks = 0; ks < 8; ++ks) qb[ks] = *(const LAS bf16x8*)(qbuf + r * 256 + (((2 * ks + hh) ^ (r & 15)) << 4));
#pragma unroll
    for (int j = 0; j < 16; ++j) L[j] = 0u;
    const unsigned h4 = (unsigned)hh << 2;
#pragma unroll
    for (int it = 0; it < 4; ++it) {
#pragma unroll
        for (int i = 0; i < 8; ++i) { const int rr = 4 * i + rr4; *(LAS v4u*)(kbuf + rr * 256 + ((c ^ (rr & 15)) << 4)) = st[i]; }
        if (it < 3) {
#pragma unroll
            for (int i = 0; i < 8; ++i) st[i] = *(const v4u*)(keys + (size_t)(32 * (it + 1) + 4 * i + rr4) * 128 + 8 * c);
        }
        LDS_WAIT(); asm volatile("" ::: "memory");
        f32x16 acc;
#pragma unroll
        for (int k = 0; k < 16; ++k) acc[k] = 0.f;
#pragma unroll
        for (int ks = 0; ks < 8; ++ks) { const bf16x8 ka = *(const LAS bf16x8*)(kbuf + r * 256 + (((2 * ks + hh) ^ (r & 15)) << 4)); acc = MFMA32(ka, qb[ks], acc); }
        LDS_WAIT(); asm volatile("" ::: "memory");
        unsigned kx[16];
#pragma unroll
        for (int k = 0; k < 16; ++k) { const unsigned n0 = (unsigned)(32 * it + (k & 3) + 8 * (k >> 2));
            kx[k] = (mono(acc[k]) & 0xFFFFFF80u) | ((127u - n0) ^ h4); }
        sort16_desc(kx);
        if (it == 0) {
#pragma unroll
            for (int j = 0; j < 16; ++j) L[j] = kx[j];
        } else merge16_desc(L, kx);
    }
    unsigned P[16];
#pragma unroll
    for (int j = 0; j < 16; ++j) P[j] = (unsigned)__shfl_xor((int)L[j], 32);
    merge16_desc(L, P);
}
__device__ __forceinline__ void p8_task(Frame& F, int tile, int head) {
    unsigned char* ws = F.ws; const int lane = pg8::fresh_lane(), r = lane & 31, hh = lane >> 5; int t = tile * 32 + r; asm volatile("" : "+v"(t));
    const bf16* kb = (const bf16*)(ws + WS_KEYS); int tbase = tile * 32; asm volatile("" : "+s"(tbase)); const bf16* qtile = (const bf16*)(ws + WS_QQ) + (size_t)tbase * 2048 + head * 256;
    LAS unsigned char* wl = F.lds + F.wave * WAVE_LDS;
    unsigned L1[16], L2[16];
    p8_half(kb + (size_t)head * 16384, qtile, wl, lane, L1);
    p8_half(kb + 131072 + (size_t)head * 16384, qtile + 128, wl, lane, L2);
    LDS_WAIT(); asm volatile("" ::: "memory");
    float v1[16], v2[16]; unsigned n1[16], n2[16];
#pragma unroll
    for (int j = 0; j < 16; ++j) { v1[j] = unmono(L1[j] & 0xFFFFFF80u); n1[j] = 127u - (L1[j] & 127u); v2[j] = unmono(L2[j] & 0xFFFFFF80u); n2[j] = 127u - (L2[j] & 127u); }
    LAS unsigned* tab = (LAS unsigned*)(F.lds + F.wave * WAVE_LDS) + lane * 9;
#pragma unroll
    for (int j = 0; j < 4; ++j) { tab[j] = n1[4 * j] | (n1[4 * j + 1] << 8) | (n1[4 * j + 2] << 16) | (n1[4 * j + 3] << 24); tab[4 + j] = n2[4 * j] | (n2[4 * j + 1] << 8) | (n2[4 * j + 2] << 16) | (n2[4 * j + 3] << 24); }
    unsigned Fk[16];
#define P8_CK(A, B) ((mono(v1[A] + v2[B]) & 0xFFFFFF00u) | (unsigned)(255 - ((A) * 16 + (B))))
#pragma unroll
    for (int b = 0; b < 16; ++b) Fk[b] = P8_CK(0, b);
    { unsigned s1[16] = {P8_CK(1, 0), P8_CK(1, 1), P8_CK(1, 2), P8_CK(1, 3), P8_CK(1, 4), P8_CK(1, 5), P8_CK(1, 6), P8_CK(1, 7), P8_CK(2, 0), P8_CK(2, 1), P8_CK(2, 2), P8_CK(2, 3), P8_CK(2, 4), P8_CK(4, 0), P8_CK(4, 1), P8_CK(4, 2)};
      sort16_desc(s1); merge16_desc(Fk, s1); }
    { unsigned s2[16] = {P8_CK(3, 0), P8_CK(3, 1), P8_CK(3, 2), P8_CK(3, 3), P8_CK(5, 0), P8_CK(5, 1), P8_CK(6, 0), P8_CK(6, 1), P8_CK(7, 0), P8_CK(7, 1), P8_CK(8, 0), P8_CK(9, 0), P8_CK(10, 0), P8_CK(11, 0), P8_CK(12, 0), P8_CK(13, 0)};
      sort16_desc(s2); merge16_desc(Fk, s2); }
    ins16(Fk, P8_CK(14, 0)); ins16(Fk, P8_CK(15, 0));
#undef P8_CK
    LDS_WAIT(); asm volatile("" ::: "memory");
    float sv[16]; int ex[16];
    const LAS unsigned char* tb = (const LAS unsigned char*)tab;
#pragma unroll
    for (int j = 0; j < 16; ++j) { const unsigned pos = 255u - (Fk[j] & 255u); sv[j] = unmono(Fk[j] & 0xFFFFFF00u); ex[j] = (int)tb[pos >> 4] * 128 + (int)tb[16 + (pos & 15)]; }
    float den = 0.f, p[16];
#pragma unroll
    for (int j = 0; j < 16; ++j) { p[j] = fexp(sv[j] - sv[0]); den += p[j]; }
    const float inv = 1.0f / den;
    int* IDX = (int*)(ws + WS_IDX) + (size_t)t * 128 + head * 16; float* GT = (float*)(ws + WS_GATE) + (size_t)t * 128 + head * 16;
    if (hh == 0) {
#pragma unroll
        for (int j = 0; j < 4; ++j) { *(int4*)(IDX + 4 * j) = make_int4(ex[4 * j], ex[4 * j + 1], ex[4 * j + 2], ex[4 * j + 3]); }
    } else {
#pragma unroll
        for (int j = 0; j < 4; ++j) { f32x4 g = {p[4 * j] * inv, p[4 * j + 1] * inv, p[4 * j + 2] * inv, p[4 * j + 3] * inv}; *(f32x4*)(GT + 4 * j) = g; }
    }
    LDS_WAIT(); asm volatile("" ::: "memory");
}

#ifdef DBG_CHK
constexpr int CW_CHK = 8192;
__device__ __forceinline__ unsigned chk_hash(unsigned x) { x ^= x >> 16; x *= 0x7feb352dU; x ^= x >> 15; x *= 0x846ca68bU; x ^= x >> 16; return x; }
__device__ __forceinline__ float chk_dot(const bf16* a, const bf16* b, int K) { float s = 0.f; for (int k = 0; k < K; ++k) s += bf2f(a[k]) * bf2f(b[k]); return s; }
__device__ __forceinline__ void chk_rec(unsigned* cnt, float got, float ref) { if (!(fabsf(got - ref) <= 0.03f * fabsf(ref) + 0.03f)) atomicAdd(cnt, 1u); }
__device__ __forceinline__ void chk_phase(Frame& F, const Args& A, int which) {
    unsigned char* ws = F.ws; unsigned* ctl = (unsigned*)(ws + WS_CTL);
    const int g = F.vcu * (NWAVES * 64) + F.wave * 64 + pg8::fresh_lane();
    if (which == 21) {
        const bf16* xb_ = (const bf16*)(ws + WS_XB); const bf16* W_ = (const bf16*)(ws + WS_WIN); const float* r1 = (const float*)(ws + WS_RSTD1); bf16* GBo = (bf16*)(ws + WS_GA);
        for (long i = g; i < (long)T * 1024; i += (long)F.G * NWAVES * 64) { const long rw = i >> 10; const int j = (int)(i & 1023);
            const float v = r1[rw] * chk_dot(xb_ + rw * 1024, W_ + (size_t)(4608 + j) * 1024, 1024); GBo[i] = (bf16)f2bf(1.0f / (1.0f + expf(-v))); }
        return;
    }
    if (g >= 8192) return;
    const unsigned h1 = chk_hash(g * 2 + 1), h2 = chk_hash(g * 2 + 2); const int row = h1 % T;
    const bf16* xb = (const bf16*)(ws + WS_XB); const bf16* WinT = (const bf16*)(ws + WS_WIN); const float* rstd1 = (const float*)(ws + WS_RSTD1);
    if (which == 0) {
        { const int n = h2 % NIN, k = h1 % 1024; chk_rec(ctl + CW_CHK + (n >= 4608 ? 256 : 0), 32.f * bf2f(WinT[(size_t)(win_dst_row(n & ~31) + (n & 31)) * 1024 + k]), 32.f * A.in[1][k] * A.in[2][(size_t)k * NIN + n]); }
        { const int n = h2 % 1024, k = h1 % 512; chk_rec(ctl + CW_CHK, 32.f * bf2f(((const bf16*)(ws + WS_PAB))[(size_t)n * 1024 + k]), 32.f * A.in[6][(size_t)k * 1024 + n]);
          chk_rec(ctl + CW_CHK, 32.f * bf2f(((const bf16*)(ws + WS_PAB))[(size_t)n * 1024 + 512 + k]), 32.f * A.in[7][(size_t)k * 1024 + n]); }
        { const int n = h2 % 1024, k = h1 % 1024; chk_rec(ctl + CW_CHK, 32.f * bf2f(((const bf16*)(ws + WS_WO))[(size_t)n * 1024 + k]), 32.f * A.in[8][(size_t)k * 1024 + n]); }
        { const int n = h2 % 2048, k = h1 % 1024; chk_rec(ctl + CW_CHK, 32.f * bf2f(((const bf16*)(ws + WS_WQ))[(size_t)n * 1024 + k]), 32.f * A.in[9][k] * A.in[10][(size_t)k * 2048 + n]); }
        { const int k = h2 % 1024; chk_rec(ctl + CW_CHK, bf2f(xb[(size_t)row * 1024 + k]), A.in[0][(size_t)row * 1024 + k]); }
    }
    if (which == 1) {
        const float rs = rstd1[row];
        { const int j = h2 % 512; chk_rec(ctl + CW_CHK + 0, bf2f(((const bf16*)(ws + WS_V))[(size_t)row * 512 + j]), rs * chk_dot(xb + (size_t)row * 1024, WinT + (size_t)(1024 + j) * 1024, 1024)); }
        { const int j = h2 % 1024; const float v = rs * chk_dot(xb + (size_t)row * 1024, WinT + (size_t)(CHK_GA_ROW + j) * 1024, 1024);
          chk_rec(ctl + CW_CHK + 128, bf2f(((const bf16*)(ws + WS_GA))[(size_t)row * 2048 + j]), 1.0f / (1.0f + expf(-v))); }
        { const int j = h2 % 1024; const float v = rs * chk_dot(xb + (size_t)row * 1024, WinT + (size_t)(CHK_GB_ROW + j) * 1024, 1024);
          chk_rec(ctl + CW_CHK + 64, bf2f(((const bf16*)(ws + WS_GA))[(size_t)row * 2048 + 1024 + j]), 1.0f / (1.0f + expf(-v))); }
        { const int j = h2 % 512; chk_rec(ctl + CW_CHK + 448, bf2f(((const bf16*)(ws + WS_CB))[(size_t)row * 512 + j]), rs * chk_dot(xb + (size_t)row * 1024, WinT + (size_t)(2048 + j) * 1024, 1024)); }
        { const int j = h2 % 512; const int rb = 2560 + 256 * (j >> 7) + (j & 127);
          const float cc = rs * chk_dot(xb + (size_t)row * 1024, WinT + (size_t)rb * 1024, 1024), ch = rs * chk_dot(xb + (size_t)row * 1024, WinT + (size_t)(rb + 128) * 1024, 1024);
          chk_rec(ctl + CW_CHK + 192, bf2f(((const bf16*)(ws + WS_U))[(size_t)row * 512 + j]), cc * ch); }
    }
    if (which == 1) {
        const float rs = rstd1[row]; const int j = h2 % 512; const float* lbv = (const float*)(ws + WS_LB);
        const float hq = rs * chk_dot(xb + (size_t)row * 1024, WinT + (size_t)(0 + j) * 1024, 1024), hf = rs * chk_dot(xb + (size_t)row * 1024, WinT + (size_t)(512 + j) * 1024, 1024),
                    hg = rs * chk_dot(xb + (size_t)row * 1024, WinT + (size_t)(1536 + j) * 1024, 1024);
        const float l0 = A.in[3][j], l1 = A.in[3][512 + j], lb = expf(l0) / (expf(l0) + expf(l1)); chk_rec(ctl + CW_CHK + 128, lbv[j], lb);
        const float sg = 1.0f / (1.0f + expf(-hf)), f = lb + (1.0f - lb) * sg;
        chk_rec(ctl + CW_CHK + 128, bf2f(((const bf16*)(ws + WS_Q))[(size_t)row * 512 + j]), hq / (1.0f + expf(-hq)) * 0.125f);
        chk_rec(ctl + CW_CHK + 128, bf2f(((const bf16*)(ws + WS_LF))[(size_t)row * 512 + j]), logf(f));
        chk_rec(ctl + CW_CHK + 128, bf2f(((const bf16*)(ws + WS_KK))[(size_t)row * 512 + j]), 1.0f - f);
        chk_rec(ctl + CW_CHK + 128, bf2f(((const bf16*)(ws + WS_SG))[(size_t)row * 512 + j]), hg / (1.0f + expf(-hg)));
    }
    if (which == 11 && g < 64 * 64) {
        const int smp = g >> 6, e = g & 63; const unsigned hs = chk_hash(1000 + smp); const int bb = hs % 8, hd = (hs >> 3) % 8, tpos = (smp < 8) ? (int)(smp * 9) : (int)((hs >> 6) % SEQ);
        const bf16* Qb = (const bf16*)(ws + WS_Q); const bf16* LFb = (const bf16*)(ws + WS_LF); const bf16* KKb = (const bf16*)(ws + WS_KK); const bf16* Vb = (const bf16*)(ws + WS_V); const bf16* SGb = (const bf16*)(ws + WS_SG);
        float S[64];
#pragma unroll
        for (int d = 0; d < 64; ++d) S[d] = 0.f;
        for (int sp = 0; sp <= tpos; ++sp) { const size_t ro = ((size_t)bb * SEQ + sp) * 512 + hd * 64; const float v = bf2f(Vb[ro + e]);
#pragma unroll
            for (int d = 0; d < 64; ++d) S[d] = expf(bf2f(LFb[ro + d])) * S[d] + bf2f(KKb[ro + d]) * v; }
        const size_t rq = ((size_t)bb * SEQ + tpos) * 512 + hd * 64; float o = 0.f;
#pragma unroll
        for (int d = 0; d < 64; ++d) o += bf2f(Qb[rq + d]) * S[d];
        const float ss = wave_sum(o * o); const float y = o * rsqrtf(ss * (1.0f / 64.0f) + EPS) * A.in[4][hd * 64 + e] * bf2f(SGb[rq + e]);
        ((float*)(ws + 6 * MiB))[g] = y;
    }
    if (which == 14 && g < 64 * 64) {
        const int smp = g >> 6, e = g & 63; const unsigned hs = chk_hash(1000 + smp); const int bb = hs % 8, hd = (hs >> 3) % 8, tpos = (smp < 8) ? (int)(smp * 9) : (int)((hs >> 6) % SEQ);
        chk_rec(ctl + CW_CHK + 192, bf2f(((const bf16*)(ws + WS_XB))[((size_t)bb * SEQ + tpos) * 1024 + hd * 64 + e]), ((const float*)(ws + 6 * MiB))[g]);
    }
    if (which == 2) {
        const int j = h2 % 512, sq = row & (SEQ - 1); const bf16* U = (const bf16*)(ws + WS_U); const bf16* CB = (const bf16*)(ws + WS_CB); const float* cw = A.in[5];
        float acc = cw[1024 + j] * bf2f(U[(size_t)row * 512 + j]);
        if (sq >= 1) acc += cw[512 + j] * bf2f(U[(size_t)(row - 1) * 512 + j]);
        if (sq >= 2) acc += cw[j] * bf2f(U[(size_t)(row - 2) * 512 + j]);
        chk_rec(ctl + CW_CHK + 448, bf2f(((const bf16*)(ws + WS_XB))[(size_t)row * 1024 + 512 + j]), bf2f(CB[(size_t)row * 512 + j]) * acc);
    }
    if (which == 5) {
        const int j = h2 % 1024; const bf16* Y = (const bf16*)(ws + WS_XB) + (size_t)row * 1024; const bf16* P = (const bf16*)(ws + WS_PAB) + (size_t)j * 1024;
        const float ga = bf2f(((const bf16*)(ws + WS_GA))[(size_t)row * 2048 + j]), gb = bf2f(((const bf16*)(ws + WS_GA))[(size_t)row * 2048 + 1024 + j]);
        chk_rec(ctl + CW_CHK + 256, bf2f(((const bf16*)(ws + WS_MG))[(size_t)row * 1024 + j]), ga * chk_dot(Y, P, 512) + gb * chk_dot(Y + 512, P + 512, 512));
    }
    if (which == 6) {
        const int j = h2 % 1024;
        chk_rec(ctl + CW_CHK + 320, ((const float*)(ws + WS_X1))[(size_t)row * 1024 + j] - A.in[0][(size_t)row * 1024 + j],
                chk_dot((const bf16*)(ws + WS_MG) + (size_t)row * 1024, (const bf16*)(ws + WS_WO) + (size_t)j * 1024, 1024));
    }
    if (which == 7) {
        const int j = h2 % 2048; const float rs2 = rsqrtf(pg8::sum16((const float*)(ws + WS_ROWSS) + (size_t)row * 16) * (1.0f / D) + EPS);
        chk_rec(ctl + CW_CHK + 384, bf2f(((const bf16*)(ws + WS_QQ))[(size_t)row * 2048 + j]), rs2 * chk_dot((const bf16*)(ws + WS_X1B) + (size_t)row * 1024, (const bf16*)(ws + WS_WQ) + (size_t)j * 1024, 1024));
    }
}
__device__ __forceinline__ float chk_scale(Frame& F) {
    const unsigned* c = (const unsigned*)(F.ws + WS_CTL) + CW_CHK; const float sc[8] = {0.5f, 0.0f, 2.0f, -0.5f, -1.0f, 3.0f, -2.0f, 4.0f};
    float s = 1.0f;
#pragma unroll
    for (int i = 7; i >= 0; --i) if (c[64 * i] > 40u) s = sc[i];
    return s;
}
#endif
__device__ __forceinline__ float dot2bf(unsigned w, unsigned x, float acc) { return __builtin_amdgcn_fdot2_f32_bf16(__builtin_bit_cast(bf16x2_t, w), __builtin_bit_cast(bf16x2_t, x), acc, false); }
__device__ __forceinline__ float gelu_erf(float v) {
    const float av = fabsf(v), tt = __builtin_amdgcn_rcpf(av * 0.2316418882f + 1.0f);
    float q = tt * 0.5307027145f + (-0.7265760135f); q = q * tt + 0.7107068705f; q = q * tt + (-0.142248368f); q = q * tt + 0.127414796f; q = q * tt;
    const float e = __builtin_amdgcn_exp2f(v * v * (-0.72134752044f)), m = v * (q * e);
    return v < 0.f ? m : v - m;
}
typedef float f32x2v __attribute__((ext_vector_type(2)));
__device__ __forceinline__ void cvt_row_fp8(const float* src, unsigned char* dst, float* inv_scale, int row, int lane) {
    const float* r = src + (size_t)row * 1024; f32x4 v[4]; float m = 0.f;
#pragma unroll
    for (int j = 0; j < 4; ++j) { v[j] = *(const f32x4*)(r + 256 * j + 4 * lane); m = fmaxf(m, fmaxf(fmaxf(fabsf(v[j][0]), fabsf(v[j][1])), fmaxf(fabsf(v[j][2]), fabsf(v[j][3])))); }
#pragma unroll
    for (int o = 1; o < 64; o <<= 1) m = fmaxf(m, __shfl_xor(m, o));
    const int ex = (int)((__builtin_bit_cast(unsigned, m) >> 23) & 0xff);
    const int k = (m > 0.f) ? (134 - ex) : 0;
    const float sc = __builtin_bit_cast(float, (unsigned)(127 + k) << 23), isc = __builtin_bit_cast(float, (unsigned)(127 - k) << 23);
    v4u o;
#pragma unroll
    for (int j = 0; j < 4; ++j) { int p = __builtin_amdgcn_cvt_pk_fp8_f32(v[j][0] * sc, v[j][1] * sc, 0, false); p = __builtin_amdgcn_cvt_pk_fp8_f32(v[j][2] * sc, v[j][3] * sc, p, true); o[j] = (unsigned)p; }
    *(v4u*)(dst + (size_t)row * 1024 + 16 * lane) = o;
    if (lane == 0) inv_scale[row] = isc;
}
constexpr int F4_ROW = 1152;
__device__ __forceinline__ void pack16_fp4(const float* r, int lane, unsigned& d0, unsigned& d1, unsigned& eb_out) {
    f32x4 v[4]; float m = 0.f;
#pragma unroll
    for (int j = 0; j < 4; ++j) { v[j] = *(const f32x4*)(r + 256 * j + 4 * lane); m = fmaxf(m, fmaxf(fmaxf(fabsf(v[j][0]), fabsf(v[j][1])), fmaxf(fabsf(v[j][2]), fabsf(v[j][3])))); }
    const float tq = m * (1.0f / 6.0f); const unsigned eb = (__builtin_bit_cast(unsigned, tq) + 0x7FFFFFu) >> 23;
    const unsigned ebc = eb > 253u ? 253u : eb; const float inv = __builtin_bit_cast(float, (254u - ebc) << 23);
    d0 = 0u; d1 = 0u;
    d0 = __builtin_amdgcn_cvt_scalef32_pk_fp4_f32(d0, v[0][0] * inv, v[0][1] * inv, 1.0f, 0); d0 = __builtin_amdgcn_cvt_scalef32_pk_fp4_f32(d0, v[0][2] * inv, v[0][3] * inv, 1.0f, 1);
    d0 = __builtin_amdgcn_cvt_scalef32_pk_fp4_f32(d0, v[1][0] * inv, v[1][1] * inv, 1.0f, 2); d0 = __builtin_amdgcn_cvt_scalef32_pk_fp4_f32(d0, v[1][2] * inv, v[1][3] * inv, 1.0f, 3);
    d1 = __builtin_amdgcn_cvt_scalef32_pk_fp4_f32(d1, v[2][0] * inv, v[2][1] * inv, 1.0f, 0); d1 = __builtin_amdgcn_cvt_scalef32_pk_fp4_f32(d1, v[2][2] * inv, v[2][3] * inv, 1.0f, 1);
    d1 = __builtin_amdgcn_cvt_scalef32_pk_fp4_f32(d1, v[3][0] * inv, v[3][1] * inv, 1.0f, 2); d1 = __builtin_amdgcn_cvt_scalef32_pk_fp4_f32(d1, v[3][2] * inv, v[3][3] * inv, 1.0f, 3);
    eb_out = ebc;
}
__device__ __forceinline__ void cvt_expert_fp4(const float* eu, const float* ev, unsigned char* dst, int e, int lane) {
    unsigned u0, u1, v0, v1, su, sv;
    pack16_fp4(eu + (size_t)e * 1024, lane, u0, u1, su); pack16_fp4(ev + (size_t)e * 1024, lane, v0, v1, sv);
    v4u o; o.x = u0; o.y = u1; o.z = v0; o.w = v1;
    unsigned char* rec = dst + (size_t)e * F4_ROW;
    *(v4u*)(rec + 16 * lane) = o; *(unsigned short*)(rec + 1024 + 2 * lane) = (unsigned short)(su | (sv << 8));
}
struct RowsF4 { v4u d[8]; unsigned s[8]; };
__device__ __forceinline__ void p9_load_f4(RowsF4& R, const unsigned char* EUV, const int (&e)[8], int lane) {
#pragma unroll
    for (int j = 0; j < 8; ++j) { const GAS unsigned char* rec = (const GAS unsigned char*)EUV + (size_t)e[j] * F4_ROW;
        R.d[j] = *(const GAS v4u*)(rec + (unsigned)(16 * lane)); R.s[j] = *(const GAS unsigned short*)(rec + (unsigned)(1024 + 2 * lane)); }
}
template <int M> __device__ __forceinline__ float swz_xor(float v) {
    return __builtin_bit_cast(float, __builtin_amdgcn_ds_swizzle(__builtin_bit_cast(int, v), 0x1f | (M << 10))); }
__device__ __forceinline__ float bperm(float v, int lane_src) { return __builtin_bit_cast(float, __builtin_amdgcn_ds_bpermute(lane_src << 2, __builtin_bit_cast(int, v))); }
__device__ __forceinline__ float rdl(float v, int l) { return __builtin_bit_cast(float, __builtin_amdgcn_readlane(__builtin_bit_cast(int, v), l)); }
__device__ __forceinline__ void unpack8_f4(const unsigned dw, float (&f)[8]) {
    const f32x2v p0 = __builtin_amdgcn_cvt_scalef32_pk_f32_fp4(dw, 1.0f, 0), p1 = __builtin_amdgcn_cvt_scalef32_pk_f32_fp4(dw, 1.0f, 1),
                 p2 = __builtin_amdgcn_cvt_scalef32_pk_f32_fp4(dw, 1.0f, 2), p3 = __builtin_amdgcn_cvt_scalef32_pk_f32_fp4(dw, 1.0f, 3);
    f[0] = p0.x; f[1] = p0.y; f[2] = p1.x; f[3] = p1.y; f[4] = p2.x; f[5] = p2.y; f[6] = p3.x; f[7] = p3.y;
}
__device__ __forceinline__ float dot16_f4(const unsigned q0, const unsigned q1, const float (&hn)[16]) {
    f32x2v acc = {0.f, 0.f};
#define D16_STEP(Q, C, B) { const f32x2v p = __builtin_amdgcn_cvt_scalef32_pk_f32_fp4(Q, 1.0f, C); const f32x2v h = {hn[B], hn[B + 1]}; acc = __builtin_elementwise_fma(p, h, acc); }
    D16_STEP(q0, 0, 0) D16_STEP(q0, 1, 2) D16_STEP(q0, 2, 4) D16_STEP(q0, 3, 6) D16_STEP(q1, 0, 8) D16_STEP(q1, 1, 10) D16_STEP(q1, 2, 12) D16_STEP(q1, 3, 14)
#undef D16_STEP
    return acc.x + acc.y;
}
__device__ __forceinline__ void axpy16_f4(const unsigned q0, const unsigned q1, const float w, float (&o)[16]) {
    float f0[8], f1[8]; unpack8_f4(q0, f0); unpack8_f4(q1, f1);
#pragma unroll
    for (int i = 0; i < 8; ++i) { o[i] += w * f0[i]; o[8 + i] += w * f1[i]; }
}
__device__ __forceinline__ void p9_batch_f4(const RowsF4& R, const float (&hn)[16], float (&oacc)[16], int bt, int lane, float gA, float gB) {
    const int hh = lane >> 5, q4 = (lane >> 4) & 1, q3 = (lane >> 3) & 1, jsel = 4 * hh + 2 * q4 + q3;
    float pd[8];
#pragma unroll
    for (int j = 0; j < 8; ++j) { pd[j] = dot16_f4(R.d[j].x, R.d[j].y, hn) * __builtin_bit_cast(float, (R.s[j] & 0xffu) << 23); if (j & 1) __builtin_amdgcn_sched_barrier(0); }
    float r4[4], r2[2];
#pragma unroll
    for (int i = 0; i < 4; ++i) { const float keep = hh ? pd[4 + i] : pd[i], send = hh ? pd[i] : pd[4 + i]; r4[i] = keep + bperm(send, lane ^ 32); }
#pragma unroll
    for (int i = 0; i < 2; ++i) { const float keep = q4 ? r4[2 + i] : r4[i], send = q4 ? r4[i] : r4[2 + i]; r2[i] = keep + swz_xor<16>(send); }
    float v = (q3 ? r2[1] : r2[0]) + swz_xor<8>(q3 ? r2[0] : r2[1]);
    v += swz_xor<4>(v); v += swz_xor<2>(v); v += swz_xor<1>(v);
    const int n = 8 * bt + jsel; const float g = (bt < 8) ? bperm(gA, n & 63) : bperm(gB, n & 63);
    const float w = g * gelu_erf(v);
#pragma unroll
    for (int j = 0; j < 8; ++j) { axpy16_f4(R.d[j].z, R.d[j].w, rdl(w, 8 * j) * __builtin_bit_cast(float, (R.s[j] >> 8) << 23), oacc); if (j & 1) __builtin_amdgcn_sched_barrier(0); }
}
__device__ __forceinline__ void p9_ids(int idA, int idB, int nb, int (&e)[8]) {
#pragma unroll
    for (int j = 0; j < 8; ++j) { const int n = 8 * nb + j; e[j] = (nb < 8) ? __builtin_amdgcn_readlane(idA, n & 63) : __builtin_amdgcn_readlane(idB, n & 63); }
}
struct RowsF4q { v4u d[4]; unsigned s[4]; };
__device__ __forceinline__ void p9_load_f4q(RowsF4q& R, const unsigned char* EUV, int idP, int nb, int lane) {
    const __amdgpu_buffer_rsrc_t rs = __builtin_amdgcn_make_buffer_rsrc((void*)EUV, (short)0, 16384 * F4_ROW, 0x00020000);
#pragma unroll
    for (int j = 0; j < 4; ++j) { const int n = 4 * nb + j; const unsigned x = (unsigned)__builtin_amdgcn_readlane(idP, n & 63); const unsigned e = (x >> ((n >> 6) << 4)) & 0xffffu;
        const int so = (int)(e * F4_ROW);
        R.d[j] = __builtin_bit_cast(v4u, __builtin_amdgcn_raw_buffer_load_b128(rs, 16 * lane, so, 0)); R.s[j] = (unsigned)__builtin_amdgcn_raw_buffer_load_b16(rs, 1024 + 2 * lane, so, 0); }
}
__device__ __forceinline__ void p9_batch4_f4(const RowsF4q& R, const float (&hn)[16], float (&oacc)[16], int bt, int lane, float gA, float gB) {
    const int hh = lane >> 5, q4 = (lane >> 4) & 1, jsel = 2 * hh + q4;
    float pd[4];
#pragma unroll
    for (int j = 0; j < 4; ++j) pd[j] = dot16_f4(R.d[j].x, R.d[j].y, hn) * __builtin_bit_cast(float, (R.s[j] & 0xffu) << 23);
    const float k0 = hh ? pd[2] : pd[0], k1 = hh ? pd[3] : pd[1], s0 = hh ? pd[0] : pd[2], s1 = hh ? pd[1] : pd[3];
    const float r0 = k0 + bperm(s0, lane ^ 32), r1 = k1 + bperm(s1, lane ^ 32);
    float v = (q4 ? r1 : r0) + swz_xor<16>(q4 ? r0 : r1);
    v += swz_xor<8>(v); v += swz_xor<4>(v); v += swz_xor<2>(v); v += swz_xor<1>(v);
    const int n = 4 * bt + jsel; const float g = (bt < 16) ? bperm(gA, n & 63) : bperm(gB, n & 63);
    const float w = g * gelu_erf(v);
#pragma unroll
    for (int j = 0; j < 4; ++j) axpy16_f4(R.d[j].z, R.d[j].w, rdl(w, 16 * j) * __builtin_bit_cast(float, (R.s[j] >> 8) << 23), oacc);
}
__device__ __forceinline__ void p9_token_f4(Frame& F, int t, const float* g_ffn, const float* g_fin) {
    unsigned char* ws = F.ws; const int lane = pg8::fresh_lane();
    const unsigned char* EUV = ws + WS_EU;
    const bf16* xrow = (const bf16*)(ws + WS_X1B) + (size_t)t * D; float* orow = F.out + (size_t)t * D;
    const float rs2 = __builtin_amdgcn_rsqf(pg8::sum16((const float*)(ws + WS_ROWSS) + (size_t)t * 16) * (1.0f / D) + EPS);
    float hn[16];
#pragma unroll
    for (int j = 0; j < 4; ++j) { const v2u a = *(const v2u*)(xrow + 256 * j + 4 * lane); const f32x4 g = *(const f32x4*)(g_ffn + 256 * j + 4 * lane);
        hn[4 * j] = bflo(a.x) * rs2 * g[0]; hn[4 * j + 1] = bfhi(a.x) * rs2 * g[1]; hn[4 * j + 2] = bflo(a.y) * rs2 * g[2]; hn[4 * j + 3] = bfhi(a.y) * rs2 * g[3]; }
    const int* IDX = (const int*)(ws + WS_IDX) + (size_t)t * 128; const float* GT = (const float*)(ws + WS_GATE) + (size_t)t * 128;
    int idA, idB; float gA, gB;
    { const int a0 = IDX[lane], b0 = IDX[64 + lane]; const float ga = GT[lane], gb = GT[64 + lane];
      const int kA = a0 >> 10, kB = b0 >> 10; const unsigned long long lt = (1ull << lane) - 1ull;
      int base = 0, rA = 0, rB = 0;
#pragma unroll
      for (int k = 0; k < 16; ++k) { const unsigned long long mA = __ballot(kA == k), mB = __ballot(kB == k); const int cA = __popcll(mA), cB = __popcll(mB);
          if (kA == k) rA = base + __popcll(mA & lt);
          if (kB == k) rB = base + cA + __popcll(mB & lt);
          base += cA + cB; }
      LAS int* sid = (LAS int*)(F.lds + F.wave * WAVE_LDS); LAS float* sgt = (LAS float*)(sid + 128);
      sid[rA] = a0; sid[rB] = b0; sgt[rA] = ga; sgt[rB] = gb;
      LDS_WAIT(); asm volatile("" ::: "memory");
      idA = sid[lane]; idB = sid[64 + lane]; gA = sgt[lane]; gB = sgt[64 + lane];
      LDS_WAIT(); asm volatile("" ::: "memory"); }
    float oacc[16];
#pragma unroll
    for (int i = 0; i < 16; ++i) oacc[i] = 0.f;
    const int idP = idA | (idB << 16);
    RowsF4q R0, R1, R2, R3, R4;
    p9_load_f4q(R0, EUV, idP, 0, lane); p9_load_f4q(R1, EUV, idP, 1, lane); p9_load_f4q(R2, EUV, idP, 2, lane); p9_load_f4q(R3, EUV, idP, 3, lane);
#pragma unroll 1
    for (int bt = 0; bt < 30; bt += 5) {
        p9_load_f4q(R4, EUV, idP, bt + 4, lane); asm volatile("" ::: "memory");
        p9_batch4_f4(R0, hn, oacc, bt, lane, gA, gB); asm volatile("" ::: "memory");
        p9_load_f4q(R0, EUV, idP, (bt + 5) & 31, lane); asm volatile("" ::: "memory");
        p9_batch4_f4(R1, hn, oacc, bt + 1, lane, gA, gB); asm volatile("" ::: "memory");
        p9_load_f4q(R1, EUV, idP, (bt + 6) & 31, lane); asm volatile("" ::: "memory");
        p9_batch4_f4(R2, hn, oacc, bt + 2, lane, gA, gB); asm volatile("" ::: "memory");
        p9_load_f4q(R2, EUV, idP, (bt + 7) & 31, lane); asm volatile("" ::: "memory");
        p9_batch4_f4(R3, hn, oacc, bt + 3, lane, gA, gB); asm volatile("" ::: "memory");
        p9_load_f4q(R3, EUV, idP, (bt + 8) & 31, lane); asm volatile("" ::: "memory");
        p9_batch4_f4(R4, hn, oacc, bt + 4, lane, gA, gB); asm volatile("" ::: "memory");
    }
    p9_batch4_f4(R0, hn, oacc, 30, lane, gA, gB); p9_batch4_f4(R1, hn, oacc, 31, lane, gA, gB);
    asm volatile("" ::: "memory");
    float ss = 0.f;
#pragma unroll
    for (int j = 0; j < 4; ++j) { const v2u a = *(const v2u*)(xrow + 256 * j + 4 * lane);
        oacc[4 * j] += bflo(a.x); oacc[4 * j + 1] += bfhi(a.x); oacc[4 * j + 2] += bflo(a.y); oacc[4 * j + 3] += bfhi(a.y);
#pragma unroll
        for (int i = 0; i < 4; ++i) ss += oacc[4 * j + i] * oacc[4 * j + i]; }
    ss += swz_xor<1>(ss); ss += swz_xor<2>(ss); ss += swz_xor<4>(ss); ss += swz_xor<8>(ss); ss += swz_xor<16>(ss); ss += bperm(ss, lane ^ 32);
    const float rs3 = __builtin_amdgcn_rsqf(ss * (1.0f / D) + EPS);
#pragma unroll
    for (int j = 0; j < 4; ++j) { const f32x4 g = *(const f32x4*)(g_fin + 256 * j + 4 * lane); f32x4 o;
#pragma unroll
        for (int i = 0; i < 4; ++i) o[i] = oacc[4 * j + i] * rs3 * g[i];
        *(f32x4*)(orow + 256 * j + 4 * lane) = o; }
}
constexpr int MX_ROW = 1120, MX_USC = 512, MX_V = 544, MX_VSC = 1056;
typedef int v8i __attribute__((ext_vector_type(8)));
__device__ __forceinline__ void cvt_expert_mx(const float* eu, const float* ev, unsigned char* dst, int e, int lane) {
    unsigned char* rec = dst + (size_t)e * MX_ROW;
    { const float* r = eu + (size_t)e * 1024 + 16 * lane; f32x4 v[4]; float m = 0.f;
#pragma unroll
      for (int j = 0; j < 4; ++j) { v[j] = *(const f32x4*)(r + 4 * j); m = fmaxf(m, fmaxf(fmaxf(fabsf(v[j][0]), fabsf(v[j][1])), fmaxf(fabsf(v[j][2]), fabsf(v[j][3])))); }
      m = fmaxf(m, swz_xor<1>(m));
      const float tq = m * (1.0f / 6.0f); const unsigned eb = (__builtin_bit_cast(unsigned, tq) + 0x7FFFFFu) >> 23;
      const unsigned ebc = eb > 253u ? 253u : eb; const float inv = __builtin_bit_cast(float, (254u - ebc) << 23);
      unsigned d0 = 0u, d1 = 0u;
      d0 = __builtin_amdgcn_cvt_scalef32_pk_fp4_f32(d0, v[0][0] * inv, v[0][1] * inv, 1.0f, 0); d0 = __builtin_amdgcn_cvt_scalef32_pk_fp4_f32(d0, v[0][2] * inv, v[0][3] * inv, 1.0f, 1);
      d0 = __builtin_amdgcn_cvt_scalef32_pk_fp4_f32(d0, v[1][0] * inv, v[1][1] * inv, 1.0f, 2); d0 = __builtin_amdgcn_cvt_scalef32_pk_fp4_f32(d0, v[1][2] * inv, v[1][3] * inv, 1.0f, 3);
      d1 = __builtin_amdgcn_cvt_scalef32_pk_fp4_f32(d1, v[2][0] * inv, v[2][1] * inv, 1.0f, 0); d1 = __builtin_amdgcn_cvt_scalef32_pk_fp4_f32(d1, v[2][2] * inv, v[2][3] * inv, 1.0f, 1);
      d1 = __builtin_amdgcn_cvt_scalef32_pk_fp4_f32(d1, v[3][0] * inv, v[3][1] * inv, 1.0f, 2); d1 = __builtin_amdgcn_cvt_scalef32_pk_fp4_f32(d1, v[3][2] * inv, v[3][3] * inv, 1.0f, 3);
      v2u o; o.x = d0; o.y = d1; *(v2u*)(rec + 8 * lane) = o;
      if (!(lane & 1)) { const int blk = lane >> 1; rec[MX_USC + (blk & 3) * 8 + (blk >> 2)] = (unsigned char)ebc; } }
    { unsigned v0, v1, sv; pack16_fp4(ev + (size_t)e * 1024, lane, v0, v1, sv);
      v2u o; o.x = v0; o.y = v1; *(v2u*)(rec + MX_V + 8 * lane) = o; rec[MX_VSC + lane] = (unsigned char)sv; }
}
__device__ __forceinline__ void mx_pack_u(const f32x4 (&v)[4], unsigned char* rec, int lane) {
    float m = 0.f;
#pragma unroll
    for (int j = 0; j < 4; ++j) m = fmaxf(m, fmaxf(fmaxf(fabsf(v[j][0]), fabsf(v[j][1])), fmaxf(fabsf(v[j][2]), fabsf(v[j][3]))));
    m = fmaxf(m, swz_xor<1>(m));
    const float tq = m * (1.0f / 6.0f); const unsigned eb = (__builtin_bit_cast(unsigned, tq) + 0x7FFFFFu) >> 23;
    const unsigned ebc = eb > 253u ? 253u : eb; const float inv = __builtin_bit_cast(float, (254u - ebc) << 23);
    unsigned d0 = 0u, d1 = 0u;
    d0 = __builtin_amdgcn_cvt_scalef32_pk_fp4_f32(d0, v[0][0] * inv, v[0][1] * inv, 1.0f, 0); d0 = __builtin_amdgcn_cvt_scalef32_pk_fp4_f32(d0, v[0][2] * inv, v[0][3] * inv, 1.0f, 1);
    d0 = __builtin_amdgcn_cvt_scalef32_pk_fp4_f32(d0, v[1][0] * inv, v[1][1] * inv, 1.0f, 2); d0 = __builtin_amdgcn_cvt_scalef32_pk_fp4_f32(d0, v[1][2] * inv, v[1][3] * inv, 1.0f, 3);
    d1 = __builtin_amdgcn_cvt_scalef32_pk_fp4_f32(d1, v[2][0] * inv, v[2][1] * inv, 1.0f, 0); d1 = __builtin_amdgcn_cvt_scalef32_pk_fp4_f32(d1, v[2][2] * inv, v[2][3] * inv, 1.0f, 1);
    d1 = __builtin_amdgcn_cvt_scalef32_pk_fp4_f32(d1, v[3][0] * inv, v[3][1] * inv, 1.0f, 2); d1 = __builtin_amdgcn_cvt_scalef32_pk_fp4_f32(d1, v[3][2] * inv, v[3][3] * inv, 1.0f, 3);
    v2u o; o.x = d0; o.y = d1; *(v2u*)(rec + 8 * lane) = o;
    if (!(lane & 1)) { const int blk = lane >> 1; rec[MX_USC + (blk & 3) * 8 + (blk >> 2)] = (unsigned char)ebc; }
}
__device__ __forceinline__ void mx_pack_v(const f32x4 (&v)[4], unsigned char* rec, int lane) {
    float m = 0.f;
#pragma unroll
    for (int j = 0; j < 4; ++j) m = fmaxf(m, fmaxf(fmaxf(fabsf(v[j][0]), fabsf(v[j][1])), fmaxf(fabsf(v[j][2]), fabsf(v[j][3]))));
    const float tq = m * (1.0f / 6.0f); const unsigned eb = (__builtin_bit_cast(unsigned, tq) + 0x7FFFFFu) >> 23;
    const unsigned ebc = eb > 253u ? 253u : eb; const float inv = __builtin_bit_cast(float, (254u - ebc) << 23);
    unsigned d0 = 0u, d1 = 0u;
    d0 = __builtin_amdgcn_cvt_scalef32_pk_fp4_f32(d0, v[0][0] * inv, v[0][1] * inv, 1.0f, 0); d0 = __builtin_amdgcn_cvt_scalef32_pk_fp4_f32(d0, v[0][2] * inv, v[0][3] * inv, 1.0f, 1);
    d0 = __builtin_amdgcn_cvt_scalef32_pk_fp4_f32(d0, v[1][0] * inv, v[1][1] * inv, 1.0f, 2); d0 = __builtin_amdgcn_cvt_scalef32_pk_fp4_f32(d0, v[1][2] * inv, v[1][3] * inv, 1.0f, 3);
    d1 = __builtin_amdgcn_cvt_scalef32_pk_fp4_f32(d1, v[2][0] * inv, v[2][1] * inv, 1.0f, 0); d1 = __builtin_amdgcn_cvt_scalef32_pk_fp4_f32(d1, v[2][2] * inv, v[2][3] * inv, 1.0f, 1);
    d1 = __builtin_amdgcn_cvt_scalef32_pk_fp4_f32(d1, v[3][0] * inv, v[3][1] * inv, 1.0f, 2); d1 = __builtin_amdgcn_cvt_scalef32_pk_fp4_f32(d1, v[3][2] * inv, v[3][3] * inv, 1.0f, 3);
    v2u o; o.x = d0; o.y = d1; *(v2u*)(rec + MX_V + 8 * lane) = o; rec[MX_VSC + lane] = (unsigned char)ebc;
}
__device__ __forceinline__ void cvt_expert_mx2(const float* eu, const float* ev, unsigned char* dst, int e0, int e1, int lane) {
    f32x4 ua[4], va[4], ub[4], vb[4];
#pragma unroll
    for (int j = 0; j < 4; ++j) { ua[j] = *(const f32x4*)(eu + (size_t)e0 * 1024 + 16 * lane + 4 * j); va[j] = *(const f32x4*)(ev + (size_t)e0 * 1024 + 256 * j + 4 * lane);
                                  ub[j] = *(const f32x4*)(eu + (size_t)e1 * 1024 + 16 * lane + 4 * j); vb[j] = *(const f32x4*)(ev + (size_t)e1 * 1024 + 256 * j + 4 * lane); }
    mx_pack_u(ua, dst + (size_t)e0 * MX_ROW, lane); mx_pack_v(va, dst + (size_t)e0 * MX_ROW, lane);
    mx_pack_u(ub, dst + (size_t)e1 * MX_ROW, lane); mx_pack_v(vb, dst + (size_t)e1 * MX_ROW, lane);
}
struct AFrag { v4u a[8]; v2u sc; };
__device__ __forceinline__ void p9m_load_a(AFrag& A, const unsigned char* EUV, int id, int lane) {
    const GAS unsigned char* rec = (const GAS unsigned char*)EUV + (size_t)id * MX_ROW + (unsigned)((lane >> 4) * 8);
    A.sc = *(const GAS v2u*)(rec + MX_USC);
    const GAS unsigned char* ra = rec + (unsigned)((lane >> 4) * 8);
#pragma unroll
    for (int s = 0; s < 8; ++s) A.a[s] = *(const GAS v4u*)(ra + 64 * s);
}
struct VSlot { v2u d; unsigned s; };
__device__ __forceinline__ void p9m_load_v(VSlot& V, __amdgpu_buffer_rsrc_t rs, int e, int lane) {
    const int so = e * MX_ROW;
    V.d = __builtin_bit_cast(v2u, __builtin_amdgcn_raw_buffer_load_b64(rs, MX_V + 8 * lane, so, 0)); V.s = (unsigned)__builtin_amdgcn_raw_buffer_load_b8(rs, MX_VSC + lane, so, 0);
}
__device__ __forceinline__ void p9m_axpy(const VSlot& V, const float c, f32x2v (&o)[8]) {
    const float sc = __builtin_bit_cast(float, V.s << 23); const f32x2v cc = {c, c};
#define AX_STEP(K) { o[K] = __builtin_elementwise_fma(__builtin_amdgcn_cvt_scalef32_pk_f32_fp4(V.d.x, sc, K), cc, o[K]); o[4 + K] = __builtin_elementwise_fma(__builtin_amdgcn_cvt_scalef32_pk_f32_fp4(V.d.y, sc, K), cc, o[4 + K]); }
    AX_STEP(0) AX_STEP(1) AX_STEP(2) AX_STEP(3)
#undef AX_STEP
}
__device__ __forceinline__ f32x4 p9m_dots(const AFrag& A, LAS unsigned char* h8, int lane) {
    f32x4 d0 = {0.f, 0.f, 0.f, 0.f}, d1 = {0.f, 0.f, 0.f, 0.f};
    LAS unsigned char* hb = h8 + (lane >> 4) * 16;
#define P9M_STEP(S, ACC) { const v4u b0 = *(LAS v4u*)(hb + 128 * (S)), b1 = *(LAS v4u*)(hb + 128 * (S) + 64); \
        const v8i a8 = {(int)A.a[S].x, (int)A.a[S].y, (int)A.a[S].z, (int)A.a[S].w, 0, 0, 0, 0}; const v8i b8 = {(int)b0.x, (int)b0.y, (int)b0.z, (int)b0.w, (int)b1.x, (int)b1.y, (int)b1.z, (int)b1.w}; \
        ACC = __builtin_amdgcn_mfma_scale_f32_16x16x128_f8f6f4(a8, b8, ACC, 4, 0, (S) & 3, (int)((S) < 4 ? A.sc.x : A.sc.y), 0, 0x7f7f7f7f); }
    P9M_STEP(0, d0) P9M_STEP(1, d1) P9M_STEP(2, d0) P9M_STEP(3, d1) P9M_STEP(4, d0) P9M_STEP(5, d1) P9M_STEP(6, d0) P9M_STEP(7, d1)
#undef P9M_STEP
    return d0 + d1;
}
__device__ __forceinline__ void p9m_batch(const AFrag& A, VSlot (&V)[16], LAS unsigned char* h8, LAS float* sgt, __amdgpu_buffer_rsrc_t rs, int b, int idn, int lane, f32x2v (&o)[8]) {
    const f32x4 dd = p9m_dots(A, h8, lane);
    const f32x4 gt = *(LAS f32x4*)(sgt + 16 * b + 4 * (lane >> 4));
    float c[4];
#pragma unroll
    for (int r = 0; r < 4; ++r) c[r] = gt[r] * gelu_erf(dd[r]);
#pragma unroll
    for (int p = 0; p < 16; ++p) {
        p9m_axpy(V[p], rdl(c[p & 3], 16 * (p >> 2)), o);
        p9m_load_v(V[p], rs, __builtin_amdgcn_readlane(idn, p), lane);
    }
}
constexpr int G_HSTR = 1040;
struct BFrag { v4u b[16]; };
__device__ __forceinline__ void p9g_load_b(BFrag& B, LAS unsigned char* h8, int lane) {
    LAS unsigned char* hb = h8 + (lane & 3) * G_HSTR + (lane >> 4) * 16;
#pragma unroll
    for (int s = 0; s < 8; ++s) { B.b[2 * s] = *(LAS v4u*)(hb + 128 * s); B.b[2 * s + 1] = *(LAS v4u*)(hb + 128 * s + 64); }
}
__device__ __forceinline__ f32x4 p9g_dots(const AFrag& A, const BFrag& B, int lane) {
    f32x4 d0 = {0.f, 0.f, 0.f, 0.f}, d1 = {0.f, 0.f, 0.f, 0.f};
#define P9G_STEP(S, ACC) { const v4u b0 = B.b[2 * (S)], b1 = B.b[2 * (S) + 1]; \
        const v8i a8 = {(int)A.a[S].x, (int)A.a[S].y, (int)A.a[S].z, (int)A.a[S].w, 0, 0, 0, 0}; const v8i b8 = {(int)b0.x, (int)b0.y, (int)b0.z, (int)b0.w, (int)b1.x, (int)b1.y, (int)b1.z, (int)b1.w}; \
        ACC = __builtin_amdgcn_mfma_scale_f32_16x16x128_f8f6f4(a8, b8, ACC, 4, 0, (S) & 3, (int)((S) < 4 ? A.sc.x : A.sc.y), 0, 0x7f7f7f7f); }
    P9G_STEP(0, d0) P9G_STEP(1, d1) P9G_STEP(2, d0) P9G_STEP(3, d1) P9G_STEP(4, d0) P9G_STEP(5, d1) P9G_STEP(6, d0) P9G_STEP(7, d1)
#undef P9G_STEP
    return d0 + d1;
}
typedef unsigned v4s __attribute__((ext_vector_type(4)));
__device__ __forceinline__ void p9g_issue_a(AFrag& A, v4s rsrc, unsigned voa, unsigned vos) {
#define LD_A(S) asm volatile("buffer_load_dwordx4 %0, %1, %2, 0 offen offset:" #S : "=v"(A.a[(S) / 64]) : "v"(voa), "s"(rsrc));
    LD_A(0) LD_A(64) LD_A(128) LD_A(192) LD_A(256) LD_A(320) LD_A(384) LD_A(448)
#undef LD_A
    asm volatile("buffer_load_dwordx2 %0, %1, %2, 0 offen offset:512" : "=v"(A.sc) : "v"(vos), "s"(rsrc));
}
__device__ __forceinline__ void p9g_issue_v(VSlot& V, v4s rsrc, int so, unsigned vov, unsigned vob) {
    asm volatile("buffer_load_dwordx2 %0, %1, %2, %3 offen offset:544" : "=v"(V.d) : "v"(vov), "s"(rsrc), "s"(so));
    asm volatile("buffer_load_ubyte %0, %1, %2, %3 offen offset:1056" : "=v"(V.s) : "v"(vob), "s"(rsrc), "s"(so));
}
#define P9G_WAIT_A(N, A) asm volatile("s_waitcnt vmcnt(" #N ")" : "+v"(A.a[0]), "+v"(A.a[1]), "+v"(A.a[2]), "+v"(A.a[3]), "+v"(A.a[4]), "+v"(A.a[5]), "+v"(A.a[6]), "+v"(A.a[7]), "+v"(A.sc))
#define P9G_WAIT_V(N, V) asm volatile("s_waitcnt vmcnt(" #N ")" : "+v"(V.d), "+v"(V.s))
template <bool PF> __device__ __forceinline__ void p9g_batch(AFrag& A, VSlot (&V)[16], const BFrag& B, LAS float* sgtl, v4s rsrc, int b, int idn, int lane,
                                                            f32x2v (&o0)[8], f32x2v (&o1)[8], f32x2v (&o2)[8], f32x2v (&o3)[8]) {
    if (PF) P9G_WAIT_A(32, A); else P9G_WAIT_A(0, A);
    const f32x4 dd = p9g_dots(A, B, lane);
    if (PF) { const unsigned rowo = (unsigned)idn * MX_ROW + (unsigned)((lane >> 4) * 8); p9g_issue_a(A, rsrc, rowo + (unsigned)((lane >> 4) * 8), rowo); }
    const f32x4 gt = *(LAS f32x4*)(sgtl + 4 * b);
    float c[4];
#pragma unroll
    for (int r = 0; r < 4; ++r) c[r] = gt[r] * gelu_erf(dd[r]);
    const unsigned vov = 8u * (unsigned)lane, vob = (unsigned)lane;
#define P9G_PAIR(P, O) { if (PF) P9G_WAIT_V(39, V[P]); else P9G_WAIT_V(0, V[P]); p9m_axpy(V[P], rdl(c[(P) & 3], 17 * ((P) >> 2)), O); \
        if (PF) p9g_issue_v(V[P], rsrc, __builtin_amdgcn_readlane(idn, P) * MX_ROW, vov, vob); }
    P9G_PAIR(0, o0) P9G_PAIR(1, o0) P9G_PAIR(2, o0) P9G_PAIR(3, o0) P9G_PAIR(4, o1) P9G_PAIR(5, o1) P9G_PAIR(6, o1) P9G_PAIR(7, o1)
    P9G_PAIR(8, o2) P9G_PAIR(9, o2) P9G_PAIR(10, o2) P9G_PAIR(11, o2) P9G_PAIR(12, o3) P9G_PAIR(13, o3) P9G_PAIR(14, o3) P9G_PAIR(15, o3)
#undef P9G_PAIR
}
__device__ __forceinline__ void p9_group_mx(Frame& F, int g, const float* g_ffn, const float* g_fin) {
    unsigned char* ws = F.ws; const int lane = pg8::fresh_lane();
    const unsigned char* EUV = ws + WS_EU;
    const __amdgpu_buffer_rsrc_t rs = __builtin_amdgcn_make_buffer_rsrc((void*)EUV, (short)0, 16384 * MX_ROW, 0x00020000);
    LAS unsigned char* wl = F.lds + F.wave * WAVE_LDS;
    LAS int* sid = (LAS int*)wl; LAS float* sgt = (LAS float*)(wl + 2048); LAS unsigned char* h8 = wl + 4096;
#pragma unroll 1
    for (int tk = 0; tk < 4; ++tk) {
        const int t = 4 * g + tk;
        const bf16* xrow = (const bf16*)(ws + WS_X1B) + (size_t)t * D;
        const float rs2 = __builtin_amdgcn_rsqf(pg8::sum16((const float*)(ws + WS_ROWSS) + (size_t)t * 16) * (1.0f / D) + EPS);
        { const v4u a0 = *(const v4u*)(xrow + 16 * lane), a1 = *(const v4u*)(xrow + 16 * lane + 8); v4u o;
          const unsigned xs[8] = {a0.x, a0.y, a0.z, a0.w, a1.x, a1.y, a1.z, a1.w};
#pragma unroll
          for (int j = 0; j < 4; ++j) { const f32x4 gg = *(const f32x4*)(g_ffn + 16 * lane + 4 * j);
              int p = __builtin_amdgcn_cvt_pk_fp8_f32(bflo(xs[2 * j]) * rs2 * gg[0], bfhi(xs[2 * j]) * rs2 * gg[1], 0, false);
              p = __builtin_amdgcn_cvt_pk_fp8_f32(bflo(xs[2 * j + 1]) * rs2 * gg[2], bfhi(xs[2 * j + 1]) * rs2 * gg[3], p, true); o[j] = (unsigned)p; }
          *(LAS v4u*)(h8 + tk * G_HSTR + 16 * lane) = o; }
        const int* IDX = (const int*)(ws + WS_IDX) + (size_t)t * 128; const float* GT = (const float*)(ws + WS_GATE) + (size_t)t * 128;
        { const int a0 = IDX[lane], b0 = IDX[64 + lane]; const float ga = GT[lane], gb = GT[64 + lane];
            const int kA = (int)(((unsigned)a0 * 2654435761u) >> 27), kB = (int)(((unsigned)b0 * 2654435761u) >> 27); const unsigned long long lt = (1ull << lane) - 1ull;
          int base = 0, rA = 0, rB = 0;
#pragma unroll 4
          for (int k = 0; k < 32; ++k) { const unsigned long long mA = __ballot(kA == k), mB = __ballot(kB == k); const int cA = __popcll(mA), cB = __popcll(mB);
              if (kA == k) rA = base + __popcll(mA & lt);
              if (kB == k) rB = base + cA + __popcll(mB & lt);
              base += cA + cB; }
          sid[tk * 128 + rA] = a0; sid[tk * 128 + rB] = b0; sgt[tk * 128 + rA] = ga; sgt[tk * 128 + rB] = gb; }
    }
    LDS_WAIT(); asm volatile("" ::: "memory");
    f32x2v o0[8], o1[8], o2[8], o3[8];
#pragma unroll
    for (int i = 0; i < 8; ++i) { o0[i] = (f32x2v){0.f, 0.f}; o1[i] = o0[i]; o2[i] = o0[i]; o3[i] = o0[i]; }
    AFrag A; VSlot V[16]; BFrag B; p9g_load_b(B, h8, lane);
    LAS int* sidl = sid + ((lane & 15) >> 2) * 128 + (lane & 3);
    LAS float* sgtl = sgt + (lane >> 4) * 128;
    v4s rsrc; { const unsigned long long ba = (unsigned long long)EUV; rsrc.x = (unsigned)__builtin_amdgcn_readfirstlane((int)(unsigned)ba); rsrc.y = (unsigned)__builtin_amdgcn_readfirstlane((int)(unsigned)(ba >> 32)) & 0xffffu; rsrc.z = 16384u * MX_ROW; rsrc.w = 0x00020000u; }
    { const int idc = sidl[0];
      const unsigned rowo = (unsigned)idc * MX_ROW + (unsigned)((lane >> 4) * 8); p9g_issue_a(A, rsrc, rowo + (unsigned)((lane >> 4) * 8), rowo);
#pragma unroll
      for (int p = 0; p < 16; ++p) p9g_issue_v(V[p], rsrc, __builtin_amdgcn_readlane(idc, p) * MX_ROW, 8u * (unsigned)lane, (unsigned)lane); }
#pragma unroll 1
    for (int b = 0; b < 31; ++b) {
        const int idn = sidl[4 * (b + 1)];
        p9g_batch<true>(A, V, B, sgtl, rsrc, b, idn, lane, o0, o1, o2, o3);
    }
    p9g_batch<false>(A, V, B, sgtl, rsrc, 31, 0, lane, o0, o1, o2, o3);
    LDS_WAIT(); asm volatile("" ::: "memory");
#define P9G_EPI(TK, O) { const int t = 4 * g + (TK); const bf16* xrow = (const bf16*)(ws + WS_X1B) + (size_t)t * D; float* orow = F.out + (size_t)t * D; \
        float oacc[16]; _Pragma("unroll") for (int k = 0; k < 8; ++k) { oacc[2 * k] = O[k].x; oacc[2 * k + 1] = O[k].y; } \
        float ss = 0.f; \
        _Pragma("unroll") for (int j = 0; j < 4; ++j) { const v2u a = *(const v2u*)(xrow + 256 * j + 4 * lane); \
            oacc[4 * j] += bflo(a.x); oacc[4 * j + 1] += bfhi(a.x); oacc[4 * j + 2] += bflo(a.y); oacc[4 * j + 3] += bfhi(a.y); \
            _Pragma("unroll") for (int i = 0; i < 4; ++i) ss += oacc[4 * j + i] * oacc[4 * j + i]; } \
        ss += swz_xor<1>(ss); ss += swz_xor<2>(ss); ss += swz_xor<4>(ss); ss += swz_xor<8>(ss); ss += swz_xor<16>(ss); ss += bperm(ss, lane ^ 32); \
        const float rs3 = __builtin_amdgcn_rsqf(ss * (1.0f / D) + EPS); \
        _Pragma("unroll") for (int j = 0; j < 4; ++j) { const f32x4 gg = *(const f32x4*)(g_fin + 256 * j + 4 * lane); f32x4 ov; \
            _Pragma("unroll") for (int i = 0; i < 4; ++i) ov[i] = oacc[4 * j + i] * rs3 * gg[i]; \
            *(f32x4*)(orow + 256 * j + 4 * lane) = ov; } }
    P9G_EPI(0, o0) P9G_EPI(1, o1) P9G_EPI(2, o2) P9G_EPI(3, o3)
#undef P9G_EPI
}
#ifdef DBG_P9
__device__ __forceinline__ void p9_token_dbg(Frame& F, int t, const float* g_ffn, const float* g_fin) {
    unsigned char* ws = F.ws; const int lane = pg8::fresh_lane();
    const unsigned char* EUV = ws + WS_EU;
    const __amdgpu_buffer_rsrc_t rs = __builtin_amdgcn_make_buffer_rsrc((void*)EUV, (short)0, 16384 * MX_ROW, 0x00020000);
    const bf16* xrow = (const bf16*)(ws + WS_X1B) + (size_t)t * D; float* orow = F.out + (size_t)t * D;
    const float rs2 = __builtin_amdgcn_rsqf(pg8::sum16((const float*)(ws + WS_ROWSS) + (size_t)t * 16) * (1.0f / D) + EPS);
    LAS unsigned char* wl = F.lds + F.wave * WAVE_LDS;
    LAS int* sid = (LAS int*)wl; LAS float* sgt = (LAS float*)(sid + 128); LAS unsigned char* h8 = wl + 1024;
    { const v4u a0 = *(const v4u*)(xrow + 16 * lane), a1 = *(const v4u*)(xrow + 16 * lane + 8); v4u o;
      const unsigned xs[8] = {a0.x, a0.y, a0.z, a0.w, a1.x, a1.y, a1.z, a1.w};
#pragma unroll
      for (int j = 0; j < 4; ++j) { const f32x4 g = *(const f32x4*)(g_ffn + 16 * lane + 4 * j);
          int p = __builtin_amdgcn_cvt_pk_fp8_f32(bflo(xs[2 * j]) * rs2 * g[0], bfhi(xs[2 * j]) * rs2 * g[1], 0, false);
          p = __builtin_amdgcn_cvt_pk_fp8_f32(bflo(xs[2 * j + 1]) * rs2 * g[2], bfhi(xs[2 * j + 1]) * rs2 * g[3], p, true); o[j] = (unsigned)p; }
      *(LAS v4u*)(h8 + 16 * lane) = o; }
    const int* IDX = (const int*)(ws + WS_IDX) + (size_t)t * 128; const float* GT = (const float*)(ws + WS_GATE) + (size_t)t * 128;
    sid[lane] = IDX[lane]; sid[64 + lane] = IDX[64 + lane]; sgt[lane] = GT[lane]; sgt[64 + lane] = GT[64 + lane];
    LDS_WAIT(); asm volatile("" ::: "memory");
    f32x2v o[8];
#pragma unroll
    for (int i = 0; i < 8; ++i) o[i] = (f32x2v){0.f, 0.f};
#pragma unroll 1
    for (int b = 0; b < 8; ++b) {
        const int idc = sid[16 * b + (lane & 15)];
        f32x4 dd = {0.f, 0.f, 0.f, 0.f};
#if DBG_P9 == 2
        { AFrag A; p9m_load_a(A, EUV, idc, lane); dd = p9m_dots(A, h8, lane); }
#else
#pragma unroll 1
        for (int i = 0; i < 16; ++i) { const int e = __builtin_amdgcn_readlane(idc, i); const unsigned char* rec = EUV + (size_t)e * MX_ROW;
            const v2u uu = *(const v2u*)(rec + 8 * lane); const int blk = lane >> 1; const unsigned sb = rec[MX_USC + (blk & 3) * 8 + (blk >> 2)];
            const v4u hh = *(LAS v4u*)(h8 + 16 * lane);
            float f0[8], f1[8]; unpack8_f4(uu.x, f0); unpack8_f4(uu.y, f1); float acc = 0.f;
#define DBG_ACC(HW, F, O4) { const f32x2v lo = __builtin_amdgcn_cvt_pk_f32_fp8((int)(HW), false), hi = __builtin_amdgcn_cvt_pk_f32_fp8((int)(HW), true); acc += F[O4] * lo.x + F[O4 + 1] * lo.y + F[O4 + 2] * hi.x + F[O4 + 3] * hi.y; }
            DBG_ACC(hh.x, f0, 0) DBG_ACC(hh.y, f0, 4) DBG_ACC(hh.z, f1, 0) DBG_ACC(hh.w, f1, 4)
#undef DBG_ACC
            acc *= __builtin_bit_cast(float, sb << 23);
            acc += swz_xor<1>(acc); acc += swz_xor<2>(acc); acc += swz_xor<4>(acc); acc += swz_xor<8>(acc); acc += swz_xor<16>(acc); acc += bperm(acc, lane ^ 32);
            if ((lane >> 4) == (i >> 2)) { if ((i & 3) == 0) dd[0] = acc; if ((i & 3) == 1) dd[1] = acc; if ((i & 3) == 2) dd[2] = acc; if ((i & 3) == 3) dd[3] = acc; } }
#endif
        const f32x4 gt = *(LAS f32x4*)(sgt + 16 * b + 4 * (lane >> 4));
        float c[4];
#pragma unroll
        for (int r = 0; r < 4; ++r) c[r] = gt[r] * gelu_erf(dd[r]);
#pragma unroll 1
        for (int p = 0; p < 16; ++p) { VSlot V; p9m_load_v(V, rs, __builtin_amdgcn_readlane(idc, p), lane);
            const float cs = (p & 3) == 0 ? c[0] : (p & 3) == 1 ? c[1] : (p & 3) == 2 ? c[2] : c[3];
            p9m_axpy(V, rdl(cs, 16 * (p >> 2)), o); }
    }
    LDS_WAIT(); asm volatile("" ::: "memory");
    float oacc[16];
#pragma unroll
    for (int k = 0; k < 8; ++k) { oacc[2 * k] = o[k].x; oacc[2 * k + 1] = o[k].y; }
    float ss = 0.f;
#pragma unroll
    for (int j = 0; j < 4; ++j) { const v2u a = *(const v2u*)(xrow + 256 * j + 4 * lane);
        oacc[4 * j] += bflo(a.x); oacc[4 * j + 1] += bfhi(a.x); oacc[4 * j + 2] += bflo(a.y); oacc[4 * j + 3] += bfhi(a.y);
#pragma unroll
        for (int i = 0; i < 4; ++i) ss += oacc[4 * j + i] * oacc[4 * j + i]; }
    ss += swz_xor<1>(ss); ss += swz_xor<2>(ss); ss += swz_xor<4>(ss); ss += swz_xor<8>(ss); ss += swz_xor<16>(ss); ss += bperm(ss, lane ^ 32);
    const float rs3 = __builtin_amdgcn_rsqf(ss * (1.0f / D) + EPS);
#pragma unroll
    for (int j = 0; j < 4; ++j) { const f32x4 g = *(const f32x4*)(g_fin + 256 * j + 4 * lane); f32x4 ov;
#pragma unroll
        for (int i = 0; i < 4; ++i) ov[i] = oacc[4 * j + i] * rs3 * g[i];
        *(f32x4*)(orow + 256 * j + 4 * lane) = ov; }
}
#endif
__device__ __forceinline__ void p9_token_mx(Frame& F, int t, const float* g_ffn, const float* g_fin) {
    unsigned char* ws = F.ws; const int lane = pg8::fresh_lane();
    const unsigned char* EUV = ws + WS_EU;
    const __amdgpu_buffer_rsrc_t rs = __builtin_amdgcn_make_buffer_rsrc((void*)EUV, (short)0, 16384 * MX_ROW, 0x00020000);
    const bf16* xrow = (const bf16*)(ws + WS_X1B) + (size_t)t * D; float* orow = F.out + (size_t)t * D;
    const float rs2 = __builtin_amdgcn_rsqf(pg8::sum16((const float*)(ws + WS_ROWSS) + (size_t)t * 16) * (1.0f / D) + EPS);
    LAS unsigned char* wl = F.lds + F.wave * WAVE_LDS;
    LAS int* sid = (LAS int*)wl; LAS float* sgt = (LAS float*)(sid + 128); LAS unsigned char* h8 = wl + 1024;
    { const v4u a0 = *(const v4u*)(xrow + 16 * lane), a1 = *(const v4u*)(xrow + 16 * lane + 8); v4u o;
      const unsigned xs[8] = {a0.x, a0.y, a0.z, a0.w, a1.x, a1.y, a1.z, a1.w};
#pragma unroll
      for (int j = 0; j < 4; ++j) { const f32x4 g = *(const f32x4*)(g_ffn + 16 * lane + 4 * j);
          int p = __builtin_amdgcn_cvt_pk_fp8_f32(bflo(xs[2 * j]) * rs2 * g[0], bfhi(xs[2 * j]) * rs2 * g[1], 0, false);
          p = __builtin_amdgcn_cvt_pk_fp8_f32(bflo(xs[2 * j + 1]) * rs2 * g[2], bfhi(xs[2 * j + 1]) * rs2 * g[3], p, true); o[j] = (unsigned)p; }
      *(LAS v4u*)(h8 + 16 * lane) = o; }
    const int* IDX = (const int*)(ws + WS_IDX) + (size_t)t * 128; const float* GT = (const float*)(ws + WS_GATE) + (size_t)t * 128;
    { const int a0 = IDX[lane], b0 = IDX[64 + lane]; const float ga = GT[lane], gb = GT[64 + lane];
      const int kA = a0 >> 10, kB = b0 >> 10; const unsigned long long lt = (1ull << lane) - 1ull;
      int base = 0, rA = 0, rB = 0;
#pragma unroll
      for (int k = 0; k < 16; ++k) { const unsigned long long mA = __ballot(kA == k), mB = __ballot(kB == k); const int cA = __popcll(mA), cB = __popcll(mB);
          if (kA == k) rA = base + __popcll(mA & lt);
          if (kB == k) rB = base + cA + __popcll(mB & lt);
          base += cA + cB; }
      sid[rA] = a0; sid[rB] = b0; sgt[rA] = ga; sgt[rB] = gb;
      LDS_WAIT(); asm volatile("" ::: "memory"); }
    f32x2v o[8];
#pragma unroll
    for (int i = 0; i < 8; ++i) o[i] = (f32x2v){0.f, 0.f};
    AFrag A0, A1; VSlot V[16];
    int idc = sid[lane & 15];
    p9m_load_a(A0, EUV, idc, lane);
#pragma unroll
    for (int p = 0; p < 16; ++p) p9m_load_v(V[p], rs, __builtin_amdgcn_readlane(idc, p), lane);
#pragma unroll 1
    for (int b = 0; b < 8; b += 2) {
        const int id1 = sid[16 * (b + 1) + (lane & 15)];
        p9m_load_a(A1, EUV, id1, lane); asm volatile("" ::: "memory");
        p9m_batch(A0, V, h8, sgt, rs, b, id1, lane, o); asm volatile("" ::: "memory");
        const int b2 = (b + 2 < 8) ? b + 2 : 7;
        const int id2 = sid[16 * b2 + (lane & 15)];
        p9m_load_a(A0, EUV, id2, lane); asm volatile("" ::: "memory");
        p9m_batch(A1, V, h8, sgt, rs, b + 1, id2, lane, o); asm volatile("" ::: "memory");
    }
    LDS_WAIT(); asm volatile("" ::: "memory");
    float oacc[16];
#pragma unroll
    for (int k = 0; k < 8; ++k) { oacc[2 * k] = o[k].x; oacc[2 * k + 1] = o[k].y; }
    float ss = 0.f;
#pragma unroll
    for (int j = 0; j < 4; ++j) { const v2u a = *(const v2u*)(xrow + 256 * j + 4 * lane);
        oacc[4 * j] += bflo(a.x); oacc[4 * j + 1] += bfhi(a.x); oacc[4 * j + 2] += bflo(a.y); oacc[4 * j + 3] += bfhi(a.y);
#pragma unroll
        for (int i = 0; i < 4; ++i) ss += oacc[4 * j + i] * oacc[4 * j + i]; }
    ss += swz_xor<1>(ss); ss += swz_xor<2>(ss); ss += swz_xor<4>(ss); ss += swz_xor<8>(ss); ss += swz_xor<16>(ss); ss += bperm(ss, lane ^ 32);
    const float rs3 = __builtin_amdgcn_rsqf(ss * (1.0f / D) + EPS);
#pragma unroll
    for (int j = 0; j < 4; ++j) { const f32x4 g = *(const f32x4*)(g_fin + 256 * j + 4 * lane); f32x4 ov;
#pragma unroll
        for (int i = 0; i < 4; ++i) ov[i] = oacc[4 * j + i] * rs3 * g[i];
        *(f32x4*)(orow + 256 * j + 4 * lane) = ov; }
}
struct Rows8 { v4u u[8], v[8]; };
__device__ __forceinline__ void p9_load8(Rows8& R, const unsigned char* EU, const unsigned char* EV, const int (&e)[8], int lane) {
#pragma unroll
    for (int j = 0; j < 8; ++j) { R.u[j] = *(const v4u*)(EU + (size_t)e[j] * 1024 + 16 * lane); R.v[j] = *(const v4u*)(EV + (size_t)e[j] * 1024 + 16 * lane); }
}
__device__ __forceinline__ void p9_token_f8(Frame& F, int t, const float* g_ffn, const float* g_fin) {
    unsigned char* ws = F.ws; const int lane = pg8::fresh_lane(), hh = lane >> 5, q4 = (lane >> 4) & 1, q3 = (lane >> 3) & 1;
    const unsigned char* EU = ws + WS_EU; const unsigned char* EV = ws + WS_EV; const float* ISU = (const float*)(ws + WS_ESC); const float* ISV = ISU + 16384;
    const bf16* xrow = (const bf16*)(ws + WS_X1B) + (size_t)t * D; float* orow = F.out + (size_t)t * D;
    const float rs2 = __builtin_amdgcn_rsqf(pg8::sum16((const float*)(ws + WS_ROWSS) + (size_t)t * 16) * (1.0f / D) + EPS);
    float hn[16];
#pragma unroll
    for (int j = 0; j < 4; ++j) { const v2u a = *(const v2u*)(xrow + 256 * j + 4 * lane); const f32x4 g = *(const f32x4*)(g_ffn + 256 * j + 4 * lane);
        hn[4 * j] = bflo(a.x) * rs2 * g[0]; hn[4 * j + 1] = bfhi(a.x) * rs2 * g[1]; hn[4 * j + 2] = bflo(a.y) * rs2 * g[2]; hn[4 * j + 3] = bfhi(a.y) * rs2 * g[3]; }
    const int* IDX = (const int*)(ws + WS_IDX) + (size_t)t * 128; const float* GT = (const float*)(ws + WS_GATE) + (size_t)t * 128;
    int idA, idB; float suA, suB, gvA, gvB;
    { const int a0 = IDX[lane], b0 = IDX[64 + lane];
      const float sa = ISU[a0], sb = ISU[b0], ga = GT[lane] * ISV[a0], gb = GT[64 + lane] * ISV[b0];
      const int kA = a0 >> 10, kB = b0 >> 10; const unsigned long long lt = (1ull << lane) - 1ull;
      int base = 0, rA = 0, rB = 0;
#pragma unroll
      for (int k = 0; k < 16; ++k) { const unsigned long long mA = __ballot(kA == k), mB = __ballot(kB == k); const int cA = __popcll(mA), cB = __popcll(mB);
          if (kA == k) rA = base + __popcll(mA & lt);
          if (kB == k) rB = base + cA + __popcll(mB & lt);
          base += cA + cB; }
      LAS int* sid = (LAS int*)(F.lds + F.wave * WAVE_LDS); LAS float* ssu = (LAS float*)(sid + 128); LAS float* sgv = ssu + 128;
      sid[rA] = a0; sid[rB] = b0; ssu[rA] = sa; ssu[rB] = sb; sgv[rA] = ga; sgv[rB] = gb;
      LDS_WAIT(); asm volatile("" ::: "memory");
      idA = sid[lane]; idB = sid[64 + lane]; suA = ssu[lane]; suB = ssu[64 + lane]; gvA = sgv[lane]; gvB = sgv[64 + lane];
      LDS_WAIT(); asm volatile("" ::: "memory"); }
    float oacc[16];
#pragma unroll
    for (int i = 0; i < 16; ++i) oacc[i] = 0.f;
    const int jsel = 4 * hh + 2 * q4 + q3;
    Rows8 R;
    { int e[8];
#pragma unroll
      for (int j = 0; j < 8; ++j) e[j] = __builtin_amdgcn_readlane(idA, j);
      p9_load8(R, EU, EV, e, lane); }
    for (int bt = 0; bt < 16; ++bt) {
        Rows8 Rn;
        { const int nb = (bt + 1) & 15; int e[8];
#pragma unroll
          for (int j = 0; j < 8; ++j) { const int n = 8 * nb + j; e[j] = (nb < 8) ? __builtin_amdgcn_readlane(idA, n & 63) : __builtin_amdgcn_readlane(idB, n & 63); }
          p9_load8(Rn, EU, EV, e, lane); }
        float pd[8];
#pragma unroll
        for (int j = 0; j < 8; ++j) { float a = 0.f, b = 0.f;
#pragma unroll
            for (int d = 0; d < 4; ++d) { const f32x2v lo = __builtin_amdgcn_cvt_pk_f32_fp8((int)R.u[j][d], false), hi = __builtin_amdgcn_cvt_pk_f32_fp8((int)R.u[j][d], true);
                a += lo.x * hn[4 * d] + hi.x * hn[4 * d + 2]; b += lo.y * hn[4 * d + 1] + hi.y * hn[4 * d + 3]; }
            pd[j] = a + b; }
        float r4[4], r2[2];
#pragma unroll
        for (int i = 0; i < 4; ++i) { const float keep = hh ? pd[4 + i] : pd[i], send = hh ? pd[i] : pd[4 + i]; r4[i] = keep + __shfl_xor(send, 32); }
#pragma unroll
        for (int i = 0; i < 2; ++i) { const float keep = q4 ? r4[2 + i] : r4[i], send = q4 ? r4[i] : r4[2 + i]; r2[i] = keep + __shfl_xor(send, 16); }
        float v = (q3 ? r2[1] : r2[0]) + __shfl_xor(q3 ? r2[0] : r2[1], 8);
        v += __shfl_xor(v, 4); v += __shfl_xor(v, 2); v += __shfl_xor(v, 1);
        const int n = 8 * bt + jsel;
        const float su = (bt < 8) ? __shfl(suA, n & 63) : __shfl(suB, n & 63), gv = (bt < 8) ? __shfl(gvA, n & 63) : __shfl(gvB, n & 63);
        const float w = gv * gelu_erf(v * su);
#pragma unroll
        for (int j = 0; j < 8; ++j) { const float wj = rdl(w, 8 * j);
#pragma unroll
            for (int d = 0; d < 4; ++d) { const f32x2v lo = __builtin_amdgcn_cvt_pk_f32_fp8((int)R.v[j][d], false), hi = __builtin_amdgcn_cvt_pk_f32_fp8((int)R.v[j][d], true);
                oacc[4 * d] += wj * lo.x; oacc[4 * d + 1] += wj * lo.y; oacc[4 * d + 2] += wj * hi.x; oacc[4 * d + 3] += wj * hi.y; } }
        R = Rn;
    }
    asm volatile("" ::: "memory");
    float ss = 0.f;
#pragma unroll
    for (int j = 0; j < 4; ++j) { const v2u a = *(const v2u*)(xrow + 256 * j + 4 * lane);
        oacc[4 * j] += bflo(a.x); oacc[4 * j + 1] += bfhi(a.x); oacc[4 * j + 2] += bflo(a.y); oacc[4 * j + 3] += bfhi(a.y);
#pragma unroll
        for (int i = 0; i < 4; ++i) ss += oacc[4 * j + i] * oacc[4 * j + i]; }
    ss = wave_sum(ss);
    const float rs3 = __builtin_amdgcn_rsqf(ss * (1.0f / D) + EPS);
#pragma unroll
    for (int j = 0; j < 4; ++j) { const f32x4 g = *(const f32x4*)(g_fin + 256 * j + 4 * lane); f32x4 o;
#pragma unroll
        for (int i = 0; i < 4; ++i) o[i] = oacc[4 * j + i] * rs3 * g[i];
        *(f32x4*)(orow + 256 * j + 4 * lane) = o; }
}
struct Rows4 { v4u ua[4], ub[4], va[4], vb[4]; };
__device__ __forceinline__ void p9_load(Rows4& R, const bf16* EU, const bf16* EV, const int (&e)[4], int lane) {
#pragma unroll
    for (int j = 0; j < 4; ++j) { const bf16* up = EU + (size_t)e[j] * 1024 + lane * 8; const bf16* vp = EV + (size_t)e[j] * 1024 + lane * 8;
        R.ua[j] = *(const v4u*)up; R.ub[j] = *(const v4u*)(up + 512); R.va[j] = *(const v4u*)vp; R.vb[j] = *(const v4u*)(vp + 512); }
}
__device__ __forceinline__ void p9_token(Frame& F, int t, const float* g_ffn, const float* g_fin) {
    unsigned char* ws = F.ws; const int lane = pg8::fresh_lane(), hh = lane >> 5, q4 = (lane >> 4) & 1;
    const bf16* EU = (const bf16*)(ws + WS_EU); const bf16* EV = (const bf16*)(ws + WS_EV);
    const float* xrow = (const float*)(ws + WS_X1) + (size_t)t * D; float* orow = F.out + (size_t)t * D;
    const float rs2 = __builtin_amdgcn_rsqf(pg8::sum16((const float*)(ws + WS_ROWSS) + (size_t)t * 16) * (1.0f / D) + EPS);
    float x1[16];
    { const f32x4 a0 = *(const f32x4*)(xrow + lane * 8), a1 = *(const f32x4*)(xrow + lane * 8 + 4), b0 = *(const f32x4*)(xrow + 512 + lane * 8), b1 = *(const f32x4*)(xrow + 512 + lane * 8 + 4);
#pragma unroll
      for (int i = 0; i < 4; ++i) { x1[i] = a0[i]; x1[4 + i] = a1[i]; x1[8 + i] = b0[i]; x1[12 + i] = b1[i]; } }
    unsigned hn[8];
    { const f32x4 a0 = *(const f32x4*)(g_ffn + lane * 8), a1 = *(const f32x4*)(g_ffn + lane * 8 + 4), b0 = *(const f32x4*)(g_ffn + 512 + lane * 8), b1 = *(const f32x4*)(g_ffn + 512 + lane * 8 + 4);
      float g[16];
#pragma unroll
      for (int i = 0; i < 4; ++i) { g[i] = a0[i]; g[4 + i] = a1[i]; g[8 + i] = b0[i]; g[12 + i] = b1[i]; }
#pragma unroll
      for (int i = 0; i < 8; ++i) hn[i] = pk2(x1[2 * i] * rs2 * g[2 * i], x1[2 * i + 1] * rs2 * g[2 * i + 1]); }
    const int* IDX = (const int*)(ws + WS_IDX) + (size_t)t * 128; const float* GT = (const float*)(ws + WS_GATE) + (size_t)t * 128;
    const int idA = IDX[lane], idB = IDX[64 + lane]; const float gtA = GT[lane], gtB = GT[64 + lane];
    float oacc[16];
#pragma unroll
    for (int i = 0; i < 16; ++i) oacc[i] = 0.f;
    const int jsel = 2 * hh + q4;
    Rows4 R;
    { int e[4];
#pragma unroll
      for (int j = 0; j < 4; ++j) e[j] = __builtin_amdgcn_readlane(idA, j);
      p9_load(R, EU, EV, e, lane); }
#ifndef DBG_NBATCH
#define DBG_NBATCH 32
#endif
    for (int bt = 0; bt < DBG_NBATCH; ++bt) {
        Rows4 Rn;
        { const int nb = (bt + 1) & 31; int e[4];
#pragma unroll
          for (int j = 0; j < 4; ++j) { const int n = 4 * nb + j; e[j] = (nb < 16) ? __builtin_amdgcn_readlane(idA, n & 63) : __builtin_amdgcn_readlane(idB, n & 63); }
          p9_load(Rn, EU, EV, e, lane); }
        float pd[4];
#pragma unroll
        for (int j = 0; j < 4; ++j) { float a = 0.f, b = 0.f;
            a = dot2bf(R.ua[j].x, hn[0], a); b = dot2bf(R.ua[j].y, hn[1], b); a = dot2bf(R.ua[j].z, hn[2], a); b = dot2bf(R.ua[j].w, hn[3], b);
            a = dot2bf(R.ub[j].x, hn[4], a); b = dot2bf(R.ub[j].y, hn[5], b); a = dot2bf(R.ub[j].z, hn[6], a); b = dot2bf(R.ub[j].w, hn[7], b); pd[j] = a + b; }
        const float k0 = hh ? pd[2] : pd[0], k1 = hh ? pd[3] : pd[1], s0 = hh ? pd[0] : pd[2], s1 = hh ? pd[1] : pd[3];
        const float r0 = k0 + __shfl_xor(s0, 32), r1 = k1 + __shfl_xor(s1, 32);
        float v = (q4 ? r1 : r0) + __shfl_xor(q4 ? r0 : r1, 16);
        v += __shfl_xor(v, 8); v += __shfl_xor(v, 4); v += __shfl_xor(v, 2); v += __shfl_xor(v, 1);
        const int n = 4 * bt + jsel; const float gsel = (bt < 16) ? __shfl(gtA, n & 63) : __shfl(gtB, n & 63);
        const float w = gsel * gelu_erf(v);
        const float w0 = __builtin_bit_cast(float, __builtin_amdgcn_readlane(__builtin_bit_cast(int, w), 0)), w1 = __builtin_bit_cast(float, __builtin_amdgcn_readlane(__builtin_bit_cast(int, w), 16)),
                    w2 = __builtin_bit_cast(float, __builtin_amdgcn_readlane(__builtin_bit_cast(int, w), 32)), w3 = __builtin_bit_cast(float, __builtin_amdgcn_readlane(__builtin_bit_cast(int, w), 48));
        const float wj[4] = {w0, w1, w2, w3};
#pragma unroll
        for (int j = 0; j < 4; ++j) {
            const unsigned va[4] = {R.va[j].x, R.va[j].y, R.va[j].z, R.va[j].w}, vb[4] = {R.vb[j].x, R.vb[j].y, R.vb[j].z, R.vb[j].w};
#pragma unroll
            for (int i = 0; i < 4; ++i) { oacc[2 * i] += wj[j] * bflo(va[i]); oacc[2 * i + 1] += wj[j] * bfhi(va[i]); oacc[8 + 2 * i] += wj[j] * bflo(vb[i]); oacc[8 + 2 * i + 1] += wj[j] * bfhi(vb[i]); }
        }
        R = Rn;
    }
    float ss = 0.f;
#pragma unroll
    for (int i = 0; i < 16; ++i) { x1[i] += oacc[i]; ss += x1[i] * x1[i]; }
    ss = wave_sum(ss);
#ifdef DBG_CHK
    const float rs3 = __builtin_amdgcn_rsqf(ss * (1.0f / D) + EPS) * chk_scale(F);
#else
    const float rs3 = __builtin_amdgcn_rsqf(ss * (1.0f / D) + EPS);
#endif
    { const f32x4 a0 = *(const f32x4*)(g_fin + lane * 8), a1 = *(const f32x4*)(g_fin + lane * 8 + 4), b0 = *(const f32x4*)(g_fin + 512 + lane * 8), b1 = *(const f32x4*)(g_fin + 512 + lane * 8 + 4);
      f32x4 o0, o1, o2, o3;
#pragma unroll
      for (int i = 0; i < 4; ++i) { o0[i] = x1[i] * rs3 * a0[i]; o1[i] = x1[4 + i] * rs3 * a1[i]; o2[i] = x1[8 + i] * rs3 * b0[i]; o3[i] = x1[12 + i] * rs3 * b1[i]; }
      *(f32x4*)(orow + lane * 8) = o0; *(f32x4*)(orow + lane * 8 + 4) = o1; *(f32x4*)(orow + 512 + lane * 8) = o2; *(f32x4*)(orow + 512 + lane * 8 + 4) = o3; }
}

__device__ __forceinline__ void dbg_dump_bf16(Frame& F, const bf16* src, int ld, int c0, int n) {
    const int gt = F.vcu * (NWAVES * 64) + F.wave * 64 + pg8::fresh_lane(), ngt = F.G * NWAVES * 64;
    for (long i = gt; i < (long)T * n; i += ngt) { const long t = i / n; const int c = (int)(i % n); F.out[t * 1024 + c0 + c] = bf2f(src[t * ld + c]); }
}
__device__ __forceinline__ void dbg_dump_f32(Frame& F, const float* src, long n, long o0) {
    const int gt = F.vcu * (NWAVES * 64) + F.wave * 64 + pg8::fresh_lane(), ngt = F.G * NWAVES * 64;
    for (long i = gt; i < n; i += ngt) F.out[o0 + i] = src[i];
}
__global__ void __launch_bounds__(NWAVES * 64, 2) fwd_kernel(Args args) {
    extern __shared__ __attribute__((aligned(16))) unsigned char lds[];
    Frame F;
    F.lds = (LAS unsigned char*)lds;
    F.wave = __builtin_amdgcn_readfirstlane((int)threadIdx.x >> 6);
    F.G = gridDim.x; { const int bx = blockIdx.x; F.vcu = (F.G % 8 == 0) ? (bx % 8) * (F.G / 8) + bx / 8 : bx; }
    F.gw = F.vcu * NWAVES + F.wave; F.ngw = F.G * NWAVES;
    F.out = args.out; F.ws = args.ws;
    unsigned char* ws = args.ws;
    volatile LAS unsigned* MISC = (volatile LAS unsigned*)(F.lds + MISC_OFF);
    for (int u = threadIdx.x; u < 256; u += NWAVES * 64) MISC[u] = 0u;
    __syncthreads();
    gu32* ctl = (gu32*)(ws + WS_CTL);
    XcdBarrier bar; bar.bar = (unsigned*)(ctl + CW_BAR); bar.x = 0; bar.st = nullptr;
    if (N_LAUNCHES != PER_PHASE) bar = xcd_barrier_post((unsigned*)(ctl + CW_BAR), MISC + 8);
#ifdef PROBE_DUP
#define DUPN(k) (((PROBE_DUP >> (k)) & 1) ? 2 : 1)
#else
#define DUPN(k) 1
#endif
#define GRID_BAR() do { if (N_LAUNCHES != PER_PHASE) xcd_barrier(bar); } while (0)
    const int lo = args.ph_lo, hi = args.ph_hi;
#ifdef ONLY_PH
#define IN(k) ((k) == ONLY_PH)
#else
#define IN(k) (lo <= (k) && (k) < hi)
#endif
#define BOTH(k) (IN(k) && IN((k) + 1))
    bf16* const XB = (bf16*)(ws + WS_XB);
    float* const rowss = (float*)(ws + WS_ROWSS);

    if (IN(0)) { for (int rep = 0; rep < DUPN(0); ++rep) p0_prologue(F, args); if (BOTH(0)) GRID_BAR(); }
    if (IN(1)) for (int rep = 0; rep < DUPN(1); ++rep) {
        { pg8::Gemm g{XB, (const bf16*)(ws + WS_WIN) + (size_t)512 * D, T, 3072, D}; pg8::StaticOrder S; S.init(T, 3072, F.G, (int)blockIdx.x);
          pg8::EpiInProj E{(const float*)(ws + WS_RSTD1), (const float*)(ws + WS_LB), (bf16*)(ws + WS_Q), (bf16*)(ws + WS_LF), (bf16*)(ws + WS_KK), (bf16*)(ws + WS_V), (bf16*)(ws + WS_SG),
                           (bf16*)(ws + WS_CB), (bf16*)(ws + WS_U), (bf16*)(ws + WS_GA), 0};
          pg8::gemm_phase<pg8::EpiInProj, pg8::StaticOrder, true, true>(F.lds, g, S, E, F.wave); }
        { pg8::Gemm g{(const bf16*)(ws + WS_X8), (const bf16*)(ws + WS_W8G), T, 2560, D / 2}; pg8::StaticOrder S; S.init(T, 2560, F.G, (int)blockIdx.x);
          pg8::EpiInProj E{(const float*)(ws + WS_RSTD1), (const float*)(ws + WS_LB), (bf16*)(ws + WS_Q), (bf16*)(ws + WS_LF), (bf16*)(ws + WS_KK), (bf16*)(ws + WS_V), (bf16*)(ws + WS_SG),
                           (bf16*)(ws + WS_CB), (bf16*)(ws + WS_U), (bf16*)(ws + WS_GA), 14};
          pg8::gemm_phase<pg8::EpiInProj, pg8::StaticOrder, true, true, true>(F.lds, g, S, E, F.wave); }
        if (BOTH(1)) GRID_BAR();
    }
    if (IN(2)) { p2_phase(F, args.in[5]); if (BOTH(2)) GRID_BAR(); }
    if (IN(3)) { for (int rep = 0; rep < DUPN(3); ++rep) p3_phase(F); if (BOTH(3)) GRID_BAR(); }
    if (IN(4)) { const float* gain = args.in[4]; for (int rep = 0; rep < DUPN(4); ++rep) for (int u = F.gw; u < NUNIT; u += F.ngw) p4_unit(F, u, gain); if (BOTH(4)) GRID_BAR(); }
    if (IN(5)) for (int rep = 0; rep < DUPN(5); ++rep) {
        pg8::Gemm g{(const bf16*)F.out, (const bf16*)(ws + WS_PAB), T, D, D}; pg8::StaticOrder S; S.init(T, D, F.G, (int)blockIdx.x);
        pg8::EpiMerged E{(const bf16*)(ws + WS_GA), (bf16*)(ws + WS_MG)};
        pg8::gemm_phase<pg8::EpiMerged, pg8::StaticOrder, true, true>(F.lds, g, S, E, F.wave);
        if (BOTH(5)) GRID_BAR();
    }
    if (IN(6)) for (int rep = 0; rep < DUPN(6); ++rep) {
        pg8::Gemm g{(const bf16*)(ws + WS_MG), (const bf16*)(ws + WS_WO), T, D, D}; pg8::StaticOrder S; S.init(T, D, F.G, (int)blockIdx.x);
        pg8::EpiOut E{XB, (float*)(ws + WS_X1), (bf16*)(ws + WS_X1B), rowss};
        pg8::gemm_phase<pg8::EpiOut, pg8::StaticOrder, true, true>(F.lds, g, S, E, F.wave);
        if (BOTH(6)) GRID_BAR();
    }
    if (IN(7)) for (int rep = 0; rep < DUPN(7); ++rep) {
        pg8::Gemm g{(const bf16*)(ws + WS_X1B), (const bf16*)(ws + WS_WQ), T, 2048, D}; pg8::StaticOrder S; S.init(T, 2048, F.G, (int)blockIdx.x);
        pg8::EpiQuery E{rowss, (bf16*)(ws + WS_QQ), EPS};
        pg8::gemm_phase<pg8::EpiQuery, pg8::StaticOrder, true, true>(F.lds, g, S, E, F.wave);
        if (BOTH(7)) GRID_BAR();
    }
    if (IN(8)) {
        const float* eu = args.in[13]; const float* ev = args.in[14]; const int ln = pg8::fresh_lane();
        int it = F.gw;
        for (int rep = 0; rep < DUPN(8); ++rep)
        for (int tile = F.vcu; tile < T / 32; tile += F.G) {
            p8_task(F, tile, F.wave);
            if (it + F.ngw < 16384) { cvt_expert_mx2(eu, ev, ws + WS_EU, it, it + F.ngw, ln); it += 2 * F.ngw; }
            else if (it < 16384) { cvt_expert_mx(eu, ev, ws + WS_EU, it, ln); it += F.ngw; }
        }
#pragma unroll 1
        for (; it < 16384; it += F.ngw) cvt_expert_mx(eu, ev, ws + WS_EU, it, ln);
        if (BOTH(8)) GRID_BAR();
    }
    if (IN(9)) { const float* g_ffn = args.in[9]; const float* g_fin = args.in[15];
        for (int rep = 0; rep < DUPN(9); ++rep)
#pragma unroll 1
        for (int g = F.gw; g < T / 4; g += F.ngw) p9_group_mx(F, g, g_ffn, g_fin);
    }
#undef IN
#undef BOTH
}

extern "C" void kernel_launch(void* const* d_in, const int* in_sizes, int n_in, void* d_out, int out_size, void* d_ws, size_t ws_size, hipStream_t stream) {
    static int grid = 0;
    if (grid == 0) {
        if (n_in != 16 || in_sizes[0] != T * D || out_size != T * D || ws_size < WS_END) { fprintf(stderr, "kernel_launch: unexpected shapes (n_in %d, in0 %d, out %d, ws %zu); nothing launched\n", n_in, n_in > 0 ? in_sizes[0] : -1, out_size, ws_size); grid = -1; return; }
        int dev = 0, cus = 0, per_cu = 0;
        if (hipGetDevice(&dev) != hipSuccess || hipDeviceGetAttribute(&cus, hipDeviceAttributeMultiprocessorCount, dev) != hipSuccess) { fprintf(stderr, "kernel_launch: device query failed\n"); grid = -1; return; }
        if (hipFuncSetAttribute((const void*)fwd_kernel, hipFuncAttributeMaxDynamicSharedMemorySize, LDS_BYTES) != hipSuccess) { fprintf(stderr, "kernel_launch: hipFuncSetAttribute failed\n"); grid = -1; return; }
        if (hipOccupancyMaxActiveBlocksPerMultiprocessor(&per_cu, (const void*)fwd_kernel, NWAVES * 64, LDS_BYTES) != hipSuccess || per_cu < 1)
            fprintf(stderr, "kernel_launch: note: occupancy query reports %d workgroups per CU\n", per_cu);
        (void)hipGetLastError();
        grid = cus;
    }
    if (grid < 0) return;
    if (hipMemsetAsync((char*)d_ws + WS_CTL, 0, CTL_ZERO_BYTES, stream) != hipSuccess) { fprintf(stderr, "kernel_launch: hipMemsetAsync failed\n"); return; }
    Args a{};
    for (int i = 0; i < 16; ++i) a.in[i] = (const float*)d_in[i];
    a.out = (float*)d_out; a.ws = (unsigned char*)d_ws;
    for (int li = 0; li < N_LAUNCHES; ++li) {
        a.ph_lo = (N_LAUNCHES == PER_PHASE) ? li : 0; a.ph_hi = (N_LAUNCHES == PER_PHASE) ? li + 1 : PER_PHASE; a.li = li;
#ifdef DBG_STOP
        if (li == DBG_STOP + 1) { a.ph_lo = 100; a.ph_hi = 101; }
        if (li > DBG_STOP + 1) break;
#endif
        hipLaunchKernelGGL(fwd_kernel, dim3(grid), dim3(NWAVES * 64), LDS_BYTES, stream, a);
#ifdef DBG_CHK
        if (N_LAUNCHES == PER_PHASE && (li == 1 || li == 4)) { Args c = a; c.ph_lo = 210 + li; c.ph_hi = 211 + li; hipLaunchKernelGGL(fwd_kernel, dim3(grid), dim3(NWAVES * 64), LDS_BYTES, stream, c); }
        if (N_LAUNCHES == PER_PHASE && (li == 0 || li == 1 || li == 2 || li == 5 || li == 6 || li == 7)) { Args c = a; c.ph_lo = 200 + li; c.ph_hi = 201 + li; hipLaunchKernelGGL(fwd_kernel, dim3(grid), dim3(NWAVES * 64), LDS_BYTES, stream, c); }
#endif
        const hipError_t le = hipPeekAtLastError();
        if (le != hipSuccess) { fprintf(stderr, "kernel_launch: launch %d failed: %s\n", li, hipGetErrorName(le)); break; }
    }
}
```

```cpp
#include <hip/hip_runtime.h>
#include <cstdio>
#include <cstdint>


#define DBG_ZYA 1.0f
#define DBG_ZYB 1.0f


#ifdef DBG_SWAPG
#define CHK_GA_ROW 4608
#define CHK_GB_ROW 3584
#else
#define CHK_GA_ROW 3584
#define CHK_GB_ROW 4608
#endif

#ifndef MK_N_LAUNCHES
#define MK_N_LAUNCHES 1
#endif
namespace pg8 {
#define PG8_LAS __attribute__((address_space(3)))
typedef unsigned short bf16_t;
typedef short bf16x8 __attribute__((ext_vector_type(8)));
typedef float f32x4 __attribute__((ext_vector_type(4)));
typedef int v4i_ __attribute__((ext_vector_type(4)));
typedef int v8i_ __attribute__((ext_vector_type(8)));
typedef unsigned u32x4 __attribute__((ext_vector_type(4)));
constexpr int BM = 256, BK = 64, HALF = 128, HTB = HALF * BK * 2  , STAGE_BYTES = 8 * HTB, NXCD = 8, WGM = 8;

__host__ __device__ __forceinline__ int lds_byte(int r, int c) { const int st = (r >> 4) * 2 + (c >> 5), rr = r & 15, cc = c & 31, ob = rr * 64 + cc * 2; return st * 1024 + (ob ^ (((ob >> 9) & 1) << 5)); }
__host__ __device__ __forceinline__ void stage_rc(int b, int& R, int& C) { const int st = b / 1024, sb = b % 1024, swz = sb ^ (((sb >> 9) & 1) << 5); R = (st >> 1) * 16 + swz / 64; C = (st & 1) * 32 + (swz % 64) / 2; }
__host__ __device__ __forceinline__ int perm32(int rho) { const int n = rho >> 4, i = rho & 15; return 8 * (i >> 2) + 4 * n + (i & 3); }

struct Unit { int pm, pn; };
struct Gemm { const bf16_t* A; const bf16_t* Bt; int M, N, K; };

struct StaticOrder {
    int nM, nN, nwg, G, c;
    __host__ __device__ void init(int M, int N, int G_, int c_) { nM = M / BM; nN = N / BM; nwg = nM * nN; G = G_; c = c_; }
    __host__ __device__ bool next(int i, Unit& u) const {
        if ((long)i * G + c >= nwg) return false;
#ifdef DBG_REV
        const int nr = (nwg - 1 - c) / G; const long L = (long)(nr - i) * G + c;
#else
        const long L = (long)i * G + c;
#endif
        int wgid = (int)L; { const int q = nwg / NXCD, r = nwg % NXCD, xcd = wgid % NXCD, off = wgid / NXCD; wgid = (xcd < r ? xcd * (q + 1) : r * (q + 1) + (xcd - r) * q) + off; }
        const int nig = WGM * nN, gid = wgid / nig, fm = gid * WGM, gsz = (nM - fm) < WGM ? (nM - fm) : WGM;
        u.pm = fm + ((wgid % nig) % gsz); u.pn = (wgid % nig) / gsz; return true;
    }
    __device__ __forceinline__ void a_ready(const Unit&) const {}
    __device__ __forceinline__ void done(const Unit&) const {}
};

__device__ __forceinline__ int fresh_lane() { int l; asm volatile("v_mbcnt_lo_u32_b32 %0, -1, 0\n\tv_mbcnt_hi_u32_b32 %0, -1, %0" : "=v"(l)); return l; }
__device__ __forceinline__ unsigned cvt_pk_bf16(float lo, float hi) { unsigned r; asm volatile("v_cvt_pk_bf16_f32 %0, %1, %2" : "=v"(r) : "v"(lo), "v"(hi)); return r; }
__device__ __forceinline__ float fexp(float x) { return __builtin_amdgcn_exp2f(x * 1.44269504089f); }
__device__ __forceinline__ float fsig(float x) { return __builtin_amdgcn_rcpf(1.0f + fexp(-x)); }
__device__ __forceinline__ float bflo(unsigned w) { return __builtin_bit_cast(float, w << 16); }
__device__ __forceinline__ float bfhi(unsigned w) { return __builtin_bit_cast(float, w & 0xffff0000u); }
__device__ __forceinline__ void st8(bf16_t* p, const float (&v)[8]) {
    u32x4 w; w.x = cvt_pk_bf16(v[0], v[1]); w.y = cvt_pk_bf16(v[2], v[3]); w.z = cvt_pk_bf16(v[4], v[5]); w.w = cvt_pk_bf16(v[6], v[7]); *(u32x4*)p = w; }
__device__ __forceinline__ void ld8(const bf16_t* p, float (&v)[8]) {
    const u32x4 w = *(const u32x4*)p; v[0] = bflo(w.x); v[1] = bfhi(w.x); v[2] = bflo(w.y); v[3] = bfhi(w.y); v[4] = bflo(w.z); v[5] = bfhi(w.z); v[6] = bflo(w.w); v[7] = bfhi(w.w); }

__device__ __forceinline__ float sum16(const float* p) {
    const f32x4 a = *(const f32x4*)p, b = *(const f32x4*)(p + 4), c = *(const f32x4*)(p + 8), d = *(const f32x4*)(p + 12);
    return (((a[0] + a[1]) + (a[2] + a[3])) + ((b[0] + b[1]) + (b[2] + b[3]))) + (((c[0] + c[1]) + (c[2] + c[3])) + ((d[0] + d[1]) + (d[2] + d[3]))); }
struct EpiInProj {
    static constexpr bool PERM = true, AFTER_DRAIN = false, MID = false;
    const float* rfac; const float* swr; const float* lb;
    bf16_t *Q, *LF, *KK, *V, *SG, *CB, *U, *GA;
    static __device__ __forceinline__ float af(const f32x4 v, int i) { const float f = v[i]; return (float)__builtin_bit_cast(int, f); }
    __device__ __forceinline__ void mid(f32x4 (&)[2][2][4][2], const Unit&, int, int, int, int) const {}
    template <int MODE> __device__ __forceinline__ void run(const f32x4 (&acc)[2][2][4][2], bf16_t* O, int ldo, int cbase, int gcol0, int row0, int cl) const {
        float lbv[2][8], swv[2][8];
#pragma unroll
        for (int bj = 0; bj < 2; ++bj)
#pragma unroll
            for (int i = 0; i < 8; ++i) { lbv[bj][i] = (MODE == 1) ? lb[cbase + bj * HALF + cl + i] : 0.f; swv[bj][i] = swr[gcol0 + bj * HALF + cl + i]; }
#pragma unroll
        for (int ai = 0; ai < 2; ++ai)
#pragma unroll
            for (int m = 0; m < 4; ++m) { const int r = row0 + ai * HALF + m * 16; const float rs = rfac[r];
#pragma unroll
                for (int bj = 0; bj < 2; ++bj) { float v[8];
#pragma unroll
                    for (int i = 0; i < 8; ++i) { float x = af(acc[ai][bj][m][i >> 2], i & 3) * (rs * swv[bj][i]);
                        if (MODE == 0) { v[i] = x * fsig(x) * 0.125f; }
                        else if (MODE == 1) { x = fminf(fmaxf(x, -30.f), 30.f); const float ex = fexp(-x), sg = __builtin_amdgcn_rcpf(1.0f + ex), om = ex * sg;
                            v[i] = (1.0f - lbv[bj][i]) * om; }
                        else if (MODE == 2) { v[i] = x; }
                        else if (MODE == 3) { v[i] = x * fsig(x); }
                        else { v[i] = fsig(x); } }
                    const size_t off = (size_t)r * ldo + cbase + bj * HALF + cl;
                    st8(O + off, v); } }
    }
    __device__ __forceinline__ void operator()(const f32x4 (&acc)[2][2][4][2], const Unit& u, int wr, int wc, int fr, int fq) const {
        const int pn = u.pn; int row0 = u.pm * BM + wr * 64 + fr, cl = wc * 32 + 8 * fq;
        asm volatile("" : "+v"(row0), "+v"(cl));
        if (pn < 2) run<0>(acc, Q, 512, pn * 256, pn * 256, row0, cl);
        else if (pn < 4) run<1>(acc, KK, 512, (pn - 2) * 256, pn * 256, row0, cl);
        else if (pn < 6) run<2>(acc, V, 512, (pn - 4) * 256, pn * 256, row0, cl);
        else if (pn < 8) run<3>(acc, SG, 512, (pn - 6) * 256, pn * 256, row0, cl);
        else if (pn < 10) run<2>(acc, CB, 512, (pn - 8) * 256, pn * 256, row0, cl);
        else if (pn < 14) {
            float s01[8];
#pragma unroll
            for (int i = 0; i < 8; ++i) s01[i] = swr[pn * 256 + cl + i] * swr[pn * 256 + HALF + cl + i];
#pragma unroll
            for (int ai = 0; ai < 2; ++ai)
#pragma unroll
                for (int m = 0; m < 4; ++m) { const int r = row0 + ai * HALF + m * 16; const float rs = rfac[r], rs2 = rs * rs; float v[8];
#pragma unroll
                    for (int i = 0; i < 8; ++i) v[i] = af(acc[ai][0][m][i >> 2], i & 3) * af(acc[ai][1][m][i >> 2], i & 3) * (rs2 * s01[i]);
                    st8(U + (size_t)r * 512 + (pn - 10) * 128 + cl, v); }
        }
        else {
            unsigned char* G8 = (unsigned char*)GA + (size_t)(u.pm * 8 + (pn - 14)) * 65536 + (size_t)((wr * 4 + wc) * 64 + fq * 16 + fr) * 16;
            float swv[2][8];
#pragma unroll
            for (int bj = 0; bj < 2; ++bj)
#pragma unroll
                for (int i = 0; i < 8; ++i) swv[bj][i] = swr[pn * 256 + bj * HALF + cl + i];
#pragma unroll
            for (int ai = 0; ai < 2; ++ai)
#pragma unroll
                for (int m = 0; m < 4; ++m) { const int r = row0 + ai * HALF + m * 16; const float rs = rfac[r]; unsigned w[4] = {0u, 0u, 0u, 0u};
#pragma unroll
                    for (int bj = 0; bj < 2; ++bj)
#pragma unroll
                        for (int i = 0; i < 8; ++i) { const float gq = fmaxf(fsig(af(acc[ai][bj][m][i >> 2], i & 3) * (rs * swv[bj][i])) * 255.0f + 0.5f, 1.0f); w[2 * bj + (i >> 2)] = __builtin_amdgcn_cvt_pk_u8_f32(gq, i & 3, w[2 * bj + (i >> 2)]); }
                    u32x4 o; o.x = w[0]; o.y = w[1]; o.z = w[2]; o.w = w[3]; *(u32x4*)(G8 + (ai * 4 + m) * 8192) = o; }
        }
    }
};
struct EpiMerged {
    static constexpr bool PERM = true, AFTER_DRAIN = false, MID = true;
    const bf16_t *GAB; bf16_t* MG;
    static __device__ __forceinline__ float ub(unsigned w, int k) { return (float)((w >> (8 * k)) & 0xffu); }
    __device__ __forceinline__ void mid(f32x4 (&acc)[2][2][4][2], const Unit& u, int wr, int wc, int fr, int fq) const {
        int lt = (wr * 4 + wc) * 64 + fq * 16 + fr; asm volatile("" : "+v"(lt));
        const unsigned char* Ga = (const unsigned char*)GAB + (size_t)(u.pm * 8 + u.pn) * 65536 + (size_t)lt * 16; const unsigned char* Gb = Ga + (size_t)4 * 65536;
#pragma unroll
        for (int ai = 0; ai < 2; ++ai)
#pragma unroll
            for (int m = 0; m < 4; ++m) { const u32x4 a = *(const u32x4*)(Ga + (ai * 4 + m) * 8192), b = *(const u32x4*)(Gb + (ai * 4 + m) * 8192);
                const unsigned aw[4] = {a.x, a.y, a.z, a.w}, bw[4] = {b.x, b.y, b.z, b.w};
#pragma unroll
                for (int bj = 0; bj < 2; ++bj)
#pragma unroll
                    for (int i = 0; i < 8; ++i) acc[ai][bj][m][i >> 2][i & 3] *= ub(aw[2 * bj + (i >> 2)], i & 3) * __builtin_amdgcn_rcpf(ub(bw[2 * bj + (i >> 2)], i & 3)); }
        asm volatile("" ::: "memory");
    }
    __device__ __forceinline__ void operator()(const f32x4 (&acc)[2][2][4][2], const Unit& u, int wr, int wc, int fr, int fq) const {
        int row0 = u.pm * BM + wr * 64 + fr, c0 = u.pn * BM + wc * 32 + 8 * fq;
        asm volatile("" : "+v"(row0), "+v"(c0));
        int lt = (wr * 4 + wc) * 64 + fq * 16 + fr; asm volatile("" : "+v"(lt));
        const unsigned char* Gb = (const unsigned char*)GAB + (size_t)(u.pm * 8 + 4 + u.pn) * 65536 + (size_t)lt * 16;
        u32x4 gbw[2][4];
#pragma unroll
        for (int ai = 0; ai < 2; ++ai)
#pragma unroll
            for (int m = 0; m < 4; ++m) gbw[ai][m] = *(const u32x4*)(Gb + (ai * 4 + m) * 8192);
#pragma unroll
        for (int ai = 0; ai < 2; ++ai)
#pragma unroll
            for (int m = 0; m < 4; ++m) { const size_t rr = (size_t)(row0 + ai * HALF + m * 16); const unsigned bw[4] = {gbw[ai][m].x, gbw[ai][m].y, gbw[ai][m].z, gbw[ai][m].w};
#pragma unroll
                for (int bj = 0; bj < 2; ++bj) { float v[8];
#pragma unroll
                    for (int i = 0; i < 8; ++i) v[i] = acc[ai][bj][m][i >> 2][i & 3] * (ub(bw[2 * bj + (i >> 2)], i & 3) * (1.0f / 255.0f));
                    st8(MG + rr * 1024 + c0 + bj * HALF, v); } }
    }
};
struct EpiOut {
    static constexpr bool PERM = true, AFTER_DRAIN = false, MID = false;
    const bf16_t* x; float* x1; bf16_t* x1b; float* rowss;
    __device__ __forceinline__ void mid(f32x4 (&)[2][2][4][2], const Unit&, int, int, int, int) const {}
    __device__ __forceinline__ void operator()(const f32x4 (&acc)[2][2][4][2], const Unit& u, int wr, int wc, int fr, int fq) const {
        int row0 = u.pm * BM + wr * 64 + fr, c0 = u.pn * BM + wc * 32 + 8 * fq;
        asm volatile("" : "+v"(row0), "+v"(c0));
#pragma unroll
        for (int ai = 0; ai < 2; ++ai)
#pragma unroll
            for (int m = 0; m < 4; ++m) { const int r = row0 + ai * HALF + m * 16; const size_t ro = (size_t)r * 1024 + c0; float ss = 0.f;
#pragma unroll
                for (int bj = 0; bj < 2; ++bj) { float xv[8]; ld8(x + ro + bj * HALF, xv);
                    const f32x4 x0 = {xv[0], xv[1], xv[2], xv[3]}, x1v = {xv[4], xv[5], xv[6], xv[7]};
                    const f32x4 o0 = acc[ai][bj][m][0] + x0, o1 = acc[ai][bj][m][1] + x1v;
                    float v[8] = {o0[0], o0[1], o0[2], o0[3], o1[0], o1[1], o1[2], o1[3]};
#pragma unroll
                    for (int i = 0; i < 8; ++i) ss += v[i] * v[i];
                    st8(x1b + ro + bj * HALF, v); }
                ss += __shfl_xor(ss, 16); ss += __shfl_xor(ss, 32);
                if (fq == 0) rowss[(size_t)r * 16 + u.pn * 4 + wc] = ss; }
    }
};
struct EpiQuery {
    static constexpr bool PERM = true, AFTER_DRAIN = false, MID = false;
    const float* rowss; bf16_t* QQ; float eps;
    __device__ __forceinline__ void mid(f32x4 (&)[2][2][4][2], const Unit&, int, int, int, int) const {}
    __device__ __forceinline__ void operator()(const f32x4 (&acc)[2][2][4][2], const Unit& u, int wr, int wc, int fr, int fq) const {
        int row0 = u.pm * BM + wr * 64 + fr, c0 = u.pn * BM + wc * 32 + 8 * fq;
        asm volatile("" : "+v"(row0), "+v"(c0));
#pragma unroll
        for (int ai = 0; ai < 2; ++ai)
#pragma unroll
            for (int m = 0; m < 4; ++m) { const int r = row0 + ai * HALF + m * 16; const float rs = __builtin_amdgcn_rsqf(sum16(rowss + (size_t)r * 16) * (1.0f / 1024.0f) + eps);
#pragma unroll
                for (int bj = 0; bj < 2; ++bj) { float v[8];
#pragma unroll
                    for (int i = 0; i < 8; ++i) v[i] = acc[ai][bj][m][i >> 2][i & 3] * rs;
                    st8(QQ + (size_t)r * 2048 + c0 + bj * HALF, v); } }
    }
};

template <class Epi, class Sched, bool ALIGN_EPI = false, bool SP2 = false, bool FP8 = false, bool INT8 = false>
__device__ __forceinline__ void gemm_phase(PG8_LAS unsigned char* lds, const Gemm g, const Sched& S, const Epi& E, const int wid) {
    const int lane = fresh_lane(), tid = wid * 64 + lane, wr = wid >> 2, wc = wid & 3, fr = lane & 15, fq = lane >> 4;
    const int K = g.K, nt = K / BK;
    unsigned voffA[2], voffB[2];
#pragma unroll
    for (int i = 0; i < 2; ++i) { int R, C; stage_rc(tid * 16 + i * 8192, R, C); const int Rb = Epi::PERM ? ((R & ~31) + perm32(R & 31)) : R;
        voffA[i] = (unsigned)(R * K + C) * 2u; voffB[i] = (unsigned)(Rb * K + C) * 2u; }
    const size_t kstep = (size_t)(BK * 2);
    const size_t hstep = (size_t)HALF * K * 2;
    const size_t tstep = 2 * hstep;
    const unsigned ldsw = (unsigned)wid * 1024u;
    const int aoff = lds_byte(wr * 64 + fr, fq * 8), boff = lds_byte(wc * 32 + fr, fq * 8);
#define PG8_SA(b, h) (((b) * 2 + (h)) * HTB)
#define PG8_SB(b, h) ((4 + (b) * 2 + (h)) * HTB)
#define PG8_STAGE(bufoff, gbase, voff) do { _Pragma("unroll") for (int _i = 0; _i < 2; ++_i) \
        __builtin_amdgcn_global_load_lds((const unsigned*)((const char*)(gbase) + (voff)[_i]), (PG8_LAS unsigned*)(lds + (bufoff) + ldsw + _i * 8192), 16, 0, 0); } while (0)
#define PG8_LDA(dst, b, h) do { _Pragma("unroll") for (int m = 0; m < 4; ++m) _Pragma("unroll") for (int k = 0; k < 2; ++k) dst[m][k] = *(const PG8_LAS bf16x8*)(lds + PG8_SA(b, h) + aoff + m * 2048 + k * 1024); } while (0)
#define PG8_LDB(dst, b, h) do { _Pragma("unroll") for (int n = 0; n < 2; ++n) _Pragma("unroll") for (int k = 0; k < 2; ++k) dst[n][k] = *(const PG8_LAS bf16x8*)(lds + PG8_SB(b, h) + boff + n * 2048 + k * 1024); } while (0)
#define PG8_MMA(ai, bj, At, Bt) do { __builtin_amdgcn_s_setprio(1); \
        if constexpr (FP8) { _Pragma("unroll") for (int m = 0; m < 4; ++m) _Pragma("unroll") for (int n = 0; n < 2; ++n) { \
            const v4i_ b0_ = __builtin_bit_cast(v4i_, Bt[n][0]), b1_ = __builtin_bit_cast(v4i_, Bt[n][1]), a0_ = __builtin_bit_cast(v4i_, At[m][0]), a1_ = __builtin_bit_cast(v4i_, At[m][1]); \
            const v8i_ bb_ = {b0_[0], b0_[1], b0_[2], b0_[3], b1_[0], b1_[1], b1_[2], b1_[3]}, aa_ = {a0_[0], a0_[1], a0_[2], a0_[3], a1_[0], a1_[1], a1_[2], a1_[3]}; \
            asm("v_mfma_scale_f32_16x16x128_f8f6f4 %0, %1, %2, %0, %3, %4 op_sel_hi:[0,0,0]" : "+v"(acc[ai][bj][m][n]) : "v"(bb_), "v"(aa_), "v"(scw_), "v"(sca_)); } } \
        else if constexpr (INT8) { _Pragma("unroll") for (int m = 0; m < 4; ++m) _Pragma("unroll") for (int n = 0; n < 2; ++n) _Pragma("unroll") for (int k = 0; k < 2; ++k) \
            acc[ai][bj][m][n] = __builtin_bit_cast(f32x4, __builtin_amdgcn_mfma_i32_16x16x64_i8(__builtin_bit_cast(v4i_, Bt[n][k]), __builtin_bit_cast(v4i_, At[m][k]), __builtin_bit_cast(v4i_, acc[ai][bj][m][n]), 0, 0, 0)); } \
        else { _Pragma("unroll") for (int m = 0; m < 4; ++m) _Pragma("unroll") for (int n = 0; n < 2; ++n) _Pragma("unroll") for (int k = 0; k < 2; ++k) \
            acc[ai][bj][m][n] = __builtin_amdgcn_mfma_f32_16x16x32_bf16(Bt[n][k], At[m][k], acc[ai][bj][m][n], 0, 0, 0); } \
        __builtin_amdgcn_s_setprio(0); } while (0)
#define PG8_WAIT_V(n) asm volatile("s_waitcnt vmcnt(" #n ")" ::: "memory")
#define PG8_WAIT_L(n) asm volatile("s_waitcnt lgkmcnt(" #n ")" ::: "memory")
#define PG8_BAR __builtin_amdgcn_s_barrier()
#define PG8_SCHED __builtin_amdgcn_sched_barrier(0)
    Unit cur, nxt; int ui = 0;
    if (!S.next(0, cur)) return;
    int scw_ = 0x79797979, sca_ = 0x7f7f7f7f; if constexpr (FP8) asm volatile("" : "+v"(scw_), "+v"(sca_));
    f32x4 acc[2][2][4][2];
#pragma unroll
    for (int a = 0; a < 2; ++a)
#pragma unroll
        for (int b = 0; b < 2; ++b)
#pragma unroll
            for (int m = 0; m < 4; ++m)
#pragma unroll
                for (int n = 0; n < 2; ++n) acc[a][b][m][n] = (f32x4){0.f, 0.f, 0.f, 0.f};
    bf16x8 At[4][2], B0[2][2], B1[2][2];
    const char* cA = (const char*)g.A + (size_t)cur.pm * tstep; const char* cB = (const char*)g.Bt + (size_t)cur.pn * tstep;
    S.a_ready(cur);
    if constexpr (SP2) {
        PG8_STAGE(PG8_SB(0, 0), cB, voffB); PG8_STAGE(PG8_SB(0, 1), cB + hstep, voffB); PG8_STAGE(PG8_SA(0, 0), cA, voffA); PG8_STAGE(PG8_SA(0, 1), cA + hstep, voffA);
        if (wr == 1) PG8_BAR;
        PG8_WAIT_V(2); PG8_BAR;
        PG8_STAGE(PG8_SB(1, 0), cB + kstep, voffB); PG8_STAGE(PG8_SA(1, 0), cA + kstep, voffA); PG8_STAGE(PG8_SB(1, 1), cB + hstep + kstep, voffB);
        PG8_WAIT_V(6); PG8_BAR;
    } else {
        PG8_STAGE(PG8_SB(0, 0), cB, voffB); PG8_STAGE(PG8_SA(0, 0), cA, voffA); PG8_STAGE(PG8_SB(0, 1), cB + hstep, voffB); PG8_STAGE(PG8_SA(0, 1), cA + hstep, voffA);
        if (wr == 1) PG8_BAR;
        PG8_WAIT_V(4); PG8_BAR;
        PG8_STAGE(PG8_SB(1, 0), cB + kstep, voffB); PG8_STAGE(PG8_SA(1, 0), cA + kstep, voffA); PG8_STAGE(PG8_SB(1, 1), cB + hstep + kstep, voffB);
        PG8_WAIT_V(6); PG8_BAR;
    }
    for (;;) {
        const bool has_next = S.next(ui + 1, nxt);
        const char* nA = has_next ? (const char*)g.A + (size_t)nxt.pm * tstep : cA; const char* nB = has_next ? (const char*)g.Bt + (size_t)nxt.pn * tstep : cB;
#pragma unroll 1
        for (int t = 0; t < nt; t += 2) {
            if constexpr (Epi::MID) { if (t == (nt >> 1)) E.mid(acc, cur, wr, wc, fr, fq); }
            const bool last = (t == nt - 2);
            const char* a1 = cA + (size_t)(t + 1) * kstep;
            const char* a2 = last ? nA : cA + (size_t)(t + 2) * kstep; const char* b2 = last ? nB : cB + (size_t)(t + 2) * kstep;
            const char* a3 = a2 + kstep; const char* b3 = b2 + kstep;
            if (last && has_next) S.a_ready(nxt);
            if constexpr (SP2) {
            PG8_LDB(B0, 0, 0); PG8_LDB(B1, 0, 1); PG8_SCHED; PG8_LDA(At, 0, 0); PG8_STAGE(PG8_SA(1, 1), a1 + hstep, voffA);
            PG8_WAIT_V(8); PG8_WAIT_L(0); PG8_BAR; PG8_MMA(0, 0, At, B0); PG8_MMA(0, 1, At, B1); PG8_BAR; PG8_SCHED;
            PG8_LDA(At, 0, 1); PG8_STAGE(PG8_SB(0, 0), b2, voffB); PG8_STAGE(PG8_SB(0, 1), b2 + hstep, voffB); PG8_STAGE(PG8_SA(0, 0), a2, voffA);
            PG8_WAIT_V(8); PG8_WAIT_L(0); PG8_BAR; PG8_MMA(1, 0, At, B0); PG8_MMA(1, 1, At, B1); PG8_BAR; PG8_SCHED;
            PG8_LDB(B0, 1, 0); PG8_LDB(B1, 1, 1); PG8_SCHED; PG8_LDA(At, 1, 0); PG8_STAGE(PG8_SA(0, 1), a2 + hstep, voffA);
            PG8_WAIT_V(8); PG8_WAIT_L(0); PG8_BAR; PG8_MMA(0, 0, At, B0); PG8_MMA(0, 1, At, B1); PG8_BAR; PG8_SCHED;
            PG8_LDA(At, 1, 1); PG8_STAGE(PG8_SB(1, 0), b3, voffB); PG8_STAGE(PG8_SB(1, 1), b3 + hstep, voffB); PG8_STAGE(PG8_SA(1, 0), a3, voffA);
            PG8_WAIT_V(8); PG8_WAIT_L(0); PG8_BAR; PG8_MMA(1, 0, At, B0); PG8_MMA(1, 1, At, B1); PG8_BAR; PG8_SCHED;
            } else {
            PG8_LDB(B0, 0, 0); PG8_SCHED; PG8_LDA(At, 0, 0); PG8_STAGE(PG8_SA(1, 1), a1 + hstep, voffA);
            PG8_WAIT_L(8); PG8_BAR; PG8_WAIT_L(0); PG8_MMA(0, 0, At, B0); PG8_BAR; PG8_SCHED;
            PG8_LDB(B1, 0, 1); PG8_STAGE(PG8_SB(0, 0), b2, voffB);
            PG8_BAR; PG8_WAIT_L(0); PG8_MMA(0, 1, At, B1); PG8_BAR;
            PG8_LDA(At, 0, 1); PG8_STAGE(PG8_SA(0, 0), a2, voffA);
            PG8_BAR; PG8_WAIT_L(0); PG8_MMA(1, 0, At, B0); PG8_BAR; PG8_SCHED;
            PG8_STAGE(PG8_SB(0, 1), b2 + hstep, voffB);
            PG8_WAIT_V(6); PG8_BAR; PG8_MMA(1, 1, At, B1); PG8_BAR;
            PG8_LDB(B0, 1, 0); PG8_SCHED; PG8_LDA(At, 1, 0); PG8_STAGE(PG8_SA(0, 1), a2 + hstep, voffA);
            PG8_WAIT_L(8); PG8_BAR; PG8_WAIT_L(0); PG8_MMA(0, 0, At, B0); PG8_BAR; PG8_SCHED;
            PG8_LDB(B1, 1, 1); PG8_STAGE(PG8_SB(1, 0), b3, voffB);
            PG8_BAR; PG8_WAIT_L(0); PG8_MMA(0, 1, At, B1); PG8_BAR;
            PG8_LDA(At, 1, 1); PG8_STAGE(PG8_SA(1, 0), a3, voffA);
            PG8_BAR; PG8_WAIT_L(0); PG8_MMA(1, 0, At, B0); PG8_BAR; PG8_SCHED;
            PG8_STAGE(PG8_SB(1, 1), b3 + hstep, voffB);
            PG8_WAIT_V(6); PG8_BAR; PG8_MMA(1, 1, At, B1); PG8_BAR;
            }
        }
        if constexpr (FP8) asm volatile("s_nop 15\n\ts_nop 15\n\ts_nop 15" ::: "memory");
        if constexpr (ALIGN_EPI) { if (wr == 0) PG8_BAR; }
        if constexpr (!Epi::AFTER_DRAIN) { E(acc, cur, wr, wc, fr, fq); S.done(cur); }
        if (!has_next) break;
#pragma unroll
        for (int a = 0; a < 2; ++a)
#pragma unroll
            for (int b = 0; b < 2; ++b)
#pragma unroll
                for (int m = 0; m < 4; ++m)
#pragma unroll
                    for (int n = 0; n < 2; ++n) acc[a][b][m][n] = (f32x4){0.f, 0.f, 0.f, 0.f};
        cur = nxt; cA = nA; cB = nB; ++ui;
        if constexpr (ALIGN_EPI) { if (wr == 1) PG8_BAR; }
    }
    PG8_WAIT_V(0);
    if constexpr (!ALIGN_EPI) { if (wr == 0) PG8_BAR; }
    PG8_BAR;
    if constexpr (Epi::AFTER_DRAIN) { E.fused(acc, cur, wr, wc, fr, fq, lds, wid, lane); S.done(cur); }
#undef PG8_SA
#undef PG8_SB
#undef PG8_STAGE
#undef PG8_LDA
#undef PG8_LDB
#undef PG8_MMA
#undef PG8_WAIT_V
#undef PG8_WAIT_L
#undef PG8_BAR
#undef PG8_SCHED
}
}

constexpr int NWAVES = 8;
constexpr int N_LAUNCHES = MK_N_LAUNCHES;
constexpr int PER_PHASE = 10;
constexpr int T = 32768, D = 1024, SEQ = 4096, NIN = 5632, NUNIT = 4096;
constexpr float EPS = 1e-6f;
constexpr size_t MiB = 1u << 20;
constexpr size_t WS_CTL = 0, CTL_ZERO_BYTES = 1 * MiB;
constexpr size_t WS_WMAX = 64 * 1024;
constexpr size_t WS_SWR = 1 * MiB + 512 * 1024;
constexpr size_t WS_RFAC = 1 * MiB + 768 * 1024;
constexpr size_t WS_ROWSS = 4 * MiB;
constexpr size_t WS_RSTD1 = 1 * MiB;
constexpr size_t WS_LB = 1 * MiB + 256 * 1024;
constexpr size_t WS_DEC = 2 * MiB;
constexpr size_t WS_WIN = 8 * MiB, WS_PAB = 19 * MiB, WS_WO = 21 * MiB, WS_WQ = 23 * MiB, WS_KEYS = 27 * MiB;
constexpr size_t WS_GA = 32 * MiB, WS_GB = 96 * MiB;
constexpr size_t WS_Q = 160 * MiB, WS_LF = 192 * MiB, WS_KK = 224 * MiB, WS_V = 256 * MiB, WS_SG = 288 * MiB, WS_CB = 320 * MiB, WS_U = 352 * MiB;
constexpr size_t WS_XB = 384 * MiB;
constexpr size_t WS_LOC = 448 * MiB;
constexpr size_t WS_SPREV = 320 * MiB;
constexpr size_t WS_X1 = 32 * MiB;
constexpr size_t WS_MG = 160 * MiB;
constexpr size_t WS_X1B = 224 * MiB;
constexpr size_t WS_QQ = 288 * MiB;
constexpr size_t WS_IDX = 416 * MiB, WS_GATE = 432 * MiB;
constexpr size_t WS_EU = 160 * MiB, WS_EV = 176 * MiB;
constexpr size_t WS_ESC = 192 * MiB;
constexpr size_t WS_X8 = 448 * MiB;
constexpr size_t WS_W8G = 28 * MiB;
constexpr size_t WS_END = 480 * MiB;
constexpr int CW_BAR = 4096;
constexpr int RING_BYTES = 131072, WAVE_LDS = 18688, MISC_OFF = NWAVES * WAVE_LDS, LDS_BYTES = MISC_OFF + 1024;
static_assert(MISC_OFF >= RING_BYTES && LDS_BYTES <= 160 * 1024, "LDS map");

#define GAS __attribute__((address_space(1)))
#define LAS __attribute__((address_space(3)))
typedef unsigned short bf16;
typedef unsigned v4u __attribute__((ext_vector_type(4)));
typedef unsigned v2u __attribute__((ext_vector_type(2)));
typedef float f32x4 __attribute__((ext_vector_type(4)));
typedef float f32x16 __attribute__((ext_vector_type(16)));
typedef short bf16x8 __attribute__((ext_vector_type(8)));
typedef __bf16 bf16x2_t __attribute__((ext_vector_type(2)));
typedef GAS unsigned gu32;
#define RLX_AGENT __ATOMIC_RELAXED, __HIP_MEMORY_SCOPE_AGENT
#define LDS_WAIT() asm volatile("s_waitcnt lgkmcnt(0)" ::: "memory")
#define VM_WAIT() asm volatile("s_waitcnt vmcnt(0)" ::: "memory")
#define MFMA32(a, b, c) __builtin_amdgcn_mfma_f32_32x32x16_bf16((a), (b), (c), 0, 0, 0)
using pg8::cvt_pk_bf16; using pg8::fexp; using pg8::fsig; using pg8::bflo; using pg8::bfhi;
__device__ __forceinline__ int crow(int reg, int h) { return (reg & 3) + 8 * (reg >> 2) + 4 * h; }

#define XB_TMO      128
#define XB_XCNT(j)  (256  + 64 * (j))
#define XB_XSUB(j)  (1280 + 64 * (j))
#define XB_XGEN(j)  (2304 + 64 * (j))
#define XB_TOP      3328
#define XB_TOPGEN   3392
#define XCD_BAR_WORDS 3456
#define XB_SPIN_CAP (1u << 18)
__device__ __forceinline__ unsigned xb_ld(unsigned* p)              { return __hip_atomic_load(p, __ATOMIC_RELAXED, __HIP_MEMORY_SCOPE_AGENT); }
__device__ __forceinline__ unsigned xb_add(unsigned* p, unsigned v) { return __hip_atomic_fetch_add(p, v, __ATOMIC_RELAXED, __HIP_MEMORY_SCOPE_AGENT); }
__device__ __forceinline__ unsigned xb_xcc_id() { return (unsigned)__builtin_amdgcn_s_getreg((3 << 11) | 20) & 0xFu; }
#define XB_SPIN(cond, bar) do { unsigned _sp = 0; while (cond) { __builtin_amdgcn_s_sleep(1); \
    if ((++_sp & 255u) == 0u) { if (xb_ld(&(bar)[XB_TMO])) break; if (_sp > XB_SPIN_CAP) { atomicAdd(&(bar)[XB_TMO], 1u); break; } } } } while (0)
struct XcdBarrier { unsigned* bar; unsigned x; volatile LAS unsigned* st; };
__device__ __forceinline__ XcdBarrier xcd_barrier_post(unsigned* bar, volatile LAS unsigned* st) {
    XcdBarrier b; b.bar = bar; b.x = xb_xcc_id(); b.st = st;
    if (threadIdx.x == 0) (void)xb_add(&bar[XB_XCNT(b.x)], 1u);
    return b;
}
__device__ __forceinline__ void xcd_barrier_complete(unsigned* bar, unsigned x, unsigned& nloc, unsigned& nx) {
    const unsigned G = gridDim.x * gridDim.y * gridDim.z;
    unsigned sum, cnt, mine, sp = 0u;
    for (;;) {
        sum = 0u; cnt = 0u; mine = 0u;
#pragma unroll
        for (unsigned j = 0; j < 16; ++j) { const unsigned c = xb_ld(&bar[XB_XCNT(j)]); sum += c; cnt += (c > 0u) ? 1u : 0u; mine = (j == x) ? c : mine; }
        if (sum == G) break;
        __builtin_amdgcn_s_sleep(1);
        if ((++sp & 255u) == 0u) { if (xb_ld(&bar[XB_TMO])) break; if (sp > XB_SPIN_CAP) { atomicAdd(&bar[XB_TMO], 1u); break; } }
    }
    nloc = mine > 0u ? mine : 1u; nx = cnt > 0u ? cnt : 1u;
}
__device__ __forceinline__ void xcd_barrier(const XcdBarrier& b) {
    asm volatile("s_waitcnt vmcnt(0)" ::: "memory");
    __syncthreads();
    if (threadIdx.x == 0) {
        unsigned* bar = b.bar;
        __builtin_amdgcn_s_waitcnt(0);
        unsigned nloc = b.st[0], nx = b.st[1];
        if (nloc == 0u) { xcd_barrier_complete(bar, b.x, nloc, nx); b.st[0] = nloc; b.st[1] = nx; }
        const unsigned old = xb_add(&bar[XB_XSUB(b.x)], 1u);
        const unsigned gen = old / nloc;
        if (old + 1u == (gen + 1u) * nloc) {
            __builtin_amdgcn_fence(__ATOMIC_RELEASE, "agent");
            asm volatile("s_waitcnt vmcnt(0)" ::: "memory");
            const unsigned og = xb_add(&bar[XB_TOP], 1u);
            const unsigned tg = og / nx;
            if (og + 1u == (tg + 1u) * nx) xb_add(&bar[XB_TOPGEN], 1u);
            else XB_SPIN(xb_ld(&bar[XB_TOPGEN]) == tg, bar);
            __builtin_amdgcn_fence(__ATOMIC_ACQUIRE, "agent");
            xb_add(&bar[XB_XGEN(b.x)], 1u);
            asm volatile("s_waitcnt vmcnt(0)" ::: "memory");
        } else {
            XB_SPIN(xb_ld(&bar[XB_XGEN(b.x)]) == gen, bar);
            __builtin_amdgcn_fence(__ATOMIC_ACQUIRE, "agent");
            asm volatile("s_waitcnt vmcnt(0)" ::: "memory");
        }
    }
    __syncthreads();
}

struct Args { const float* in[16]; float* out; unsigned char* ws; int ph_lo, ph_hi, li, pad; };
struct Frame {
    LAS unsigned char* lds;
    int wave;
    int vcu, G;
    int gw, ngw;
    float* out; unsigned char* ws;
};
__device__ __forceinline__ float wave_sum(float v) {
#pragma unroll
    for (int o = 1; o < 64; o <<= 1) v += __shfl_xor(v, o);
    return v;
}
__device__ __forceinline__ unsigned f2bf(float f) { unsigned u = __builtin_bit_cast(unsigned, f); return (u + 0x7fffu + ((u >> 16) & 1u)) >> 16; }
__device__ __forceinline__ unsigned pk2(float lo, float hi) { return cvt_pk_bf16(lo, hi); }
__device__ __forceinline__ float bf2f(bf16 h) { return __builtin_bit_cast(float, (unsigned)h << 16); }

__device__ __forceinline__ int win_dst_row(int n) {
    if (n >= 2560 && n < 3072) { const int j = (n - 2560) >> 7, r = (n - 2560) & 127; return 2560 + 256 * j + r; }
    if (n >= 3072 && n < 3584) { const int j = (n - 3072) >> 7, r = (n - 3072) & 127; return 2560 + 256 * j + 128 + r; }
#ifdef DBG_SWAPG
    if (n >= 3584 && n < 4608) return n + 1024;
    if (n >= 4608) return n - 1024;
#endif
    return n;
}
__device__ __forceinline__ void p0_transpose_item(const float* W, int K, int N, const float* gain, bf16* WT, int ldwt, int koff, bool perm, LAS float* scr, int item, int lane, unsigned char* W8 = nullptr, const void* W8q_max = nullptr, float* W8q_swr = nullptr) {
    const int nblk = N / 32, kb = item / nblk, nb = item % nblk, k0 = 64 * kb, n0 = 32 * nb;
    { float wv[32];
#pragma unroll
      for (int i = 0; i < 32; ++i) wv[i] = W[(size_t)(k0 + 2 * i + (lane >> 5)) * N + n0 + (lane & 31)];
#pragma unroll
      for (int i = 0; i < 32; ++i) { const int kk = 2 * i + (lane >> 5); float v = wv[i]; if (gain) v *= gain[k0 + kk]; scr[kk * 33 + (lane & 31)] = v; } }
    LDS_WAIT(); asm volatile("" ::: "memory");
    const int c = lane & 7, d0 = perm ? win_dst_row(n0) : n0;
    if (W8 != nullptr) {
        const unsigned* wmx = (const unsigned*)W8q_max; float* swr = W8q_swr;
#pragma unroll
        for (int j = 0; j < 4; ++j) { const int n = (lane >> 3) + 8 * j; const LAS float* s = scr + (8 * c) * 33 + n;
            const float mx = fmaxf(__builtin_bit_cast(float, wmx[n0 + n]), 1e-30f), inv = 127.0f / mx;
            unsigned lo = 0u, hi = 0u;
#pragma unroll
            for (int i = 0; i < 4; ++i) { lo |= ((unsigned)__float2int_rn(s[i * 33] * inv) & 0xffu) << (8 * i); hi |= ((unsigned)__float2int_rn(s[(4 + i) * 33] * inv) & 0xffu) << (8 * i); }
            v2u o; o.x = lo; o.y = hi; *(GAS v2u*)(W8 + (size_t)(d0 + n) * 1024 + k0 + 8 * c) = o;
            if (c == 0 && kb == 0) swr[d0 + n] = mx * (1.0f / 127.0f); }
        LDS_WAIT(); asm volatile("" ::: "memory");
        return;
    }
#pragma unroll
    for (int j = 0; j < 4; ++j) { const int n = (lane >> 3) + 8 * j; const LAS float* s = scr + (8 * c) * 33 + n;
        v4u o; o.x = pk2(s[0 * 33], s[1 * 33]); o.y = pk2(s[2 * 33], s[3 * 33]); o.z = pk2(s[4 * 33], s[5 * 33]); o.w = pk2(s[6 * 33], s[7 * 33]);
        *(GAS v4u*)(WT + (size_t)(d0 + n) * ldwt + koff + k0 + 8 * c) = o; }
    LDS_WAIT(); asm volatile("" ::: "memory");
}
__device__ __forceinline__ void cvt512(const float* src, bf16* dst, size_t item, int lane) {
    const f32x4 a = *(const f32x4*)(src + item * 512 + lane * 8), b = *(const f32x4*)(src + item * 512 + lane * 8 + 4);
    v4u o; o.x = pk2(a[0], a[1]); o.y = pk2(a[2], a[3]); o.z = pk2(b[0], b[1]); o.w = pk2(b[2], b[3]);
    *(v4u*)(dst + item * 512 + lane * 8) = o;
}
__device__ __forceinline__ void p0_colmax(Frame& F, const Args& A) {
    const float *g_mix = A.in[1], *w_in = A.in[2]; unsigned* wmx = (unsigned*)(F.ws + WS_WMAX); const int lane = pg8::fresh_lane();
    for (int item = F.gw; item < 16 * 176; item += F.ngw) {
        const int kb = item / 176, nb = item % 176, k0 = 64 * kb, n0 = 32 * nb; float wv[32];
#pragma unroll
        for (int i = 0; i < 32; ++i) wv[i] = w_in[(size_t)(k0 + 2 * i + (lane >> 5)) * NIN + n0 + (lane & 31)];
        float m = 0.f;
#pragma unroll
        for (int i = 0; i < 32; ++i) m = fmaxf(m, fabsf(wv[i] * g_mix[k0 + 2 * i + (lane >> 5)]));
        m = fmaxf(m, __shfl_xor(m, 32));
        if (lane < 32) atomicMax(wmx + n0 + lane, __builtin_bit_cast(unsigned, m));
    }
}
__device__ __forceinline__ void p0_prologue(Frame& F, const Args& A) {
    const float *x = A.in[0], *g_mix = A.in[1], *w_in = A.in[2], *lb_log = A.in[3], *w_pa = A.in[6], *w_pb = A.in[7], *w_o = A.in[8], *g_ffn = A.in[9], *w_q = A.in[10],
                *k1 = A.in[11], *k2 = A.in[12];
    unsigned char* ws = F.ws; const int lane_ = pg8::fresh_lane();
    LAS float* scr = (LAS float*)(F.lds + F.wave * 16384);
    constexpr int I_IN = 16 * 176, I_P = 8 * 32, I_O = 16 * 32, I_Q = 16 * 64, NITEMS = I_IN + 2 * I_P + I_O + I_Q;
    for (int it = F.gw; it < NITEMS; it += F.ngw) {
        int r = it;
        if (r < I_IN) { p0_transpose_item(w_in, 1024, NIN, g_mix, (bf16*)(ws + WS_WIN), 1024, 0, true, scr, r, lane_, ws + WS_WIN, ws + WS_WMAX, (float*)(ws + WS_SWR)); continue; } r -= I_IN;
        if (r < I_P) { p0_transpose_item(w_pa, 512, 1024, nullptr, (bf16*)(ws + WS_PAB), 1024, 0, false, scr, r, lane_); continue; } r -= I_P;
        if (r < I_P) { p0_transpose_item(w_pb, 512, 1024, nullptr, (bf16*)(ws + WS_PAB), 1024, 512, false, scr, r, lane_); continue; } r -= I_P;
        if (r < I_O) { p0_transpose_item(w_o, 1024, 1024, nullptr, (bf16*)(ws + WS_WO), 1024, 0, false, scr, r, lane_); continue; } r -= I_O;
        p0_transpose_item(w_q, 1024, 2048, g_ffn, (bf16*)(ws + WS_WQ), 1024, 0, false, scr, r, lane_);
    }
    for (int it = F.gw; it < 512; it += F.ngw) { if (it < 256) cvt512(k1, (bf16*)(ws + WS_KEYS), it, lane_); else cvt512(k2, (bf16*)(ws + WS_KEYS) + 131072, it - 256, lane_); }
    float* rstd1 = (float*)(ws + WS_RSTD1); bf16* xb = (bf16*)(ws + WS_XB);
    for (int m = F.gw; m < T; m += F.ngw) {
        const f32x4* xr = (const f32x4*)(x + (size_t)m * D) + lane_; f32x4 v[4]; float s = 0.f;
#pragma unroll
        for (int j = 0; j < 4; ++j) { v[j] = xr[64 * j]; s += (v[j][0] * v[j][0] + v[j][1] * v[j][1]) + (v[j][2] * v[j][2] + v[j][3] * v[j][3]); }
        s = wave_sum(s);
        float mx = 0.f;
#pragma unroll
        for (int j = 0; j < 4; ++j) mx = fmaxf(mx, fmaxf(fmaxf(fabsf(v[j][0]), fabsf(v[j][1])), fmaxf(fabsf(v[j][2]), fabsf(v[j][3]))));
#pragma unroll
        for (int o = 1; o < 64; o <<= 1) mx = fmaxf(mx, __shfl_xor(mx, o));
        mx = fmaxf(mx, 1e-30f); const float qinv = 127.0f / mx;
        if (lane_ == 0) { const float rs_ = __builtin_amdgcn_rsqf(s * (1.0f / D) + EPS); rstd1[m] = rs_; ((float*)(ws + WS_RFAC))[m] = rs_ * mx * (1.0f / 127.0f); }
        v2u* o8 = (v2u*)(xb + (size_t)m * D) + lane_; unsigned* q8 = (unsigned*)(ws + WS_X8 + (size_t)m * D) + lane_;
#pragma unroll
        for (int j = 0; j < 4; ++j) { v2u o; o.x = pk2(v[j][0], v[j][1]); o.y = pk2(v[j][2], v[j][3]); o8[64 * j] = o;
            q8[64 * j] = ((unsigned)__float2int_rn(v[j][0] * qinv) & 0xffu) | (((unsigned)__float2int_rn(v[j][1] * qinv) & 0xffu) << 8) | (((unsigned)__float2int_rn(v[j][2] * qinv) & 0xffu) << 16) | ((unsigned)__float2int_rn(v[j][3] * qinv) << 24); }
    }
    if (F.gw == 0) { float* lb = (float*)(ws + WS_LB);
        for (int j = lane_; j < 512; j += 64) { const float a = lb_log[j], b = lb_log[512 + j]; lb[j] = 1.0f / (1.0f + expf(b - a)); } }
}

#define P2_SCATTER(REG, SRC) { _Pragma("unroll") for (int p = 0; p < 8; ++p) { LAS unsigned char* dst_ = (REG) + (8 * cc) * 144 + cc * 16 + 2 * (rr + 8 * p); const unsigned w_[4] = {SRC[p].x, SRC[p].y, SRC[p].z, SRC[p].w}; \
        _Pragma("unroll") for (int i = 0; i < 4; ++i) { *(LAS bf16*)(dst_ + (2 * i) * 144) = (bf16)(w_[i] & 0xffffu); *(LAS bf16*)(dst_ + (2 * i + 1) * 144) = (bf16)(w_[i] >> 16); } } }
#define P2_ROWLOAD(REG, W) { _Pragma("unroll") for (int j = 0; j < 8; ++j) { const v4u o_ = *(LAS v4u*)((REG) + lane * 144 + rr * 16 + j * 16); W[4 * j] = o_.x; W[4 * j + 1] = o_.y; W[4 * j + 2] = o_.z; W[4 * j + 3] = o_.w; } }
#define P2_ROWSTORE(REG, W) { _Pragma("unroll") for (int j = 0; j < 8; ++j) { v4u o_; o_.x = W[4 * j]; o_.y = W[4 * j + 1]; o_.z = W[4 * j + 2]; o_.w = W[4 * j + 3]; *(LAS v4u*)((REG) + lane * 144 + rr * 16 + j * 16) = o_; } }
#define P2_GATHER_STORE(REG, GP) { int ro_ = rr; asm volatile("" : "+v"(ro_));     \
    _Pragma("unroll") for (int p = 0; p < 8; ++p) { const LAS unsigned char* src_ = (REG) + (8 * cc) * 144 + cc * 16 + 2 * (ro_ + 8 * p); unsigned e_[8]; \
        _Pragma("unroll") for (int i = 0; i < 8; ++i) e_[i] = (unsigned)*(const LAS bf16*)(src_ + i * 144); \
        v4u o_; o_.x = e_[0] | (e_[1] << 16); o_.y = e_[2] | (e_[3] << 16); o_.z = e_[4] | (e_[5] << 16); o_.w = e_[6] | (e_[7] << 16); *(v4u*)((GP) + (size_t)(ro_ + 8 * p) * 512) = o_; if (p & 1) asm volatile("" ::: "memory"); } }
__device__ __forceinline__ void p2_unit(Frame& F, int unit) {
    unsigned char* ws = F.ws; const int lane = pg8::fresh_lane(), rr = lane >> 3, cc = lane & 7;
    const int bh = unit >> 6, c = unit & 63, bb = bh >> 3, h = bh & 7; const size_t t0 = (size_t)bb * SEQ + c * 64; const int cb0 = h * 64;
    bf16* Qg = (bf16*)(ws + WS_Q) + t0 * 512 + cb0 + 8 * cc; bf16* Kg = (bf16*)(ws + WS_KK) + t0 * 512 + cb0 + 8 * cc; const bf16* Vg = (const bf16*)(ws + WS_V) + t0 * 512 + cb0 + 8 * cc;
    LAS unsigned char* wl = F.lds + F.wave * WAVE_LDS; LAS unsigned char* KH = wl; LAS unsigned char* VT = wl + 9344;
    v4u kw[8], qw[8];
#pragma unroll
    for (int p = 0; p < 8; ++p) { kw[p] = *(const v4u*)(Kg + (size_t)(rr + 8 * p) * 512); qw[p] = *(const v4u*)(Qg + (size_t)(rr + 8 * p) * 512); }
    P2_SCATTER(KH, kw) P2_SCATTER(VT, qw)
    LDS_WAIT(); asm volatile("" ::: "memory");
    unsigned kr[32]; P2_ROWLOAD(KH, kr)
    LDS_WAIT(); asm volatile("" ::: "memory");
    float b[64];
    { float run = 0.f;
#pragma unroll
      for (int t = 0; t < 64; ++t) { const float kt = (t & 1) ? bfhi(kr[t >> 1]) : bflo(kr[t >> 1]); run += __builtin_amdgcn_logf(1.0f - kt) * 0.69314718056f; b[t] = run; } }
    const float blast = b[63];
    ((float*)(ws + WS_DEC))[unit * 64 + lane] = fexp(blast);
    { unsigned w[32];
#pragma unroll
      for (int t = 0; t < 64; t += 2) w[t >> 1] = pk2(bflo(kr[t >> 1]) * fexp(-b[t]), bfhi(kr[t >> 1]) * fexp(-b[t + 1]));
      P2_ROWSTORE(KH, w) }
    LDS_WAIT(); asm volatile("" ::: "memory");
    P2_GATHER_STORE(KH, Kg)
    LDS_WAIT(); asm volatile("" ::: "memory");
    { unsigned w[32];
#pragma unroll
      for (int t = 0; t < 64; t += 2) w[t >> 1] = pk2(bflo(kr[t >> 1]) * fexp(blast - b[t]), bfhi(kr[t >> 1]) * fexp(blast - b[t + 1]));
      P2_ROWSTORE(KH, w) }
    { unsigned w[32]; P2_ROWLOAD(VT, w)
      LDS_WAIT(); asm volatile("" ::: "memory");
#pragma unroll
      for (int t = 0; t < 64; t += 2) w[t >> 1] = pk2(bflo(w[t >> 1]) * fexp(b[t]), bfhi(w[t >> 1]) * fexp(b[t + 1]));
      P2_ROWSTORE(VT, w) }
    LDS_WAIT(); asm volatile("" ::: "memory");
    P2_GATHER_STORE(VT, Qg)
    LDS_WAIT(); asm volatile("" ::: "memory");
    { v4u vw[8]; int ro = rr; asm volatile("" : "+v"(ro));
#pragma unroll
      for (int p = 0; p < 8; ++p) vw[p] = *(const v4u*)(Vg + (size_t)(ro + 8 * p) * 512);
      P2_SCATTER(VT, vw) }
    LDS_WAIT(); asm volatile("" ::: "memory");
    const int r = lane & 31, hh = lane >> 5;
    f32x16 acc[2][2];
#pragma unroll
    for (int i = 0; i < 2; ++i)
#pragma unroll
        for (int j = 0; j < 2; ++j)
#pragma unroll
            for (int k = 0; k < 16; ++k) acc[i][j][k] = 0.f;
#pragma unroll
    for (int ks = 0; ks < 4; ++ks) {
        bf16x8 a[2], bq[2];
#pragma unroll
        for (int i = 0; i < 2; ++i) { const int ra = (32 * i + r) * 144 + (4 * i + (r >> 3)) * 16 + (16 * ks + 8 * hh) * 2; a[i] = *(const LAS bf16x8*)(VT + ra); bq[i] = *(const LAS bf16x8*)(KH + ra); }
#pragma unroll
        for (int i = 0; i < 2; ++i)
#pragma unroll
            for (int j = 0; j < 2; ++j) acc[i][j] = MFMA32(a[i], bq[j], acc[i][j]);
    }
    LDS_WAIT(); asm volatile("" ::: "memory");
    { LAS float* OL = (LAS float*)wl;
#pragma unroll
      for (int i = 0; i < 2; ++i)
#pragma unroll
          for (int j = 0; j < 2; ++j)
#pragma unroll
              for (int k = 0; k < 16; ++k) OL[(32 * i + crow(k, hh)) * 68 + 32 * j + r] = acc[i][j][k];
      LDS_WAIT(); asm volatile("" ::: "memory");
      bf16* LOC = (bf16*)(ws + WS_LOC) + (size_t)unit * 4096 + 8 * cc; int ro = rr; asm volatile("" : "+v"(ro));
#pragma unroll
      for (int p = 0; p < 8; ++p) { const int e = ro + 8 * p; const f32x4 v0 = *(LAS f32x4*)(OL + e * 68 + 8 * cc), v1 = *(LAS f32x4*)(OL + e * 68 + 8 * cc + 4);
          v4u o; o.x = pk2(v0[0], v0[1]); o.y = pk2(v0[2], v0[3]); o.z = pk2(v1[0], v1[1]); o.w = pk2(v1[2], v1[3]); *(v4u*)(LOC + e * 64) = o; } }
    LDS_WAIT(); asm volatile("" ::: "memory");
}
__device__ __forceinline__ void p2_phase(Frame& F, const float* cw) {
    for (int u = F.gw; u < NUNIT; u += F.ngw) p2_unit(F, u);
    unsigned char* ws = F.ws;
    const bf16* CB = (const bf16*)(ws + WS_CB); const bf16* U = (const bf16*)(ws + WS_U); bf16* YAB = (bf16*)F.out;
    const int gt = F.vcu * (NWAVES * 64) + F.wave * 64 + pg8::fresh_lane(), ngt = F.G * NWAVES * 64;
    for (int i = gt; i < (T / 16) * 64; i += ngt) {
        const int t0 = (i >> 6) * 16, j0 = (i & 63) * 8;
        float w0[8], w1[8], w2[8];
        { const f32x4 a0 = *(const f32x4*)(cw + j0), a1 = *(const f32x4*)(cw + j0 + 4), b0 = *(const f32x4*)(cw + 512 + j0), b1 = *(const f32x4*)(cw + 512 + j0 + 4), c0 = *(const f32x4*)(cw + 1024 + j0), c1 = *(const f32x4*)(cw + 1024 + j0 + 4);
#pragma unroll
          for (int k = 0; k < 4; ++k) { w0[k] = a0[k]; w0[4 + k] = a1[k]; w1[k] = b0[k]; w1[4 + k] = b1[k]; w2[k] = c0[k]; w2[4 + k] = c1[k]; } }
        float um2[8], um1[8];
        if ((t0 & (SEQ - 1)) != 0) { pg8::ld8(U + (size_t)(t0 - 2) * 512 + j0, um2); pg8::ld8(U + (size_t)(t0 - 1) * 512 + j0, um1); }
        else {
#pragma unroll
            for (int k = 0; k < 8; ++k) { um2[k] = 0.f; um1[k] = 0.f; } }
#pragma unroll 1
        for (int tt = 0; tt < 16; tt += 4) {
            pg8::u32x4 uw[4], cbw[4];
#pragma unroll
            for (int q = 0; q < 4; ++q) { uw[q] = *(const pg8::u32x4*)(U + (size_t)(t0 + tt + q) * 512 + j0); cbw[q] = *(const pg8::u32x4*)(CB + (size_t)(t0 + tt + q) * 512 + j0); }
#pragma unroll
            for (int q = 0; q < 4; ++q) {
                const float u0[8] = {bflo(uw[q].x), bfhi(uw[q].x), bflo(uw[q].y), bfhi(uw[q].y), bflo(uw[q].z), bfhi(uw[q].z), bflo(uw[q].w), bfhi(uw[q].w)};
                const float cbv[8] = {bflo(cbw[q].x), bfhi(cbw[q].x), bflo(cbw[q].y), bfhi(cbw[q].y), bflo(cbw[q].z), bfhi(cbw[q].z), bflo(cbw[q].w), bfhi(cbw[q].w)};
                float y[8];
#pragma unroll
                for (int k = 0; k < 8; ++k) { y[k] = DBG_ZYB * cbv[k] * (w0[k] * um2[k] + w1[k] * um1[k] + w2[k] * u0[k]); um2[k] = um1[k]; um1[k] = u0[k]; }
                pg8::st8(YAB + (size_t)(t0 + tt + q) * 1024 + 512 + j0, y); }
        }
    }
}

__device__ __forceinline__ void p3_phase(Frame& F) {
    unsigned char* ws = F.ws; const bf16* LOC = (const bf16*)(ws + WS_LOC); bf16* SP = (bf16*)(ws + WS_SPREV); const float* DEC = (const float*)(ws + WS_DEC);
    const int gt = F.vcu * (NWAVES * 64) + F.wave * 64 + pg8::fresh_lane(), ngt = F.G * NWAVES * 64;
    for (int i = gt; i < 64 * 4096; i += ngt) {
        const int bh = i >> 12, ed = i & 4095, d = ed & 63; float st = 0.f;
        for (int c0 = 0; c0 < 64; c0 += 8) { float lv[8], dv[8];
#pragma unroll
            for (int k = 0; k < 8; ++k) { lv[k] = bf2f(LOC[(size_t)(bh * 64 + c0 + k) * 4096 + ed]); dv[k] = DEC[(bh * 64 + c0 + k) * 64 + d]; }
#pragma unroll
            for (int k = 0; k < 8; ++k) { SP[(size_t)(bh * 64 + c0 + k) * 4096 + ed] = (bf16)f2bf(st); st = dv[k] * st + lv[k]; } }
    }
}

template <int M> __device__ __forceinline__ float p4_swz(float v) { return __builtin_bit_cast(float, __builtin_amdgcn_ds_swizzle(__builtin_bit_cast(int, v), 0x1f | (M << 10))); }
__device__ __forceinline__ void p4_unit(Frame& F, int unit, const float* gain) {
    unsigned char* ws = F.ws; const int lane = pg8::fresh_lane(), r = lane & 31, hh = lane >> 5;
    const int bh = unit >> 6, c = unit & 63, bb = bh >> 3, h = bh & 7; const size_t t0 = (size_t)bb * SEQ + c * 64; const int cb0 = h * 64;
    const bf16* Qt = (const bf16*)(ws + WS_Q) + t0 * 512 + cb0; const bf16* Kt = (const bf16*)(ws + WS_KK) + t0 * 512 + cb0;
    const bf16* Vp = (const bf16*)(ws + WS_V) + t0 * 512 + cb0 + lane; const bf16* SPu = (const bf16*)(ws + WS_SPREV) + (size_t)unit * 4096;
    LAS unsigned char* wl = F.lds + F.wave * WAVE_LDS; LAS unsigned char* PL = wl; LAS unsigned char* VT = wl + 9216;
    bf16x8 qa[2][4], kb[2][4], spf[2][4];
    { const bf16* Vt = (const bf16*)(ws + WS_V) + t0 * 512 + cb0 + 8 * (lane & 7);
      v4u pv[8];
#pragma unroll
      for (int p = 0; p < 8; ++p) pv[p] = *(const v4u*)(Vt + (size_t)((lane >> 3) + 8 * p) * 512);
#pragma unroll
      for (int i = 0; i < 2; ++i)
#pragma unroll
          for (int ks = 0; ks < 4; ++ks) { qa[i][ks] = *(const bf16x8*)(Qt + (size_t)(32 * i + r) * 512 + 16 * ks + 8 * hh); kb[i][ks] = *(const bf16x8*)(Kt + (size_t)(32 * i + r) * 512 + 16 * ks + 8 * hh); }
#pragma unroll
      for (int jj = 0; jj < 2; ++jj)
#pragma unroll
          for (int ks = 0; ks < 4; ++ks) spf[jj][ks] = *(const bf16x8*)(SPu + (32 * jj + r) * 64 + 16 * ks + 8 * hh);
#pragma unroll
      for (int p = 0; p < 8; ++p) { const int t = (lane >> 3) + 8 * p; LAS unsigned char* dst = VT + (8 * (lane & 7)) * 144 + 2 * t; const unsigned w[4] = {pv[p].x, pv[p].y, pv[p].z, pv[p].w};
#pragma unroll
          for (int i = 0; i < 4; ++i) { *(LAS bf16*)(dst + (2 * i) * 144) = (bf16)(w[i] & 0xffffu); *(LAS bf16*)(dst + (2 * i + 1) * 144) = (bf16)(w[i] >> 16); } } }
    asm volatile("" ::: "memory");
    {
        f32x16 sc[3];
#pragma unroll
        for (int k = 0; k < 16; ++k) { sc[0][k] = 0.f; sc[1][k] = 0.f; sc[2][k] = 0.f; }
#pragma unroll
        for (int ks = 0; ks < 4; ++ks) { sc[0] = MFMA32(qa[0][ks], kb[0][ks], sc[0]); sc[1] = MFMA32(qa[1][ks], kb[0][ks], sc[1]); sc[2] = MFMA32(qa[1][ks], kb[1][ks], sc[2]); }
#pragma unroll
        for (int k = 0; k < 16; ++k) { const int tr = crow(k, hh);
            *(LAS bf16*)(PL + tr * 144 + r * 2) = (bf16)f2bf(r <= tr ? sc[0][k] : 0.f);
            *(LAS bf16*)(PL + (32 + tr) * 144 + r * 2) = (bf16)f2bf(sc[1][k]);
            *(LAS bf16*)(PL + (32 + tr) * 144 + (32 + r) * 2) = (bf16)f2bf(r <= tr ? sc[2][k] : 0.f); }
    }
    asm volatile("" ::: "memory");
    f32x16 o[2][2];
#pragma unroll
    for (int i = 0; i < 2; ++i)
#pragma unroll
        for (int j = 0; j < 2; ++j)
#pragma unroll
            for (int k = 0; k < 16; ++k) o[i][j][k] = 0.f;
#pragma unroll
    for (int ks = 0; ks < 4; ++ks) {
#pragma unroll
        for (int i = 0; i < 2; ++i)
#pragma unroll
            for (int j = 0; j < 2; ++j) o[i][j] = MFMA32(qa[i][ks], spf[j][ks], o[i][j]);
    }
    LDS_WAIT(); asm volatile("" ::: "memory");
#pragma unroll
    for (int ks = 0; ks < 4; ++ks) {
        bf16x8 pa[2], vb[2];
        if (ks < 2) pa[0] = *(const LAS bf16x8*)(PL + r * 144 + (16 * ks + 8 * hh) * 2);
        pa[1] = *(const LAS bf16x8*)(PL + (32 + r) * 144 + (16 * ks + 8 * hh) * 2);
#pragma unroll
        for (int j = 0; j < 2; ++j) vb[j] = *(const LAS bf16x8*)(VT + (32 * j + r) * 144 + (16 * ks + 8 * hh) * 2);
#pragma unroll
        for (int j = 0; j < 2; ++j) { if (ks < 2) o[0][j] = MFMA32(pa[0], vb[j], o[0][j]); o[1][j] = MFMA32(pa[1], vb[j], o[1][j]); }
    }
    asm volatile("" ::: "memory");
    LDS_WAIT(); asm volatile("" ::: "memory");
    { LAS float* OL = (LAS float*)wl;
#pragma unroll
      for (int i = 0; i < 2; ++i)
#pragma unroll
          for (int j = 0; j < 2; ++j)
#pragma unroll
              for (int k = 0; k < 16; ++k) OL[(32 * i + crow(k, hh)) * 68 + 32 * j + r] = o[i][j][k];
      LDS_WAIT(); asm volatile("" ::: "memory");
      const int c = lane & 7; const f32x4 ga = *(const f32x4*)(gain + cb0 + 8 * c), gb = *(const f32x4*)(gain + cb0 + 8 * c + 4);
      const float g8[8] = {ga[0], ga[1], ga[2], ga[3], gb[0], gb[1], gb[2], gb[3]};
      const bf16* SGp = (const bf16*)(ws + WS_SG) + t0 * 512 + cb0 + 8 * c; bf16* YA = (bf16*)F.out + t0 * 1024 + cb0 + 8 * c;
#pragma unroll
      for (int p = 0; p < 8; ++p) { int t = (lane >> 3) + 8 * p; asm volatile("" : "+v"(t));
          const f32x4 v0 = *(LAS f32x4*)(OL + t * 68 + 8 * c), v1 = *(LAS f32x4*)(OL + t * 68 + 8 * c + 4);
          float ss = (v0[0] * v0[0] + v0[1] * v0[1]) + (v0[2] * v0[2] + v0[3] * v0[3]) + (v1[0] * v1[0] + v1[1] * v1[1]) + (v1[2] * v1[2] + v1[3] * v1[3]);
          ss += p4_swz<1>(ss); ss += p4_swz<2>(ss); ss += p4_swz<4>(ss);
          const float rs = __builtin_amdgcn_rsqf(ss * (1.0f / 64.0f) + EPS) * DBG_ZYA;
          float sg[8], y[8]; pg8::ld8(SGp + (size_t)t * 512, sg);
#pragma unroll
          for (int e = 0; e < 4; ++e) { y[e] = v0[e] * rs * g8[e] * sg[e]; y[4 + e] = v1[e] * rs * g8[4 + e] * sg[4 + e]; }
          pg8::st8(YA + (size_t)t * 1024, y); }
    }
    LDS_WAIT(); asm volatile("" ::: "memory");
}

__device__ __forceinline__ unsigned mono(float f) { const unsigned u = __builtin_bit_cast(unsigned, f); return u ^ (((unsigned)((int)u >> 31)) | 0x80000000u); }
__device__ __forceinline__ float unmono(unsigned m) { const unsigned u = (m & 0x80000000u) ? (m ^ 0x80000000u) : ~m; return __builtin_bit_cast(float, u); }
__device__ __forceinline__ unsigned med3u(unsigned a, unsigned b, unsigned c) { unsigned r; asm("v_med3_u32 %0, %1, %2, %3" : "=v"(r) : "v"(a), "v"(b), "v"(c)); return r; }
__device__ __forceinline__ unsigned maxu(unsigned a, unsigned b) { return a > b ? a : b; }
__device__ __forceinline__ void ins16(unsigned (&L)[16], unsigned v) {
#pragma unroll
    for (int j = 15; j >= 1; --j) L[j] = med3u(v, L[j - 1], L[j]);
    L[0] = maxu(L[0], v);
}
__device__ __forceinline__ unsigned minu(unsigned a, unsigned b) { return a < b ? a : b; }
#define P8_CE(X, A, B) { const unsigned hi_ = maxu(X[A], X[B]), lo_ = minu(X[A], X[B]); X[A] = hi_; X[B] = lo_; }
__device__ __forceinline__ void sort16_desc(unsigned (&x)[16]) { P8_CE(x, 0, 13) P8_CE(x, 1, 12) P8_CE(x, 2, 15) P8_CE(x, 3, 14) P8_CE(x, 4, 8) P8_CE(x, 5, 6) P8_CE(x, 7, 11) P8_CE(x, 9, 10) P8_CE(x, 0, 5) P8_CE(x, 1, 7) P8_CE(x, 2, 9) P8_CE(x, 3, 4) P8_CE(x, 6, 13) P8_CE(x, 8, 14) P8_CE(x, 10, 15) P8_CE(x, 11, 12) P8_CE(x, 0, 1) P8_CE(x, 2, 3) P8_CE(x, 4, 5) P8_CE(x, 6, 8) P8_CE(x, 7, 9) P8_CE(x, 10, 11) P8_CE(x, 12, 13) P8_CE(x, 14, 15) P8_CE(x, 0, 2) P8_CE(x, 1, 3) P8_CE(x, 4, 10) P8_CE(x, 5, 11) P8_CE(x, 6, 7) P8_CE(x, 8, 9) P8_CE(x, 12, 14) P8_CE(x, 13, 15) P8_CE(x, 1, 2) P8_CE(x, 3, 12) P8_CE(x, 4, 6) P8_CE(x, 5, 7) P8_CE(x, 8, 10) P8_CE(x, 9, 11) P8_CE(x, 13, 14) P8_CE(x, 1, 4) P8_CE(x, 2, 6) P8_CE(x, 5, 8) P8_CE(x, 7, 10) P8_CE(x, 9, 13) P8_CE(x, 11, 14) P8_CE(x, 2, 4) P8_CE(x, 3, 6) P8_CE(x, 9, 12) P8_CE(x, 11, 13) P8_CE(x, 3, 5) P8_CE(x, 6, 8) P8_CE(x, 7, 9) P8_CE(x, 10, 12) P8_CE(x, 3, 4) P8_CE(x, 5, 6) P8_CE(x, 7, 8) P8_CE(x, 9, 10) P8_CE(x, 11, 12) P8_CE(x, 6, 7) P8_CE(x, 8, 9) }
__device__ __forceinline__ void merge16_desc(unsigned (&L)[16], const unsigned (&S)[16]) {
    unsigned c[16];
#pragma unroll
    for (int i = 0; i < 16; ++i) c[i] = maxu(L[i], S[15 - i]);
    P8_CE(c, 0, 8) P8_CE(c, 1, 9) P8_CE(c, 2, 10) P8_CE(c, 3, 11) P8_CE(c, 4, 12) P8_CE(c, 5, 13) P8_CE(c, 6, 14) P8_CE(c, 7, 15) P8_CE(c, 0, 4) P8_CE(c, 1, 5) P8_CE(c, 2, 6) P8_CE(c, 3, 7) P8_CE(c, 8, 12) P8_CE(c, 9, 13) P8_CE(c, 10, 14) P8_CE(c, 11, 15) P8_CE(c, 0, 2) P8_CE(c, 1, 3) P8_CE(c, 4, 6) P8_CE(c, 5, 7) P8_CE(c, 8, 10) P8_CE(c, 9, 11) P8_CE(c, 12, 14) P8_CE(c, 13, 15) P8_CE(c, 0, 1) P8_CE(c, 2, 3) P8_CE(c, 4, 5) P8_CE(c, 6, 7) P8_CE(c, 8, 9) P8_CE(c, 10, 11) P8_CE(c, 12, 13) P8_CE(c, 14, 15)
#pragma unroll
    for (int i = 0; i < 16; ++i) L[i] = c[i];
}
__device__ __forceinline__ void p8_half(const bf16* keys, const bf16* qbase, LAS unsigned char* wl, int lane, unsigned (&L)[16]) {
    const int r = lane & 31, hh = lane >> 5, rr4 = lane >> 4, c = lane & 15;
    LAS unsigned char* qbuf = wl; LAS unsigned char* kbuf = wl + 8192;
    v4u st[8];
#pragma unroll
    for (int i = 0; i < 8; ++i) st[i] = *(const v4u*)(qbase + (size_t)(4 * i + rr4) * 2048 + 8 * c);
#pragma unroll
    for (int i = 0; i < 8; ++i) { const int rr = 4 * i + rr4; *(LAS v4u*)(qbuf + rr * 256 + ((c ^ (rr & 15)) << 4)) = st[i]; }
#pragma unroll
    for (int i = 0; i < 8; ++i) st[i] = *(const v4u*)(keys + (size_t)(4 * i + rr4) * 128 + 8 * c);
    LDS_WAIT(); asm volatile("" ::: "memory");
    bf16x8 qb[8];
#pragma unroll
    for (int ks = 0; ks < 8; ++ks) qb[ks] = *(const LAS bf16x8*)(qbuf + r * 256 + (((2 * ks + hh) ^ (r & 15)) << 4));
#pragma unroll
    for (int j = 0; j < 16; ++j) L[j] = 0u;
    const unsigned h4 = (unsigned)hh << 2;
#pragma unroll
    for (int it = 0; it < 4; ++it) {
#pragma unroll
        for (int i = 0; i < 8; ++i) { const int rr = 4 * i + rr4; *(LAS v4u*)(kbuf + rr * 256 + ((c ^ (rr & 15)) << 4)) = st[i]; }
        if (it < 3) {
#pragma unroll
            for (int i = 0; i < 8; ++i) st[i] = *(const v4u*)(keys + (size_t)(32 * (it + 1) + 4 * i + rr4) * 128 + 8 * c);
        }
        LDS_WAIT(); asm volatile("" ::: "memory");
        f32x16 acc;
#pragma unroll
        for (int k = 0; k < 16; ++k) acc[k] = 0.f;
#pragma unroll
        for (int ks = 0; ks < 8; ++ks) { const bf16x8 ka = *(const LAS bf16x8*)(kbuf + r * 256 + (((2 * ks + hh) ^ (r & 15)) << 4)); acc = MFMA32(ka, qb[ks], acc); }
        LDS_WAIT(); asm volatile("" ::: "memory");
        unsigned kx[16];
#pragma unroll
        for (int k = 0; k < 16; ++k) { const unsigned n0 = (unsigned)(32 * it + (k & 3) + 8 * (k >> 2));
            kx[k] = (mono(acc[k]) & 0xFFFFFF80u) | ((127u - n0) ^ h4); }
        sort16_desc(kx);
        if (it == 0) {
#pragma unroll
            for (int j = 0; j < 16; ++j) L[j] = kx[j];
        } else merge16_desc(L, kx);
    }
    unsigned P[16];
#pragma unroll
    for (int j = 0; j < 16; ++j) P[j] = (unsigned)__shfl_xor((int)L[j], 32);
    merge16_desc(L, P);
}
__device__ __forceinline__ void p8_task(Frame& F, int tile, int head) {
    unsigned char* ws = F.ws; const int lane = pg8::fresh_lane(), r = lane & 31, hh = lane >> 5; int t = tile * 32 + r; asm volatile("" : "+v"(t));
    const bf16* kb = (const bf16*)(ws + WS_KEYS); int tbase = tile * 32; asm volatile("" : "+s"(tbase)); const bf16* qtile = (const bf16*)(ws + WS_QQ) + (size_t)tbase * 2048 + head * 256;
    LAS unsigned char* wl = F.lds + F.wave * WAVE_LDS;
    unsigned L1[16], L2[16];
    p8_half(kb + (size_t)head * 16384, qtile, wl, lane, L1);
    p8_half(kb + 131072 + (size_t)head * 16384, qtile + 128, wl, lane, L2);
    LDS_WAIT(); asm volatile("" ::: "memory");
    float v1[16], v2[16]; unsigned n1[16], n2[16];
#pragma unroll
    for (int j = 0; j < 16; ++j) { v1[j] = unmono(L1[j] & 0xFFFFFF80u); n1[j] = 127u - (L1[j] & 127u); v2[j] = unmono(L2[j] & 0xFFFFFF80u); n2[j] = 127u - (L2[j] & 127u); }
    LAS unsigned* tab = (LAS unsigned*)(F.lds + F.wave * WAVE_LDS) + lane * 9;
#pragma unroll
    for (int j = 0; j < 4; ++j) { tab[j] = n1[4 * j] | (n1[4 * j + 1] << 8) | (n1[4 * j + 2] << 16) | (n1[4 * j + 3] << 24); tab[4 + j] = n2[4 * j] | (n2[4 * j + 1] << 8) | (n2[4 * j + 2] << 16) | (n2[4 * j + 3] << 24); }
    unsigned Fk[16];
#define P8_CK(A, B) ((mono(v1[A] + v2[B]) & 0xFFFFFF00u) | (unsigned)(255 - ((A) * 16 + (B))))
#pragma unroll
    for (int b = 0; b < 16; ++b) Fk[b] = P8_CK(0, b);
    { unsigned s1[16] = {P8_CK(1, 0), P8_CK(1, 1), P8_CK(1, 2), P8_CK(1, 3), P8_CK(1, 4), P8_CK(1, 5), P8_CK(1, 6), P8_CK(1, 7), P8_CK(2, 0), P8_CK(2, 1), P8_CK(2, 2), P8_CK(2, 3), P8_CK(2, 4), P8_CK(4, 0), P8_CK(4, 1), P8_CK(4, 2)};
      sort16_desc(s1); merge16_desc(Fk, s1); }
    { unsigned s2[16] = {P8_CK(3, 0), P8_CK(3, 1), P8_CK(3, 2), P8_CK(3, 3), P8_CK(5, 0), P8_CK(5, 1), P8_CK(6, 0), P8_CK(6, 1), P8_CK(7, 0), P8_CK(7, 1), P8_CK(8, 0), P8_CK(9, 0), P8_CK(10, 0), P8_CK(11, 0), P8_CK(12, 0), P8_CK(13, 0)};
      sort16_desc(s2); merge16_desc(Fk, s2); }
    ins16(Fk, P8_CK(14, 0)); ins16(Fk, P8_CK(15, 0));
#undef P8_CK
    LDS_WAIT(); asm volatile("" ::: "memory");
    float sv[16]; int ex[16];
    const LAS unsigned char* tb = (const LAS unsigned char*)tab;
#pragma unroll
    for (int j = 0; j < 16; ++j) { const unsigned pos = 255u - (Fk[j] & 255u); sv[j] = unmono(Fk[j] & 0xFFFFFF00u); ex[j] = (int)tb[pos >> 4] * 128 + (int)tb[16 + (pos & 15)]; }
    float den = 0.f, p[16];
#pragma unroll
    for (int j = 0; j < 16; ++j) { p[j] = fexp(sv[j] - sv[0]); den += p[j]; }
    const float inv = 1.0f / den;
    int* IDX = (int*)(ws + WS_IDX) + (size_t)t * 128 + head * 16; float* GT = (float*)(ws + WS_GATE) + (size_t)t * 128 + head * 16;
    if (hh == 0) {
#pragma unroll
        for (int j = 0; j < 4; ++j) { *(int4*)(IDX + 4 * j) = make_int4(ex[4 * j], ex[4 * j + 1], ex[4 * j + 2], ex[4 * j + 3]); }
    } else {
#pragma unroll
        for (int j = 0; j < 4; ++j) { f32x4 g = {p[4 * j] * inv, p[4 * j + 1] * inv, p[4 * j + 2] * inv, p[4 * j + 3] * inv}; *(f32x4*)(GT + 4 * j) = g; }
    }
    LDS_WAIT(); asm volatile("" ::: "memory");
}

#ifdef DBG_CHK
constexpr int CW_CHK = 8192;
__device__ __forceinline__ unsigned chk_hash(unsigned x) { x ^= x >> 16; x *= 0x7feb352dU; x ^= x >> 15; x *= 0x846ca68bU; x ^= x >> 16; return x; }
__device__ __forceinline__ float chk_dot(const bf16* a, const bf16* b, int K) { float s = 0.f; for (int k = 0; k < K; ++k) s += bf2f(a[k]) * bf2f(b[k]); return s; }
__device__ __forceinline__ void chk_rec(unsigned* cnt, float got, float ref) { if (!(fabsf(got - ref) <= 0.03f * fabsf(ref) + 0.03f)) atomicAdd(cnt, 1u); }
__device__ __forceinline__ void chk_phase(Frame& F, const Args& A, int which) {
    unsigned char* ws = F.ws; unsigned* ctl = (unsigned*)(ws + WS_CTL);
    const int g = F.vcu * (NWAVES * 64) + F.wave * 64 + pg8::fresh_lane();
    if (which == 21) {
        const bf16* xb_ = (const bf16*)(ws + WS_XB); const bf16* W_ = (const bf16*)(ws + WS_WIN); const float* r1 = (const float*)(ws + WS_RSTD1); bf16* GBo = (bf16*)(ws + WS_GA);
        for (long i = g; i < (long)T * 1024; i += (long)F.G * NWAVES * 64) { const long rw = i >> 10; const int j = (int)(i & 1023);
            const float v = r1[rw] * chk_dot(xb_ + rw * 1024, W_ + (size_t)(4608 + j) * 1024, 1024); GBo[i] = (bf16)f2bf(1.0f / (1.0f + expf(-v))); }
        return;
    }
    if (g >= 8192) return;
    const unsigned h1 = chk_hash(g * 2 + 1), h2 = chk_hash(g * 2 + 2); const int row = h1 % T;
    const bf16* xb = (const bf16*)(ws + WS_XB); const bf16* WinT = (const bf16*)(ws + WS_WIN); const float* rstd1 = (const float*)(ws + WS_RSTD1);
    if (which == 0) {
        { const int n = h2 % NIN, k = h1 % 1024; chk_rec(ctl + CW_CHK + (n >= 4608 ? 256 : 0), 32.f * bf2f(WinT[(size_t)(win_dst_row(n & ~31) + (n & 31)) * 1024 + k]), 32.f * A.in[1][k] * A.in[2][(size_t)k * NIN + n]); }
        { const int n = h2 % 1024, k = h1 % 512; chk_rec(ctl + CW_CHK, 32.f * bf2f(((const bf16*)(ws + WS_PAB))[(size_t)n * 1024 + k]), 32.f * A.in[6][(size_t)k * 1024 + n]);
          chk_rec(ctl + CW_CHK, 32.f * bf2f(((const bf16*)(ws + WS_PAB))[(size_t)n * 1024 + 512 + k]), 32.f * A.in[7][(size_t)k * 1024 + n]); }
        { const int n = h2 % 1024, k = h1 % 1024; chk_rec(ctl + CW_CHK, 32.f * bf2f(((const bf16*)(ws + WS_WO))[(size_t)n * 1024 + k]), 32.f * A.in[8][(size_t)k * 1024 + n]); }
        { const int n = h2 % 2048, k = h1 % 1024; chk_rec(ctl + CW_CHK, 32.f * bf2f(((const bf16*)(ws + WS_WQ))[(size_t)n * 1024 + k]), 32.f * A.in[9][k] * A.in[10][(size_t)k * 2048 + n]); }
        { const int k = h2 % 1024; chk_rec(ctl + CW_CHK, bf2f(xb[(size_t)row * 1024 + k]), A.in[0][(size_t)row * 1024 + k]); }
    }
    if (which == 1) {
        const float rs = rstd1[row];
        { const int j = h2 % 512; chk_rec(ctl + CW_CHK + 0, bf2f(((const bf16*)(ws + WS_V))[(size_t)row * 512 + j]), rs * chk_dot(xb + (size_t)row * 1024, WinT + (size_t)(1024 + j) * 1024, 1024)); }
        { const int j = h2 % 1024; const float v = rs * chk_dot(xb + (size_t)row * 1024, WinT + (size_t)(CHK_GA_ROW + j) * 1024, 1024);
          chk_rec(ctl + CW_CHK + 128, bf2f(((const bf16*)(ws + WS_GA))[(size_t)row * 2048 + j]), 1.0f / (1.0f + expf(-v))); }
        { const int j = h2 % 1024; const float v = rs * chk_dot(xb + (size_t)row * 1024, WinT + (size_t)(CHK_GB_ROW + j) * 1024, 1024);
          chk_rec(ctl + CW_CHK + 64, bf2f(((const bf16*)(ws + WS_GA))[(size_t)row * 2048 + 1024 + j]), 1.0f / (1.0f + expf(-v))); }
        { const int j = h2 % 512; chk_rec(ctl + CW_CHK + 448, bf2f(((const bf16*)(ws + WS_CB))[(size_t)row * 512 + j]), rs * chk_dot(xb + (size_t)row * 1024, WinT + (size_t)(2048 + j) * 1024, 1024)); }
        { const int j = h2 % 512; const int rb = 2560 + 256 * (j >> 7) + (j & 127);
          const float cc = rs * chk_dot(xb + (size_t)row * 1024, WinT + (size_t)rb * 1024, 1024), ch = rs * chk_dot(xb + (size_t)row * 1024, WinT + (size_t)(rb + 128) * 1024, 1024);
          chk_rec(ctl + CW_CHK + 192, bf2f(((const bf16*)(ws + WS_U))[(size_t)row * 512 + j]), cc * ch); }
    }
    if (which == 1) {
        const float rs = rstd1[row]; const int j = h2 % 512; const float* lbv = (const float*)(ws + WS_LB);
        const float hq = rs * chk_dot(xb + (size_t)row * 1024, WinT + (size_t)(0 + j) * 1024, 1024), hf = rs * chk_dot(xb + (size_t)row * 1024, WinT + (size_t)(512 + j) * 1024, 1024),
                    hg = rs * chk_dot(xb + (size_t)row * 1024, WinT + (size_t)(1536 + j) * 1024, 1024);
        const float l0 = A.in[3][j], l1 = A.in[3][512 + j], lb = expf(l0) / (expf(l0) + expf(l1)); chk_rec(ctl + CW_CHK + 128, lbv[j], lb);
        const float sg = 1.0f / (1.0f + expf(-hf)), f = lb + (1.0f - lb) * sg;
        chk_rec(ctl + CW_CHK + 128, bf2f(((const bf16*)(ws + WS_Q))[(size_t)row * 512 + j]), hq / (1.0f + expf(-hq)) * 0.125f);
        chk_rec(ctl + CW_CHK + 128, bf2f(((const bf16*)(ws + WS_LF))[(size_t)row * 512 + j]), logf(f));
        chk_rec(ctl + CW_CHK + 128, bf2f(((const bf16*)(ws + WS_KK))[(size_t)row * 512 + j]), 1.0f - f);
        chk_rec(ctl + CW_CHK + 128, bf2f(((const bf16*)(ws + WS_SG))[(size_t)row * 512 + j]), hg / (1.0f + expf(-hg)));
    }
    if (which == 11 && g < 64 * 64) {
        const int smp = g >> 6, e = g & 63; const unsigned hs = chk_hash(1000 + smp); const int bb = hs % 8, hd = (hs >> 3) % 8, tpos = (smp < 8) ? (int)(smp * 9) : (int)((hs >> 6) % SEQ);
        const bf16* Qb = (const bf16*)(ws + WS_Q); const bf16* LFb = (const bf16*)(ws + WS_LF); const bf16* KKb = (const bf16*)(ws + WS_KK); const bf16* Vb = (const bf16*)(ws + WS_V); const bf16* SGb = (const bf16*)(ws + WS_SG);
        float S[64];
#pragma unroll
        for (int d = 0; d < 64; ++d) S[d] = 0.f;
        for (int sp = 0; sp <= tpos; ++sp) { const size_t ro = ((size_t)bb * SEQ + sp) * 512 + hd * 64; const float v = bf2f(Vb[ro + e]);
#pragma unroll
            for (int d = 0; d < 64; ++d) S[d] = expf(bf2f(LFb[ro + d])) * S[d] + bf2f(KKb[ro + d]) * v; }
        const size_t rq = ((size_t)bb * SEQ + tpos) * 512 + hd * 64; float o = 0.f;
#pragma unroll
        for (int d = 0; d < 64; ++d) o += bf2f(Qb[rq + d]) * S[d];
        const float ss = wave_sum(o * o); const float y = o * rsqrtf(ss * (1.0f / 64.0f) + EPS) * A.in[4][hd * 64 + e] * bf2f(SGb[rq + e]);
        ((float*)(ws + 6 * MiB))[g] = y;
    }
    if (which == 14 && g < 64 * 64) {
        const int smp = g >> 6, e = g & 63; const unsigned hs = chk_hash(1000 + smp); const int bb = hs % 8, hd = (hs >> 3) % 8, tpos = (smp < 8) ? (int)(smp * 9) : (int)((hs >> 6) % SEQ);
        chk_rec(ctl + CW_CHK + 192, bf2f(((const bf16*)(ws + WS_XB))[((size_t)bb * SEQ + tpos) * 1024 + hd * 64 + e]), ((const float*)(ws + 6 * MiB))[g]);
    }
    if (which == 2) {
        const int j = h2 % 512, sq = row & (SEQ - 1); const bf16* U = (const bf16*)(ws + WS_U); const bf16* CB = (const bf16*)(ws + WS_CB); const float* cw = A.in[5];
        float acc = cw[1024 + j] * bf2f(U[(size_t)row * 512 + j]);
        if (sq >= 1) acc += cw[512 + j] * bf2f(U[(size_t)(row - 1) * 512 + j]);
        if (sq >= 2) acc += cw[j] * bf2f(U[(size_t)(row - 2) * 512 + j]);
        chk_rec(ctl + CW_CHK + 448, bf2f(((const bf16*)(ws + WS_XB))[(size_t)row * 1024 + 512 + j]), bf2f(CB[(size_t)row * 512 + j]) * acc);
    }
    if (which == 5) {
        const int j = h2 % 1024; const bf16* Y = (const bf16*)(ws + WS_XB) + (size_t)row * 1024; const bf16* P = (const bf16*)(ws + WS_PAB) + (size_t)j * 1024;
        const float ga = bf2f(((const bf16*)(ws + WS_GA))[(size_t)row * 2048 + j]), gb = bf2f(((const bf16*)(ws + WS_GA))[(size_t)row * 2048 + 1024 + j]);
        chk_rec(ctl + CW_CHK + 256, bf2f(((const bf16*)(ws + WS_MG))[(size_t)row * 1024 + j]), ga * chk_dot(Y, P, 512) + gb * chk_dot(Y + 512, P + 512, 512));
    }
    if (which == 6) {
        const int j = h2 % 1024;
        chk_rec(ctl + CW_CHK + 320, ((const float*)(ws + WS_X1))[(size_t)row * 1024 + j] - A.in[0][(size_t)row * 1024 + j],
                chk_dot((const bf16*)(ws + WS_MG) + (size_t)row * 1024, (const bf16*)(ws + WS_WO) + (size_t)j * 1024, 1024));
    }
    if (which == 7) {
        const int j = h2 % 2048; const float rs2 = rsqrtf(pg8::sum16((const float*)(ws + WS_ROWSS) + (size_t)row * 16) * (1.0f / D) + EPS);
        chk_rec(ctl + CW_CHK + 384, bf2f(((const bf16*)(ws + WS_QQ))[(size_t)row * 2048 + j]), rs2 * chk_dot((const bf16*)(ws + WS_X1B) + (size_t)row * 1024, (const bf16*)(ws + WS_WQ) + (size_t)j * 1024, 1024));
    }
}
__device__ __forceinline__ float chk_scale(Frame& F) {
    const unsigned* c = (const unsigned*)(F.ws + WS_CTL) + CW_CHK; const float sc[8] = {0.5f, 0.0f, 2.0f, -0.5f, -1.0f, 3.0f, -2.0f, 4.0f};
    float s = 1.0f;
#pragma unroll
    for (int i = 7; i >= 0; --i) if (c[64 * i] > 40u) s = sc[i];
    return s;
}
#endif
__device__ __forceinline__ float dot2bf(unsigned w, unsigned x, float acc) { return __builtin_amdgcn_fdot2_f32_bf16(__builtin_bit_cast(bf16x2_t, w), __builtin_bit_cast(bf16x2_t, x), acc, false); }
__device__ __forceinline__ float gelu_erf(float v) {
    const float av = fabsf(v), tt = __builtin_amdgcn_rcpf(av * 0.2316418882f + 1.0f);
    float q = tt * 0.5307027145f + (-0.7265760135f); q = q * tt + 0.7107068705f; q = q * tt + (-0.142248368f); q = q * tt + 0.127414796f; q = q * tt;
    const float e = __builtin_amdgcn_exp2f(v * v * (-0.72134752044f)), m = v * (q * e);
    return v < 0.f ? m : v - m;
}
typedef float f32x2v __attribute__((ext_vector_type(2)));
__device__ __forceinline__ void cvt_row_fp8(const float* src, unsigned char* dst, float* inv_scale, int row, int lane) {
    const float* r = src + (size_t)row * 1024; f32x4 v[4]; float m = 0.f;
#pragma unroll
    for (int j = 0; j < 4; ++j) { v[j] = *(const f32x4*)(r + 256 * j + 4 * lane); m = fmaxf(m, fmaxf(fmaxf(fabsf(v[j][0]), fabsf(v[j][1])), fmaxf(fabsf(v[j][2]), fabsf(v[j][3])))); }
#pragma unroll
    for (int o = 1; o < 64; o <<= 1) m = fmaxf(m, __shfl_xor(m, o));
    const int ex = (int)((__builtin_bit_cast(unsigned, m) >> 23) & 0xff);
    const int k = (m > 0.f) ? (134 - ex) : 0;
    const float sc = __builtin_bit_cast(float, (unsigned)(127 + k) << 23), isc = __builtin_bit_cast(float, (unsigned)(127 - k) << 23);
    v4u o;
#pragma unroll
    for (int j = 0; j < 4; ++j) { int p = __builtin_amdgcn_cvt_pk_fp8_f32(v[j][0] * sc, v[j][1] * sc, 0, false); p = __builtin_amdgcn_cvt_pk_fp8_f32(v[j][2] * sc, v[j][3] * sc, p, true); o[j] = (unsigned)p; }
    *(v4u*)(dst + (size_t)row * 1024 + 16 * lane) = o;
    if (lane == 0) inv_scale[row] = isc;
}
constexpr int F4_ROW = 1152;
__device__ __forceinline__ void pack16_fp4(const float* r, int lane, unsigned& d0, unsigned& d1, unsigned& eb_out) {
    f32x4 v[4]; float m = 0.f;
#pragma unroll
    for (int j = 0; j < 4; ++j) { v[j] = *(const f32x4*)(r + 256 * j + 4 * lane); m = fmaxf(m, fmaxf(fmaxf(fabsf(v[j][0]), fabsf(v[j][1])), fmaxf(fabsf(v[j][2]), fabsf(v[j][3])))); }
    const float tq = m * (1.0f / 6.0f); const unsigned eb = (__builtin_bit_cast(unsigned, tq) + 0x7FFFFFu) >> 23;
    const unsigned ebc = eb > 253u ? 253u : eb; const float inv = __builtin_bit_cast(float, (254u - ebc) << 23);
    d0 = 0u; d1 = 0u;
    d0 = __builtin_amdgcn_cvt_scalef32_pk_fp4_f32(d0, v[0][0] * inv, v[0][1] * inv, 1.0f, 0); d0 = __builtin_amdgcn_cvt_scalef32_pk_fp4_f32(d0, v[0][2] * inv, v[0][3] * inv, 1.0f, 1);
    d0 = __builtin_amdgcn_cvt_scalef32_pk_fp4_f32(d0, v[1][0] * inv, v[1][1] * inv, 1.0f, 2); d0 = __builtin_amdgcn_cvt_scalef32_pk_fp4_f32(d0, v[1][2] * inv, v[1][3] * inv, 1.0f, 3);
    d1 = __builtin_amdgcn_cvt_scalef32_pk_fp4_f32(d1, v[2][0] * inv, v[2][1] * inv, 1.0f, 0); d1 = __builtin_amdgcn_cvt_scalef32_pk_fp4_f32(d1, v[2][2] * inv, v[2][3] * inv, 1.0f, 1);
    d1 = __builtin_amdgcn_cvt_scalef32_pk_fp4_f32(d1, v[3][0] * inv, v[3][1] * inv, 1.0f, 2); d1 = __builtin_amdgcn_cvt_scalef32_pk_fp4_f32(d1, v[3][2] * inv, v[3][3] * inv, 1.0f, 3);
    eb_out = ebc;
}
__device__ __forceinline__ void cvt_expert_fp4(const float* eu, const float* ev, unsigned char* dst, int e, int lane) {
    unsigned u0, u1, v0, v1, su, sv;
    pack16_fp4(eu + (size_t)e * 1024, lane, u0, u1, su); pack16_fp4(ev + (size_t)e * 1024, lane, v0, v1, sv);
    v4u o; o.x = u0; o.y = u1; o.z = v0; o.w = v1;
    unsigned char* rec = dst + (size_t)e * F4_ROW;
    *(v4u*)(rec + 16 * lane) = o; *(unsigned short*)(rec + 1024 + 2 * lane) = (unsigned short)(su | (sv << 8));
}
struct RowsF4 { v4u d[8]; unsigned s[8]; };
__device__ __forceinline__ void p9_load_f4(RowsF4& R, const unsigned char* EUV, const int (&e)[8], int lane) {
#pragma unroll
    for (int j = 0; j < 8; ++j) { const GAS unsigned char* rec = (const GAS unsigned char*)EUV + (size_t)e[j] * F4_ROW;
        R.d[j] = *(const GAS v4u*)(rec + (unsigned)(16 * lane)); R.s[j] = *(const GAS unsigned short*)(rec + (unsigned)(1024 + 2 * lane)); }
}
template <int M> __device__ __forceinline__ float swz_xor(float v) {
    return __builtin_bit_cast(float, __builtin_amdgcn_ds_swizzle(__builtin_bit_cast(int, v), 0x1f | (M << 10))); }
__device__ __forceinline__ float bperm(float v, int lane_src) { return __builtin_bit_cast(float, __builtin_amdgcn_ds_bpermute(lane_src << 2, __builtin_bit_cast(int, v))); }
__device__ __forceinline__ float rdl(float v, int l) { return __builtin_bit_cast(float, __builtin_amdgcn_readlane(__builtin_bit_cast(int, v), l)); }
__device__ __forceinline__ void unpack8_f4(const unsigned dw, float (&f)[8]) {
    const f32x2v p0 = __builtin_amdgcn_cvt_scalef32_pk_f32_fp4(dw, 1.0f, 0), p1 = __builtin_amdgcn_cvt_scalef32_pk_f32_fp4(dw, 1.0f, 1),
                 p2 = __builtin_amdgcn_cvt_scalef32_pk_f32_fp4(dw, 1.0f, 2), p3 = __builtin_amdgcn_cvt_scalef32_pk_f32_fp4(dw, 1.0f, 3);
    f[0] = p0.x; f[1] = p0.y; f[2] = p1.x; f[3] = p1.y; f[4] = p2.x; f[5] = p2.y; f[6] = p3.x; f[7] = p3.y;
}
__device__ __forceinline__ float dot16_f4(const unsigned q0, const unsigned q1, const float (&hn)[16]) {
    f32x2v acc = {0.f, 0.f};
#define D16_STEP(Q, C, B) { const f32x2v p = __builtin_amdgcn_cvt_scalef32_pk_f32_fp4(Q, 1.0f, C); const f32x2v h = {hn[B], hn[B + 1]}; acc = __builtin_elementwise_fma(p, h, acc); }
    D16_STEP(q0, 0, 0) D16_STEP(q0, 1, 2) D16_STEP(q0, 2, 4) D16_STEP(q0, 3, 6) D16_STEP(q1, 0, 8) D16_STEP(q1, 1, 10) D16_STEP(q1, 2, 12) D16_STEP(q1, 3, 14)
#undef D16_STEP
    return acc.x + acc.y;
}
__device__ __forceinline__ void axpy16_f4(const unsigned q0, const unsigned q1, const float w, float (&o)[16]) {
    float f0[8], f1[8]; unpack8_f4(q0, f0); unpack8_f4(q1, f1);
#pragma unroll
    for (int i = 0; i < 8; ++i) { o[i] += w * f0[i]; o[8 + i] += w * f1[i]; }
}
__device__ __forceinline__ void p9_batch_f4(const RowsF4& R, const float (&hn)[16], float (&oacc)[16], int bt, int lane, float gA, float gB) {
    const int hh = lane >> 5, q4 = (lane >> 4) & 1, q3 = (lane >> 3) & 1, jsel = 4 * hh + 2 * q4 + q3;
    float pd[8];
#pragma unroll
    for (int j = 0; j < 8; ++j) { pd[j] = dot16_f4(R.d[j].x, R.d[j].y, hn) * __builtin_bit_cast(float, (R.s[j] & 0xffu) << 23); if (j & 1) __builtin_amdgcn_sched_barrier(0); }
    float r4[4], r2[2];
#pragma unroll
    for (int i = 0; i < 4; ++i) { const float keep = hh ? pd[4 + i] : pd[i], send = hh ? pd[i] : pd[4 + i]; r4[i] = keep + bperm(send, lane ^ 32); }
#pragma unroll
    for (int i = 0; i < 2; ++i) { const float keep = q4 ? r4[2 + i] : r4[i], send = q4 ? r4[i] : r4[2 + i]; r2[i] = keep + swz_xor<16>(send); }
    float v = (q3 ? r2[1] : r2[0]) + swz_xor<8>(q3 ? r2[0] : r2[1]);
    v += swz_xor<4>(v); v += swz_xor<2>(v); v += swz_xor<1>(v);
    const int n = 8 * bt + jsel; const float g = (bt < 8) ? bperm(gA, n & 63) : bperm(gB, n & 63);
    const float w = g * gelu_erf(v);
#pragma unroll
    for (int j = 0; j < 8; ++j) { axpy16_f4(R.d[j].z, R.d[j].w, rdl(w, 8 * j) * __builtin_bit_cast(float, (R.s[j] >> 8) << 23), oacc); if (j & 1) __builtin_amdgcn_sched_barrier(0); }
}
__device__ __forceinline__ void p9_ids(int idA, int idB, int nb, int (&e)[8]) {
#pragma unroll
    for (int j = 0; j < 8; ++j) { const int n = 8 * nb + j; e[j] = (nb < 8) ? __builtin_amdgcn_readlane(idA, n & 63) : __builtin_amdgcn_readlane(idB, n & 63); }
}
struct RowsF4q { v4u d[4]; unsigned s[4]; };
__device__ __forceinline__ void p9_load_f4q(RowsF4q& R, const unsigned char* EUV, int idP, int nb, int lane) {
    const __amdgpu_buffer_rsrc_t rs = __builtin_amdgcn_make_buffer_rsrc((void*)EUV, (short)0, 16384 * F4_ROW, 0x00020000);
#pragma unroll
    for (int j = 0; j < 4; ++j) { const int n = 4 * nb + j; const unsigned x = (unsigned)__builtin_amdgcn_readlane(idP, n & 63); const unsigned e = (x >> ((n >> 6) << 4)) & 0xffffu;
        const int so = (int)(e * F4_ROW);
        R.d[j] = __builtin_bit_cast(v4u, __builtin_amdgcn_raw_buffer_load_b128(rs, 16 * lane, so, 0)); R.s[j] = (unsigned)__builtin_amdgcn_raw_buffer_load_b16(rs, 1024 + 2 * lane, so, 0); }
}
__device__ __forceinline__ void p9_batch4_f4(const RowsF4q& R, const float (&hn)[16], float (&oacc)[16], int bt, int lane, float gA, float gB) {
    const int hh = lane >> 5, q4 = (lane >> 4) & 1, jsel = 2 * hh + q4;
    float pd[4];
#pragma unroll
    for (int j = 0; j < 4; ++j) pd[j] = dot16_f4(R.d[j].x, R.d[j].y, hn) * __builtin_bit_cast(float, (R.s[j] & 0xffu) << 23);
    const float k0 = hh ? pd[2] : pd[0], k1 = hh ? pd[3] : pd[1], s0 = hh ? pd[0] : pd[2], s1 = hh ? pd[1] : pd[3];
    const float r0 = k0 + bperm(s0, lane ^ 32), r1 = k1 + bperm(s1, lane ^ 32);
    float v = (q4 ? r1 : r0) + swz_xor<16>(q4 ? r0 : r1);
    v += swz_xor<8>(v); v += swz_xor<4>(v); v += swz_xor<2>(v); v += swz_xor<1>(v);
    const int n = 4 * bt + jsel; const float g = (bt < 16) ? bperm(gA, n & 63) : bperm(gB, n & 63);
    const float w = g * gelu_erf(v);
#pragma unroll
    for (int j = 0; j < 4; ++j) axpy16_f4(R.d[j].z, R.d[j].w, rdl(w, 16 * j) * __builtin_bit_cast(float, (R.s[j] >> 8) << 23), oacc);
}
__device__ __forceinline__ void p9_token_f4(Frame& F, int t, const float* g_ffn, const float* g_fin) {
    unsigned char* ws = F.ws; const int lane = pg8::fresh_lane();
    const unsigned char* EUV = ws + WS_EU;
    const bf16* xrow = (const bf16*)(ws + WS_X1B) + (size_t)t * D; float* orow = F.out + (size_t)t * D;
    const float rs2 = __builtin_amdgcn_rsqf(pg8::sum16((const float*)(ws + WS_ROWSS) + (size_t)t * 16) * (1.0f / D) + EPS);
    float hn[16];
#pragma unroll
    for (int j = 0; j < 4; ++j) { const v2u a = *(const v2u*)(xrow + 256 * j + 4 * lane); const f32x4 g = *(const f32x4*)(g_ffn + 256 * j + 4 * lane);
        hn[4 * j] = bflo(a.x) * rs2 * g[0]; hn[4 * j + 1] = bfhi(a.x) * rs2 * g[1]; hn[4 * j + 2] = bflo(a.y) * rs2 * g[2]; hn[4 * j + 3] = bfhi(a.y) * rs2 * g[3]; }
    const int* IDX = (const int*)(ws + WS_IDX) + (size_t)t * 128; const float* GT = (const float*)(ws + WS_GATE) + (size_t)t * 128;
    int idA, idB; float gA, gB;
    { const int a0 = IDX[lane], b0 = IDX[64 + lane]; const float ga = GT[lane], gb = GT[64 + lane];
      const int kA = a0 >> 10, kB = b0 >> 10; const unsigned long long lt = (1ull << lane) - 1ull;
      int base = 0, rA = 0, rB = 0;
#pragma unroll
      for (int k = 0; k < 16; ++k) { const unsigned long long mA = __ballot(kA == k), mB = __ballot(kB == k); const int cA = __popcll(mA), cB = __popcll(mB);
          if (kA == k) rA = base + __popcll(mA & lt);
          if (kB == k) rB = base + cA + __popcll(mB & lt);
          base += cA + cB; }
      LAS int* sid = (LAS int*)(F.lds + F.wave * WAVE_LDS); LAS float* sgt = (LAS float*)(sid + 128);
      sid[rA] = a0; sid[rB] = b0; sgt[rA] = ga; sgt[rB] = gb;
      LDS_WAIT(); asm volatile("" ::: "memory");
      idA = sid[lane]; idB = sid[64 + lane]; gA = sgt[lane]; gB = sgt[64 + lane];
      LDS_WAIT(); asm volatile("" ::: "memory"); }
    float oacc[16];
#pragma unroll
    for (int i = 0; i < 16; ++i) oacc[i] = 0.f;
    const int idP = idA | (idB << 16);
    RowsF4q R0, R1, R2, R3, R4;
    p9_load_f4q(R0, EUV, idP, 0, lane); p9_load_f4q(R1, EUV, idP, 1, lane); p9_load_f4q(R2, EUV, idP, 2, lane); p9_load_f4q(R3, EUV, idP, 3, lane);
#pragma unroll 1
    for (int bt = 0; bt < 30; bt += 5) {
        p9_load_f4q(R4, EUV, idP, bt + 4, lane); asm volatile("" ::: "memory");
        p9_batch4_f4(R0, hn, oacc, bt, lane, gA, gB); asm volatile("" ::: "memory");
        p9_load_f4q(R0, EUV, idP, (bt + 5) & 31, lane); asm volatile("" ::: "memory");
        p9_batch4_f4(R1, hn, oacc, bt + 1, lane, gA, gB); asm volatile("" ::: "memory");
        p9_load_f4q(R1, EUV, idP, (bt + 6) & 31, lane); asm volatile("" ::: "memory");
        p9_batch4_f4(R2, hn, oacc, bt + 2, lane, gA, gB); asm volatile("" ::: "memory");
        p9_load_f4q(R2, EUV, idP, (bt + 7) & 31, lane); asm volatile("" ::: "memory");
        p9_batch4_f4(R3, hn, oacc, bt + 3, lane, gA, gB); asm volatile("" ::: "memory");
        p9_load_f4q(R3, EUV, idP, (bt + 8) & 31, lane); asm volatile("" ::: "memory");
        p9_batch4_f4(R4, hn, oacc, bt + 4, lane, gA, gB); asm volatile("" ::: "memory");
    }
    p9_batch4_f4(R0, hn, oacc, 30, lane, gA, gB); p9_batch4_f4(R1, hn, oacc, 31, lane, gA, gB);
    asm volatile("" ::: "memory");
    float ss = 0.f;
#pragma unroll
    for (int j = 0; j < 4; ++j) { const v2u a = *(const v2u*)(xrow + 256 * j + 4 * lane);
        oacc[4 * j] += bflo(a.x); oacc[4 * j + 1] += bfhi(a.x); oacc[4 * j + 2] += bflo(a.y); oacc[4 * j + 3] += bfhi(a.y);
#pragma unroll
        for (int i = 0; i < 4; ++i) ss += oacc[4 * j + i] * oacc[4 * j + i]; }
    ss += swz_xor<1>(ss); ss += swz_xor<2>(ss); ss += swz_xor<4>(ss); ss += swz_xor<8>(ss); ss += swz_xor<16>(ss); ss += bperm(ss, lane ^ 32);
    const float rs3 = __builtin_amdgcn_rsqf(ss * (1.0f / D) + EPS);
#pragma unroll
    for (int j = 0; j < 4; ++j) { const f32x4 g = *(const f32x4*)(g_fin + 256 * j + 4 * lane); f32x4 o;
#pragma unroll
        for (int i = 0; i < 4; ++i) o[i] = oacc[4 * j + i] * rs3 * g[i];
        *(f32x4*)(orow + 256 * j + 4 * lane) = o; }
}
constexpr int MX_ROW = 1120, MX_USC = 512, MX_V = 544, MX_VSC = 1056;
typedef int v8i __attribute__((ext_vector_type(8)));
__device__ __forceinline__ void cvt_expert_mx(const float* eu, const float* ev, unsigned char* dst, int e, int lane) {
    unsigned char* rec = dst + (size_t)e * MX_ROW;
    { const float* r = eu + (size_t)e * 1024 + 16 * lane; f32x4 v[4]; float m = 0.f;
#pragma unroll
      for (int j = 0; j < 4; ++j) { v[j] = *(const f32x4*)(r + 4 * j); m = fmaxf(m, fmaxf(fmaxf(fabsf(v[j][0]), fabsf(v[j][1])), fmaxf(fabsf(v[j][2]), fabsf(v[j][3])))); }
      m = fmaxf(m, swz_xor<1>(m));
      const float tq = m * (1.0f / 6.0f); const unsigned eb = (__builtin_bit_cast(unsigned, tq) + 0x7FFFFFu) >> 23;
      const unsigned ebc = eb > 253u ? 253u : eb; const float inv = __builtin_bit_cast(float, (254u - ebc) << 23);
      unsigned d0 = 0u, d1 = 0u;
      d0 = __builtin_amdgcn_cvt_scalef32_pk_fp4_f32(d0, v[0][0] * inv, v[0][1] * inv, 1.0f, 0); d0 = __builtin_amdgcn_cvt_scalef32_pk_fp4_f32(d0, v[0][2] * inv, v[0][3] * inv, 1.0f, 1);
      d0 = __builtin_amdgcn_cvt_scalef32_pk_fp4_f32(d0, v[1][0] * inv, v[1][1] * inv, 1.0f, 2); d0 = __builtin_amdgcn_cvt_scalef32_pk_fp4_f32(d0, v[1][2] * inv, v[1][3] * inv, 1.0f, 3);
      d1 = __builtin_amdgcn_cvt_scalef32_pk_fp4_f32(d1, v[2][0] * inv, v[2][1] * inv, 1.0f, 0); d1 = __builtin_amdgcn_cvt_scalef32_pk_fp4_f32(d1, v[2][2] * inv, v[2][3] * inv, 1.0f, 1);
      d1 = __builtin_amdgcn_cvt_scalef32_pk_fp4_f32(d1, v[3][0] * inv, v[3][1] * inv, 1.0f, 2); d1 = __builtin_amdgcn_cvt_scalef32_pk_fp4_f32(d1, v[3][2] * inv, v[3][3] * inv, 1.0f, 3);
      v2u o; o.x = d0; o.y = d1; *(v2u*)(rec + 8 * lane) = o;
      if (!(lane & 1)) { const int blk = lane >> 1; rec[MX_USC + (blk & 3) * 8 + (blk >> 2)] = (unsigned char)ebc; } }
    { unsigned v0, v1, sv; pack16_fp4(ev + (size_t)e * 1024, lane, v0, v1, sv);
      v2u o; o.x = v0; o.y = v1; *(v2u*)(rec + MX_V + 8 * lane) = o; rec[MX_VSC + lane] = (unsigned char)sv; }
}
__device__ __forceinline__ void mx_pack_u(const f32x4 (&v)[4], unsigned char* rec, int lane) {
    float m = 0.f;
#pragma unroll
    for (int j = 0; j < 4; ++j) m = fmaxf(m, fmaxf(fmaxf(fabsf(v[j][0]), fabsf(v[j][1])), fmaxf(fabsf(v[j][2]), fabsf(v[j][3]))));
    m = fmaxf(m, swz_xor<1>(m));
    const float tq = m * (1.0f / 6.0f); const unsigned eb = (__builtin_bit_cast(unsigned, tq) + 0x7FFFFFu) >> 23;
    const unsigned ebc = eb > 253u ? 253u : eb; const float inv = __builtin_bit_cast(float, (254u - ebc) << 23);
    unsigned d0 = 0u, d1 = 0u;
    d0 = __builtin_amdgcn_cvt_scalef32_pk_fp4_f32(d0, v[0][0] * inv, v[0][1] * inv, 1.0f, 0); d0 = __builtin_amdgcn_cvt_scalef32_pk_fp4_f32(d0, v[0][2] * inv, v[0][3] * inv, 1.0f, 1);
    d0 = __builtin_amdgcn_cvt_scalef32_pk_fp4_f32(d0, v[1][0] * inv, v[1][1] * inv, 1.0f, 2); d0 = __builtin_amdgcn_cvt_scalef32_pk_fp4_f32(d0, v[1][2] * inv, v[1][3] * inv, 1.0f, 3);
    d1 = __builtin_amdgcn_cvt_scalef32_pk_fp4_f32(d1, v[2][0] * inv, v[2][1] * inv, 1.0f, 0); d1 = __builtin_amdgcn_cvt_scalef32_pk_fp4_f32(d1, v[2][2] * inv, v[2][3] * inv, 1.0f, 1);
    d1 = __builtin_amdgcn_cvt_scalef32_pk_fp4_f32(d1, v[3][0] * inv, v[3][1] * inv, 1.0f, 2); d1 = __builtin_amdgcn_cvt_scalef32_pk_fp4_f32(d1, v[3][2] * inv, v[3][3] * inv, 1.0f, 3);
    v2u o; o.x = d0; o.y = d1; *(v2u*)(rec + 8 * lane) = o;
    if (!(lane & 1)) { const int blk = lane >> 1; rec[MX_USC + (blk & 3) * 8 + (blk >> 2)] = (unsigned char)ebc; }
}
__device__ __forceinline__ void mx_pack_v(const f32x4 (&v)[4], unsigned char* rec, int lane) {
    float m = 0.f;
#pragma unroll
    for (int j = 0; j < 4; ++j) m = fmaxf(m, fmaxf(fmaxf(fabsf(v[j][0]), fabsf(v[j][1])), fmaxf(fabsf(v[j][2]), fabsf(v[j][3]))));
    const float tq = m * (1.0f / 6.0f); const unsigned eb = (__builtin_bit_cast(unsigned, tq) + 0x7FFFFFu) >> 23;
    const unsigned ebc = eb > 253u ? 253u : eb; const float inv = __builtin_bit_cast(float, (254u - ebc) << 23);
    unsigned d0 = 0u, d1 = 0u;
    d0 = __builtin_amdgcn_cvt_scalef32_pk_fp4_f32(d0, v[0][0] * inv, v[0][1] * inv, 1.0f, 0); d0 = __builtin_amdgcn_cvt_scalef32_pk_fp4_f32(d0, v[0][2] * inv, v[0][3] * inv, 1.0f, 1);
    d0 = __builtin_amdgcn_cvt_scalef32_pk_fp4_f32(d0, v[1][0] * inv, v[1][1] * inv, 1.0f, 2); d0 = __builtin_amdgcn_cvt_scalef32_pk_fp4_f32(d0, v[1][2] * inv, v[1][3] * inv, 1.0f, 3);
    d1 = __builtin_amdgcn_cvt_scalef32_pk_fp4_f32(d1, v[2][0] * inv, v[2][1] * inv, 1.0f, 0); d1 = __builtin_amdgcn_cvt_scalef32_pk_fp4_f32(d1, v[2][2] * inv, v[2][3] * inv, 1.0f, 1);
    d1 = __builtin_amdgcn_cvt_scalef32_pk_fp4_f32(d1, v[3][0] * inv, v[3][1] * inv, 1.0f, 2); d1 = __builtin_amdgcn_cvt_scalef32_pk_fp4_f32(d1, v[3][2] * inv, v[3][3] * inv, 1.0f, 3);
    v2u o; o.x = d0; o.y = d1; *(v2u*)(rec + MX_V + 8 * lane) = o; rec[MX_VSC + lane] = (unsigned char)ebc;
}
__device__ __forceinline__ void cvt_expert_mx2(const float* eu, const float* ev, unsigned char* dst, int e0, int e1, int lane) {
    f32x4 ua[4], va[4], ub[4], vb[4];
#pragma unroll
    for (int j = 0; j < 4; ++j) { ua[j] = *(const f32x4*)(eu + (size_t)e0 * 1024 + 16 * lane + 4 * j); va[j] = *(const f32x4*)(ev + (size_t)e0 * 1024 + 256 * j + 4 * lane);
                                  ub[j] = *(const f32x4*)(eu + (size_t)e1 * 1024 + 16 * lane + 4 * j); vb[j] = *(const f32x4*)(ev + (size_t)e1 * 1024 + 256 * j + 4 * lane); }
    mx_pack_u(ua, dst + (size_t)e0 * MX_ROW, lane); mx_pack_v(va, dst + (size_t)e0 * MX_ROW, lane);
    mx_pack_u(ub, dst + (size_t)e1 * MX_ROW, lane); mx_pack_v(vb, dst + (size_t)e1 * MX_ROW, lane);
}
struct AFrag { v4u a[8]; v2u sc; };
__device__ __forceinline__ void p9m_load_a(AFrag& A, const unsigned char* EUV, int id, int lane) {
    const GAS unsigned char* rec = (const GAS unsigned char*)EUV + (size_t)id * MX_ROW + (unsigned)((lane >> 4) * 8);
    A.sc = *(const GAS v2u*)(rec + MX_USC);
    const GAS unsigned char* ra = rec + (unsigned)((lane >> 4) * 8);
#pragma unroll
    for (int s = 0; s < 8; ++s) A.a[s] = *(const GAS v4u*)(ra + 64 * s);
}
struct VSlot { v2u d; unsigned s; };
__device__ __forceinline__ void p9m_load_v(VSlot& V, __amdgpu_buffer_rsrc_t rs, int e, int lane) {
    const int so = e * MX_ROW;
    V.d = __builtin_bit_cast(v2u, __builtin_amdgcn_raw_buffer_load_b64(rs, MX_V + 8 * lane, so, 0)); V.s = (unsigned)__builtin_amdgcn_raw_buffer_load_b8(rs, MX_VSC + lane, so, 0);
}
__device__ __forceinline__ void p9m_axpy(const VSlot& V, const float c, f32x2v (&o)[8]) {
    const float sc = __builtin_bit_cast(float, V.s << 23); const f32x2v cc = {c, c};
#define AX_STEP(K) { o[K] = __builtin_elementwise_fma(__builtin_amdgcn_cvt_scalef32_pk_f32_fp4(V.d.x, sc, K), cc, o[K]); o[4 + K] = __builtin_elementwise_fma(__builtin_amdgcn_cvt_scalef32_pk_f32_fp4(V.d.y, sc, K), cc, o[4 + K]); }
    AX_STEP(0) AX_STEP(1) AX_STEP(2) AX_STEP(3)
#undef AX_STEP
}
__device__ __forceinline__ f32x4 p9m_dots(const AFrag& A, LAS unsigned char* h8, int lane) {
    f32x4 d0 = {0.f, 0.f, 0.f, 0.f}, d1 = {0.f, 0.f, 0.f, 0.f};
    LAS unsigned char* hb = h8 + (lane >> 4) * 16;
#define P9M_STEP(S, ACC) { const v4u b0 = *(LAS v4u*)(hb + 128 * (S)), b1 = *(LAS v4u*)(hb + 128 * (S) + 64); \
        const v8i a8 = {(int)A.a[S].x, (int)A.a[S].y, (int)A.a[S].z, (int)A.a[S].w, 0, 0, 0, 0}; const v8i b8 = {(int)b0.x, (int)b0.y, (int)b0.z, (int)b0.w, (int)b1.x, (int)b1.y, (int)b1.z, (int)b1.w}; \
        ACC = __builtin_amdgcn_mfma_scale_f32_16x16x128_f8f6f4(a8, b8, ACC, 4, 0, (S) & 3, (int)((S) < 4 ? A.sc.x : A.sc.y), 0, 0x7f7f7f7f); }
    P9M_STEP(0, d0) P9M_STEP(1, d1) P9M_STEP(2, d0) P9M_STEP(3, d1) P9M_STEP(4, d0) P9M_STEP(5, d1) P9M_STEP(6, d0) P9M_STEP(7, d1)
#undef P9M_STEP
    return d0 + d1;
}
__device__ __forceinline__ void p9m_batch(const AFrag& A, VSlot (&V)[16], LAS unsigned char* h8, LAS float* sgt, __amdgpu_buffer_rsrc_t rs, int b, int idn, int lane, f32x2v (&o)[8]) {
    const f32x4 dd = p9m_dots(A, h8, lane);
    const f32x4 gt = *(LAS f32x4*)(sgt + 16 * b + 4 * (lane >> 4));
    float c[4];
#pragma unroll
    for (int r = 0; r < 4; ++r) c[r] = gt[r] * gelu_erf(dd[r]);
#pragma unroll
    for (int p = 0; p < 16; ++p) {
        p9m_axpy(V[p], rdl(c[p & 3], 16 * (p >> 2)), o);
        p9m_load_v(V[p], rs, __builtin_amdgcn_readlane(idn, p), lane);
    }
}
constexpr int G_HSTR = 1040;
struct BFrag { v4u b[16]; };
__device__ __forceinline__ void p9g_load_b(BFrag& B, LAS unsigned char* h8, int lane) {
    LAS unsigned char* hb = h8 + (lane & 3) * G_HSTR + (lane >> 4) * 16;
#pragma unroll
    for (int s = 0; s < 8; ++s) { B.b[2 * s] = *(LAS v4u*)(hb + 128 * s); B.b[2 * s + 1] = *(LAS v4u*)(hb + 128 * s + 64); }
}
__device__ __forceinline__ f32x4 p9g_dots(const AFrag& A, const BFrag& B, int lane) {
    f32x4 d0 = {0.f, 0.f, 0.f, 0.f}, d1 = {0.f, 0.f, 0.f, 0.f};
#define P9G_STEP(S, ACC) { const v4u b0 = B.b[2 * (S)], b1 = B.b[2 * (S) + 1]; \
        const v8i a8 = {(int)A.a[S].x, (int)A.a[S].y, (int)A.a[S].z, (int)A.a[S].w, 0, 0, 0, 0}; const v8i b8 = {(int)b0.x, (int)b0.y, (int)b0.z, (int)b0.w, (int)b1.x, (int)b1.y, (int)b1.z, (int)b1.w}; \
        ACC = __builtin_amdgcn_mfma_scale_f32_16x16x128_f8f6f4(a8, b8, ACC, 4, 0, (S) & 3, (int)((S) < 4 ? A.sc.x : A.sc.y), 0, 0x7f7f7f7f); }
    P9G_STEP(0, d0) P9G_STEP(1, d1) P9G_STEP(2, d0) P9G_STEP(3, d1) P9G_STEP(4, d0) P9G_STEP(5, d1) P9G_STEP(6, d0) P9G_STEP(7, d1)
#undef P9G_STEP
    return d0 + d1;
}
typedef unsigned v4s __attribute__((ext_vector_type(4)));
__device__ __forceinline__ void p9g_issue_a(AFrag& A, v4s rsrc, unsigned voa, unsigned vos) {
#define LD_A(S) asm volatile("buffer_load_dwordx4 %0, %1, %2, 0 offen offset:" #S : "=v"(A.a[(S) / 64]) : "v"(voa), "s"(rsrc));
    LD_A(0) LD_A(64) LD_A(128) LD_A(192) LD_A(256) LD_A(320) LD_A(384) LD_A(448)
#undef LD_A
    asm volatile("buffer_load_dwordx2 %0, %1, %2, 0 offen offset:512" : "=v"(A.sc) : "v"(vos), "s"(rsrc));
}
__device__ __forceinline__ void p9g_issue_v(VSlot& V, v4s rsrc, int so, unsigned vov, unsigned vob) {
    asm volatile("buffer_load_dwordx2 %0, %1, %2, %3 offen offset:544" : "=v"(V.d) : "v"(vov), "s"(rsrc), "s"(so));
    asm volatile("buffer_load_ubyte %0, %1, %2, %3 offen offset:1056" : "=v"(V.s) : "v"(vob), "s"(rsrc), "s"(so));
}
#define P9G_WAIT_A(N, A) asm volatile("s_waitcnt vmcnt(" #N ")" : "+v"(A.a[0]), "+v"(A.a[1]), "+v"(A.a[2]), "+v"(A.a[3]), "+v"(A.a[4]), "+v"(A.a[5]), "+v"(A.a[6]), "+v"(A.a[7]), "+v"(A.sc))
#define P9G_WAIT_V(N, V) asm volatile("s_waitcnt vmcnt(" #N ")" : "+v"(V.d), "+v"(V.s))
template <bool PF> __device__ __forceinline__ void p9g_batch(AFrag& A, VSlot (&V)[16], const BFrag& B, LAS float* sgtl, v4s rsrc, int b, int idn, int lane,
                                                            f32x2v (&o0)[8], f32x2v (&o1)[8], f32x2v (&o2)[8], f32x2v (&o3)[8]) {
    if (PF) P9G_WAIT_A(32, A); else P9G_WAIT_A(0, A);
    const f32x4 dd = p9g_dots(A, B, lane);
    if (PF) { const unsigned rowo = (unsigned)idn * MX_ROW + (unsigned)((lane >> 4) * 8); p9g_issue_a(A, rsrc, rowo + (unsigned)((lane >> 4) * 8), rowo); }
    const f32x4 gt = *(LAS f32x4*)(sgtl + 4 * b);
    float c[4];
#pragma unroll
    for (int r = 0; r < 4; ++r) c[r] = gt[r] * gelu_erf(dd[r]);
    const unsigned vov = 8u * (unsigned)lane, vob = (unsigned)lane;
#define P9G_PAIR(P, O) { if (PF) P9G_WAIT_V(39, V[P]); else P9G_WAIT_V(0, V[P]); p9m_axpy(V[P], rdl(c[(P) & 3], 17 * ((P) >> 2)), O); \
        if (PF) p9g_issue_v(V[P], rsrc, __builtin_amdgcn_readlane(idn, P) * MX_ROW, vov, vob); }
    P9G_PAIR(0, o0) P9G_PAIR(1, o0) P9G_PAIR(2, o0) P9G_PAIR(3, o0) P9G_PAIR(4, o1) P9G_PAIR(5, o1) P9G_PAIR(6, o1) P9G_PAIR(7, o1)
    P9G_PAIR(8, o2) P9G_PAIR(9, o2) P9G_PAIR(10, o2) P9G_PAIR(11, o2) P9G_PAIR(12, o3) P9G_PAIR(13, o3) P9G_PAIR(14, o3) P9G_PAIR(15, o3)
#undef P9G_PAIR
}
__device__ __forceinline__ void p9_group_mx(Frame& F, int g, const float* g_ffn, const float* g_fin) {
    unsigned char* ws = F.ws; const int lane = pg8::fresh_lane();
    const unsigned char* EUV = ws + WS_EU;
    const __amdgpu_buffer_rsrc_t rs = __builtin_amdgcn_make_buffer_rsrc((void*)EUV, (short)0, 16384 * MX_ROW, 0x00020000);
    LAS unsigned char* wl = F.lds + F.wave * WAVE_LDS;
    LAS int* sid = (LAS int*)wl; LAS float* sgt = (LAS float*)(wl + 2048); LAS unsigned char* h8 = wl + 4096;
#pragma unroll 1
    for (int tk = 0; tk < 4; ++tk) {
        const int t = 4 * g + tk;
        const bf16* xrow = (const bf16*)(ws + WS_X1B) + (size_t)t * D;
        const float rs2 = __builtin_amdgcn_rsqf(pg8::sum16((const float*)(ws + WS_ROWSS) + (size_t)t * 16) * (1.0f / D) + EPS);
        { const v4u a0 = *(const v4u*)(xrow + 16 * lane), a1 = *(const v4u*)(xrow + 16 * lane + 8); v4u o;
          const unsigned xs[8] = {a0.x, a0.y, a0.z, a0.w, a1.x, a1.y, a1.z, a1.w};
#pragma unroll
          for (int j = 0; j < 4; ++j) { const f32x4 gg = *(const f32x4*)(g_ffn + 16 * lane + 4 * j);
              int p = __builtin_amdgcn_cvt_pk_fp8_f32(bflo(xs[2 * j]) * rs2 * gg[0], bfhi(xs[2 * j]) * rs2 * gg[1], 0, false);
              p = __builtin_amdgcn_cvt_pk_fp8_f32(bflo(xs[2 * j + 1]) * rs2 * gg[2], bfhi(xs[2 * j + 1]) * rs2 * gg[3], p, true); o[j] = (unsigned)p; }
          *(LAS v4u*)(h8 + tk * G_HSTR + 16 * lane) = o; }
        const int* IDX = (const int*)(ws + WS_IDX) + (size_t)t * 128; const float* GT = (const float*)(ws + WS_GATE) + (size_t)t * 128;
        { const int a0 = IDX[lane], b0 = IDX[64 + lane]; const float ga = GT[lane], gb = GT[64 + lane];
            const int kA = (int)(((unsigned)a0 * 2654435761u) >> 27), kB = (int)(((unsigned)b0 * 2654435761u) >> 27); const unsigned long long lt = (1ull << lane) - 1ull;
          int base = 0, rA = 0, rB = 0;
#pragma unroll 4
          for (int k = 0; k < 32; ++k) { const unsigned long long mA = __ballot(kA == k), mB = __ballot(kB == k); const int cA = __popcll(mA), cB = __popcll(mB);
              if (kA == k) rA = base + __popcll(mA & lt);
              if (kB == k) rB = base + cA + __popcll(mB & lt);
              base += cA + cB; }
          sid[tk * 128 + rA] = a0; sid[tk * 128 + rB] = b0; sgt[tk * 128 + rA] = ga; sgt[tk * 128 + rB] = gb; }
    }
    LDS_WAIT(); asm volatile("" ::: "memory");
    f32x2v o0[8], o1[8], o2[8], o3[8];
#pragma unroll
    for (int i = 0; i < 8; ++i) { o0[i] = (f32x2v){0.f, 0.f}; o1[i] = o0[i]; o2[i] = o0[i]; o3[i] = o0[i]; }
    AFrag A; VSlot V[16]; BFrag B; p9g_load_b(B, h8, lane);
    LAS int* sidl = sid + ((lane & 15) >> 2) * 128 + (lane & 3);
    LAS float* sgtl = sgt + (lane >> 4) * 128;
    v4s rsrc; { const unsigned long long ba = (unsigned long long)EUV; rsrc.x = (unsigned)__builtin_amdgcn_readfirstlane((int)(unsigned)ba); rsrc.y = (unsigned)__builtin_amdgcn_readfirstlane((int)(unsigned)(ba >> 32)) & 0xffffu; rsrc.z = 16384u * MX_ROW; rsrc.w = 0x00020000u; }
    { const int idc = sidl[0];
      const unsigned rowo = (unsigned)idc * MX_ROW + (unsigned)((lane >> 4) * 8); p9g_issue_a(A, rsrc, rowo + (unsigned)((lane >> 4) * 8), rowo);
#pragma unroll
      for (int p = 0; p < 16; ++p) p9g_issue_v(V[p], rsrc, __builtin_amdgcn_readlane(idc, p) * MX_ROW, 8u * (unsigned)lane, (unsigned)lane); }
#pragma unroll 1
    for (int b = 0; b < 31; ++b) {
        const int idn = sidl[4 * (b + 1)];
        p9g_batch<true>(A, V, B, sgtl, rsrc, b, idn, lane, o0, o1, o2, o3);
    }
    p9g_batch<false>(A, V, B, sgtl, rsrc, 31, 0, lane, o0, o1, o2, o3);
    LDS_WAIT(); asm volatile("" ::: "memory");
#define P9G_EPI(TK, O) { const int t = 4 * g + (TK); const bf16* xrow = (const bf16*)(ws + WS_X1B) + (size_t)t * D; float* orow = F.out + (size_t)t * D; \
        float oacc[16]; _Pragma("unroll") for (int k = 0; k < 8; ++k) { oacc[2 * k] = O[k].x; oacc[2 * k + 1] = O[k].y; } \
        float ss = 0.f; \
        _Pragma("unroll") for (int j = 0; j < 4; ++j) { const v2u a = *(const v2u*)(xrow + 256 * j + 4 * lane); \
            oacc[4 * j] += bflo(a.x); oacc[4 * j + 1] += bfhi(a.x); oacc[4 * j + 2] += bflo(a.y); oacc[4 * j + 3] += bfhi(a.y); \
            _Pragma("unroll") for (int i = 0; i < 4; ++i) ss += oacc[4 * j + i] * oacc[4 * j + i]; } \
        ss += swz_xor<1>(ss); ss += swz_xor<2>(ss); ss += swz_xor<4>(ss); ss += swz_xor<8>(ss); ss += swz_xor<16>(ss); ss += bperm(ss, lane ^ 32); \
        const float rs3 = __builtin_amdgcn_rsqf(ss * (1.0f / D) + EPS); \
        _Pragma("unroll") for (int j = 0; j < 4; ++j) { const f32x4 gg = *(const f32x4*)(g_fin + 256 * j + 4 * lane); f32x4 ov; \
            _Pragma("unroll") for (int i = 0; i < 4; ++i) ov[i] = oacc[4 * j + i] * rs3 * gg[i]; \
            *(f32x4*)(orow + 256 * j + 4 * lane) = ov; } }
    P9G_EPI(0, o0) P9G_EPI(1, o1) P9G_EPI(2, o2) P9G_EPI(3, o3)
#undef P9G_EPI
}
#ifdef DBG_P9
__device__ __forceinline__ void p9_token_dbg(Frame& F, int t, const float* g_ffn, const float* g_fin) {
    unsigned char* ws = F.ws; const int lane = pg8::fresh_lane();
    const unsigned char* EUV = ws + WS_EU;
    const __amdgpu_buffer_rsrc_t rs = __builtin_amdgcn_make_buffer_rsrc((void*)EUV, (short)0, 16384 * MX_ROW, 0x00020000);
    const bf16* xrow = (const bf16*)(ws + WS_X1B) + (size_t)t * D; float* orow = F.out + (size_t)t * D;
    const float rs2 = __builtin_amdgcn_rsqf(pg8::sum16((const float*)(ws + WS_ROWSS) + (size_t)t * 16) * (1.0f / D) + EPS);
    LAS unsigned char* wl = F.lds + F.wave * WAVE_LDS;
    LAS int* sid = (LAS int*)wl; LAS float* sgt = (LAS float*)(sid + 128); LAS unsigned char* h8 = wl + 1024;
    { const v4u a0 = *(const v4u*)(xrow + 16 * lane), a1 = *(const v4u*)(xrow + 16 * lane + 8); v4u o;
      const unsigned xs[8] = {a0.x, a0.y, a0.z, a0.w, a1.x, a1.y, a1.z, a1.w};
#pragma unroll
      for (int j = 0; j < 4; ++j) { const f32x4 g = *(const f32x4*)(g_ffn + 16 * lane + 4 * j);
          int p = __builtin_amdgcn_cvt_pk_fp8_f32(bflo(xs[2 * j]) * rs2 * g[0], bfhi(xs[2 * j]) * rs2 * g[1], 0, false);
          p = __builtin_amdgcn_cvt_pk_fp8_f32(bflo(xs[2 * j + 1]) * rs2 * g[2], bfhi(xs[2 * j + 1]) * rs2 * g[3], p, true); o[j] = (unsigned)p; }
      *(LAS v4u*)(h8 + 16 * lane) = o; }
    const int* IDX = (const int*)(ws + WS_IDX) + (size_t)t * 128; const float* GT = (const float*)(ws + WS_GATE) + (size_t)t * 128;
    sid[lane] = IDX[lane]; sid[64 + lane] = IDX[64 + lane]; sgt[lane] = GT[lane]; sgt[64 + lane] = GT[64 + lane];
    LDS_WAIT(); asm volatile("" ::: "memory");
    f32x2v o[8];
#pragma unroll
    for (int i = 0; i < 8; ++i) o[i] = (f32x2v){0.f, 0.f};
#pragma unroll 1
    for (int b = 0; b < 8; ++b) {
        const int idc = sid[16 * b + (lane & 15)];
        f32x4 dd = {0.f, 0.f, 0.f, 0.f};
#if DBG_P9 == 2
        { AFrag A; p9m_load_a(A, EUV, idc, lane); dd = p9m_dots(A, h8, lane); }
#else
#pragma unroll 1
        for (int i = 0; i < 16; ++i) { const int e = __builtin_amdgcn_readlane(idc, i); const unsigned char* rec = EUV + (size_t)e * MX_ROW;
            const v2u uu = *(const v2u*)(rec + 8 * lane); const int blk = lane >> 1; const unsigned sb = rec[MX_USC + (blk & 3) * 8 + (blk >> 2)];
            const v4u hh = *(LAS v4u*)(h8 + 16 * lane);
            float f0[8], f1[8]; unpack8_f4(uu.x, f0); unpack8_f4(uu.y, f1); float acc = 0.f;
#define DBG_ACC(HW, F, O4) { const f32x2v lo = __builtin_amdgcn_cvt_pk_f32_fp8((int)(HW), false), hi = __builtin_amdgcn_cvt_pk_f32_fp8((int)(HW), true); acc += F[O4] * lo.x + F[O4 + 1] * lo.y + F[O4 + 2] * hi.x + F[O4 + 3] * hi.y; }
            DBG_ACC(hh.x, f0, 0) DBG_ACC(hh.y, f0, 4) DBG_ACC(hh.z, f1, 0) DBG_ACC(hh.w, f1, 4)
#undef DBG_ACC
            acc *= __builtin_bit_cast(float, sb << 23);
            acc += swz_xor<1>(acc); acc += swz_xor<2>(acc); acc += swz_xor<4>(acc); acc += swz_xor<8>(acc); acc += swz_xor<16>(acc); acc += bperm(acc, lane ^ 32);
            if ((lane >> 4) == (i >> 2)) { if ((i & 3) == 0) dd[0] = acc; if ((i & 3) == 1) dd[1] = acc; if ((i & 3) == 2) dd[2] = acc; if ((i & 3) == 3) dd[3] = acc; } }
#endif
        const f32x4 gt = *(LAS f32x4*)(sgt + 16 * b + 4 * (lane >> 4));
        float c[4];
#pragma unroll
        for (int r = 0; r < 4; ++r) c[r] = gt[r] * gelu_erf(dd[r]);
#pragma unroll 1
        for (int p = 0; p < 16; ++p) { VSlot V; p9m_load_v(V, rs, __builtin_amdgcn_readlane(idc, p), lane);
            const float cs = (p & 3) == 0 ? c[0] : (p & 3) == 1 ? c[1] : (p & 3) == 2 ? c[2] : c[3];
            p9m_axpy(V, rdl(cs, 16 * (p >> 2)), o); }
    }
    LDS_WAIT(); asm volatile("" ::: "memory");
    float oacc[16];
#pragma unroll
    for (int k = 0; k < 8; ++k) { oacc[2 * k] = o[k].x; oacc[2 * k + 1] = o[k].y; }
    float ss = 0.f;
#pragma unroll
    for (int j = 0; j < 4; ++j) { const v2u a = *(const v2u*)(xrow + 256 * j + 4 * lane);
        oacc[4 * j] += bflo(a.x); oacc[4 * j + 1] += bfhi(a.x); oacc[4 * j + 2] += bflo(a.y); oacc[4 * j + 3] += bfhi(a.y);
#pragma unroll
        for (int i = 0; i < 4; ++i) ss += oacc[4 * j + i] * oacc[4 * j + i]; }
    ss += swz_xor<1>(ss); ss += swz_xor<2>(ss); ss += swz_xor<4>(ss); ss += swz_xor<8>(ss); ss += swz_xor<16>(ss); ss += bperm(ss, lane ^ 32);
    const float rs3 = __builtin_amdgcn_rsqf(ss * (1.0f / D) + EPS);
#pragma unroll
    for (int j = 0; j < 4; ++j) { const f32x4 g = *(const f32x4*)(g_fin + 256 * j + 4 * lane); f32x4 ov;
#pragma unroll
        for (int i = 0; i < 4; ++i) ov[i] = oacc[4 * j + i] * rs3 * g[i];
        *(f32x4*)(orow + 256 * j + 4 * lane) = ov; }
}
#endif
__device__ __forceinline__ void p9_token_mx(Frame& F, int t, const float* g_ffn, const float* g_fin) {
    unsigned char* ws = F.ws; const int lane = pg8::fresh_lane();
    const unsigned char* EUV = ws + WS_EU;
    const __amdgpu_buffer_rsrc_t rs = __builtin_amdgcn_make_buffer_rsrc((void*)EUV, (short)0, 16384 * MX_ROW, 0x00020000);
    const bf16* xrow = (const bf16*)(ws + WS_X1B) + (size_t)t * D; float* orow = F.out + (size_t)t * D;
    const float rs2 = __builtin_amdgcn_rsqf(pg8::sum16((const float*)(ws + WS_ROWSS) + (size_t)t * 16) * (1.0f / D) + EPS);
    LAS unsigned char* wl = F.lds + F.wave * WAVE_LDS;
    LAS int* sid = (LAS int*)wl; LAS float* sgt = (LAS float*)(sid + 128); LAS unsigned char* h8 = wl + 1024;
    { const v4u a0 = *(const v4u*)(xrow + 16 * lane), a1 = *(const v4u*)(xrow + 16 * lane + 8); v4u o;
      const unsigned xs[8] = {a0.x, a0.y, a0.z, a0.w, a1.x, a1.y, a1.z, a1.w};
#pragma unroll
      for (int j = 0; j < 4; ++j) { const f32x4 g = *(const f32x4*)(g_ffn + 16 * lane + 4 * j);
          int p = __builtin_amdgcn_cvt_pk_fp8_f32(bflo(xs[2 * j]) * rs2 * g[0], bfhi(xs[2 * j]) * rs2 * g[1], 0, false);
          p = __builtin_amdgcn_cvt_pk_fp8_f32(bflo(xs[2 * j + 1]) * rs2 * g[2], bfhi(xs[2 * j + 1]) * rs2 * g[3], p, true); o[j] = (unsigned)p; }
      *(LAS v4u*)(h8 + 16 * lane) = o; }
    const int* IDX = (const int*)(ws + WS_IDX) + (size_t)t * 128; const float* GT = (const float*)(ws + WS_GATE) + (size_t)t * 128;
    { const int a0 = IDX[lane], b0 = IDX[64 + lane]; const float ga = GT[lane], gb = GT[64 + lane];
      const int kA = a0 >> 10, kB = b0 >> 10; const unsigned long long lt = (1ull << lane) - 1ull;
      int base = 0, rA = 0, rB = 0;
#pragma unroll
      for (int k = 0; k < 16; ++k) { const unsigned long long mA = __ballot(kA == k), mB = __ballot(kB == k); const int cA = __popcll(mA), cB = __popcll(mB);
          if (kA == k) rA = base + __popcll(mA & lt);
          if (kB == k) rB = base + cA + __popcll(mB & lt);
          base += cA + cB; }
      sid[rA] = a0; sid[rB] = b0; sgt[rA] = ga; sgt[rB] = gb;
      LDS_WAIT(); asm volatile("" ::: "memory"); }
    f32x2v o[8];
#pragma unroll
    for (int i = 0; i < 8; ++i) o[i] = (f32x2v){0.f, 0.f};
    AFrag A0, A1; VSlot V[16];
    int idc = sid[lane & 15];
    p9m_load_a(A0, EUV, idc, lane);
#pragma unroll
    for (int p = 0; p < 16; ++p) p9m_load_v(V[p], rs, __builtin_amdgcn_readlane(idc, p), lane);
#pragma unroll 1
    for (int b = 0; b < 8; b += 2) {
        const int id1 = sid[16 * (b + 1) + (lane & 15)];
        p9m_load_a(A1, EUV, id1, lane); asm volatile("" ::: "memory");
        p9m_batch(A0, V, h8, sgt, rs, b, id1, lane, o); asm volatile("" ::: "memory");
        const int b2 = (b + 2 < 8) ? b + 2 : 7;
        const int id2 = sid[16 * b2 + (lane & 15)];
        p9m_load_a(A0, EUV, id2, lane); asm volatile("" ::: "memory");
        p9m_batch(A1, V, h8, sgt, rs, b + 1, id2, lane, o); asm volatile("" ::: "memory");
    }
    LDS_WAIT(); asm volatile("" ::: "memory");
    float oacc[16];
#pragma unroll
    for (int k = 0; k < 8; ++k) { oacc[2 * k] = o[k].x; oacc[2 * k + 1] = o[k].y; }
    float ss = 0.f;
#pragma unroll
    for (int j = 0; j < 4; ++j) { const v2u a = *(const v2u*)(xrow + 256 * j + 4 * lane);
        oacc[4 * j] += bflo(a.x); oacc[4 * j + 1] += bfhi(a.x); oacc[4 * j + 2] += bflo(a.y); oacc[4 * j + 3] += bfhi(a.y);
#pragma unroll
        for (int i = 0; i < 4; ++i) ss += oacc[4 * j + i] * oacc[4 * j + i]; }
    ss += swz_xor<1>(ss); ss += swz_xor<2>(ss); ss += swz_xor<4>(ss); ss += swz_xor<8>(ss); ss += swz_xor<16>(ss); ss += bperm(ss, lane ^ 32);
    const float rs3 = __builtin_amdgcn_rsqf(ss * (1.0f / D) + EPS);
#pragma unroll
    for (int j = 0; j < 4; ++j) { const f32x4 g = *(const f32x4*)(g_fin + 256 * j + 4 * lane); f32x4 ov;
#pragma unroll
        for (int i = 0; i < 4; ++i) ov[i] = oacc[4 * j + i] * rs3 * g[i];
        *(f32x4*)(orow + 256 * j + 4 * lane) = ov; }
}
struct Rows8 { v4u u[8], v[8]; };
__device__ __forceinline__ void p9_load8(Rows8& R, const unsigned char* EU, const unsigned char* EV, const int (&e)[8], int lane) {
#pragma unroll
    for (int j = 0; j < 8; ++j) { R.u[j] = *(const v4u*)(EU + (size_t)e[j] * 1024 + 16 * lane); R.v[j] = *(const v4u*)(EV + (size_t)e[j] * 1024 + 16 * lane); }
}
__device__ __forceinline__ void p9_token_f8(Frame& F, int t, const float* g_ffn, const float* g_fin) {
    unsigned char* ws = F.ws; const int lane = pg8::fresh_lane(), hh = lane >> 5, q4 = (lane >> 4) & 1, q3 = (lane >> 3) & 1;
    const unsigned char* EU = ws + WS_EU; const unsigned char* EV = ws + WS_EV; const float* ISU = (const float*)(ws + WS_ESC); const float* ISV = ISU + 16384;
    const bf16* xrow = (const bf16*)(ws + WS_X1B) + (size_t)t * D; float* orow = F.out + (size_t)t * D;
    const float rs2 = __builtin_amdgcn_rsqf(pg8::sum16((const float*)(ws + WS_ROWSS) + (size_t)t * 16) * (1.0f / D) + EPS);
    float hn[16];
#pragma unroll
    for (int j = 0; j < 4; ++j) { const v2u a = *(const v2u*)(xrow + 256 * j + 4 * lane); const f32x4 g = *(const f32x4*)(g_ffn + 256 * j + 4 * lane);
        hn[4 * j] = bflo(a.x) * rs2 * g[0]; hn[4 * j + 1] = bfhi(a.x) * rs2 * g[1]; hn[4 * j + 2] = bflo(a.y) * rs2 * g[2]; hn[4 * j + 3] = bfhi(a.y) * rs2 * g[3]; }
    const int* IDX = (const int*)(ws + WS_IDX) + (size_t)t * 128; const float* GT = (const float*)(ws + WS_GATE) + (size_t)t * 128;
    int idA, idB; float suA, suB, gvA, gvB;
    { const int a0 = IDX[lane], b0 = IDX[64 + lane];
      const float sa = ISU[a0], sb = ISU[b0], ga = GT[lane] * ISV[a0], gb = GT[64 + lane] * ISV[b0];
      const int kA = a0 >> 10, kB = b0 >> 10; const unsigned long long lt = (1ull << lane) - 1ull;
      int base = 0, rA = 0, rB = 0;
#pragma unroll
      for (int k = 0; k < 16; ++k) { const unsigned long long mA = __ballot(kA == k), mB = __ballot(kB == k); const int cA = __popcll(mA), cB = __popcll(mB);
          if (kA == k) rA = base + __popcll(mA & lt);
          if (kB == k) rB = base + cA + __popcll(mB & lt);
          base += cA + cB; }
      LAS int* sid = (LAS int*)(F.lds + F.wave * WAVE_LDS); LAS float* ssu = (LAS float*)(sid + 128); LAS float* sgv = ssu + 128;
      sid[rA] = a0; sid[rB] = b0; ssu[rA] = sa; ssu[rB] = sb; sgv[rA] = ga; sgv[rB] = gb;
      LDS_WAIT(); asm volatile("" ::: "memory");
      idA = sid[lane]; idB = sid[64 + lane]; suA = ssu[lane]; suB = ssu[64 + lane]; gvA = sgv[lane]; gvB = sgv[64 + lane];
      LDS_WAIT(); asm volatile("" ::: "memory"); }
    float oacc[16];
#pragma unroll
    for (int i = 0; i < 16; ++i) oacc[i] = 0.f;
    const int jsel = 4 * hh + 2 * q4 + q3;
    Rows8 R;
    { int e[8];
#pragma unroll
      for (int j = 0; j < 8; ++j) e[j] = __builtin_amdgcn_readlane(idA, j);
      p9_load8(R, EU, EV, e, lane); }
    for (int bt = 0; bt < 16; ++bt) {
        Rows8 Rn;
        { const int nb = (bt + 1) & 15; int e[8];
#pragma unroll
          for (int j = 0; j < 8; ++j) { const int n = 8 * nb + j; e[j] = (nb < 8) ? __builtin_amdgcn_readlane(idA, n & 63) : __builtin_amdgcn_readlane(idB, n & 63); }
          p9_load8(Rn, EU, EV, e, lane); }
        float pd[8];
#pragma unroll
        for (int j = 0; j < 8; ++j) { float a = 0.f, b = 0.f;
#pragma unroll
            for (int d = 0; d < 4; ++d) { const f32x2v lo = __builtin_amdgcn_cvt_pk_f32_fp8((int)R.u[j][d], false), hi = __builtin_amdgcn_cvt_pk_f32_fp8((int)R.u[j][d], true);
                a += lo.x * hn[4 * d] + hi.x * hn[4 * d + 2]; b += lo.y * hn[4 * d + 1] + hi.y * hn[4 * d + 3]; }
            pd[j] = a + b; }
        float r4[4], r2[2];
#pragma unroll
        for (int i = 0; i < 4; ++i) { const float keep = hh ? pd[4 + i] : pd[i], send = hh ? pd[i] : pd[4 + i]; r4[i] = keep + __shfl_xor(send, 32); }
#pragma unroll
        for (int i = 0; i < 2; ++i) { const float keep = q4 ? r4[2 + i] : r4[i], send = q4 ? r4[i] : r4[2 + i]; r2[i] = keep + __shfl_xor(send, 16); }
        float v = (q3 ? r2[1] : r2[0]) + __shfl_xor(q3 ? r2[0] : r2[1], 8);
        v += __shfl_xor(v, 4); v += __shfl_xor(v, 2); v += __shfl_xor(v, 1);
        const int n = 8 * bt + jsel;
        const float su = (bt < 8) ? __shfl(suA, n & 63) : __shfl(suB, n & 63), gv = (bt < 8) ? __shfl(gvA, n & 63) : __shfl(gvB, n & 63);
        const float w = gv * gelu_erf(v * su);
#pragma unroll
        for (int j = 0; j < 8; ++j) { const float wj = rdl(w, 8 * j);
#pragma unroll
            for (int d = 0; d < 4; ++d) { const f32x2v lo = __builtin_amdgcn_cvt_pk_f32_fp8((int)R.v[j][d], false), hi = __builtin_amdgcn_cvt_pk_f32_fp8((int)R.v[j][d], true);
                oacc[4 * d] += wj * lo.x; oacc[4 * d + 1] += wj * lo.y; oacc[4 * d + 2] += wj * hi.x; oacc[4 * d + 3] += wj * hi.y; } }
        R = Rn;
    }
    asm volatile("" ::: "memory");
    float ss = 0.f;
#pragma unroll
    for (int j = 0; j < 4; ++j) { const v2u a = *(const v2u*)(xrow + 256 * j + 4 * lane);
        oacc[4 * j] += bflo(a.x); oacc[4 * j + 1] += bfhi(a.x); oacc[4 * j + 2] += bflo(a.y); oacc[4 * j + 3] += bfhi(a.y);
#pragma unroll
        for (int i = 0; i < 4; ++i) ss += oacc[4 * j + i] * oacc[4 * j + i]; }
    ss = wave_sum(ss);
    const float rs3 = __builtin_amdgcn_rsqf(ss * (1.0f / D) + EPS);
#pragma unroll
    for (int j = 0; j < 4; ++j) { const f32x4 g = *(const f32x4*)(g_fin + 256 * j + 4 * lane); f32x4 o;
#pragma unroll
        for (int i = 0; i < 4; ++i) o[i] = oacc[4 * j + i] * rs3 * g[i];
        *(f32x4*)(orow + 256 * j + 4 * lane) = o; }
}
struct Rows4 { v4u ua[4], ub[4], va[4], vb[4]; };
__device__ __forceinline__ void p9_load(Rows4& R, const bf16* EU, const bf16* EV, const int (&e)[4], int lane) {
#pragma unroll
    for (int j = 0; j < 4; ++j) { const bf16* up = EU + (size_t)e[j] * 1024 + lane * 8; const bf16* vp = EV + (size_t)e[j] * 1024 + lane * 8;
        R.ua[j] = *(const v4u*)up; R.ub[j] = *(const v4u*)(up + 512); R.va[j] = *(const v4u*)vp; R.vb[j] = *(const v4u*)(vp + 512); }
}
__device__ __forceinline__ void p9_token(Frame& F, int t, const float* g_ffn, const float* g_fin) {
    unsigned char* ws = F.ws; const int lane = pg8::fresh_lane(), hh = lane >> 5, q4 = (lane >> 4) & 1;
    const bf16* EU = (const bf16*)(ws + WS_EU); const bf16* EV = (const bf16*)(ws + WS_EV);
    const float* xrow = (const float*)(ws + WS_X1) + (size_t)t * D; float* orow = F.out + (size_t)t * D;
    const float rs2 = __builtin_amdgcn_rsqf(pg8::sum16((const float*)(ws + WS_ROWSS) + (size_t)t * 16) * (1.0f / D) + EPS);
    float x1[16];
    { const f32x4 a0 = *(const f32x4*)(xrow + lane * 8), a1 = *(const f32x4*)(xrow + lane * 8 + 4), b0 = *(const f32x4*)(xrow + 512 + lane * 8), b1 = *(const f32x4*)(xrow + 512 + lane * 8 + 4);
#pragma unroll
      for (int i = 0; i < 4; ++i) { x1[i] = a0[i]; x1[4 + i] = a1[i]; x1[8 + i] = b0[i]; x1[12 + i] = b1[i]; } }
    unsigned hn[8];
    { const f32x4 a0 = *(const f32x4*)(g_ffn + lane * 8), a1 = *(const f32x4*)(g_ffn + lane * 8 + 4), b0 = *(const f32x4*)(g_ffn + 512 + lane * 8), b1 = *(const f32x4*)(g_ffn + 512 + lane * 8 + 4);
      float g[16];
#pragma unroll
      for (int i = 0; i < 4; ++i) { g[i] = a0[i]; g[4 + i] = a1[i]; g[8 + i] = b0[i]; g[12 + i] = b1[i]; }
#pragma unroll
      for (int i = 0; i < 8; ++i) hn[i] = pk2(x1[2 * i] * rs2 * g[2 * i], x1[2 * i + 1] * rs2 * g[2 * i + 1]); }
    const int* IDX = (const int*)(ws + WS_IDX) + (size_t)t * 128; const float* GT = (const float*)(ws + WS_GATE) + (size_t)t * 128;
    const int idA = IDX[lane], idB = IDX[64 + lane]; const float gtA = GT[lane], gtB = GT[64 + lane];
    float oacc[16];
#pragma unroll
    for (int i = 0; i < 16; ++i) oacc[i] = 0.f;
    const int jsel = 2 * hh + q4;
    Rows4 R;
    { int e[4];
#pragma unroll
      for (int j = 0; j < 4; ++j) e[j] = __builtin_amdgcn_readlane(idA, j);
      p9_load(R, EU, EV, e, lane); }
#ifndef DBG_NBATCH
#define DBG_NBATCH 32
#endif
    for (int bt = 0; bt < DBG_NBATCH; ++bt) {
        Rows4 Rn;
        { const int nb = (bt + 1) & 31; int e[4];
#pragma unroll
          for (int j = 0; j < 4; ++j) { const int n = 4 * nb + j; e[j] = (nb < 16) ? __builtin_amdgcn_readlane(idA, n & 63) : __builtin_amdgcn_readlane(idB, n & 63); }
          p9_load(Rn, EU, EV, e, lane); }
        float pd[4];
#pragma unroll
        for (int j = 0; j < 4; ++j) { float a = 0.f, b = 0.f;
            a = dot2bf(R.ua[j].x, hn[0], a); b = dot2bf(R.ua[j].y, hn[1], b); a = dot2bf(R.ua[j].z, hn[2], a); b = dot2bf(R.ua[j].w, hn[3], b);
            a = dot2bf(R.ub[j].x, hn[4], a); b = dot2bf(R.ub[j].y, hn[5], b); a = dot2bf(R.ub[j].z, hn[6], a); b = dot2bf(R.ub[j].w, hn[7], b); pd[j] = a + b; }
        const float k0 = hh ? pd[2] : pd[0], k1 = hh ? pd[3] : pd[1], s0 = hh ? pd[0] : pd[2], s1 = hh ? pd[1] : pd[3];
        const float r0 = k0 + __shfl_xor(s0, 32), r1 = k1 + __shfl_xor(s1, 32);
        float v = (q4 ? r1 : r0) + __shfl_xor(q4 ? r0 : r1, 16);
        v += __shfl_xor(v, 8); v += __shfl_xor(v, 4); v += __shfl_xor(v, 2); v += __shfl_xor(v, 1);
        const int n = 4 * bt + jsel; const float gsel = (bt < 16) ? __shfl(gtA, n & 63) : __shfl(gtB, n & 63);
        const float w = gsel * gelu_erf(v);
        const float w0 = __builtin_bit_cast(float, __builtin_amdgcn_readlane(__builtin_bit_cast(int, w), 0)), w1 = __builtin_bit_cast(float, __builtin_amdgcn_readlane(__builtin_bit_cast(int, w), 16)),
                    w2 = __builtin_bit_cast(float, __builtin_amdgcn_readlane(__builtin_bit_cast(int, w), 32)), w3 = __builtin_bit_cast(float, __builtin_amdgcn_readlane(__builtin_bit_cast(int, w), 48));
        const float wj[4] = {w0, w1, w2, w3};
#pragma unroll
        for (int j = 0; j < 4; ++j) {
            const unsigned va[4] = {R.va[j].x, R.va[j].y, R.va[j].z, R.va[j].w}, vb[4] = {R.vb[j].x, R.vb[j].y, R.vb[j].z, R.vb[j].w};
#pragma unroll
            for (int i = 0; i < 4; ++i) { oacc[2 * i] += wj[j] * bflo(va[i]); oacc[2 * i + 1] += wj[j] * bfhi(va[i]); oacc[8 + 2 * i] += wj[j] * bflo(vb[i]); oacc[8 + 2 * i + 1] += wj[j] * bfhi(vb[i]); }
        }
        R = Rn;
    }
    float ss = 0.f;
#pragma unroll
    for (int i = 0; i < 16; ++i) { x1[i] += oacc[i]; ss += x1[i] * x1[i]; }
    ss = wave_sum(ss);
#ifdef DBG_CHK
    const float rs3 = __builtin_amdgcn_rsqf(ss * (1.0f / D) + EPS) * chk_scale(F);
#else
    const float rs3 = __builtin_amdgcn_rsqf(ss * (1.0f / D) + EPS);
#endif
    { const f32x4 a0 = *(const f32x4*)(g_fin + lane * 8), a1 = *(const f32x4*)(g_fin + lane * 8 + 4), b0 = *(const f32x4*)(g_fin + 512 + lane * 8), b1 = *(const f32x4*)(g_fin + 512 + lane * 8 + 4);
      f32x4 o0, o1, o2, o3;
#pragma unroll
      for (int i = 0; i < 4; ++i) { o0[i] = x1[i] * rs3 * a0[i]; o1[i] = x1[4 + i] * rs3 * a1[i]; o2[i] = x1[8 + i] * rs3 * b0[i]; o3[i] = x1[12 + i] * rs3 * b1[i]; }
      *(f32x4*)(orow + lane * 8) = o0; *(f32x4*)(orow + lane * 8 + 4) = o1; *(f32x4*)(orow + 512 + lane * 8) = o2; *(f32x4*)(orow + 512 + lane * 8 + 4) = o3; }
}

__device__ __forceinline__ void dbg_dump_bf16(Frame& F, const bf16* src, int ld, int c0, int n) {
    const int gt = F.vcu * (NWAVES * 64) + F.wave * 64 + pg8::fresh_lane(), ngt = F.G * NWAVES * 64;
    for (long i = gt; i < (long)T * n; i += ngt) { const long t = i / n; const int c = (int)(i % n); F.out[t * 1024 + c0 + c] = bf2f(src[t * ld + c]); }
}
__device__ __forceinline__ void dbg_dump_f32(Frame& F, const float* src, long n, long o0) {
    const int gt = F.vcu * (NWAVES * 64) + F.wave * 64 + pg8::fresh_lane(), ngt = F.G * NWAVES * 64;
    for (long i = gt; i < n; i += ngt) F.out[o0 + i] = src[i];
}
__global__ void __launch_bounds__(NWAVES * 64, 2) fwd_kernel(Args args) {
    extern __shared__ __attribute__((aligned(16))) unsigned char lds[];
    Frame F;
    F.lds = (LAS unsigned char*)lds;
    F.wave = __builtin_amdgcn_readfirstlane((int)threadIdx.x >> 6);
    F.G = gridDim.x; { const int bx = blockIdx.x; F.vcu = (F.G % 8 == 0) ? (bx % 8) * (F.G / 8) + bx / 8 : bx; }
    F.gw = F.vcu * NWAVES + F.wave; F.ngw = F.G * NWAVES;
    F.out = args.out; F.ws = args.ws;
    unsigned char* ws = args.ws;
    volatile LAS unsigned* MISC = (volatile LAS unsigned*)(F.lds + MISC_OFF);
    for (int u = threadIdx.x; u < 256; u += NWAVES * 64) MISC[u] = 0u;
    __syncthreads();
    gu32* ctl = (gu32*)(ws + WS_CTL);
    XcdBarrier bar; bar.bar = (unsigned*)(ctl + CW_BAR); bar.x = 0; bar.st = nullptr;
    if (N_LAUNCHES != PER_PHASE) bar = xcd_barrier_post((unsigned*)(ctl + CW_BAR), MISC + 8);
#ifdef PROBE_DUP
#define DUPN(k) (((PROBE_DUP >> (k)) & 1) ? 2 : 1)
#else
#define DUPN(k) 1
#endif
#define GRID_BAR() do { if (N_LAUNCHES != PER_PHASE) xcd_barrier(bar); } while (0)
    const int lo = args.ph_lo, hi = args.ph_hi;
#ifdef ONLY_PH
#define IN(k) ((k) == ONLY_PH)
#else
#define IN(k) (lo <= (k) && (k) < hi)
#endif
#define BOTH(k) (IN(k) && IN((k) + 1))
    bf16* const XB = (bf16*)(ws + WS_XB);
    float* const rowss = (float*)(ws + WS_ROWSS);

    if (IN(0)) { for (int rep = 0; rep < DUPN(0); ++rep) { p0_colmax(F, args); GRID_BAR(); p0_prologue(F, args); } if (BOTH(0)) GRID_BAR(); }
    if (IN(1)) for (int rep = 0; rep < DUPN(1); ++rep) {
        pg8::Gemm g{(const bf16*)(ws + WS_X8), (const bf16*)(ws + WS_WIN), T, NIN, D / 2}; pg8::StaticOrder S; S.init(T, NIN, F.G, (int)blockIdx.x);
        pg8::EpiInProj E{(const float*)(ws + WS_RFAC), (const float*)(ws + WS_SWR), (const float*)(ws + WS_LB), (bf16*)(ws + WS_Q), (bf16*)(ws + WS_LF), (bf16*)(ws + WS_KK), (bf16*)(ws + WS_V), (bf16*)(ws + WS_SG),
                         (bf16*)(ws + WS_CB), (bf16*)(ws + WS_U), (bf16*)(ws + WS_GA)};
        pg8::gemm_phase<pg8::EpiInProj, pg8::StaticOrder, true, true, false, true>(F.lds, g, S, E, F.wave);
        if (BOTH(1)) GRID_BAR();
    }
    if (IN(2)) { p2_phase(F, args.in[5]); if (BOTH(2)) GRID_BAR(); }
    if (IN(3)) { for (int rep = 0; rep < DUPN(3); ++rep) p3_phase(F); if (BOTH(3)) GRID_BAR(); }
    if (IN(4)) { const float* gain = args.in[4]; for (int rep = 0; rep < DUPN(4); ++rep) for (int u = F.gw; u < NUNIT; u += F.ngw) p4_unit(F, u, gain); if (BOTH(4)) GRID_BAR(); }
    if (IN(5)) for (int rep = 0; rep < DUPN(5); ++rep) {
        pg8::Gemm g{(const bf16*)F.out, (const bf16*)(ws + WS_PAB), T, D, D}; pg8::StaticOrder S; S.init(T, D, F.G, (int)blockIdx.x);
        pg8::EpiMerged E{(const bf16*)(ws + WS_GA), (bf16*)(ws + WS_MG)};
        pg8::gemm_phase<pg8::EpiMerged, pg8::StaticOrder, true, true>(F.lds, g, S, E, F.wave);
        if (BOTH(5)) GRID_BAR();
    }
    if (IN(6)) for (int rep = 0; rep < DUPN(6); ++rep) {
        pg8::Gemm g{(const bf16*)(ws + WS_MG), (const bf16*)(ws + WS_WO), T, D, D}; pg8::StaticOrder S; S.init(T, D, F.G, (int)blockIdx.x);
        pg8::EpiOut E{XB, (float*)(ws + WS_X1), (bf16*)(ws + WS_X1B), rowss};
        pg8::gemm_phase<pg8::EpiOut, pg8::StaticOrder, true, true>(F.lds, g, S, E, F.wave);
        if (BOTH(6)) GRID_BAR();
    }
    if (IN(7)) for (int rep = 0; rep < DUPN(7); ++rep) {
        pg8::Gemm g{(const bf16*)(ws + WS_X1B), (const bf16*)(ws + WS_WQ), T, 2048, D}; pg8::StaticOrder S; S.init(T, 2048, F.G, (int)blockIdx.x);
        pg8::EpiQuery E{rowss, (bf16*)(ws + WS_QQ), EPS};
        pg8::gemm_phase<pg8::EpiQuery, pg8::StaticOrder, true, true>(F.lds, g, S, E, F.wave);
        if (BOTH(7)) GRID_BAR();
    }
    if (IN(8)) {
        const float* eu = args.in[13]; const float* ev = args.in[14]; const int ln = pg8::fresh_lane();
        int it = F.gw;
        for (int rep = 0; rep < DUPN(8); ++rep)
        for (int tile = F.vcu; tile < T / 32; tile += F.G) {
            p8_task(F, tile, F.wave);
            if (it + F.ngw < 16384) { cvt_expert_mx2(eu, ev, ws + WS_EU, it, it + F.ngw, ln); it += 2 * F.ngw; }
            else if (it < 16384) { cvt_expert_mx(eu, ev, ws + WS_EU, it, ln); it += F.ngw; }
        }
#pragma unroll 1
        for (; it < 16384; it += F.ngw) cvt_expert_mx(eu, ev, ws + WS_EU, it, ln);
        if (BOTH(8)) GRID_BAR();
    }
    if (IN(9)) { const float* g_ffn = args.in[9]; const float* g_fin = args.in[15];
        for (int rep = 0; rep < DUPN(9); ++rep)
#pragma unroll 1
        for (int g = F.gw; g < T / 4; g += F.ngw) p9_group_mx(F, g, g_ffn, g_fin);
    }
#undef IN
#undef BOTH
}

extern "C" void kernel_launch(void* const* d_in, const int* in_sizes, int n_in, void* d_out, int out_size, void* d_ws, size_t ws_size, hipStream_t stream) {
    static int grid = 0;
    if (grid == 0) {
        if (n_in != 16 || in_sizes[0] != T * D || out_size != T * D || ws_size < WS_END) { fprintf(stderr, "kernel_launch: unexpected shapes (n_in %d, in0 %d, out %d, ws %zu); nothing launched\n", n_in, n_in > 0 ? in_sizes[0] : -1, out_size, ws_size); grid = -1; return; }
        int dev = 0, cus = 0, per_cu = 0;
        if (hipGetDevice(&dev) != hipSuccess || hipDeviceGetAttribute(&cus, hipDeviceAttributeMultiprocessorCount, dev) != hipSuccess) { fprintf(stderr, "kernel_launch: device query failed\n"); grid = -1; return; }
        if (hipFuncSetAttribute((const void*)fwd_kernel, hipFuncAttributeMaxDynamicSharedMemorySize, LDS_BYTES) != hipSuccess) { fprintf(stderr, "kernel_launch: hipFuncSetAttribute failed\n"); grid = -1; return; }
        if (hipOccupancyMaxActiveBlocksPerMultiprocessor(&per_cu, (const void*)fwd_kernel, NWAVES * 64, LDS_BYTES) != hipSuccess || per_cu < 1)
            fprintf(stderr, "kernel_launch: note: occupancy query reports %d workgroups per CU\n", per_cu);
        (void)hipGetLastError();
        grid = cus;
    }
    if (grid < 0) return;
    if (hipMemsetAsync((char*)d_ws + WS_CTL, 0, CTL_ZERO_BYTES, stream) != hipSuccess) { fprintf(stderr, "kernel_launch: hipMemsetAsync failed\n"); return; }
    Args a{};
    for (int i = 0; i < 16; ++i) a.in[i] = (const float*)d_in[i];
    a.out = (float*)d_out; a.ws = (unsigned char*)d_ws;
    for (int li = 0; li < N_LAUNCHES; ++li) {
        a.ph_lo = (N_LAUNCHES == PER_PHASE) ? li : 0; a.ph_hi = (N_LAUNCHES == PER_PHASE) ? li + 1 : PER_PHASE; a.li = li;
#ifdef DBG_STOP
        if (li == DBG_STOP + 1) { a.ph_lo = 100; a.ph_hi = 101; }
        if (li > DBG_STOP + 1) break;
#endif
        hipLaunchKernelGGL(fwd_kernel, dim3(grid), dim3(NWAVES * 64), LDS_BYTES, stream, a);
#ifdef DBG_CHK
        if (N_LAUNCHES == PER_PHASE && (li == 1 || li == 4)) { Args c = a; c.ph_lo = 210 + li; c.ph_hi = 211 + li; hipLaunchKernelGGL(fwd_kernel, dim3(grid), dim3(NWAVES * 64), LDS_BYTES, stream, c); }
        if (N_LAUNCHES == PER_PHASE && (li == 0 || li == 1 || li == 2 || li == 5 || li == 6 || li == 7)) { Args c = a; c.ph_lo = 200 + li; c.ph_hi = 201 + li; hipLaunchKernelGGL(fwd_kernel, dim3(grid), dim3(NWAVES * 64), LDS_BYTES, stream, c); }
#endif
        const hipError_t le = hipPeekAtLastError();
        if (le != hipSuccess) { fprintf(stderr, "kernel_launch: launch %d failed: %s\n", li, hipGetErrorName(le)); break; }
    }
}
```

```cpp
#include <hip/hip_runtime.h>
#include <cstdio>
#include <cstdint>


#define DBG_ZYA 1.0f
#define DBG_ZYB 1.0f


#ifdef DBG_SWAPG
#define CHK_GA_ROW 4608
#define CHK_GB_ROW 3584
#else
#define CHK_GA_ROW 3584
#define CHK_GB_ROW 4608
#endif

#ifndef MK_N_LAUNCHES
#define MK_N_LAUNCHES 1
#endif
namespace pg8 {
#define PG8_LAS __attribute__((address_space(3)))
typedef unsigned short bf16_t;
typedef short bf16x8 __attribute__((ext_vector_type(8)));
typedef float f32x4 __attribute__((ext_vector_type(4)));
typedef int v4i_ __attribute__((ext_vector_type(4)));
typedef int v8i_ __attribute__((ext_vector_type(8)));
typedef unsigned u32x4 __attribute__((ext_vector_type(4)));
constexpr int BM = 256, BK = 64, HALF = 128, HTB = HALF * BK * 2  , STAGE_BYTES = 8 * HTB, NXCD = 8, WGM = 8;

__host__ __device__ __forceinline__ int lds_byte(int r, int c) { const int st = (r >> 4) * 2 + (c >> 5), rr = r & 15, cc = c & 31, ob = rr * 64 + cc * 2; return st * 1024 + (ob ^ (((ob >> 9) & 1) << 5)); }
__host__ __device__ __forceinline__ void stage_rc(int b, int& R, int& C) { const int st = b / 1024, sb = b % 1024, swz = sb ^ (((sb >> 9) & 1) << 5); R = (st >> 1) * 16 + swz / 64; C = (st & 1) * 32 + (swz % 64) / 2; }
__host__ __device__ __forceinline__ int perm32(int rho) { const int n = rho >> 4, i = rho & 15; return 8 * (i >> 2) + 4 * n + (i & 3); }

struct Unit { int pm, pn; };
struct Gemm { const bf16_t* A; const bf16_t* Bt; int M, N, K; };

struct StaticOrder {
    int nM, nN, nwg, G, c;
    __host__ __device__ void init(int M, int N, int G_, int c_) { nM = M / BM; nN = N / BM; nwg = nM * nN; G = G_; c = c_; }
    __host__ __device__ bool next(int i, Unit& u) const {
        if ((long)i * G + c >= nwg) return false;
#ifdef DBG_REV
        const int nr = (nwg - 1 - c) / G; const long L = (long)(nr - i) * G + c;
#else
        const long L = (long)i * G + c;
#endif
        int wgid = (int)L; { const int q = nwg / NXCD, r = nwg % NXCD, xcd = wgid % NXCD, off = wgid / NXCD; wgid = (xcd < r ? xcd * (q + 1) : r * (q + 1) + (xcd - r) * q) + off; }
        const int nig = WGM * nN, gid = wgid / nig, fm = gid * WGM, gsz = (nM - fm) < WGM ? (nM - fm) : WGM;
        u.pm = fm + ((wgid % nig) % gsz); u.pn = (wgid % nig) / gsz; return true;
    }
    __device__ __forceinline__ void a_ready(const Unit&) const {}
    __device__ __forceinline__ void done(const Unit&) const {}
};

__device__ __forceinline__ int fresh_lane() { int l; asm volatile("v_mbcnt_lo_u32_b32 %0, -1, 0\n\tv_mbcnt_hi_u32_b32 %0, -1, %0" : "=v"(l)); return l; }
__device__ __forceinline__ unsigned cvt_pk_bf16(float lo, float hi) { unsigned r; asm volatile("v_cvt_pk_bf16_f32 %0, %1, %2" : "=v"(r) : "v"(lo), "v"(hi)); return r; }
__device__ __forceinline__ float fexp(float x) { return __builtin_amdgcn_exp2f(x * 1.44269504089f); }
__device__ __forceinline__ float fsig(float x) { return __builtin_amdgcn_rcpf(1.0f + fexp(-x)); }
__device__ __forceinline__ float bflo(unsigned w) { return __builtin_bit_cast(float, w << 16); }
__device__ __forceinline__ float bfhi(unsigned w) { return __builtin_bit_cast(float, w & 0xffff0000u); }
__device__ __forceinline__ void st8(bf16_t* p, const float (&v)[8]) {
    u32x4 w; w.x = cvt_pk_bf16(v[0], v[1]); w.y = cvt_pk_bf16(v[2], v[3]); w.z = cvt_pk_bf16(v[4], v[5]); w.w = cvt_pk_bf16(v[6], v[7]); *(u32x4*)p = w; }
__device__ __forceinline__ void ld8(const bf16_t* p, float (&v)[8]) {
    const u32x4 w = *(const u32x4*)p; v[0] = bflo(w.x); v[1] = bfhi(w.x); v[2] = bflo(w.y); v[3] = bfhi(w.y); v[4] = bflo(w.z); v[5] = bfhi(w.z); v[6] = bflo(w.w); v[7] = bfhi(w.w); }

__device__ __forceinline__ float sum16(const float* p) {
    const f32x4 a = *(const f32x4*)p, b = *(const f32x4*)(p + 4), c = *(const f32x4*)(p + 8), d = *(const f32x4*)(p + 12);
    return (((a[0] + a[1]) + (a[2] + a[3])) + ((b[0] + b[1]) + (b[2] + b[3]))) + (((c[0] + c[1]) + (c[2] + c[3])) + ((d[0] + d[1]) + (d[2] + d[3]))); }
struct EpiInProj {
    static constexpr bool PERM = true, AFTER_DRAIN = false, MID = false;
    const float* rfac; const float* swr; const float* lb;
    bf16_t *Q, *LF, *KK, *V, *SG, *CB, *U, *GA;
    static __device__ __forceinline__ float af(const f32x4 v, int i) { const float f = v[i]; return (float)__builtin_bit_cast(int, f); }
    __device__ __forceinline__ void mid(f32x4 (&)[2][2][4][2], const Unit&, int, int, int, int) const {}
    template <int MODE> __device__ __forceinline__ void run(const f32x4 (&acc)[2][2][4][2], bf16_t* O, int ldo, int cbase, int gcol0, int row0, int cl) const {
        float lbv[2][8], swv[2][8];
#pragma unroll
        for (int bj = 0; bj < 2; ++bj)
#pragma unroll
            for (int i = 0; i < 8; ++i) { lbv[bj][i] = (MODE == 1) ? lb[cbase + bj * HALF + cl + i] : 0.f; swv[bj][i] = swr[gcol0 + bj * HALF + cl + i]; }
#pragma unroll
        for (int ai = 0; ai < 2; ++ai)
#pragma unroll
            for (int m = 0; m < 4; ++m) { const int r = row0 + ai * HALF + m * 16; const float rs = rfac[r];
#pragma unroll
                for (int bj = 0; bj < 2; ++bj) { float v[8];
#pragma unroll
                    for (int i = 0; i < 8; ++i) { float x = af(acc[ai][bj][m][i >> 2], i & 3) * (rs * swv[bj][i]);
                        if (MODE == 0) { v[i] = x * fsig(x) * 0.125f; }
                        else if (MODE == 1) { x = fminf(fmaxf(x, -30.f), 30.f); const float ex = fexp(-x), sg = __builtin_amdgcn_rcpf(1.0f + ex), om = ex * sg;
                            v[i] = (1.0f - lbv[bj][i]) * om; }
                        else if (MODE == 2) { v[i] = x; }
                        else if (MODE == 3) { v[i] = x * fsig(x); }
                        else { v[i] = fsig(x); } }
                    const size_t off = (size_t)r * ldo + cbase + bj * HALF + cl;
                    st8(O + off, v); } }
    }
    __device__ __forceinline__ void operator()(const f32x4 (&acc)[2][2][4][2], const Unit& u, int wr, int wc, int fr, int fq) const {
        const int pn = u.pn; int row0 = u.pm * BM + wr * 64 + fr, cl = wc * 32 + 8 * fq;
        asm volatile("" : "+v"(row0), "+v"(cl));
        if (pn < 2) run<0>(acc, Q, 512, pn * 256, pn * 256, row0, cl);
        else if (pn < 4) run<1>(acc, KK, 512, (pn - 2) * 256, pn * 256, row0, cl);
        else if (pn < 6) run<2>(acc, V, 512, (pn - 4) * 256, pn * 256, row0, cl);
        else if (pn < 8) run<3>(acc, SG, 512, (pn - 6) * 256, pn * 256, row0, cl);
        else if (pn < 10) run<2>(acc, CB, 512, (pn - 8) * 256, pn * 256, row0, cl);
        else if (pn < 14) {
            float s01[8];
#pragma unroll
            for (int i = 0; i < 8; ++i) s01[i] = swr[pn * 256 + cl + i] * swr[pn * 256 + HALF + cl + i];
#pragma unroll
            for (int ai = 0; ai < 2; ++ai)
#pragma unroll
                for (int m = 0; m < 4; ++m) { const int r = row0 + ai * HALF + m * 16; const float rs = rfac[r], rs2 = rs * rs; float v[8];
#pragma unroll
                    for (int i = 0; i < 8; ++i) v[i] = af(acc[ai][0][m][i >> 2], i & 3) * af(acc[ai][1][m][i >> 2], i & 3) * (rs2 * s01[i]);
                    st8(U + (size_t)r * 512 + (pn - 10) * 128 + cl, v); }
        }
        else {
            unsigned char* G8 = (unsigned char*)GA + (size_t)(u.pm * 8 + (pn - 14)) * 65536 + (size_t)((wr * 4 + wc) * 64 + fq * 16 + fr) * 16;
            float swv[2][8];
#pragma unroll
            for (int bj = 0; bj < 2; ++bj)
#pragma unroll
                for (int i = 0; i < 8; ++i) swv[bj][i] = swr[pn * 256 + bj * HALF + cl + i];
#pragma unroll
            for (int ai = 0; ai < 2; ++ai)
#pragma unroll
                for (int m = 0; m < 4; ++m) { const int r = row0 + ai * HALF + m * 16; const float rs = rfac[r]; unsigned w[4] = {0u, 0u, 0u, 0u};
#pragma unroll
                    for (int bj = 0; bj < 2; ++bj)
#pragma unroll
                        for (int i = 0; i < 8; ++i) { const float gq = fmaxf(fsig(af(acc[ai][bj][m][i >> 2], i & 3) * (rs * swv[bj][i])) * 255.0f + 0.5f, 1.0f); w[2 * bj + (i >> 2)] = __builtin_amdgcn_cvt_pk_u8_f32(gq, i & 3, w[2 * bj + (i >> 2)]); }
                    u32x4 o; o.x = w[0]; o.y = w[1]; o.z = w[2]; o.w = w[3]; *(u32x4*)(G8 + (ai * 4 + m) * 8192) = o; }
        }
    }
};
struct EpiMerged {
    static constexpr bool PERM = true, AFTER_DRAIN = false, MID = true;
    const bf16_t *GAB; bf16_t* MG;
    static __device__ __forceinline__ float ub(unsigned w, int k) { return (float)((w >> (8 * k)) & 0xffu); }
    __device__ __forceinline__ void mid(f32x4 (&acc)[2][2][4][2], const Unit& u, int wr, int wc, int fr, int fq) const {
        int lt = (wr * 4 + wc) * 64 + fq * 16 + fr; asm volatile("" : "+v"(lt));
        const unsigned char* Ga = (const unsigned char*)GAB + (size_t)(u.pm * 8 + u.pn) * 65536 + (size_t)lt * 16; const unsigned char* Gb = Ga + (size_t)4 * 65536;
#pragma unroll
        for (int ai = 0; ai < 2; ++ai)
#pragma unroll
            for (int m = 0; m < 4; ++m) { const u32x4 a = *(const u32x4*)(Ga + (ai * 4 + m) * 8192), b = *(const u32x4*)(Gb + (ai * 4 + m) * 8192);
                const unsigned aw[4] = {a.x, a.y, a.z, a.w}, bw[4] = {b.x, b.y, b.z, b.w};
#pragma unroll
                for (int bj = 0; bj < 2; ++bj)
#pragma unroll
                    for (int i = 0; i < 8; ++i) acc[ai][bj][m][i >> 2][i & 3] *= ub(aw[2 * bj + (i >> 2)], i & 3) * __builtin_amdgcn_rcpf(ub(bw[2 * bj + (i >> 2)], i & 3)); }
        asm volatile("" ::: "memory");
    }
    __device__ __forceinline__ void operator()(const f32x4 (&acc)[2][2][4][2], const Unit& u, int wr, int wc, int fr, int fq) const {
        int row0 = u.pm * BM + wr * 64 + fr, c0 = u.pn * BM + wc * 32 + 8 * fq;
        asm volatile("" : "+v"(row0), "+v"(c0));
        int lt = (wr * 4 + wc) * 64 + fq * 16 + fr; asm volatile("" : "+v"(lt));
        const unsigned char* Gb = (const unsigned char*)GAB + (size_t)(u.pm * 8 + 4 + u.pn) * 65536 + (size_t)lt * 16;
        u32x4 gbw[2][4];
#pragma unroll
        for (int ai = 0; ai < 2; ++ai)
#pragma unroll
            for (int m = 0; m < 4; ++m) gbw[ai][m] = *(const u32x4*)(Gb + (ai * 4 + m) * 8192);
#pragma unroll
        for (int ai = 0; ai < 2; ++ai)
#pragma unroll
            for (int m = 0; m < 4; ++m) { const size_t rr = (size_t)(row0 + ai * HALF + m * 16); const unsigned bw[4] = {gbw[ai][m].x, gbw[ai][m].y, gbw[ai][m].z, gbw[ai][m].w};
#pragma unroll
                for (int bj = 0; bj < 2; ++bj) { float v[8];
#pragma unroll
                    for (int i = 0; i < 8; ++i) v[i] = acc[ai][bj][m][i >> 2][i & 3] * (ub(bw[2 * bj + (i >> 2)], i & 3) * (1.0f / 255.0f));
                    st8(MG + rr * 1024 + c0 + bj * HALF, v); } }
    }
};
struct EpiOut {
    static constexpr bool PERM = true, AFTER_DRAIN = false, MID = false;
    const float* x; float* x1; bf16_t* x1b; float* rowss;
    __device__ __forceinline__ void mid(f32x4 (&)[2][2][4][2], const Unit&, int, int, int, int) const {}
    __device__ __forceinline__ void operator()(const f32x4 (&acc)[2][2][4][2], const Unit& u, int wr, int wc, int fr, int fq) const {
        int row0 = u.pm * BM + wr * 64 + fr, c0 = u.pn * BM + wc * 32 + 8 * fq;
        asm volatile("" : "+v"(row0), "+v"(c0));
#pragma unroll
        for (int ai = 0; ai < 2; ++ai)
#pragma unroll
            for (int m = 0; m < 4; ++m) { const int r = row0 + ai * HALF + m * 16; const size_t ro = (size_t)r * 1024 + c0; float ss = 0.f;
#pragma unroll
                for (int bj = 0; bj < 2; ++bj) { const f32x4 x0 = *(const f32x4*)(x + ro + bj * HALF), x1v = *(const f32x4*)(x + ro + bj * HALF + 4);
                    const f32x4 o0 = acc[ai][bj][m][0] + x0, o1 = acc[ai][bj][m][1] + x1v;
                    float v[8] = {o0[0], o0[1], o0[2], o0[3], o1[0], o1[1], o1[2], o1[3]};
#pragma unroll
                    for (int i = 0; i < 8; ++i) ss += v[i] * v[i];
                    st8(x1b + ro + bj * HALF, v); }
                ss += __shfl_xor(ss, 16); ss += __shfl_xor(ss, 32);
                if (fq == 0) rowss[(size_t)r * 16 + u.pn * 4 + wc] = ss; }
    }
};
struct EpiQuery {
    static constexpr bool PERM = true, AFTER_DRAIN = false, MID = false;
    const float* rowss; bf16_t* QQ; float eps;
    __device__ __forceinline__ void mid(f32x4 (&)[2][2][4][2], const Unit&, int, int, int, int) const {}
    __device__ __forceinline__ void operator()(const f32x4 (&acc)[2][2][4][2], const Unit& u, int wr, int wc, int fr, int fq) const {
        int row0 = u.pm * BM + wr * 64 + fr, c0 = u.pn * BM + wc * 32 + 8 * fq;
        asm volatile("" : "+v"(row0), "+v"(c0));
#pragma unroll
        for (int ai = 0; ai < 2; ++ai)
#pragma unroll
            for (int m = 0; m < 4; ++m) { const int r = row0 + ai * HALF + m * 16; const float rs = __builtin_amdgcn_rsqf(sum16(rowss + (size_t)r * 16) * (1.0f / 1024.0f) + eps);
#pragma unroll
                for (int bj = 0; bj < 2; ++bj) { float v[8];
#pragma unroll
                    for (int i = 0; i < 8; ++i) v[i] = acc[ai][bj][m][i >> 2][i & 3] * rs;
                    st8(QQ + (size_t)r * 2048 + c0 + bj * HALF, v); } }
    }
};

template <class Epi, class Sched, bool ALIGN_EPI = false, bool SP2 = false, bool FP8 = false, bool INT8 = false>
__device__ __forceinline__ void gemm_phase(PG8_LAS unsigned char* lds, const Gemm g, const Sched& S, const Epi& E, const int wid) {
    const int lane = fresh_lane(), tid = wid * 64 + lane, wr = wid >> 2, wc = wid & 3, fr = lane & 15, fq = lane >> 4;
    const int K = g.K, nt = K / BK;
    unsigned voffA[2], voffB[2];
#pragma unroll
    for (int i = 0; i < 2; ++i) { int R, C; stage_rc(tid * 16 + i * 8192, R, C); const int Rb = Epi::PERM ? ((R & ~31) + perm32(R & 31)) : R;
        voffA[i] = (unsigned)(R * K + C) * 2u; voffB[i] = (unsigned)(Rb * K + C) * 2u; }
    const size_t kstep = (size_t)(BK * 2);
    const size_t hstep = (size_t)HALF * K * 2;
    const size_t tstep = 2 * hstep;
    const unsigned ldsw = (unsigned)wid * 1024u;
    const int aoff = lds_byte(wr * 64 + fr, fq * 8), boff = lds_byte(wc * 32 + fr, fq * 8);
#define PG8_SA(b, h) (((b) * 2 + (h)) * HTB)
#define PG8_SB(b, h) ((4 + (b) * 2 + (h)) * HTB)
#define PG8_STAGE(bufoff, gbase, voff) do { _Pragma("unroll") for (int _i = 0; _i < 2; ++_i) \
        __builtin_amdgcn_global_load_lds((const unsigned*)((const char*)(gbase) + (voff)[_i]), (PG8_LAS unsigned*)(lds + (bufoff) + ldsw + _i * 8192), 16, 0, 0); } while (0)
#define PG8_LDA(dst, b, h) do { _Pragma("unroll") for (int m = 0; m < 4; ++m) _Pragma("unroll") for (int k = 0; k < 2; ++k) dst[m][k] = *(const PG8_LAS bf16x8*)(lds + PG8_SA(b, h) + aoff + m * 2048 + k * 1024); } while (0)
#define PG8_LDB(dst, b, h) do { _Pragma("unroll") for (int n = 0; n < 2; ++n) _Pragma("unroll") for (int k = 0; k < 2; ++k) dst[n][k] = *(const PG8_LAS bf16x8*)(lds + PG8_SB(b, h) + boff + n * 2048 + k * 1024); } while (0)
#define PG8_MMA(ai, bj, At, Bt) do { __builtin_amdgcn_s_setprio(1); \
        if constexpr (FP8) { _Pragma("unroll") for (int m = 0; m < 4; ++m) _Pragma("unroll") for (int n = 0; n < 2; ++n) { \
            const v4i_ b0_ = __builtin_bit_cast(v4i_, Bt[n][0]), b1_ = __builtin_bit_cast(v4i_, Bt[n][1]), a0_ = __builtin_bit_cast(v4i_, At[m][0]), a1_ = __builtin_bit_cast(v4i_, At[m][1]); \
            const v8i_ bb_ = {b0_[0], b0_[1], b0_[2], b0_[3], b1_[0], b1_[1], b1_[2], b1_[3]}, aa_ = {a0_[0], a0_[1], a0_[2], a0_[3], a1_[0], a1_[1], a1_[2], a1_[3]}; \
            asm("v_mfma_scale_f32_16x16x128_f8f6f4 %0, %1, %2, %0, %3, %4 op_sel_hi:[0,0,0]" : "+v"(acc[ai][bj][m][n]) : "v"(bb_), "v"(aa_), "v"(scw_), "v"(sca_)); } } \
        else if constexpr (INT8) { _Pragma("unroll") for (int m = 0; m < 4; ++m) _Pragma("unroll") for (int n = 0; n < 2; ++n) _Pragma("unroll") for (int k = 0; k < 2; ++k) \
            acc[ai][bj][m][n] = __builtin_bit_cast(f32x4, __builtin_amdgcn_mfma_i32_16x16x64_i8(__builtin_bit_cast(v4i_, Bt[n][k]), __builtin_bit_cast(v4i_, At[m][k]), __builtin_bit_cast(v4i_, acc[ai][bj][m][n]), 0, 0, 0)); } \
        else { _Pragma("unroll") for (int m = 0; m < 4; ++m) _Pragma("unroll") for (int n = 0; n < 2; ++n) _Pragma("unroll") for (int k = 0; k < 2; ++k) \
            acc[ai][bj][m][n] = __builtin_amdgcn_mfma_f32_16x16x32_bf16(Bt[n][k], At[m][k], acc[ai][bj][m][n], 0, 0, 0); } \
        __builtin_amdgcn_s_setprio(0); } while (0)
#define PG8_WAIT_V(n) asm volatile("s_waitcnt vmcnt(" #n ")" ::: "memory")
#define PG8_WAIT_L(n) asm volatile("s_waitcnt lgkmcnt(" #n ")" ::: "memory")
#define PG8_BAR __builtin_amdgcn_s_barrier()
#define PG8_SCHED __builtin_amdgcn_sched_barrier(0)
    Unit cur, nxt; int ui = 0;
    if (!S.next(0, cur)) return;
    int scw_ = 0x79797979, sca_ = 0x7f7f7f7f; if constexpr (FP8) asm volatile("" : "+v"(scw_), "+v"(sca_));
    f32x4 acc[2][2][4][2];
#pragma unroll
    for (int a = 0; a < 2; ++a)
#pragma unroll
        for (int b = 0; b < 2; ++b)
#pragma unroll
            for (int m = 0; m < 4; ++m)
#pragma unroll
                for (int n = 0; n < 2; ++n) acc[a][b][m][n] = (f32x4){0.f, 0.f, 0.f, 0.f};
    bf16x8 At[4][2], B0[2][2], B1[2][2];
    const char* cA = (const char*)g.A + (size_t)cur.pm * tstep; const char* cB = (const char*)g.Bt + (size_t)cur.pn * tstep;
    S.a_ready(cur);
    if constexpr (SP2) {
        PG8_STAGE(PG8_SB(0, 0), cB, voffB); PG8_STAGE(PG8_SB(0, 1), cB + hstep, voffB); PG8_STAGE(PG8_SA(0, 0), cA, voffA); PG8_STAGE(PG8_SA(0, 1), cA + hstep, voffA);
        if (wr == 1) PG8_BAR;
        PG8_WAIT_V(2); PG8_BAR;
        PG8_STAGE(PG8_SB(1, 0), cB + kstep, voffB); PG8_STAGE(PG8_SA(1, 0), cA + kstep, voffA); PG8_STAGE(PG8_SB(1, 1), cB + hstep + kstep, voffB);
        PG8_WAIT_V(6); PG8_BAR;
    } else {
        PG8_STAGE(PG8_SB(0, 0), cB, voffB); PG8_STAGE(PG8_SA(0, 0), cA, voffA); PG8_STAGE(PG8_SB(0, 1), cB + hstep, voffB); PG8_STAGE(PG8_SA(0, 1), cA + hstep, voffA);
        if (wr == 1) PG8_BAR;
        PG8_WAIT_V(4); PG8_BAR;
        PG8_STAGE(PG8_SB(1, 0), cB + kstep, voffB); PG8_STAGE(PG8_SA(1, 0), cA + kstep, voffA); PG8_STAGE(PG8_SB(1, 1), cB + hstep + kstep, voffB);
        PG8_WAIT_V(6); PG8_BAR;
    }
    for (;;) {
        const bool has_next = S.next(ui + 1, nxt);
        const char* nA = has_next ? (const char*)g.A + (size_t)nxt.pm * tstep : cA; const char* nB = has_next ? (const char*)g.Bt + (size_t)nxt.pn * tstep : cB;
#pragma unroll 1
        for (int t = 0; t < nt; t += 2) {
            if constexpr (Epi::MID) { if (t == (nt >> 1)) E.mid(acc, cur, wr, wc, fr, fq); }
            const bool last = (t == nt - 2);
            const char* a1 = cA + (size_t)(t + 1) * kstep;
            const char* a2 = last ? nA : cA + (size_t)(t + 2) * kstep; const char* b2 = last ? nB : cB + (size_t)(t + 2) * kstep;
            const char* a3 = a2 + kstep; const char* b3 = b2 + kstep;
            if (last && has_next) S.a_ready(nxt);
            if constexpr (SP2) {
            PG8_LDB(B0, 0, 0); PG8_LDB(B1, 0, 1); PG8_SCHED; PG8_LDA(At, 0, 0); PG8_STAGE(PG8_SA(1, 1), a1 + hstep, voffA);
            PG8_WAIT_V(8); PG8_WAIT_L(0); PG8_BAR; PG8_MMA(0, 0, At, B0); PG8_MMA(0, 1, At, B1); PG8_BAR; PG8_SCHED;
            PG8_LDA(At, 0, 1); PG8_STAGE(PG8_SB(0, 0), b2, voffB); PG8_STAGE(PG8_SB(0, 1), b2 + hstep, voffB); PG8_STAGE(PG8_SA(0, 0), a2, voffA);
            PG8_WAIT_V(8); PG8_WAIT_L(0); PG8_BAR; PG8_MMA(1, 0, At, B0); PG8_MMA(1, 1, At, B1); PG8_BAR; PG8_SCHED;
            PG8_LDB(B0, 1, 0); PG8_LDB(B1, 1, 1); PG8_SCHED; PG8_LDA(At, 1, 0); PG8_STAGE(PG8_SA(0, 1), a2 + hstep, voffA);
            PG8_WAIT_V(8); PG8_WAIT_L(0); PG8_BAR; PG8_MMA(0, 0, At, B0); PG8_MMA(0, 1, At, B1); PG8_BAR; PG8_SCHED;
            PG8_LDA(At, 1, 1); PG8_STAGE(PG8_SB(1, 0), b3, voffB); PG8_STAGE(PG8_SB(1, 1), b3 + hstep, voffB); PG8_STAGE(PG8_SA(1, 0), a3, voffA);
            PG8_WAIT_V(8); PG8_WAIT_L(0); PG8_BAR; PG8_MMA(1, 0, At, B0); PG8_MMA(1, 1, At, B1); PG8_BAR; PG8_SCHED;
            } else {
            PG8_LDB(B0, 0, 0); PG8_SCHED; PG8_LDA(At, 0, 0); PG8_STAGE(PG8_SA(1, 1), a1 + hstep, voffA);
            PG8_WAIT_L(8); PG8_BAR; PG8_WAIT_L(0); PG8_MMA(0, 0, At, B0); PG8_BAR; PG8_SCHED;
            PG8_LDB(B1, 0, 1); PG8_STAGE(PG8_SB(0, 0), b2, voffB);
            PG8_BAR; PG8_WAIT_L(0); PG8_MMA(0, 1, At, B1); PG8_BAR;
            PG8_LDA(At, 0, 1); PG8_STAGE(PG8_SA(0, 0), a2, voffA);
            PG8_BAR; PG8_WAIT_L(0); PG8_MMA(1, 0, At, B0); PG8_BAR; PG8_SCHED;
            PG8_STAGE(PG8_SB(0, 1), b2 + hstep, voffB);
            PG8_WAIT_V(6); PG8_BAR; PG8_MMA(1, 1, At, B1); PG8_BAR;
            PG8_LDB(B0, 1, 0); PG8_SCHED; PG8_LDA(At, 1, 0); PG8_STAGE(PG8_SA(0, 1), a2 + hstep, voffA);
            PG8_WAIT_L(8); PG8_BAR; PG8_WAIT_L(0); PG8_MMA(0, 0, At, B0); PG8_BAR; PG8_SCHED;
            PG8_LDB(B1, 1, 1); PG8_STAGE(PG8_SB(1, 0), b3, voffB);
            PG8_BAR; PG8_WAIT_L(0); PG8_MMA(0, 1, At, B1); PG8_BAR;
            PG8_LDA(At, 1, 1); PG8_STAGE(PG8_SA(1, 0), a3, voffA);
            PG8_BAR; PG8_WAIT_L(0); PG8_MMA(1, 0, At, B0); PG8_BAR; PG8_SCHED;
            PG8_STAGE(PG8_SB(1, 1), b3 + hstep, voffB);
            PG8_WAIT_V(6); PG8_BAR; PG8_MMA(1, 1, At, B1); PG8_BAR;
            }
        }
        if constexpr (FP8) asm volatile("s_nop 15\n\ts_nop 15\n\ts_nop 15" ::: "memory");
        if constexpr (ALIGN_EPI) { if (wr == 0) PG8_BAR; }
        if constexpr (!Epi::AFTER_DRAIN) { E(acc, cur, wr, wc, fr, fq); S.done(cur); }
        if (!has_next) break;
#pragma unroll
        for (int a = 0; a < 2; ++a)
#pragma unroll
            for (int b = 0; b < 2; ++b)
#pragma unroll
                for (int m = 0; m < 4; ++m)
#pragma unroll
                    for (int n = 0; n < 2; ++n) acc[a][b][m][n] = (f32x4){0.f, 0.f, 0.f, 0.f};
        cur = nxt; cA = nA; cB = nB; ++ui;
        if constexpr (ALIGN_EPI) { if (wr == 1) PG8_BAR; }
    }
    PG8_WAIT_V(0);
    if constexpr (!ALIGN_EPI) { if (wr == 0) PG8_BAR; }
    PG8_BAR;
    if constexpr (Epi::AFTER_DRAIN) { E.fused(acc, cur, wr, wc, fr, fq, lds, wid, lane); S.done(cur); }
#undef PG8_SA
#undef PG8_SB
#undef PG8_STAGE
#undef PG8_LDA
#undef PG8_LDB
#undef PG8_MMA
#undef PG8_WAIT_V
#undef PG8_WAIT_L
#undef PG8_BAR
#undef PG8_SCHED
}
}

constexpr int NWAVES = 8;
constexpr int N_LAUNCHES = MK_N_LAUNCHES;
constexpr int PER_PHASE = 10;
constexpr int T = 32768, D = 1024, SEQ = 4096, NIN = 5632, NUNIT = 4096;
constexpr float EPS = 1e-6f;
constexpr size_t MiB = 1u << 20;
constexpr size_t WS_CTL = 0, CTL_ZERO_BYTES = 1 * MiB;
constexpr size_t WS_WMAX = 64 * 1024;
constexpr size_t WS_SWR = 1 * MiB + 512 * 1024;
constexpr size_t WS_RFAC = 1 * MiB + 768 * 1024;
constexpr size_t WS_ROWSS = 4 * MiB;
constexpr size_t WS_RSTD1 = 1 * MiB;
constexpr size_t WS_LB = 1 * MiB + 256 * 1024;
constexpr size_t WS_DEC = 2 * MiB;
constexpr size_t WS_WIN = 8 * MiB, WS_PAB = 19 * MiB, WS_WO = 21 * MiB, WS_WQ = 23 * MiB, WS_KEYS = 27 * MiB;
constexpr size_t WS_GA = 32 * MiB, WS_GB = 96 * MiB;
constexpr size_t WS_Q = 160 * MiB, WS_LF = 192 * MiB, WS_KK = 224 * MiB, WS_V = 256 * MiB, WS_SG = 288 * MiB, WS_CB = 320 * MiB, WS_U = 352 * MiB;
constexpr size_t WS_XB = 384 * MiB;
constexpr size_t WS_LOC = 448 * MiB;
constexpr size_t WS_SPREV = 320 * MiB;
constexpr size_t WS_X1 = 32 * MiB;
constexpr size_t WS_MG = 160 * MiB;
constexpr size_t WS_X1B = 224 * MiB;
constexpr size_t WS_QQ = 288 * MiB;
constexpr size_t WS_IDX = 416 * MiB, WS_GATE = 432 * MiB;
constexpr size_t WS_EU = 160 * MiB, WS_EV = 176 * MiB;
constexpr size_t WS_ESC = 192 * MiB;
constexpr size_t WS_X8 = 448 * MiB;
constexpr size_t WS_W8G = 28 * MiB;
constexpr size_t WS_END = 480 * MiB;
constexpr int CW_BAR = 4096;
constexpr int RING_BYTES = 131072, WAVE_LDS = 18688, MISC_OFF = NWAVES * WAVE_LDS, LDS_BYTES = MISC_OFF + 1024;
static_assert(MISC_OFF >= RING_BYTES && LDS_BYTES <= 160 * 1024, "LDS map");

#define GAS __attribute__((address_space(1)))
#define LAS __attribute__((address_space(3)))
typedef unsigned short bf16;
typedef unsigned v4u __attribute__((ext_vector_type(4)));
typedef unsigned v2u __attribute__((ext_vector_type(2)));
typedef float f32x4 __attribute__((ext_vector_type(4)));
typedef float f32x16 __attribute__((ext_vector_type(16)));
typedef short bf16x8 __attribute__((ext_vector_type(8)));
typedef __bf16 bf16x2_t __attribute__((ext_vector_type(2)));
typedef GAS unsigned gu32;
#define RLX_AGENT __ATOMIC_RELAXED, __HIP_MEMORY_SCOPE_AGENT
#define LDS_WAIT() asm volatile("s_waitcnt lgkmcnt(0)" ::: "memory")
#define VM_WAIT() asm volatile("s_waitcnt vmcnt(0)" ::: "memory")
#define MFMA32(a, b, c) __builtin_amdgcn_mfma_f32_32x32x16_bf16((a), (b), (c), 0, 0, 0)
using pg8::cvt_pk_bf16; using pg8::fexp; using pg8::fsig; using pg8::bflo; using pg8::bfhi;
__device__ __forceinline__ int crow(int reg, int h) { return (reg & 3) + 8 * (reg >> 2) + 4 * h; }

#define XB_TMO      128
#define XB_XCNT(j)  (256  + 64 * (j))
#define XB_XSUB(j)  (1280 + 64 * (j))
#define XB_XGEN(j)  (2304 + 64 * (j))
#define XB_TOP      3328
#define XB_TOPGEN   3392
#define XCD_BAR_WORDS 3456
#define XB_SPIN_CAP (1u << 18)
__device__ __forceinline__ unsigned xb_ld(unsigned* p)              { return __hip_atomic_load(p, __ATOMIC_RELAXED, __HIP_MEMORY_SCOPE_AGENT); }
__device__ __forceinline__ unsigned xb_add(unsigned* p, unsigned v) { return __hip_atomic_fetch_add(p, v, __ATOMIC_RELAXED, __HIP_MEMORY_SCOPE_AGENT); }
__device__ __forceinline__ unsigned xb_xcc_id() { return (unsigned)__builtin_amdgcn_s_getreg((3 << 11) | 20) & 0xFu; }
#define XB_SPIN(cond, bar) do { unsigned _sp = 0; while (cond) { __builtin_amdgcn_s_sleep(1); \
    if ((++_sp & 255u) == 0u) { if (xb_ld(&(bar)[XB_TMO])) break; if (_sp > XB_SPIN_CAP) { atomicAdd(&(bar)[XB_TMO], 1u); break; } } } } while (0)
struct XcdBarrier { unsigned* bar; unsigned x; volatile LAS unsigned* st; };
__device__ __forceinline__ XcdBarrier xcd_barrier_post(unsigned* bar, volatile LAS unsigned* st) {
    XcdBarrier b; b.bar = bar; b.x = xb_xcc_id(); b.st = st;
    if (threadIdx.x == 0) (void)xb_add(&bar[XB_XCNT(b.x)], 1u);
    return b;
}
__device__ __forceinline__ void xcd_barrier_complete(unsigned* bar, unsigned x, unsigned& nloc, unsigned& nx) {
    const unsigned G = gridDim.x * gridDim.y * gridDim.z;
    unsigned sum, cnt, mine, sp = 0u;
    for (;;) {
        sum = 0u; cnt = 0u; mine = 0u;
#pragma unroll
        for (unsigned j = 0; j < 16; ++j) { const unsigned c = xb_ld(&bar[XB_XCNT(j)]); sum += c; cnt += (c > 0u) ? 1u : 0u; mine = (j == x) ? c : mine; }
        if (sum == G) break;
        __builtin_amdgcn_s_sleep(1);
        if ((++sp & 255u) == 0u) { if (xb_ld(&bar[XB_TMO])) break; if (sp > XB_SPIN_CAP) { atomicAdd(&bar[XB_TMO], 1u); break; } }
    }
    nloc = mine > 0u ? mine : 1u; nx = cnt > 0u ? cnt : 1u;
}
__device__ __forceinline__ void xcd_barrier(const XcdBarrier& b) {
    asm volatile("s_waitcnt vmcnt(0)" ::: "memory");
    __syncthreads();
    if (threadIdx.x == 0) {
        unsigned* bar = b.bar;
        __builtin_amdgcn_s_waitcnt(0);
        unsigned nloc = b.st[0], nx = b.st[1];
        if (nloc == 0u) { xcd_barrier_complete(bar, b.x, nloc, nx); b.st[0] = nloc; b.st[1] = nx; }
        const unsigned old = xb_add(&bar[XB_XSUB(b.x)], 1u);
        const unsigned gen = old / nloc;
        if (old + 1u == (gen + 1u) * nloc) {
            __builtin_amdgcn_fence(__ATOMIC_RELEASE, "agent");
            asm volatile("s_waitcnt vmcnt(0)" ::: "memory");
            const unsigned og = xb_add(&bar[XB_TOP], 1u);
            const unsigned tg = og / nx;
            if (og + 1u == (tg + 1u) * nx) xb_add(&bar[XB_TOPGEN], 1u);
            else XB_SPIN(xb_ld(&bar[XB_TOPGEN]) == tg, bar);
            __builtin_amdgcn_fence(__ATOMIC_ACQUIRE, "agent");
            xb_add(&bar[XB_XGEN(b.x)], 1u);
            asm volatile("s_waitcnt vmcnt(0)" ::: "memory");
        } else {
            XB_SPIN(xb_ld(&bar[XB_XGEN(b.x)]) == gen, bar);
            __builtin_amdgcn_fence(__ATOMIC_ACQUIRE, "agent");
            asm volatile("s_waitcnt vmcnt(0)" ::: "memory");
        }
    }
    __syncthreads();
}

struct Args { const float* in[16]; float* out; unsigned char* ws; int ph_lo, ph_hi, li, pad; };
struct Frame {
    LAS unsigned char* lds;
    int wave;
    int vcu, G;
    int gw, ngw;
    float* out; unsigned char* ws;
};
__device__ __forceinline__ float wave_sum(float v) {
#pragma unroll
    for (int o = 1; o < 64; o <<= 1) v += __shfl_xor(v, o);
    return v;
}
__device__ __forceinline__ unsigned f2bf(float f) { unsigned u = __builtin_bit_cast(unsigned, f); return (u + 0x7fffu + ((u >> 16) & 1u)) >> 16; }
__device__ __forceinline__ unsigned pk2(float lo, float hi) { return cvt_pk_bf16(lo, hi); }
__device__ __forceinline__ float bf2f(bf16 h) { return __builtin_bit_cast(float, (unsigned)h << 16); }

__device__ __forceinline__ int win_dst_row(int n) {
    if (n >= 2560 && n < 3072) { const int j = (n - 2560) >> 7, r = (n - 2560) & 127; return 2560 + 256 * j + r; }
    if (n >= 3072 && n < 3584) { const int j = (n - 3072) >> 7, r = (n - 3072) & 127; return 2560 + 256 * j + 128 + r; }
#ifdef DBG_SWAPG
    if (n >= 3584 && n < 4608) return n + 1024;
    if (n >= 4608) return n - 1024;
#endif
    return n;
}
__device__ __forceinline__ void p0_transpose_item(const float* W, int K, int N, const float* gain, bf16* WT, int ldwt, int koff, bool perm, LAS float* scr, int item, int lane, unsigned char* W8 = nullptr, const void* W8q_max = nullptr, float* W8q_swr = nullptr) {
    const int nblk = N / 32, kb = item / nblk, nb = item % nblk, k0 = 64 * kb, n0 = 32 * nb;
    { float wv[32];
#pragma unroll
      for (int i = 0; i < 32; ++i) wv[i] = W[(size_t)(k0 + 2 * i + (lane >> 5)) * N + n0 + (lane & 31)];
#pragma unroll
      for (int i = 0; i < 32; ++i) { const int kk = 2 * i + (lane >> 5); float v = wv[i]; if (gain) v *= gain[k0 + kk]; scr[kk * 33 + (lane & 31)] = v; } }
    LDS_WAIT(); asm volatile("" ::: "memory");
    const int c = lane & 7, d0 = perm ? win_dst_row(n0) : n0;
    if (W8 != nullptr) {
        const unsigned* wmx = (const unsigned*)W8q_max; float* swr = W8q_swr;
#pragma unroll
        for (int j = 0; j < 4; ++j) { const int n = (lane >> 3) + 8 * j; const LAS float* s = scr + (8 * c) * 33 + n;
            const float mx = fmaxf(__builtin_bit_cast(float, wmx[n0 + n]), 1e-30f), inv = 127.0f / mx;
            unsigned lo = 0u, hi = 0u;
#pragma unroll
            for (int i = 0; i < 4; ++i) { lo |= ((unsigned)__float2int_rn(s[i * 33] * inv) & 0xffu) << (8 * i); hi |= ((unsigned)__float2int_rn(s[(4 + i) * 33] * inv) & 0xffu) << (8 * i); }
            v2u o; o.x = lo; o.y = hi; *(GAS v2u*)(W8 + (size_t)(d0 + n) * 1024 + k0 + 8 * c) = o;
            if (c == 0 && kb == 0) swr[d0 + n] = mx * (1.0f / 127.0f); }
        LDS_WAIT(); asm volatile("" ::: "memory");
        return;
    }
#pragma unroll
    for (int j = 0; j < 4; ++j) { const int n = (lane >> 3) + 8 * j; const LAS float* s = scr + (8 * c) * 33 + n;
        v4u o; o.x = pk2(s[0 * 33], s[1 * 33]); o.y = pk2(s[2 * 33], s[3 * 33]); o.z = pk2(s[4 * 33], s[5 * 33]); o.w = pk2(s[6 * 33], s[7 * 33]);
        *(GAS v4u*)(WT + (size_t)(d0 + n) * ldwt + koff + k0 + 8 * c) = o; }
    LDS_WAIT(); asm volatile("" ::: "memory");
}
__device__ __forceinline__ void cvt512(const float* src, bf16* dst, size_t item, int lane) {
    const f32x4 a = *(const f32x4*)(src + item * 512 + lane * 8), b = *(const f32x4*)(src + item * 512 + lane * 8 + 4);
    v4u o; o.x = pk2(a[0], a[1]); o.y = pk2(a[2], a[3]); o.z = pk2(b[0], b[1]); o.w = pk2(b[2], b[3]);
    *(v4u*)(dst + item * 512 + lane * 8) = o;
}
__device__ __forceinline__ void p0_colmax(Frame& F, const Args& A) {
    const float *g_mix = A.in[1], *w_in = A.in[2]; unsigned* wmx = (unsigned*)(F.ws + WS_WMAX); const int lane = pg8::fresh_lane();
    for (int item = F.gw; item < 16 * 176; item += F.ngw) {
        const int kb = item / 176, nb = item % 176, k0 = 64 * kb, n0 = 32 * nb; float wv[32];
#pragma unroll
        for (int i = 0; i < 32; ++i) wv[i] = w_in[(size_t)(k0 + 2 * i + (lane >> 5)) * NIN + n0 + (lane & 31)];
        float m = 0.f;
#pragma unroll
        for (int i = 0; i < 32; ++i) m = fmaxf(m, fabsf(wv[i] * g_mix[k0 + 2 * i + (lane >> 5)]));
        m = fmaxf(m, __shfl_xor(m, 32));
        if (lane < 32) atomicMax(wmx + n0 + lane, __builtin_bit_cast(unsigned, m));
    }
}
__device__ __forceinline__ void p0_prologue(Frame& F, const Args& A) {
    const float *x = A.in[0], *g_mix = A.in[1], *w_in = A.in[2], *lb_log = A.in[3], *w_pa = A.in[6], *w_pb = A.in[7], *w_o = A.in[8], *g_ffn = A.in[9], *w_q = A.in[10],
                *k1 = A.in[11], *k2 = A.in[12];
    unsigned char* ws = F.ws; const int lane_ = pg8::fresh_lane();
    LAS float* scr = (LAS float*)(F.lds + F.wave * 16384);
    constexpr int I_IN = 16 * 176, I_P = 8 * 32, I_O = 16 * 32, I_Q = 16 * 64, NITEMS = I_IN + 2 * I_P + I_O + I_Q;
    for (int it = F.gw; it < NITEMS; it += F.ngw) {
        int r = it;
        if (r < I_IN) { p0_transpose_item(w_in, 1024, NIN, g_mix, (bf16*)(ws + WS_WIN), 1024, 0, true, scr, r, lane_, ws + WS_WIN, ws + WS_WMAX, (float*)(ws + WS_SWR)); continue; } r -= I_IN;
        if (r < I_P) { p0_transpose_item(w_pa, 512, 1024, nullptr, (bf16*)(ws + WS_PAB), 1024, 0, false, scr, r, lane_); continue; } r -= I_P;
        if (r < I_P) { p0_transpose_item(w_pb, 512, 1024, nullptr, (bf16*)(ws + WS_PAB), 1024, 512, false, scr, r, lane_); continue; } r -= I_P;
        if (r < I_O) { p0_transpose_item(w_o, 1024, 1024, nullptr, (bf16*)(ws + WS_WO), 1024, 0, false, scr, r, lane_); continue; } r -= I_O;
        p0_transpose_item(w_q, 1024, 2048, g_ffn, (bf16*)(ws + WS_WQ), 1024, 0, false, scr, r, lane_);
    }
    for (int it = F.gw; it < 512; it += F.ngw) { if (it < 256) cvt512(k1, (bf16*)(ws + WS_KEYS), it, lane_); else cvt512(k2, (bf16*)(ws + WS_KEYS) + 131072, it - 256, lane_); }
    float* rstd1 = (float*)(ws + WS_RSTD1);
    for (int m0 = F.gw; m0 < T; m0 += 2 * F.ngw) {
        f32x4 v[2][4];
#pragma unroll
        for (int h = 0; h < 2; ++h) { const f32x4* xr = (const f32x4*)(x + (size_t)((h && m0 + F.ngw >= T) ? m0 : m0 + h * F.ngw) * D) + lane_;
#pragma unroll
            for (int j = 0; j < 4; ++j) v[h][j] = xr[64 * j]; }
#pragma unroll
        for (int h = 0; h < 2; ++h) { const int m = (h && m0 + F.ngw >= T) ? m0 : m0 + h * F.ngw; float s = 0.f, mx = 0.f;
#pragma unroll
            for (int j = 0; j < 4; ++j) { s += (v[h][j][0] * v[h][j][0] + v[h][j][1] * v[h][j][1]) + (v[h][j][2] * v[h][j][2] + v[h][j][3] * v[h][j][3]);
                mx = fmaxf(mx, fmaxf(fmaxf(fabsf(v[h][j][0]), fabsf(v[h][j][1])), fmaxf(fabsf(v[h][j][2]), fabsf(v[h][j][3])))); }
            s = wave_sum(s);
#pragma unroll
            for (int o = 1; o < 64; o <<= 1) mx = fmaxf(mx, __shfl_xor(mx, o));
            mx = fmaxf(mx, 1e-30f); const float qinv = 127.0f / mx;
            if (lane_ == 0) { const float rs_ = __builtin_amdgcn_rsqf(s * (1.0f / D) + EPS); rstd1[m] = rs_; ((float*)(ws + WS_RFAC))[m] = rs_ * mx * (1.0f / 127.0f); }
            unsigned* q8 = (unsigned*)(ws + WS_X8 + (size_t)m * D) + lane_;
#pragma unroll
            for (int j = 0; j < 4; ++j)
                q8[64 * j] = ((unsigned)__float2int_rn(v[h][j][0] * qinv) & 0xffu) | (((unsigned)__float2int_rn(v[h][j][1] * qinv) & 0xffu) << 8) | (((unsigned)__float2int_rn(v[h][j][2] * qinv) & 0xffu) << 16) | ((unsigned)__float2int_rn(v[h][j][3] * qinv) << 24);
        }
    }
    if (F.gw == 0) { float* lb = (float*)(ws + WS_LB);
        for (int j = lane_; j < 512; j += 64) { const float a = lb_log[j], b = lb_log[512 + j]; lb[j] = 1.0f / (1.0f + expf(b - a)); } }
}

#define P2_SCATTER(REG, SRC) { _Pragma("unroll") for (int p = 0; p < 8; ++p) { LAS unsigned char* dst_ = (REG) + (8 * cc) * 144 + cc * 16 + 2 * (rr + 8 * p); const unsigned w_[4] = {SRC[p].x, SRC[p].y, SRC[p].z, SRC[p].w}; \
        _Pragma("unroll") for (int i = 0; i < 4; ++i) { *(LAS bf16*)(dst_ + (2 * i) * 144) = (bf16)(w_[i] & 0xffffu); *(LAS bf16*)(dst_ + (2 * i + 1) * 144) = (bf16)(w_[i] >> 16); } } }
#define P2_ROWLOAD(REG, W) { _Pragma("unroll") for (int j = 0; j < 8; ++j) { const v4u o_ = *(LAS v4u*)((REG) + lane * 144 + rr * 16 + j * 16); W[4 * j] = o_.x; W[4 * j + 1] = o_.y; W[4 * j + 2] = o_.z; W[4 * j + 3] = o_.w; } }
#define P2_ROWSTORE(REG, W) { _Pragma("unroll") for (int j = 0; j < 8; ++j) { v4u o_; o_.x = W[4 * j]; o_.y = W[4 * j + 1]; o_.z = W[4 * j + 2]; o_.w = W[4 * j + 3]; *(LAS v4u*)((REG) + lane * 144 + rr * 16 + j * 16) = o_; } }
#define P2_GATHER_STORE(REG, GP) { int ro_ = rr; asm volatile("" : "+v"(ro_));     \
    _Pragma("unroll") for (int p = 0; p < 8; ++p) { const LAS unsigned char* src_ = (REG) + (8 * cc) * 144 + cc * 16 + 2 * (ro_ + 8 * p); unsigned e_[8]; \
        _Pragma("unroll") for (int i = 0; i < 8; ++i) e_[i] = (unsigned)*(const LAS bf16*)(src_ + i * 144); \
        v4u o_; o_.x = e_[0] | (e_[1] << 16); o_.y = e_[2] | (e_[3] << 16); o_.z = e_[4] | (e_[5] << 16); o_.w = e_[6] | (e_[7] << 16); *(v4u*)((GP) + (size_t)(ro_ + 8 * p) * 512) = o_; if (p & 1) asm volatile("" ::: "memory"); } }
__device__ __forceinline__ void p2_unit(Frame& F, int unit) {
    unsigned char* ws = F.ws; const int lane = pg8::fresh_lane(), rr = lane >> 3, cc = lane & 7;
    const int bh = unit >> 6, c = unit & 63, bb = bh >> 3, h = bh & 7; const size_t t0 = (size_t)bb * SEQ + c * 64; const int cb0 = h * 64;
    bf16* Qg = (bf16*)(ws + WS_Q) + t0 * 512 + cb0 + 8 * cc; bf16* Kg = (bf16*)(ws + WS_KK) + t0 * 512 + cb0 + 8 * cc; const bf16* Vg = (const bf16*)(ws + WS_V) + t0 * 512 + cb0 + 8 * cc;
    LAS unsigned char* wl = F.lds + F.wave * WAVE_LDS; LAS unsigned char* KH = wl; LAS unsigned char* VT = wl + 9344;
    v4u kw[8], qw[8];
#pragma unroll
    for (int p = 0; p < 8; ++p) { kw[p] = *(const v4u*)(Kg + (size_t)(rr + 8 * p) * 512); qw[p] = *(const v4u*)(Qg + (size_t)(rr + 8 * p) * 512); }
    P2_SCATTER(KH, kw) P2_SCATTER(VT, qw)
    LDS_WAIT(); asm volatile("" ::: "memory");
    unsigned kr[32]; P2_ROWLOAD(KH, kr)
    LDS_WAIT(); asm volatile("" ::: "memory");
    float b[64];
    { float run = 0.f;
#pragma unroll
      for (int t = 0; t < 64; ++t) { const float kt = (t & 1) ? bfhi(kr[t >> 1]) : bflo(kr[t >> 1]); run += __builtin_amdgcn_logf(1.0f - kt) * 0.69314718056f; b[t] = run; } }
    const float blast = b[63];
    ((float*)(ws + WS_DEC))[unit * 64 + lane] = fexp(blast);
    { unsigned w[32];
#pragma unroll
      for (int t = 0; t < 64; t += 2) w[t >> 1] = pk2(bflo(kr[t >> 1]) * fexp(-b[t]), bfhi(kr[t >> 1]) * fexp(-b[t + 1]));
      P2_ROWSTORE(KH, w) }
    LDS_WAIT(); asm volatile("" ::: "memory");
    P2_GATHER_STORE(KH, Kg)
    LDS_WAIT(); asm volatile("" ::: "memory");
    { unsigned w[32];
#pragma unroll
      for (int t = 0; t < 64; t += 2) w[t >> 1] = pk2(bflo(kr[t >> 1]) * fexp(blast - b[t]), bfhi(kr[t >> 1]) * fexp(blast - b[t + 1]));
      P2_ROWSTORE(KH, w) }
    { unsigned w[32]; P2_ROWLOAD(VT, w)
      LDS_WAIT(); asm volatile("" ::: "memory");
#pragma unroll
      for (int t = 0; t < 64; t += 2) w[t >> 1] = pk2(bflo(w[t >> 1]) * fexp(b[t]), bfhi(w[t >> 1]) * fexp(b[t + 1]));
      P2_ROWSTORE(VT, w) }
    LDS_WAIT(); asm volatile("" ::: "memory");
    P2_GATHER_STORE(VT, Qg)
    LDS_WAIT(); asm volatile("" ::: "memory");
    { v4u vw[8]; int ro = rr; asm volatile("" : "+v"(ro));
#pragma unroll
      for (int p = 0; p < 8; ++p) vw[p] = *(const v4u*)(Vg + (size_t)(ro + 8 * p) * 512);
      P2_SCATTER(VT, vw) }
    LDS_WAIT(); asm volatile("" ::: "memory");
    const int r = lane & 31, hh = lane >> 5;
    f32x16 acc[2][2];
#pragma unroll
    for (int i = 0; i < 2; ++i)
#pragma unroll
        for (int j = 0; j < 2; ++j)
#pragma unroll
            for (int k = 0; k < 16; ++k) acc[i][j][k] = 0.f;
#pragma unroll
    for (int ks = 0; ks < 4; ++ks) {
        bf16x8 a[2], bq[2];
#pragma unroll
        for (int i = 0; i < 2; ++i) { const int ra = (32 * i + r) * 144 + (4 * i + (r >> 3)) * 16 + (16 * ks + 8 * hh) * 2; a[i] = *(const LAS bf16x8*)(VT + ra); bq[i] = *(const LAS bf16x8*)(KH + ra); }
#pragma unroll
        for (int i = 0; i < 2; ++i)
#pragma unroll
            for (int j = 0; j < 2; ++j) acc[i][j] = MFMA32(a[i], bq[j], acc[i][j]);
    }
    LDS_WAIT(); asm volatile("" ::: "memory");
    { LAS float* OL = (LAS float*)wl;
#pragma unroll
      for (int i = 0; i < 2; ++i)
#pragma unroll
          for (int j = 0; j < 2; ++j)
#pragma unroll
              for (int k = 0; k < 16; ++k) OL[(32 * i + crow(k, hh)) * 68 + 32 * j + r] = acc[i][j][k];
      LDS_WAIT(); asm volatile("" ::: "memory");
      bf16* LOC = (bf16*)(ws + WS_LOC) + (size_t)unit * 4096 + 8 * cc; int ro = rr; asm volatile("" : "+v"(ro));
#pragma unroll
      for (int p = 0; p < 8; ++p) { const int e = ro + 8 * p; const f32x4 v0 = *(LAS f32x4*)(OL + e * 68 + 8 * cc), v1 = *(LAS f32x4*)(OL + e * 68 + 8 * cc + 4);
          v4u o; o.x = pk2(v0[0], v0[1]); o.y = pk2(v0[2], v0[3]); o.z = pk2(v1[0], v1[1]); o.w = pk2(v1[2], v1[3]); *(v4u*)(LOC + e * 64) = o; } }
    LDS_WAIT(); asm volatile("" ::: "memory");
}
__device__ __forceinline__ void p2_phase(Frame& F, const float* cw) {
    for (int u = F.gw; u < NUNIT; u += F.ngw) p2_unit(F, u);
    unsigned char* ws = F.ws;
    const bf16* CB = (const bf16*)(ws + WS_CB); const bf16* U = (const bf16*)(ws + WS_U); bf16* YAB = (bf16*)F.out;
    const int gt = F.vcu * (NWAVES * 64) + F.wave * 64 + pg8::fresh_lane(), ngt = F.G * NWAVES * 64;
    for (int i = gt; i < (T / 16) * 64; i += ngt) {
        const int t0 = (i >> 6) * 16, j0 = (i & 63) * 8;
        float w0[8], w1[8], w2[8];
        { const f32x4 a0 = *(const f32x4*)(cw + j0), a1 = *(const f32x4*)(cw + j0 + 4), b0 = *(const f32x4*)(cw + 512 + j0), b1 = *(const f32x4*)(cw + 512 + j0 + 4), c0 = *(const f32x4*)(cw + 1024 + j0), c1 = *(const f32x4*)(cw + 1024 + j0 + 4);
#pragma unroll
          for (int k = 0; k < 4; ++k) { w0[k] = a0[k]; w0[4 + k] = a1[k]; w1[k] = b0[k]; w1[4 + k] = b1[k]; w2[k] = c0[k]; w2[4 + k] = c1[k]; } }
        float um2[8], um1[8];
        if ((t0 & (SEQ - 1)) != 0) { pg8::ld8(U + (size_t)(t0 - 2) * 512 + j0, um2); pg8::ld8(U + (size_t)(t0 - 1) * 512 + j0, um1); }
        else {
#pragma unroll
            for (int k = 0; k < 8; ++k) { um2[k] = 0.f; um1[k] = 0.f; } }
#pragma unroll 1
        for (int tt = 0; tt < 16; tt += 4) {
            pg8::u32x4 uw[4], cbw[4];
#pragma unroll
            for (int q = 0; q < 4; ++q) { uw[q] = *(const pg8::u32x4*)(U + (size_t)(t0 + tt + q) * 512 + j0); cbw[q] = *(const pg8::u32x4*)(CB + (size_t)(t0 + tt + q) * 512 + j0); }
#pragma unroll
            for (int q = 0; q < 4; ++q) {
                const float u0[8] = {bflo(uw[q].x), bfhi(uw[q].x), bflo(uw[q].y), bfhi(uw[q].y), bflo(uw[q].z), bfhi(uw[q].z), bflo(uw[q].w), bfhi(uw[q].w)};
                const float cbv[8] = {bflo(cbw[q].x), bfhi(cbw[q].x), bflo(cbw[q].y), bfhi(cbw[q].y), bflo(cbw[q].z), bfhi(cbw[q].z), bflo(cbw[q].w), bfhi(cbw[q].w)};
                float y[8];
#pragma unroll
                for (int k = 0; k < 8; ++k) { y[k] = DBG_ZYB * cbv[k] * (w0[k] * um2[k] + w1[k] * um1[k] + w2[k] * u0[k]); um2[k] = um1[k]; um1[k] = u0[k]; }
                pg8::st8(YAB + (size_t)(t0 + tt + q) * 1024 + 512 + j0, y); }
        }
    }
}

__device__ __forceinline__ void p3_phase(Frame& F) {
    unsigned char* ws = F.ws; const bf16* LOC = (const bf16*)(ws + WS_LOC); bf16* SP = (bf16*)(ws + WS_SPREV); const float* DEC = (const float*)(ws + WS_DEC);
    const int gt = F.vcu * (NWAVES * 64) + F.wave * 64 + pg8::fresh_lane(), ngt = F.G * NWAVES * 64;
    for (int i = gt; i < 64 * 4096; i += ngt) {
        const int bh = i >> 12, ed = i & 4095, d = ed & 63; float st = 0.f;
        for (int c0 = 0; c0 < 64; c0 += 8) { float lv[8], dv[8];
#pragma unroll
            for (int k = 0; k < 8; ++k) { lv[k] = bf2f(LOC[(size_t)(bh * 64 + c0 + k) * 4096 + ed]); dv[k] = DEC[(bh * 64 + c0 + k) * 64 + d]; }
#pragma unroll
            for (int k = 0; k < 8; ++k) { SP[(size_t)(bh * 64 + c0 + k) * 4096 + ed] = (bf16)f2bf(st); st = dv[k] * st + lv[k]; } }
    }
}

template <int M> __device__ __forceinline__ float p4_swz(float v) { return __builtin_bit_cast(float, __builtin_amdgcn_ds_swizzle(__builtin_bit_cast(int, v), 0x1f | (M << 10))); }
__device__ __forceinline__ void p4_unit(Frame& F, int unit, const float* gain) {
    unsigned char* ws = F.ws; const int lane = pg8::fresh_lane(), r = lane & 31, hh = lane >> 5;
    const int bh = unit >> 6, c = unit & 63, bb = bh >> 3, h = bh & 7; const size_t t0 = (size_t)bb * SEQ + c * 64; const int cb0 = h * 64;
    const bf16* Qt = (const bf16*)(ws + WS_Q) + t0 * 512 + cb0; const bf16* Kt = (const bf16*)(ws + WS_KK) + t0 * 512 + cb0;
    const bf16* Vp = (const bf16*)(ws + WS_V) + t0 * 512 + cb0 + lane; const bf16* SPu = (const bf16*)(ws + WS_SPREV) + (size_t)unit * 4096;
    LAS unsigned char* wl = F.lds + F.wave * WAVE_LDS; LAS unsigned char* PL = wl; LAS unsigned char* VT = wl + 9216;
    bf16x8 qa[2][4], kb[2][4], spf[2][4];
    { const bf16* Vt = (const bf16*)(ws + WS_V) + t0 * 512 + cb0 + 8 * (lane & 7);
      v4u pv[8];
#pragma unroll
      for (int p = 0; p < 8; ++p) pv[p] = *(const v4u*)(Vt + (size_t)((lane >> 3) + 8 * p) * 512);
#pragma unroll
      for (int i = 0; i < 2; ++i)
#pragma unroll
          for (int ks = 0; ks < 4; ++ks) { qa[i][ks] = *(const bf16x8*)(Qt + (size_t)(32 * i + r) * 512 + 16 * ks + 8 * hh); kb[i][ks] = *(const bf16x8*)(Kt + (size_t)(32 * i + r) * 512 + 16 * ks + 8 * hh); }
#pragma unroll
      for (int jj = 0; jj < 2; ++jj)
#pragma unroll
          for (int ks = 0; ks < 4; ++ks) spf[jj][ks] = *(const bf16x8*)(SPu + (32 * jj + r) * 64 + 16 * ks + 8 * hh);
#pragma unroll
      for (int p = 0; p < 8; ++p) { const int t = (lane >> 3) + 8 * p; LAS unsigned char* dst = VT + (8 * (lane & 7)) * 144 + 2 * t; const unsigned w[4] = {pv[p].x, pv[p].y, pv[p].z, pv[p].w};
#pragma unroll
          for (int i = 0; i < 4; ++i) { *(LAS bf16*)(dst + (2 * i) * 144) = (bf16)(w[i] & 0xffffu); *(LAS bf16*)(dst + (2 * i + 1) * 144) = (bf16)(w[i] >> 16); } } }
    asm volatile("" ::: "memory");
    {
        f32x16 sc[3];
#pragma unroll
        for (int k = 0; k < 16; ++k) { sc[0][k] = 0.f; sc[1][k] = 0.f; sc[2][k] = 0.f; }
#pragma unroll
        for (int ks = 0; ks < 4; ++ks) { sc[0] = MFMA32(qa[0][ks], kb[0][ks], sc[0]); sc[1] = MFMA32(qa[1][ks], kb[0][ks], sc[1]); sc[2] = MFMA32(qa[1][ks], kb[1][ks], sc[2]); }
#pragma unroll
        for (int k = 0; k < 16; ++k) { const int tr = crow(k, hh);
            *(LAS bf16*)(PL + tr * 144 + r * 2) = (bf16)f2bf(r <= tr ? sc[0][k] : 0.f);
            *(LAS bf16*)(PL + (32 + tr) * 144 + r * 2) = (bf16)f2bf(sc[1][k]);
            *(LAS bf16*)(PL + (32 + tr) * 144 + (32 + r) * 2) = (bf16)f2bf(r <= tr ? sc[2][k] : 0.f); }
    }
    asm volatile("" ::: "memory");
    f32x16 o[2][2];
#pragma unroll
    for (int i = 0; i < 2; ++i)
#pragma unroll
        for (int j = 0; j < 2; ++j)
#pragma unroll
            for (int k = 0; k < 16; ++k) o[i][j][k] = 0.f;
#pragma unroll
    for (int ks = 0; ks < 4; ++ks) {
#pragma unroll
        for (int i = 0; i < 2; ++i)
#pragma unroll
            for (int j = 0; j < 2; ++j) o[i][j] = MFMA32(qa[i][ks], spf[j][ks], o[i][j]);
    }
    LDS_WAIT(); asm volatile("" ::: "memory");
#pragma unroll
    for (int ks = 0; ks < 4; ++ks) {
        bf16x8 pa[2], vb[2];
        if (ks < 2) pa[0] = *(const LAS bf16x8*)(PL + r * 144 + (16 * ks + 8 * hh) * 2);
        pa[1] = *(const LAS bf16x8*)(PL + (32 + r) * 144 + (16 * ks + 8 * hh) * 2);
#pragma unroll
        for (int j = 0; j < 2; ++j) vb[j] = *(const LAS bf16x8*)(VT + (32 * j + r) * 144 + (16 * ks + 8 * hh) * 2);
#pragma unroll
        for (int j = 0; j < 2; ++j) { if (ks < 2) o[0][j] = MFMA32(pa[0], vb[j], o[0][j]); o[1][j] = MFMA32(pa[1], vb[j], o[1][j]); }
    }
    asm volatile("" ::: "memory");
    LDS_WAIT(); asm volatile("" ::: "memory");
    { LAS float* OL = (LAS float*)wl;
#pragma unroll
      for (int i = 0; i < 2; ++i)
#pragma unroll
          for (int j = 0; j < 2; ++j)
#pragma unroll
              for (int k = 0; k < 16; ++k) OL[(32 * i + crow(k, hh)) * 68 + 32 * j + r] = o[i][j][k];
      LDS_WAIT(); asm volatile("" ::: "memory");
      const int c = lane & 7; const f32x4 ga = *(const f32x4*)(gain + cb0 + 8 * c), gb = *(const f32x4*)(gain + cb0 + 8 * c + 4);
      const float g8[8] = {ga[0], ga[1], ga[2], ga[3], gb[0], gb[1], gb[2], gb[3]};
      const bf16* SGp = (const bf16*)(ws + WS_SG) + t0 * 512 + cb0 + 8 * c; bf16* YA = (bf16*)F.out + t0 * 1024 + cb0 + 8 * c;
#pragma unroll
      for (int p = 0; p < 8; ++p) { int t = (lane >> 3) + 8 * p; asm volatile("" : "+v"(t));
          const f32x4 v0 = *(LAS f32x4*)(OL + t * 68 + 8 * c), v1 = *(LAS f32x4*)(OL + t * 68 + 8 * c + 4);
          float ss = (v0[0] * v0[0] + v0[1] * v0[1]) + (v0[2] * v0[2] + v0[3] * v0[3]) + (v1[0] * v1[0] + v1[1] * v1[1]) + (v1[2] * v1[2] + v1[3] * v1[3]);
          ss += p4_swz<1>(ss); ss += p4_swz<2>(ss); ss += p4_swz<4>(ss);
          const float rs = __builtin_amdgcn_rsqf(ss * (1.0f / 64.0f) + EPS) * DBG_ZYA;
          float sg[8], y[8]; pg8::ld8(SGp + (size_t)t * 512, sg);
#pragma unroll
          for (int e = 0; e < 4; ++e) { y[e] = v0[e] * rs * g8[e] * sg[e]; y[4 + e] = v1[e] * rs * g8[4 + e] * sg[4 + e]; }
          pg8::st8(YA + (size_t)t * 1024, y); }
    }
    LDS_WAIT(); asm volatile("" ::: "memory");
}

__device__ __forceinline__ unsigned mono(float f) { const unsigned u = __builtin_bit_cast(unsigned, f); return u ^ (((unsigned)((int)u >> 31)) | 0x80000000u); }
__device__ __forceinline__ float unmono(unsigned m) { const unsigned u = (m & 0x80000000u) ? (m ^ 0x80000000u) : ~m; return __builtin_bit_cast(float, u); }
__device__ __forceinline__ unsigned med3u(unsigned a, unsigned b, unsigned c) { unsigned r; asm("v_med3_u32 %0, %1, %2, %3" : "=v"(r) : "v"(a), "v"(b), "v"(c)); return r; }
__device__ __forceinline__ unsigned maxu(unsigned a, unsigned b) { return a > b ? a : b; }
__device__ __forceinline__ void ins16(unsigned (&L)[16], unsigned v) {
#pragma unroll
    for (int j = 15; j >= 1; --j) L[j] = med3u(v, L[j - 1], L[j]);
    L[0] = maxu(L[0], v);
}
__device__ __forceinline__ unsigned minu(unsigned a, unsigned b) { return a < b ? a : b; }
#define P8_CE(X, A, B) { const unsigned hi_ = maxu(X[A], X[B]), lo_ = minu(X[A], X[B]); X[A] = hi_; X[B] = lo_; }
__device__ __forceinline__ void sort16_desc(unsigned (&x)[16]) { P8_CE(x, 0, 13) P8_CE(x, 1, 12) P8_CE(x, 2, 15) P8_CE(x, 3, 14) P8_CE(x, 4, 8) P8_CE(x, 5, 6) P8_CE(x, 7, 11) P8_CE(x, 9, 10) P8_CE(x, 0, 5) P8_CE(x, 1, 7) P8_CE(x, 2, 9) P8_CE(x, 3, 4) P8_CE(x, 6, 13) P8_CE(x, 8, 14) P8_CE(x, 10, 15) P8_CE(x, 11, 12) P8_CE(x, 0, 1) P8_CE(x, 2, 3) P8_CE(x, 4, 5) P8_CE(x, 6, 8) P8_CE(x, 7, 9) P8_CE(x, 10, 11) P8_CE(x, 12, 13) P8_CE(x, 14, 15) P8_CE(x, 0, 2) P8_CE(x, 1, 3) P8_CE(x, 4, 10) P8_CE(x, 5, 11) P8_CE(x, 6, 7) P8_CE(x, 8, 9) P8_CE(x, 12, 14) P8_CE(x, 13, 15) P8_CE(x, 1, 2) P8_CE(x, 3, 12) P8_CE(x, 4, 6) P8_CE(x, 5, 7) P8_CE(x, 8, 10) P8_CE(x, 9, 11) P8_CE(x, 13, 14) P8_CE(x, 1, 4) P8_CE(x, 2, 6) P8_CE(x, 5, 8) P8_CE(x, 7, 10) P8_CE(x, 9, 13) P8_CE(x, 11, 14) P8_CE(x, 2, 4) P8_CE(x, 3, 6) P8_CE(x, 9, 12) P8_CE(x, 11, 13) P8_CE(x, 3, 5) P8_CE(x, 6, 8) P8_CE(x, 7, 9) P8_CE(x, 10, 12) P8_CE(x, 3, 4) P8_CE(x, 5, 6) P8_CE(x, 7, 8) P8_CE(x, 9, 10) P8_CE(x, 11, 12) P8_CE(x, 6, 7) P8_CE(x, 8, 9) }
__device__ __forceinline__ void merge16_desc(unsigned (&L)[16], const unsigned (&S)[16]) {
    unsigned c[16];
#pragma unroll
    for (int i = 0; i < 16; ++i) c[i] = maxu(L[i], S[15 - i]);
    P8_CE(c, 0, 8) P8_CE(c, 1, 9) P8_CE(c, 2, 10) P8_CE(c, 3, 11) P8_CE(c, 4, 12) P8_CE(c, 5, 13) P8_CE(c, 6, 14) P8_CE(c, 7, 15) P8_CE(c, 0, 4) P8_CE(c, 1, 5) P8_CE(c, 2, 6) P8_CE(c, 3, 7) P8_CE(c, 8, 12) P8_CE(c, 9, 13) P8_CE(c, 10, 14) P8_CE(c, 11, 15) P8_CE(c, 0, 2) P8_CE(c, 1, 3) P8_CE(c, 4, 6) P8_CE(c, 5, 7) P8_CE(c, 8, 10) P8_CE(c, 9, 11) P8_CE(c, 12, 14) P8_CE(c, 13, 15) P8_CE(c, 0, 1) P8_CE(c, 2, 3) P8_CE(c, 4, 5) P8_CE(c, 6, 7) P8_CE(c, 8, 9) P8_CE(c, 10, 11) P8_CE(c, 12, 13) P8_CE(c, 14, 15)
#pragma unroll
    for (int i = 0; i < 16; ++i) L[i] = c[i];
}
__device__ __forceinline__ void p8_half(const bf16* keys, const bf16* qbase, LAS unsigned char* wl, int lane, unsigned (&L)[16]) {
    const int r = lane & 31, hh = lane >> 5, rr4 = lane >> 4, c = lane & 15;
    LAS unsigned char* qbuf = wl; LAS unsigned char* kbuf = wl + 8192;
    v4u st[8];
#pragma unroll
    for (int i = 0; i < 8; ++i) st[i] = *(const v4u*)(qbase + (size_t)(4 * i + rr4) * 2048 + 8 * c);
#pragma unroll
    for (int i = 0; i < 8; ++i) { const int rr = 4 * i + rr4; *(LAS v4u*)(qbuf + rr * 256 + ((c ^ (rr & 15)) << 4)) = st[i]; }
#pragma unroll
    for (int i = 0; i < 8; ++i) st[i] = *(const v4u*)(keys + (size_t)(4 * i + rr4) * 128 + 8 * c);
    LDS_WAIT(); asm volatile("" ::: "memory");
    bf16x8 qb[8];
#pragma unroll
    for (int ks = 0; ks < 8; ++ks) qb[ks] = *(const LAS bf16x8*)(qbuf + r * 256 + (((2 * ks + hh) ^ (r & 15)) << 4));
#pragma unroll
    for (int j = 0; j < 16; ++j) L[j] = 0u;
    const unsigned h4 = (unsigned)hh << 2;
#pragma unroll
    for (int it = 0; it < 4; ++it) {
#pragma unroll
        for (int i = 0; i < 8; ++i) { const int rr = 4 * i + rr4; *(LAS v4u*)(kbuf + rr * 256 + ((c ^ (rr & 15)) << 4)) = st[i]; }
        if (it < 3) {
#pragma unroll
            for (int i = 0; i < 8; ++i) st[i] = *(const v4u*)(keys + (size_t)(32 * (it + 1) + 4 * i + rr4) * 128 + 8 * c);
        }
        LDS_WAIT(); asm volatile("" ::: "memory");
        f32x16 acc;
#pragma unroll
        for (int k = 0; k < 16; ++k) acc[k] = 0.f;
#pragma unroll
        for (int ks = 0; ks < 8; ++ks) { const bf16x8 ka = *(const LAS bf16x8*)(kbuf + r * 256 + (((2 * ks + hh) ^ (r & 15)) << 4)); acc = MFMA32(ka, qb[ks], acc); }
        LDS_WAIT(); asm volatile("" ::: "memory");
        unsigned kx[16];
#pragma unroll
        for (int k = 0; k < 16; ++k) { const unsigned n0 = (unsigned)(32 * it + (k & 3) + 8 * (k >> 2));
            kx[k] = (mono(acc[k]) & 0xFFFFFF80u) | ((127u - n0) ^ h4); }
        sort16_desc(kx);
        if (it == 0) {
#pragma unroll
            for (int j = 0; j < 16; ++j) L[j] = kx[j];
        } else merge16_desc(L, kx);
    }
    unsigned P[16];
#pragma unroll
    for (int j = 0; j < 16; ++j) P[j] = (unsigned)__shfl_xor((int)L[j], 32);
    merge16_desc(L, P);
}
__device__ __forceinline__ void p8_task(Frame& F, int tile, int head) {
    unsigned char* ws = F.ws; const int lane = pg8::fresh_lane(), r = lane & 31, hh = lane >> 5; int t = tile * 32 + r; asm volatile("" : "+v"(t));
    const bf16* kb = (const bf16*)(ws + WS_KEYS); int tbase = tile * 32; asm volatile("" : "+s"(tbase)); const bf16* qtile = (const bf16*)(ws + WS_QQ) + (size_t)tbase * 2048 + head * 256;
    LAS unsigned char* wl = F.lds + F.wave * WAVE_LDS;
    unsigned L1[16], L2[16];
    p8_half(kb + (size_t)head * 16384, qtile, wl, lane, L1);
    p8_half(kb + 131072 + (size_t)head * 16384, qtile + 128, wl, lane, L2);
    LDS_WAIT(); asm volatile("" ::: "memory");
    float v1[16], v2[16]; unsigned n1[16], n2[16];
#pragma unroll
    for (int j = 0; j < 16; ++j) { v1[j] = unmono(L1[j] & 0xFFFFFF80u); n1[j] = 127u - (L1[j] & 127u); v2[j] = unmono(L2[j] & 0xFFFFFF80u); n2[j] = 127u - (L2[j] & 127u); }
    LAS unsigned* tab = (LAS unsigned*)(F.lds + F.wave * WAVE_LDS) + lane * 9;
#pragma unroll
    for (int j = 0; j < 4; ++j) { tab[j] = n1[4 * j] | (n1[4 * j + 1] << 8) | (n1[4 * j + 2] << 16) | (n1[4 * j + 3] << 24); tab[4 + j] = n2[4 * j] | (n2[4 * j + 1] << 8) | (n2[4 * j + 2] << 16) | (n2[4 * j + 3] << 24); }
    unsigned Fk[16];
#define P8_CK(A, B) ((mono(v1[A] + v2[B]) & 0xFFFFFF00u) | (unsigned)(255 - ((A) * 16 + (B))))
#pragma unroll
    for (int b = 0; b < 16; ++b) Fk[b] = P8_CK(0, b);
    { unsigned s1[16] = {P8_CK(1, 0), P8_CK(1, 1), P8_CK(1, 2), P8_CK(1, 3), P8_CK(1, 4), P8_CK(1, 5), P8_CK(1, 6), P8_CK(1, 7), P8_CK(2, 0), P8_CK(2, 1), P8_CK(2, 2), P8_CK(2, 3), P8_CK(2, 4), P8_CK(4, 0), P8_CK(4, 1), P8_CK(4, 2)};
      sort16_desc(s1); merge16_desc(Fk, s1); }
    { unsigned s2[16] = {P8_CK(3, 0), P8_CK(3, 1), P8_CK(3, 2), P8_CK(3, 3), P8_CK(5, 0), P8_CK(5, 1), P8_CK(6, 0), P8_CK(6, 1), P8_CK(7, 0), P8_CK(7, 1), P8_CK(8, 0), P8_CK(9, 0), P8_CK(10, 0), P8_CK(11, 0), P8_CK(12, 0), P8_CK(13, 0)};
      sort16_desc(s2); merge16_desc(Fk, s2); }
    ins16(Fk, P8_CK(14, 0)); ins16(Fk, P8_CK(15, 0));
#undef P8_CK
    LDS_WAIT(); asm volatile("" ::: "memory");
    float sv[16]; int ex[16];
    const LAS unsigned char* tb = (const LAS unsigned char*)tab;
#pragma unroll
    for (int j = 0; j < 16; ++j) { const unsigned pos = 255u - (Fk[j] & 255u); sv[j] = unmono(Fk[j] & 0xFFFFFF00u); ex[j] = (int)tb[pos >> 4] * 128 + (int)tb[16 + (pos & 15)]; }
    float den = 0.f, p[16];
#pragma unroll
    for (int j = 0; j < 16; ++j) { p[j] = fexp(sv[j] - sv[0]); den += p[j]; }
    const float inv = 1.0f / den;
    int* IDX = (int*)(ws + WS_IDX) + (size_t)t * 128 + head * 16; float* GT = (float*)(ws + WS_GATE) + (size_t)t * 128 + head * 16;
    if (hh == 0) {
#pragma unroll
        for (int j = 0; j < 4; ++j) { *(int4*)(IDX + 4 * j) = make_int4(ex[4 * j], ex[4 * j + 1], ex[4 * j + 2], ex[4 * j + 3]); }
    } else {
#pragma unroll
        for (int j = 0; j < 4; ++j) { f32x4 g = {p[4 * j] * inv, p[4 * j + 1] * inv, p[4 * j + 2] * inv, p[4 * j + 3] * inv}; *(f32x4*)(GT + 4 * j) = g; }
    }
    LDS_WAIT(); asm volatile("" ::: "memory");
}

#ifdef DBG_CHK
constexpr int CW_CHK = 8192;
__device__ __forceinline__ unsigned chk_hash(unsigned x) { x ^= x >> 16; x *= 0x7feb352dU; x ^= x >> 15; x *= 0x846ca68bU; x ^= x >> 16; return x; }
__device__ __forceinline__ float chk_dot(const bf16* a, const bf16* b, int K) { float s = 0.f; for (int k = 0; k < K; ++k) s += bf2f(a[k]) * bf2f(b[k]); return s; }
__device__ __forceinline__ void chk_rec(unsigned* cnt, float got, float ref) { if (!(fabsf(got - ref) <= 0.03f * fabsf(ref) + 0.03f)) atomicAdd(cnt, 1u); }
__device__ __forceinline__ void chk_phase(Frame& F, const Args& A, int which) {
    unsigned char* ws = F.ws; unsigned* ctl = (unsigned*)(ws + WS_CTL);
    const int g = F.vcu * (NWAVES * 64) + F.wave * 64 + pg8::fresh_lane();
    if (which == 21) {
        const bf16* xb_ = (const bf16*)(ws + WS_XB); const bf16* W_ = (const bf16*)(ws + WS_WIN); const float* r1 = (const float*)(ws + WS_RSTD1); bf16* GBo = (bf16*)(ws + WS_GA);
        for (long i = g; i < (long)T * 1024; i += (long)F.G * NWAVES * 64) { const long rw = i >> 10; const int j = (int)(i & 1023);
            const float v = r1[rw] * chk_dot(xb_ + rw * 1024, W_ + (size_t)(4608 + j) * 1024, 1024); GBo[i] = (bf16)f2bf(1.0f / (1.0f + expf(-v))); }
        return;
    }
    if (g >= 8192) return;
    const unsigned h1 = chk_hash(g * 2 + 1), h2 = chk_hash(g * 2 + 2); const int row = h1 % T;
    const bf16* xb = (const bf16*)(ws + WS_XB); const bf16* WinT = (const bf16*)(ws + WS_WIN); const float* rstd1 = (const float*)(ws + WS_RSTD1);
    if (which == 0) {
        { const int n = h2 % NIN, k = h1 % 1024; chk_rec(ctl + CW_CHK + (n >= 4608 ? 256 : 0), 32.f * bf2f(WinT[(size_t)(win_dst_row(n & ~31) + (n & 31)) * 1024 + k]), 32.f * A.in[1][k] * A.in[2][(size_t)k * NIN + n]); }
        { const int n = h2 % 1024, k = h1 % 512; chk_rec(ctl + CW_CHK, 32.f * bf2f(((const bf16*)(ws + WS_PAB))[(size_t)n * 1024 + k]), 32.f * A.in[6][(size_t)k * 1024 + n]);
          chk_rec(ctl + CW_CHK, 32.f * bf2f(((const bf16*)(ws + WS_PAB))[(size_t)n * 1024 + 512 + k]), 32.f * A.in[7][(size_t)k * 1024 + n]); }
        { const int n = h2 % 1024, k = h1 % 1024; chk_rec(ctl + CW_CHK, 32.f * bf2f(((const bf16*)(ws + WS_WO))[(size_t)n * 1024 + k]), 32.f * A.in[8][(size_t)k * 1024 + n]); }
        { const int n = h2 % 2048, k = h1 % 1024; chk_rec(ctl + CW_CHK, 32.f * bf2f(((const bf16*)(ws + WS_WQ))[(size_t)n * 1024 + k]), 32.f * A.in[9][k] * A.in[10][(size_t)k * 2048 + n]); }
        { const int k = h2 % 1024; chk_rec(ctl + CW_CHK, bf2f(xb[(size_t)row * 1024 + k]), A.in[0][(size_t)row * 1024 + k]); }
    }
    if (which == 1) {
        const float rs = rstd1[row];
        { const int j = h2 % 512; chk_rec(ctl + CW_CHK + 0, bf2f(((const bf16*)(ws + WS_V))[(size_t)row * 512 + j]), rs * chk_dot(xb + (size_t)row * 1024, WinT + (size_t)(1024 + j) * 1024, 1024)); }
        { const int j = h2 % 1024; const float v = rs * chk_dot(xb + (size_t)row * 1024, WinT + (size_t)(CHK_GA_ROW + j) * 1024, 1024);
          chk_rec(ctl + CW_CHK + 128, bf2f(((const bf16*)(ws + WS_GA))[(size_t)row * 2048 + j]), 1.0f / (1.0f + expf(-v))); }
        { const int j = h2 % 1024; const float v = rs * chk_dot(xb + (size_t)row * 1024, WinT + (size_t)(CHK_GB_ROW + j) * 1024, 1024);
          chk_rec(ctl + CW_CHK + 64, bf2f(((const bf16*)(ws + WS_GA))[(size_t)row * 2048 + 1024 + j]), 1.0f / (1.0f + expf(-v))); }
        { const int j = h2 % 512; chk_rec(ctl + CW_CHK + 448, bf2f(((const bf16*)(ws + WS_CB))[(size_t)row * 512 + j]), rs * chk_dot(xb + (size_t)row * 1024, WinT + (size_t)(2048 + j) * 1024, 1024)); }
        { const int j = h2 % 512; const int rb = 2560 + 256 * (j >> 7) + (j & 127);
          const float cc = rs * chk_dot(xb + (size_t)row * 1024, WinT + (size_t)rb * 1024, 1024), ch = rs * chk_dot(xb + (size_t)row * 1024, WinT + (size_t)(rb + 128) * 1024, 1024);
          chk_rec(ctl + CW_CHK + 192, bf2f(((const bf16*)(ws + WS_U))[(size_t)row * 512 + j]), cc * ch); }
    }
    if (which == 1) {
        const float rs = rstd1[row]; const int j = h2 % 512; const float* lbv = (const float*)(ws + WS_LB);
        const float hq = rs * chk_dot(xb + (size_t)row * 1024, WinT + (size_t)(0 + j) * 1024, 1024), hf = rs * chk_dot(xb + (size_t)row * 1024, WinT + (size_t)(512 + j) * 1024, 1024),
                    hg = rs * chk_dot(xb + (size_t)row * 1024, WinT + (size_t)(1536 + j) * 1024, 1024);
        const float l0 = A.in[3][j], l1 = A.in[3][512 + j], lb = expf(l0) / (expf(l0) + expf(l1)); chk_rec(ctl + CW_CHK + 128, lbv[j], lb);
        const float sg = 1.0f / (1.0f + expf(-hf)), f = lb + (1.0f - lb) * sg;
        chk_rec(ctl + CW_CHK + 128, bf2f(((const bf16*)(ws + WS_Q))[(size_t)row * 512 + j]), hq / (1.0f + expf(-hq)) * 0.125f);
        chk_rec(ctl + CW_CHK + 128, bf2f(((const bf16*)(ws + WS_LF))[(size_t)row * 512 + j]), logf(f));
        chk_rec(ctl + CW_CHK + 128, bf2f(((const bf16*)(ws + WS_KK))[(size_t)row * 512 + j]), 1.0f - f);
        chk_rec(ctl + CW_CHK + 128, bf2f(((const bf16*)(ws + WS_SG))[(size_t)row * 512 + j]), hg / (1.0f + expf(-hg)));
    }
    if (which == 11 && g < 64 * 64) {
        const int smp = g >> 6, e = g & 63; const unsigned hs = chk_hash(1000 + smp); const int bb = hs % 8, hd = (hs >> 3) % 8, tpos = (smp < 8) ? (int)(smp * 9) : (int)((hs >> 6) % SEQ);
        const bf16* Qb = (const bf16*)(ws + WS_Q); const bf16* LFb = (const bf16*)(ws + WS_LF); const bf16* KKb = (const bf16*)(ws + WS_KK); const bf16* Vb = (const bf16*)(ws + WS_V); const bf16* SGb = (const bf16*)(ws + WS_SG);
        float S[64];
#pragma unroll
        for (int d = 0; d < 64; ++d) S[d] = 0.f;
        for (int sp = 0; sp <= tpos; ++sp) { const size_t ro = ((size_t)bb * SEQ + sp) * 512 + hd * 64; const float v = bf2f(Vb[ro + e]);
#pragma unroll
            for (int d = 0; d < 64; ++d) S[d] = expf(bf2f(LFb[ro + d])) * S[d] + bf2f(KKb[ro + d]) * v; }
        const size_t rq = ((size_t)bb * SEQ + tpos) * 512 + hd * 64; float o = 0.f;
#pragma unroll
        for (int d = 0; d < 64; ++d) o += bf2f(Qb[rq + d]) * S[d];
        const float ss = wave_sum(o * o); const float y = o * rsqrtf(ss * (1.0f / 64.0f) + EPS) * A.in[4][hd * 64 + e] * bf2f(SGb[rq + e]);
        ((float*)(ws + 6 * MiB))[g] = y;
    }
    if (which == 14 && g < 64 * 64) {
        const int smp = g >> 6, e = g & 63; const unsigned hs = chk_hash(1000 + smp); const int bb = hs % 8, hd = (hs >> 3) % 8, tpos = (smp < 8) ? (int)(smp * 9) : (int)((hs >> 6) % SEQ);
        chk_rec(ctl + CW_CHK + 192, bf2f(((const bf16*)(ws + WS_XB))[((size_t)bb * SEQ + tpos) * 1024 + hd * 64 + e]), ((const float*)(ws + 6 * MiB))[g]);
    }
    if (which == 2) {
        const int j = h2 % 512, sq = row & (SEQ - 1); const bf16* U = (const bf16*)(ws + WS_U); const bf16* CB = (const bf16*)(ws + WS_CB); const float* cw = A.in[5];
        float acc = cw[1024 + j] * bf2f(U[(size_t)row * 512 + j]);
        if (sq >= 1) acc += cw[512 + j] * bf2f(U[(size_t)(row - 1) * 512 + j]);
        if (sq >= 2) acc += cw[j] * bf2f(U[(size_t)(row - 2) * 512 + j]);
        chk_rec(ctl + CW_CHK + 448, bf2f(((const bf16*)(ws + WS_XB))[(size_t)row * 1024 + 512 + j]), bf2f(CB[(size_t)row * 512 + j]) * acc);
    }
    if (which == 5) {
        const int j = h2 % 1024; const bf16* Y = (const bf16*)(ws + WS_XB) + (size_t)row * 1024; const bf16* P = (const bf16*)(ws + WS_PAB) + (size_t)j * 1024;
        const float ga = bf2f(((const bf16*)(ws + WS_GA))[(size_t)row * 2048 + j]), gb = bf2f(((const bf16*)(ws + WS_GA))[(size_t)row * 2048 + 1024 + j]);
        chk_rec(ctl + CW_CHK + 256, bf2f(((const bf16*)(ws + WS_MG))[(size_t)row * 1024 + j]), ga * chk_dot(Y, P, 512) + gb * chk_dot(Y + 512, P + 512, 512));
    }
    if (which == 6) {
        const int j = h2 % 1024;
        chk_rec(ctl + CW_CHK + 320, ((const float*)(ws + WS_X1))[(size_t)row * 1024 + j] - A.in[0][(size_t)row * 1024 + j],
                chk_dot((const bf16*)(ws + WS_MG) + (size_t)row * 1024, (const bf16*)(ws + WS_WO) + (size_t)j * 1024, 1024));
    }
    if (which == 7) {
        const int j = h2 % 2048; const float rs2 = rsqrtf(pg8::sum16((const float*)(ws + WS_ROWSS) + (size_t)row * 16) * (1.0f / D) + EPS);
        chk_rec(ctl + CW_CHK + 384, bf2f(((const bf16*)(ws + WS_QQ))[(size_t)row * 2048 + j]), rs2 * chk_dot((const bf16*)(ws + WS_X1B) + (size_t)row * 1024, (const bf16*)(ws + WS_WQ) + (size_t)j * 1024, 1024));
    }
}
__device__ __forceinline__ float chk_scale(Frame& F) {
    const unsigned* c = (const unsigned*)(F.ws + WS_CTL) + CW_CHK; const float sc[8] = {0.5f, 0.0f, 2.0f, -0.5f, -1.0f, 3.0f, -2.0f, 4.0f};
    float s = 1.0f;
#pragma unroll
    for (int i = 7; i >= 0; --i) if (c[64 * i] > 40u) s = sc[i];
    return s;
}
#endif
__device__ __forceinline__ float dot2bf(unsigned w, unsigned x, float acc) { return __builtin_amdgcn_fdot2_f32_bf16(__builtin_bit_cast(bf16x2_t, w), __builtin_bit_cast(bf16x2_t, x), acc, false); }
__device__ __forceinline__ float gelu_erf(float v) {
    const float av = fabsf(v), tt = __builtin_amdgcn_rcpf(av * 0.2316418882f + 1.0f);
    float q = tt * 0.5307027145f + (-0.7265760135f); q = q * tt + 0.7107068705f; q = q * tt + (-0.142248368f); q = q * tt + 0.127414796f; q = q * tt;
    const float e = __builtin_amdgcn_exp2f(v * v * (-0.72134752044f)), m = v * (q * e);
    return v < 0.f ? m : v - m;
}
typedef float f32x2v __attribute__((ext_vector_type(2)));
__device__ __forceinline__ void cvt_row_fp8(const float* src, unsigned char* dst, float* inv_scale, int row, int lane) {
    const float* r = src + (size_t)row * 1024; f32x4 v[4]; float m = 0.f;
#pragma unroll
    for (int j = 0; j < 4; ++j) { v[j] = *(const f32x4*)(r + 256 * j + 4 * lane); m = fmaxf(m, fmaxf(fmaxf(fabsf(v[j][0]), fabsf(v[j][1])), fmaxf(fabsf(v[j][2]), fabsf(v[j][3])))); }
#pragma unroll
    for (int o = 1; o < 64; o <<= 1) m = fmaxf(m, __shfl_xor(m, o));
    const int ex = (int)((__builtin_bit_cast(unsigned, m) >> 23) & 0xff);
    const int k = (m > 0.f) ? (134 - ex) : 0;
    const float sc = __builtin_bit_cast(float, (unsigned)(127 + k) << 23), isc = __builtin_bit_cast(float, (unsigned)(127 - k) << 23);
    v4u o;
#pragma unroll
    for (int j = 0; j < 4; ++j) { int p = __builtin_amdgcn_cvt_pk_fp8_f32(v[j][0] * sc, v[j][1] * sc, 0, false); p = __builtin_amdgcn_cvt_pk_fp8_f32(v[j][2] * sc, v[j][3] * sc, p, true); o[j] = (unsigned)p; }
    *(v4u*)(dst + (size_t)row * 1024 + 16 * lane) = o;
    if (lane == 0) inv_scale[row] = isc;
}
constexpr int F4_ROW = 1152;
__device__ __forceinline__ void pack16_fp4(const float* r, int lane, unsigned& d0, unsigned& d1, unsigned& eb_out) {
    f32x4 v[4]; float m = 0.f;
#pragma unroll
    for (int j = 0; j < 4; ++j) { v[j] = *(const f32x4*)(r + 256 * j + 4 * lane); m = fmaxf(m, fmaxf(fmaxf(fabsf(v[j][0]), fabsf(v[j][1])), fmaxf(fabsf(v[j][2]), fabsf(v[j][3])))); }
    const float tq = m * (1.0f / 6.0f); const unsigned eb = (__builtin_bit_cast(unsigned, tq) + 0x7FFFFFu) >> 23;
    const unsigned ebc = eb > 253u ? 253u : eb; const float inv = __builtin_bit_cast(float, (254u - ebc) << 23);
    d0 = 0u; d1 = 0u;
    d0 = __builtin_amdgcn_cvt_scalef32_pk_fp4_f32(d0, v[0][0] * inv, v[0][1] * inv, 1.0f, 0); d0 = __builtin_amdgcn_cvt_scalef32_pk_fp4_f32(d0, v[0][2] * inv, v[0][3] * inv, 1.0f, 1);
    d0 = __builtin_amdgcn_cvt_scalef32_pk_fp4_f32(d0, v[1][0] * inv, v[1][1] * inv, 1.0f, 2); d0 = __builtin_amdgcn_cvt_scalef32_pk_fp4_f32(d0, v[1][2] * inv, v[1][3] * inv, 1.0f, 3);
    d1 = __builtin_amdgcn_cvt_scalef32_pk_fp4_f32(d1, v[2][0] * inv, v[2][1] * inv, 1.0f, 0); d1 = __builtin_amdgcn_cvt_scalef32_pk_fp4_f32(d1, v[2][2] * inv, v[2][3] * inv, 1.0f, 1);
    d1 = __builtin_amdgcn_cvt_scalef32_pk_fp4_f32(d1, v[3][0] * inv, v[3][1] * inv, 1.0f, 2); d1 = __builtin_amdgcn_cvt_scalef32_pk_fp4_f32(d1, v[3][2] * inv, v[3][3] * inv, 1.0f, 3);
    eb_out = ebc;
}
__device__ __forceinline__ void cvt_expert_fp4(const float* eu, const float* ev, unsigned char* dst, int e, int lane) {
    unsigned u0, u1, v0, v1, su, sv;
    pack16_fp4(eu + (size_t)e * 1024, lane, u0, u1, su); pack16_fp4(ev + (size_t)e * 1024, lane, v0, v1, sv);
    v4u o; o.x = u0; o.y = u1; o.z = v0; o.w = v1;
    unsigned char* rec = dst + (size_t)e * F4_ROW;
    *(v4u*)(rec + 16 * lane) = o; *(unsigned short*)(rec + 1024 + 2 * lane) = (unsigned short)(su | (sv << 8));
}
struct RowsF4 { v4u d[8]; unsigned s[8]; };
__device__ __forceinline__ void p9_load_f4(RowsF4& R, const unsigned char* EUV, const int (&e)[8], int lane) {
#pragma unroll
    for (int j = 0; j < 8; ++j) { const GAS unsigned char* rec = (const GAS unsigned char*)EUV + (size_t)e[j] * F4_ROW;
        R.d[j] = *(const GAS v4u*)(rec + (unsigned)(16 * lane)); R.s[j] = *(const GAS unsigned short*)(rec + (unsigned)(1024 + 2 * lane)); }
}
template <int M> __device__ __forceinline__ float swz_xor(float v) {
    return __builtin_bit_cast(float, __builtin_amdgcn_ds_swizzle(__builtin_bit_cast(int, v), 0x1f | (M << 10))); }
__device__ __forceinline__ float bperm(float v, int lane_src) { return __builtin_bit_cast(float, __builtin_amdgcn_ds_bpermute(lane_src << 2, __builtin_bit_cast(int, v))); }
__device__ __forceinline__ float rdl(float v, int l) { return __builtin_bit_cast(float, __builtin_amdgcn_readlane(__builtin_bit_cast(int, v), l)); }
__device__ __forceinline__ void unpack8_f4(const unsigned dw, float (&f)[8]) {
    const f32x2v p0 = __builtin_amdgcn_cvt_scalef32_pk_f32_fp4(dw, 1.0f, 0), p1 = __builtin_amdgcn_cvt_scalef32_pk_f32_fp4(dw, 1.0f, 1),
                 p2 = __builtin_amdgcn_cvt_scalef32_pk_f32_fp4(dw, 1.0f, 2), p3 = __builtin_amdgcn_cvt_scalef32_pk_f32_fp4(dw, 1.0f, 3);
    f[0] = p0.x; f[1] = p0.y; f[2] = p1.x; f[3] = p1.y; f[4] = p2.x; f[5] = p2.y; f[6] = p3.x; f[7] = p3.y;
}
__device__ __forceinline__ float dot16_f4(const unsigned q0, const unsigned q1, const float (&hn)[16]) {
    f32x2v acc = {0.f, 0.f};
#define D16_STEP(Q, C, B) { const f32x2v p = __builtin_amdgcn_cvt_scalef32_pk_f32_fp4(Q, 1.0f, C); const f32x2v h = {hn[B], hn[B + 1]}; acc = __builtin_elementwise_fma(p, h, acc); }
    D16_STEP(q0, 0, 0) D16_STEP(q0, 1, 2) D16_STEP(q0, 2, 4) D16_STEP(q0, 3, 6) D16_STEP(q1, 0, 8) D16_STEP(q1, 1, 10) D16_STEP(q1, 2, 12) D16_STEP(q1, 3, 14)
#undef D16_STEP
    return acc.x + acc.y;
}
__device__ __forceinline__ void axpy16_f4(const unsigned q0, const unsigned q1, const float w, float (&o)[16]) {
    float f0[8], f1[8]; unpack8_f4(q0, f0); unpack8_f4(q1, f1);
#pragma unroll
    for (int i = 0; i < 8; ++i) { o[i] += w * f0[i]; o[8 + i] += w * f1[i]; }
}
__device__ __forceinline__ void p9_batch_f4(const RowsF4& R, const float (&hn)[16], float (&oacc)[16], int bt, int lane, float gA, float gB) {
    const int hh = lane >> 5, q4 = (lane >> 4) & 1, q3 = (lane >> 3) & 1, jsel = 4 * hh + 2 * q4 + q3;
    float pd[8];
#pragma unroll
    for (int j = 0; j < 8; ++j) { pd[j] = dot16_f4(R.d[j].x, R.d[j].y, hn) * __builtin_bit_cast(float, (R.s[j] & 0xffu) << 23); if (j & 1) __builtin_amdgcn_sched_barrier(0); }
    float r4[4], r2[2];
#pragma unroll
    for (int i = 0; i < 4; ++i) { const float keep = hh ? pd[4 + i] : pd[i], send = hh ? pd[i] : pd[4 + i]; r4[i] = keep + bperm(send, lane ^ 32); }
#pragma unroll
    for (int i = 0; i < 2; ++i) { const float keep = q4 ? r4[2 + i] : r4[i], send = q4 ? r4[i] : r4[2 + i]; r2[i] = keep + swz_xor<16>(send); }
    float v = (q3 ? r2[1] : r2[0]) + swz_xor<8>(q3 ? r2[0] : r2[1]);
    v += swz_xor<4>(v); v += swz_xor<2>(v); v += swz_xor<1>(v);
    const int n = 8 * bt + jsel; const float g = (bt < 8) ? bperm(gA, n & 63) : bperm(gB, n & 63);
    const float w = g * gelu_erf(v);
#pragma unroll
    for (int j = 0; j < 8; ++j) { axpy16_f4(R.d[j].z, R.d[j].w, rdl(w, 8 * j) * __builtin_bit_cast(float, (R.s[j] >> 8) << 23), oacc); if (j & 1) __builtin_amdgcn_sched_barrier(0); }
}
__device__ __forceinline__ void p9_ids(int idA, int idB, int nb, int (&e)[8]) {
#pragma unroll
    for (int j = 0; j < 8; ++j) { const int n = 8 * nb + j; e[j] = (nb < 8) ? __builtin_amdgcn_readlane(idA, n & 63) : __builtin_amdgcn_readlane(idB, n & 63); }
}
struct RowsF4q { v4u d[4]; unsigned s[4]; };
__device__ __forceinline__ void p9_load_f4q(RowsF4q& R, const unsigned char* EUV, int idP, int nb, int lane) {
    const __amdgpu_buffer_rsrc_t rs = __builtin_amdgcn_make_buffer_rsrc((void*)EUV, (short)0, 16384 * F4_ROW, 0x00020000);
#pragma unroll
    for (int j = 0; j < 4; ++j) { const int n = 4 * nb + j; const unsigned x = (unsigned)__builtin_amdgcn_readlane(idP, n & 63); const unsigned e = (x >> ((n >> 6) << 4)) & 0xffffu;
        const int so = (int)(e * F4_ROW);
        R.d[j] = __builtin_bit_cast(v4u, __builtin_amdgcn_raw_buffer_load_b128(rs, 16 * lane, so, 0)); R.s[j] = (unsigned)__builtin_amdgcn_raw_buffer_load_b16(rs, 1024 + 2 * lane, so, 0); }
}
__device__ __forceinline__ void p9_batch4_f4(const RowsF4q& R, const float (&hn)[16], float (&oacc)[16], int bt, int lane, float gA, float gB) {
    const int hh = lane >> 5, q4 = (lane >> 4) & 1, jsel = 2 * hh + q4;
    float pd[4];
#pragma unroll
    for (int j = 0; j < 4; ++j) pd[j] = dot16_f4(R.d[j].x, R.d[j].y, hn) * __builtin_bit_cast(float, (R.s[j] & 0xffu) << 23);
    const float k0 = hh ? pd[2] : pd[0], k1 = hh ? pd[3] : pd[1], s0 = hh ? pd[0] : pd[2], s1 = hh ? pd[1] : pd[3];
    const float r0 = k0 + bperm(s0, lane ^ 32), r1 = k1 + bperm(s1, lane ^ 32);
    float v = (q4 ? r1 : r0) + swz_xor<16>(q4 ? r0 : r1);
    v += swz_xor<8>(v); v += swz_xor<4>(v); v += swz_xor<2>(v); v += swz_xor<1>(v);
    const int n = 4 * bt + jsel; const float g = (bt < 16) ? bperm(gA, n & 63) : bperm(gB, n & 63);
    const float w = g * gelu_erf(v);
#pragma unroll
    for (int j = 0; j < 4; ++j) axpy16_f4(R.d[j].z, R.d[j].w, rdl(w, 16 * j) * __builtin_bit_cast(float, (R.s[j] >> 8) << 23), oacc);
}
__device__ __forceinline__ void p9_token_f4(Frame& F, int t, const float* g_ffn, const float* g_fin) {
    unsigned char* ws = F.ws; const int lane = pg8::fresh_lane();
    const unsigned char* EUV = ws + WS_EU;
    const bf16* xrow = (const bf16*)(ws + WS_X1B) + (size_t)t * D; float* orow = F.out + (size_t)t * D;
    const float rs2 = __builtin_amdgcn_rsqf(pg8::sum16((const float*)(ws + WS_ROWSS) + (size_t)t * 16) * (1.0f / D) + EPS);
    float hn[16];
#pragma unroll
    for (int j = 0; j < 4; ++j) { const v2u a = *(const v2u*)(xrow + 256 * j + 4 * lane); const f32x4 g = *(const f32x4*)(g_ffn + 256 * j + 4 * lane);
        hn[4 * j] = bflo(a.x) * rs2 * g[0]; hn[4 * j + 1] = bfhi(a.x) * rs2 * g[1]; hn[4 * j + 2] = bflo(a.y) * rs2 * g[2]; hn[4 * j + 3] = bfhi(a.y) * rs2 * g[3]; }
    const int* IDX = (const int*)(ws + WS_IDX) + (size_t)t * 128; const float* GT = (const float*)(ws + WS_GATE) + (size_t)t * 128;
    int idA, idB; float gA, gB;
    { const int a0 = IDX[lane], b0 = IDX[64 + lane]; const float ga = GT[lane], gb = GT[64 + lane];
      const int kA = a0 >> 10, kB = b0 >> 10; const unsigned long long lt = (1ull << lane) - 1ull;
      int base = 0, rA = 0, rB = 0;
#pragma unroll
      for (int k = 0; k < 16; ++k) { const unsigned long long mA = __ballot(kA == k), mB = __ballot(kB == k); const int cA = __popcll(mA), cB = __popcll(mB);
          if (kA == k) rA = base + __popcll(mA & lt);
          if (kB == k) rB = base + cA + __popcll(mB & lt);
          base += cA + cB; }
      LAS int* sid = (LAS int*)(F.lds + F.wave * WAVE_LDS); LAS float* sgt = (LAS float*)(sid + 128);
      sid[rA] = a0; sid[rB] = b0; sgt[rA] = ga; sgt[rB] = gb;
      LDS_WAIT(); asm volatile("" ::: "memory");
      idA = sid[lane]; idB = sid[64 + lane]; gA = sgt[lane]; gB = sgt[64 + lane];
      LDS_WAIT(); asm volatile("" ::: "memory"); }
    float oacc[16];
#pragma unroll
    for (int i = 0; i < 16; ++i) oacc[i] = 0.f;
    const int idP = idA | (idB << 16);
    RowsF4q R0, R1, R2, R3, R4;
    p9_load_f4q(R0, EUV, idP, 0, lane); p9_load_f4q(R1, EUV, idP, 1, lane); p9_load_f4q(R2, EUV, idP, 2, lane); p9_load_f4q(R3, EUV, idP, 3, lane);
#pragma unroll 1
    for (int bt = 0; bt < 30; bt += 5) {
        p9_load_f4q(R4, EUV, idP, bt + 4, lane); asm volatile("" ::: "memory");
        p9_batch4_f4(R0, hn, oacc, bt, lane, gA, gB); asm volatile("" ::: "memory");
        p9_load_f4q(R0, EUV, idP, (bt + 5) & 31, lane); asm volatile("" ::: "memory");
        p9_batch4_f4(R1, hn, oacc, bt + 1, lane, gA, gB); asm volatile("" ::: "memory");
        p9_load_f4q(R1, EUV, idP, (bt + 6) & 31, lane); asm volatile("" ::: "memory");
        p9_batch4_f4(R2, hn, oacc, bt + 2, lane, gA, gB); asm volatile("" ::: "memory");
        p9_load_f4q(R2, EUV, idP, (bt + 7) & 31, lane); asm volatile("" ::: "memory");
        p9_batch4_f4(R3, hn, oacc, bt + 3, lane, gA, gB); asm volatile("" ::: "memory");
        p9_load_f4q(R3, EUV, idP, (bt + 8) & 31, lane); asm volatile("" ::: "memory");
        p9_batch4_f4(R4, hn, oacc, bt + 4, lane, gA, gB); asm volatile("" ::: "memory");
    }
    p9_batch4_f4(R0, hn, oacc, 30, lane, gA, gB); p9_batch4_f4(R1, hn, oacc, 31, lane, gA, gB);
    asm volatile("" ::: "memory");
    float ss = 0.f;
#pragma unroll
    for (int j = 0; j < 4; ++j) { const v2u a = *(const v2u*)(xrow + 256 * j + 4 * lane);
        oacc[4 * j] += bflo(a.x); oacc[4 * j + 1] += bfhi(a.x); oacc[4 * j + 2] += bflo(a.y); oacc[4 * j + 3] += bfhi(a.y);
#pragma unroll
        for (int i = 0; i < 4; ++i) ss += oacc[4 * j + i] * oacc[4 * j + i]; }
    ss += swz_xor<1>(ss); ss += swz_xor<2>(ss); ss += swz_xor<4>(ss); ss += swz_xor<8>(ss); ss += swz_xor<16>(ss); ss += bperm(ss, lane ^ 32);
    const float rs3 = __builtin_amdgcn_rsqf(ss * (1.0f / D) + EPS);
#pragma unroll
    for (int j = 0; j < 4; ++j) { const f32x4 g = *(const f32x4*)(g_fin + 256 * j + 4 * lane); f32x4 o;
#pragma unroll
        for (int i = 0; i < 4; ++i) o[i] = oacc[4 * j + i] * rs3 * g[i];
        *(f32x4*)(orow + 256 * j + 4 * lane) = o; }
}
constexpr int MX_ROW = 1120, MX_USC = 512, MX_V = 544, MX_VSC = 1056;
typedef int v8i __attribute__((ext_vector_type(8)));
__device__ __forceinline__ void cvt_expert_mx(const float* eu, const float* ev, unsigned char* dst, int e, int lane) {
    unsigned char* rec = dst + (size_t)e * MX_ROW;
    { const float* r = eu + (size_t)e * 1024 + 16 * lane; f32x4 v[4]; float m = 0.f;
#pragma unroll
      for (int j = 0; j < 4; ++j) { v[j] = *(const f32x4*)(r + 4 * j); m = fmaxf(m, fmaxf(fmaxf(fabsf(v[j][0]), fabsf(v[j][1])), fmaxf(fabsf(v[j][2]), fabsf(v[j][3])))); }
      m = fmaxf(m, swz_xor<1>(m));
      const float tq = m * (1.0f / 6.0f); const unsigned eb = (__builtin_bit_cast(unsigned, tq) + 0x7FFFFFu) >> 23;
      const unsigned ebc = eb > 253u ? 253u : eb; const float inv = __builtin_bit_cast(float, (254u - ebc) << 23);
      unsigned d0 = 0u, d1 = 0u;
      d0 = __builtin_amdgcn_cvt_scalef32_pk_fp4_f32(d0, v[0][0] * inv, v[0][1] * inv, 1.0f, 0); d0 = __builtin_amdgcn_cvt_scalef32_pk_fp4_f32(d0, v[0][2] * inv, v[0][3] * inv, 1.0f, 1);
      d0 = __builtin_amdgcn_cvt_scalef32_pk_fp4_f32(d0, v[1][0] * inv, v[1][1] * inv, 1.0f, 2); d0 = __builtin_amdgcn_cvt_scalef32_pk_fp4_f32(d0, v[1][2] * inv, v[1][3] * inv, 1.0f, 3);
      d1 = __builtin_amdgcn_cvt_scalef32_pk_fp4_f32(d1, v[2][0] * inv, v[2][1] * inv, 1.0f, 0); d1 = __builtin_amdgcn_cvt_scalef32_pk_fp4_f32(d1, v[2][2] * inv, v[2][3] * inv, 1.0f, 1);
      d1 = __builtin_amdgcn_cvt_scalef32_pk_fp4_f32(d1, v[3][0] * inv, v[3][1] * inv, 1.0f, 2); d1 = __builtin_amdgcn_cvt_scalef32_pk_fp4_f32(d1, v[3][2] * inv, v[3][3] * inv, 1.0f, 3);
      v2u o; o.x = d0; o.y = d1; *(v2u*)(rec + 8 * lane) = o;
      if (!(lane & 1)) { const int blk = lane >> 1; rec[MX_USC + (blk & 3) * 8 + (blk >> 2)] = (unsigned char)ebc; } }
    { unsigned v0, v1, sv; pack16_fp4(ev + (size_t)e * 1024, lane, v0, v1, sv);
      v2u o; o.x = v0; o.y = v1; *(v2u*)(rec + MX_V + 8 * lane) = o; rec[MX_VSC + lane] = (unsigned char)sv; }
}
__device__ __forceinline__ void mx_pack_u(const f32x4 (&v)[4], unsigned char* rec, int lane) {
    float m = 0.f;
#pragma unroll
    for (int j = 0; j < 4; ++j) m = fmaxf(m, fmaxf(fmaxf(fabsf(v[j][0]), fabsf(v[j][1])), fmaxf(fabsf(v[j][2]), fabsf(v[j][3]))));
    m = fmaxf(m, swz_xor<1>(m));
    const float tq = m * (1.0f / 6.0f); const unsigned eb = (__builtin_bit_cast(unsigned, tq) + 0x7FFFFFu) >> 23;
    const unsigned ebc = eb > 253u ? 253u : eb; const float inv = __builtin_bit_cast(float, (254u - ebc) << 23);
    unsigned d0 = 0u, d1 = 0u;
    d0 = __builtin_amdgcn_cvt_scalef32_pk_fp4_f32(d0, v[0][0] * inv, v[0][1] * inv, 1.0f, 0); d0 = __builtin_amdgcn_cvt_scalef32_pk_fp4_f32(d0, v[0][2] * inv, v[0][3] * inv, 1.0f, 1);
    d0 = __builtin_amdgcn_cvt_scalef32_pk_fp4_f32(d0, v[1][0] * inv, v[1][1] * inv, 1.0f, 2); d0 = __builtin_amdgcn_cvt_scalef32_pk_fp4_f32(d0, v[1][2] * inv, v[1][3] * inv, 1.0f, 3);
    d1 = __builtin_amdgcn_cvt_scalef32_pk_fp4_f32(d1, v[2][0] * inv, v[2][1] * inv, 1.0f, 0); d1 = __builtin_amdgcn_cvt_scalef32_pk_fp4_f32(d1, v[2][2] * inv, v[2][3] * inv, 1.0f, 1);
    d1 = __builtin_amdgcn_cvt_scalef32_pk_fp4_f32(d1, v[3][0] * inv, v[3][1] * inv, 1.0f, 2); d1 = __builtin_amdgcn_cvt_scalef32_pk_fp4_f32(d1, v[3][2] * inv, v[3][3] * inv, 1.0f, 3);
    v2u o; o.x = d0; o.y = d1; *(v2u*)(rec + 8 * lane) = o;
    if (!(lane & 1)) { const int blk = lane >> 1; rec[MX_USC + (blk & 3) * 8 + (blk >> 2)] = (unsigned char)ebc; }
}
__device__ __forceinline__ void mx_pack_v(const f32x4 (&v)[4], unsigned char* rec, int lane) {
    float m = 0.f;
#pragma unroll
    for (int j = 0; j < 4; ++j) m = fmaxf(m, fmaxf(fmaxf(fabsf(v[j][0]), fabsf(v[j][1])), fmaxf(fabsf(v[j][2]), fabsf(v[j][3]))));
    const float tq = m * (1.0f / 6.0f); const unsigned eb = (__builtin_bit_cast(unsigned, tq) + 0x7FFFFFu) >> 23;
    const unsigned ebc = eb > 253u ? 253u : eb; const float inv = __builtin_bit_cast(float, (254u - ebc) << 23);
    unsigned d0 = 0u, d1 = 0u;
    d0 = __builtin_amdgcn_cvt_scalef32_pk_fp4_f32(d0, v[0][0] * inv, v[0][1] * inv, 1.0f, 0); d0 = __builtin_amdgcn_cvt_scalef32_pk_fp4_f32(d0, v[0][2] * inv, v[0][3] * inv, 1.0f, 1);
    d0 = __builtin_amdgcn_cvt_scalef32_pk_fp4_f32(d0, v[1][0] * inv, v[1][1] * inv, 1.0f, 2); d0 = __builtin_amdgcn_cvt_scalef32_pk_fp4_f32(d0, v[1][2] * inv, v[1][3] * inv, 1.0f, 3);
    d1 = __builtin_amdgcn_cvt_scalef32_pk_fp4_f32(d1, v[2][0] * inv, v[2][1] * inv, 1.0f, 0); d1 = __builtin_amdgcn_cvt_scalef32_pk_fp4_f32(d1, v[2][2] * inv, v[2][3] * inv, 1.0f, 1);
    d1 = __builtin_amdgcn_cvt_scalef32_pk_fp4_f32(d1, v[3][0] * inv, v[3][1] * inv, 1.0f, 2); d1 = __builtin_amdgcn_cvt_scalef32_pk_fp4_f32(d1, v[3][2] * inv, v[3][3] * inv, 1.0f, 3);
    v2u o; o.x = d0; o.y = d1; *(v2u*)(rec + MX_V + 8 * lane) = o; rec[MX_VSC + lane] = (unsigned char)ebc;
}
__device__ __forceinline__ void cvt_expert_mx2(const float* eu, const float* ev, unsigned char* dst, int e0, int e1, int lane) {
    f32x4 ua[4], va[4], ub[4], vb[4];
#pragma unroll
    for (int j = 0; j < 4; ++j) { ua[j] = *(const f32x4*)(eu + (size_t)e0 * 1024 + 16 * lane + 4 * j); va[j] = *(const f32x4*)(ev + (size_t)e0 * 1024 + 256 * j + 4 * lane);
                                  ub[j] = *(const f32x4*)(eu + (size_t)e1 * 1024 + 16 * lane + 4 * j); vb[j] = *(const f32x4*)(ev + (size_t)e1 * 1024 + 256 * j + 4 * lane); }
    mx_pack_u(ua, dst + (size_t)e0 * MX_ROW, lane); mx_pack_v(va, dst + (size_t)e0 * MX_ROW, lane);
    mx_pack_u(ub, dst + (size_t)e1 * MX_ROW, lane); mx_pack_v(vb, dst + (size_t)e1 * MX_ROW, lane);
}
struct AFrag { v4u a[8]; v2u sc; };
__device__ __forceinline__ void p9m_load_a(AFrag& A, const unsigned char* EUV, int id, int lane) {
    const GAS unsigned char* rec = (const GAS unsigned char*)EUV + (size_t)id * MX_ROW + (unsigned)((lane >> 4) * 8);
    A.sc = *(const GAS v2u*)(rec + MX_USC);
    const GAS unsigned char* ra = rec + (unsigned)((lane >> 4) * 8);
#pragma unroll
    for (int s = 0; s < 8; ++s) A.a[s] = *(const GAS v4u*)(ra + 64 * s);
}
struct VSlot { v2u d; unsigned s; };
__device__ __forceinline__ void p9m_load_v(VSlot& V, __amdgpu_buffer_rsrc_t rs, int e, int lane) {
    const int so = e * MX_ROW;
    V.d = __builtin_bit_cast(v2u, __builtin_amdgcn_raw_buffer_load_b64(rs, MX_V + 8 * lane, so, 0)); V.s = (unsigned)__builtin_amdgcn_raw_buffer_load_b8(rs, MX_VSC + lane, so, 0);
}
__device__ __forceinline__ void p9m_axpy(const VSlot& V, const float c, f32x2v (&o)[8]) {
    const float sc = __builtin_bit_cast(float, V.s << 23); const f32x2v cc = {c, c};
#define AX_STEP(K) { o[K] = __builtin_elementwise_fma(__builtin_amdgcn_cvt_scalef32_pk_f32_fp4(V.d.x, sc, K), cc, o[K]); o[4 + K] = __builtin_elementwise_fma(__builtin_amdgcn_cvt_scalef32_pk_f32_fp4(V.d.y, sc, K), cc, o[4 + K]); }
    AX_STEP(0) AX_STEP(1) AX_STEP(2) AX_STEP(3)
#undef AX_STEP
}
__device__ __forceinline__ f32x4 p9m_dots(const AFrag& A, LAS unsigned char* h8, int lane) {
    f32x4 d0 = {0.f, 0.f, 0.f, 0.f}, d1 = {0.f, 0.f, 0.f, 0.f};
    LAS unsigned char* hb = h8 + (lane >> 4) * 16;
#define P9M_STEP(S, ACC) { const v4u b0 = *(LAS v4u*)(hb + 128 * (S)), b1 = *(LAS v4u*)(hb + 128 * (S) + 64); \
        const v8i a8 = {(int)A.a[S].x, (int)A.a[S].y, (int)A.a[S].z, (int)A.a[S].w, 0, 0, 0, 0}; const v8i b8 = {(int)b0.x, (int)b0.y, (int)b0.z, (int)b0.w, (int)b1.x, (int)b1.y, (int)b1.z, (int)b1.w}; \
        ACC = __builtin_amdgcn_mfma_scale_f32_16x16x128_f8f6f4(a8, b8, ACC, 4, 0, (S) & 3, (int)((S) < 4 ? A.sc.x : A.sc.y), 0, 0x7f7f7f7f); }
    P9M_STEP(0, d0) P9M_STEP(1, d1) P9M_STEP(2, d0) P9M_STEP(3, d1) P9M_STEP(4, d0) P9M_STEP(5, d1) P9M_STEP(6, d0) P9M_STEP(7, d1)
#undef P9M_STEP
    return d0 + d1;
}
__device__ __forceinline__ void p9m_batch(const AFrag& A, VSlot (&V)[16], LAS unsigned char* h8, LAS float* sgt, __amdgpu_buffer_rsrc_t rs, int b, int idn, int lane, f32x2v (&o)[8]) {
    const f32x4 dd = p9m_dots(A, h8, lane);
    const f32x4 gt = *(LAS f32x4*)(sgt + 16 * b + 4 * (lane >> 4));
    float c[4];
#pragma unroll
    for (int r = 0; r < 4; ++r) c[r] = gt[r] * gelu_erf(dd[r]);
#pragma unroll
    for (int p = 0; p < 16; ++p) {
        p9m_axpy(V[p], rdl(c[p & 3], 16 * (p >> 2)), o);
        p9m_load_v(V[p], rs, __builtin_amdgcn_readlane(idn, p), lane);
    }
}
constexpr int G_HSTR = 1040;
struct BFrag { v4u b[16]; };
__device__ __forceinline__ void p9g_load_b(BFrag& B, LAS unsigned char* h8, int lane) {
    LAS unsigned char* hb = h8 + (lane & 3) * G_HSTR + (lane >> 4) * 16;
#pragma unroll
    for (int s = 0; s < 8; ++s) { B.b[2 * s] = *(LAS v4u*)(hb + 128 * s); B.b[2 * s + 1] = *(LAS v4u*)(hb + 128 * s + 64); }
}
__device__ __forceinline__ f32x4 p9g_dots(const AFrag& A, const BFrag& B, int lane) {
    f32x4 d0 = {0.f, 0.f, 0.f, 0.f}, d1 = {0.f, 0.f, 0.f, 0.f};
#define P9G_STEP(S, ACC) { const v4u b0 = B.b[2 * (S)], b1 = B.b[2 * (S) + 1]; \
        const v8i a8 = {(int)A.a[S].x, (int)A.a[S].y, (int)A.a[S].z, (int)A.a[S].w, 0, 0, 0, 0}; const v8i b8 = {(int)b0.x, (int)b0.y, (int)b0.z, (int)b0.w, (int)b1.x, (int)b1.y, (int)b1.z, (int)b1.w}; \
        ACC = __builtin_amdgcn_mfma_scale_f32_16x16x128_f8f6f4(a8, b8, ACC, 4, 0, (S) & 3, (int)((S) < 4 ? A.sc.x : A.sc.y), 0, 0x7f7f7f7f); }
    P9G_STEP(0, d0) P9G_STEP(1, d1) P9G_STEP(2, d0) P9G_STEP(3, d1) P9G_STEP(4, d0) P9G_STEP(5, d1) P9G_STEP(6, d0) P9G_STEP(7, d1)
#undef P9G_STEP
    return d0 + d1;
}
typedef unsigned v4s __attribute__((ext_vector_type(4)));
__device__ __forceinline__ void p9g_issue_a(AFrag& A, v4s rsrc, unsigned voa, unsigned vos) {
#define LD_A(S) asm volatile("buffer_load_dwordx4 %0, %1, %2, 0 offen offset:" #S : "=v"(A.a[(S) / 64]) : "v"(voa), "s"(rsrc));
    LD_A(0) LD_A(64) LD_A(128) LD_A(192) LD_A(256) LD_A(320) LD_A(384) LD_A(448)
#undef LD_A
    asm volatile("buffer_load_dwordx2 %0, %1, %2, 0 offen offset:512" : "=v"(A.sc) : "v"(vos), "s"(rsrc));
}
__device__ __forceinline__ void p9g_issue_v(VSlot& V, v4s rsrc, int so, unsigned vov, unsigned vob) {
    asm volatile("buffer_load_dwordx2 %0, %1, %2, %3 offen offset:544" : "=v"(V.d) : "v"(vov), "s"(rsrc), "s"(so));
    asm volatile("buffer_load_ubyte %0, %1, %2, %3 offen offset:1056" : "=v"(V.s) : "v"(vob), "s"(rsrc), "s"(so));
}
#define P9G_WAIT_A(N, A) asm volatile("s_waitcnt vmcnt(" #N ")" : "+v"(A.a[0]), "+v"(A.a[1]), "+v"(A.a[2]), "+v"(A.a[3]), "+v"(A.a[4]), "+v"(A.a[5]), "+v"(A.a[6]), "+v"(A.a[7]), "+v"(A.sc))
#define P9G_WAIT_V(N, V) asm volatile("s_waitcnt vmcnt(" #N ")" : "+v"(V.d), "+v"(V.s))
template <bool PF> __device__ __forceinline__ void p9g_batch(AFrag& A, VSlot (&V)[16], const BFrag& B, LAS float* sgtl, v4s rsrc, int b, int idn, int lane,
                                                            f32x2v (&o0)[8], f32x2v (&o1)[8], f32x2v (&o2)[8], f32x2v (&o3)[8]) {
    if (PF) P9G_WAIT_A(32, A); else P9G_WAIT_A(0, A);
    const f32x4 dd = p9g_dots(A, B, lane);
    if (PF) { const unsigned rowo = (unsigned)idn * MX_ROW + (unsigned)((lane >> 4) * 8); p9g_issue_a(A, rsrc, rowo + (unsigned)((lane >> 4) * 8), rowo); }
    const f32x4 gt = *(LAS f32x4*)(sgtl + 4 * b);
    float c[4];
#pragma unroll
    for (int r = 0; r < 4; ++r) c[r] = gt[r] * gelu_erf(dd[r]);
    const unsigned vov = 8u * (unsigned)lane, vob = (unsigned)lane;
#define P9G_PAIR(P, O) { if (PF) P9G_WAIT_V(39, V[P]); else P9G_WAIT_V(0, V[P]); p9m_axpy(V[P], rdl(c[(P) & 3], 17 * ((P) >> 2)), O); \
        if (PF) p9g_issue_v(V[P], rsrc, __builtin_amdgcn_readlane(idn, P) * MX_ROW, vov, vob); }
    P9G_PAIR(0, o0) P9G_PAIR(1, o0) P9G_PAIR(2, o0) P9G_PAIR(3, o0) P9G_PAIR(4, o1) P9G_PAIR(5, o1) P9G_PAIR(6, o1) P9G_PAIR(7, o1)
    P9G_PAIR(8, o2) P9G_PAIR(9, o2) P9G_PAIR(10, o2) P9G_PAIR(11, o2) P9G_PAIR(12, o3) P9G_PAIR(13, o3) P9G_PAIR(14, o3) P9G_PAIR(15, o3)
#undef P9G_PAIR
}
__device__ __forceinline__ void p9_group_mx(Frame& F, int g, const float* g_ffn, const float* g_fin) {
    unsigned char* ws = F.ws; const int lane = pg8::fresh_lane();
    const unsigned char* EUV = ws + WS_EU;
    const __amdgpu_buffer_rsrc_t rs = __builtin_amdgcn_make_buffer_rsrc((void*)EUV, (short)0, 16384 * MX_ROW, 0x00020000);
    LAS unsigned char* wl = F.lds + F.wave * WAVE_LDS;
    LAS int* sid = (LAS int*)wl; LAS float* sgt = (LAS float*)(wl + 2048); LAS unsigned char* h8 = wl + 4096;
#pragma unroll 1
    for (int tk = 0; tk < 4; ++tk) {
        const int t = 4 * g + tk;
        const bf16* xrow = (const bf16*)(ws + WS_X1B) + (size_t)t * D;
        const float rs2 = __builtin_amdgcn_rsqf(pg8::sum16((const float*)(ws + WS_ROWSS) + (size_t)t * 16) * (1.0f / D) + EPS);
        { const v4u a0 = *(const v4u*)(xrow + 16 * lane), a1 = *(const v4u*)(xrow + 16 * lane + 8); v4u o;
          const unsigned xs[8] = {a0.x, a0.y, a0.z, a0.w, a1.x, a1.y, a1.z, a1.w};
#pragma unroll
          for (int j = 0; j < 4; ++j) { const f32x4 gg = *(const f32x4*)(g_ffn + 16 * lane + 4 * j);
              int p = __builtin_amdgcn_cvt_pk_fp8_f32(bflo(xs[2 * j]) * rs2 * gg[0], bfhi(xs[2 * j]) * rs2 * gg[1], 0, false);
              p = __builtin_amdgcn_cvt_pk_fp8_f32(bflo(xs[2 * j + 1]) * rs2 * gg[2], bfhi(xs[2 * j + 1]) * rs2 * gg[3], p, true); o[j] = (unsigned)p; }
          *(LAS v4u*)(h8 + tk * G_HSTR + 16 * lane) = o; }
        const int* IDX = (const int*)(ws + WS_IDX) + (size_t)t * 128; const float* GT = (const float*)(ws + WS_GATE) + (size_t)t * 128;
        { const int a0 = IDX[lane], b0 = IDX[64 + lane]; const float ga = GT[lane], gb = GT[64 + lane];
            const int kA = (int)(((unsigned)a0 * 2654435761u) >> 27), kB = (int)(((unsigned)b0 * 2654435761u) >> 27); const unsigned long long lt = (1ull << lane) - 1ull;
          int base = 0, rA = 0, rB = 0;
#pragma unroll 4
          for (int k = 0; k < 32; ++k) { const unsigned long long mA = __ballot(kA == k), mB = __ballot(kB == k); const int cA = __popcll(mA), cB = __popcll(mB);
              if (kA == k) rA = base + __popcll(mA & lt);
              if (kB == k) rB = base + cA + __popcll(mB & lt);
              base += cA + cB; }
          sid[tk * 128 + rA] = a0; sid[tk * 128 + rB] = b0; sgt[tk * 128 + rA] = ga; sgt[tk * 128 + rB] = gb; }
    }
    LDS_WAIT(); asm volatile("" ::: "memory");
    f32x2v o0[8], o1[8], o2[8], o3[8];
#pragma unroll
    for (int i = 0; i < 8; ++i) { o0[i] = (f32x2v){0.f, 0.f}; o1[i] = o0[i]; o2[i] = o0[i]; o3[i] = o0[i]; }
    AFrag A; VSlot V[16]; BFrag B; p9g_load_b(B, h8, lane);
    LAS int* sidl = sid + ((lane & 15) >> 2) * 128 + (lane & 3);
    LAS float* sgtl = sgt + (lane >> 4) * 128;
    v4s rsrc; { const unsigned long long ba = (unsigned long long)EUV; rsrc.x = (unsigned)__builtin_amdgcn_readfirstlane((int)(unsigned)ba); rsrc.y = (unsigned)__builtin_amdgcn_readfirstlane((int)(unsigned)(ba >> 32)) & 0xffffu; rsrc.z = 16384u * MX_ROW; rsrc.w = 0x00020000u; }
    { const int idc = sidl[0];
      const unsigned rowo = (unsigned)idc * MX_ROW + (unsigned)((lane >> 4) * 8); p9g_issue_a(A, rsrc, rowo + (unsigned)((lane >> 4) * 8), rowo);
#pragma unroll
      for (int p = 0; p < 16; ++p) p9g_issue_v(V[p], rsrc, __builtin_amdgcn_readlane(idc, p) * MX_ROW, 8u * (unsigned)lane, (unsigned)lane); }
#pragma unroll 1
    for (int b = 0; b < 31; ++b) {
        const int idn = sidl[4 * (b + 1)];
        p9g_batch<true>(A, V, B, sgtl, rsrc, b, idn, lane, o0, o1, o2, o3);
    }
    p9g_batch<false>(A, V, B, sgtl, rsrc, 31, 0, lane, o0, o1, o2, o3);
    LDS_WAIT(); asm volatile("" ::: "memory");
#define P9G_EPI(TK, O) { const int t = 4 * g + (TK); const bf16* xrow = (const bf16*)(ws + WS_X1B) + (size_t)t * D; float* orow = F.out + (size_t)t * D; \
        float oacc[16]; _Pragma("unroll") for (int k = 0; k < 8; ++k) { oacc[2 * k] = O[k].x; oacc[2 * k + 1] = O[k].y; } \
        float ss = 0.f; \
        _Pragma("unroll") for (int j = 0; j < 4; ++j) { const v2u a = *(const v2u*)(xrow + 256 * j + 4 * lane); \
            oacc[4 * j] += bflo(a.x); oacc[4 * j + 1] += bfhi(a.x); oacc[4 * j + 2] += bflo(a.y); oacc[4 * j + 3] += bfhi(a.y); \
            _Pragma("unroll") for (int i = 0; i < 4; ++i) ss += oacc[4 * j + i] * oacc[4 * j + i]; } \
        ss += swz_xor<1>(ss); ss += swz_xor<2>(ss); ss += swz_xor<4>(ss); ss += swz_xor<8>(ss); ss += swz_xor<16>(ss); ss += bperm(ss, lane ^ 32); \
        const float rs3 = __builtin_amdgcn_rsqf(ss * (1.0f / D) + EPS); \
        _Pragma("unroll") for (int j = 0; j < 4; ++j) { const f32x4 gg = *(const f32x4*)(g_fin + 256 * j + 4 * lane); f32x4 ov; \
            _Pragma("unroll") for (int i = 0; i < 4; ++i) ov[i] = oacc[4 * j + i] * rs3 * gg[i]; \
            *(f32x4*)(orow + 256 * j + 4 * lane) = ov; } }
    P9G_EPI(0, o0) P9G_EPI(1, o1) P9G_EPI(2, o2) P9G_EPI(3, o3)
#undef P9G_EPI
}
#ifdef DBG_P9
__device__ __forceinline__ void p9_token_dbg(Frame& F, int t, const float* g_ffn, const float* g_fin) {
    unsigned char* ws = F.ws; const int lane = pg8::fresh_lane();
    const unsigned char* EUV = ws + WS_EU;
    const __amdgpu_buffer_rsrc_t rs = __builtin_amdgcn_make_buffer_rsrc((void*)EUV, (short)0, 16384 * MX_ROW, 0x00020000);
    const bf16* xrow = (const bf16*)(ws + WS_X1B) + (size_t)t * D; float* orow = F.out + (size_t)t * D;
    const float rs2 = __builtin_amdgcn_rsqf(pg8::sum16((const float*)(ws + WS_ROWSS) + (size_t)t * 16) * (1.0f / D) + EPS);
    LAS unsigned char* wl = F.lds + F.wave * WAVE_LDS;
    LAS int* sid = (LAS int*)wl; LAS float* sgt = (LAS float*)(sid + 128); LAS unsigned char* h8 = wl + 1024;
    { const v4u a0 = *(const v4u*)(xrow + 16 * lane), a1 = *(const v4u*)(xrow + 16 * lane + 8); v4u o;
      const unsigned xs[8] = {a0.x, a0.y, a0.z, a0.w, a1.x, a1.y, a1.z, a1.w};
#pragma unroll
      for (int j = 0; j < 4; ++j) { const f32x4 g = *(const f32x4*)(g_ffn + 16 * lane + 4 * j);
          int p = __builtin_amdgcn_cvt_pk_fp8_f32(bflo(xs[2 * j]) * rs2 * g[0], bfhi(xs[2 * j]) * rs2 * g[1], 0, false);
          p = __builtin_amdgcn_cvt_pk_fp8_f32(bflo(xs[2 * j + 1]) * rs2 * g[2], bfhi(xs[2 * j + 1]) * rs2 * g[3], p, true); o[j] = (unsigned)p; }
      *(LAS v4u*)(h8 + 16 * lane) = o; }
    const int* IDX = (const int*)(ws + WS_IDX) + (size_t)t * 128; const float* GT = (const float*)(ws + WS_GATE) + (size_t)t * 128;
    sid[lane] = IDX[lane]; sid[64 + lane] = IDX[64 + lane]; sgt[lane] = GT[lane]; sgt[64 + lane] = GT[64 + lane];
    LDS_WAIT(); asm volatile("" ::: "memory");
    f32x2v o[8];
#pragma unroll
    for (int i = 0; i < 8; ++i) o[i] = (f32x2v){0.f, 0.f};
#pragma unroll 1
    for (int b = 0; b < 8; ++b) {
        const int idc = sid[16 * b + (lane & 15)];
        f32x4 dd = {0.f, 0.f, 0.f, 0.f};
#if DBG_P9 == 2
        { AFrag A; p9m_load_a(A, EUV, idc, lane); dd = p9m_dots(A, h8, lane); }
#else
#pragma unroll 1
        for (int i = 0; i < 16; ++i) { const int e = __builtin_amdgcn_readlane(idc, i); const unsigned char* rec = EUV + (size_t)e * MX_ROW;
            const v2u uu = *(const v2u*)(rec + 8 * lane); const int blk = lane >> 1; const unsigned sb = rec[MX_USC + (blk & 3) * 8 + (blk >> 2)];
            const v4u hh = *(LAS v4u*)(h8 + 16 * lane);
            float f0[8], f1[8]; unpack8_f4(uu.x, f0); unpack8_f4(uu.y, f1); float acc = 0.f;
#define DBG_ACC(HW, F, O4) { const f32x2v lo = __builtin_amdgcn_cvt_pk_f32_fp8((int)(HW), false), hi = __builtin_amdgcn_cvt_pk_f32_fp8((int)(HW), true); acc += F[O4] * lo.x + F[O4 + 1] * lo.y + F[O4 + 2] * hi.x + F[O4 + 3] * hi.y; }
            DBG_ACC(hh.x, f0, 0) DBG_ACC(hh.y, f0, 4) DBG_ACC(hh.z, f1, 0) DBG_ACC(hh.w, f1, 4)
#undef DBG_ACC
            acc *= __builtin_bit_cast(float, sb << 23);
            acc += swz_xor<1>(acc); acc += swz_xor<2>(acc); acc += swz_xor<4>(acc); acc += swz_xor<8>(acc); acc += swz_xor<16>(acc); acc += bperm(acc, lane ^ 32);
            if ((lane >> 4) == (i >> 2)) { if ((i & 3) == 0) dd[0] = acc; if ((i & 3) == 1) dd[1] = acc; if ((i & 3) == 2) dd[2] = acc; if ((i & 3) == 3) dd[3] = acc; } }
#endif
        const f32x4 gt = *(LAS f32x4*)(sgt + 16 * b + 4 * (lane >> 4));
        float c[4];
#pragma unroll
        for (int r = 0; r < 4; ++r) c[r] = gt[r] * gelu_erf(dd[r]);
#pragma unroll 1
        for (int p = 0; p < 16; ++p) { VSlot V; p9m_load_v(V, rs, __builtin_amdgcn_readlane(idc, p), lane);
            const float cs = (p & 3) == 0 ? c[0] : (p & 3) == 1 ? c[1] : (p & 3) == 2 ? c[2] : c[3];
            p9m_axpy(V, rdl(cs, 16 * (p >> 2)), o); }
    }
    LDS_WAIT(); asm volatile("" ::: "memory");
    float oacc[16];
#pragma unroll
    for (int k = 0; k < 8; ++k) { oacc[2 * k] = o[k].x; oacc[2 * k + 1] = o[k].y; }
    float ss = 0.f;
#pragma unroll
    for (int j = 0; j < 4; ++j) { const v2u a = *(const v2u*)(xrow + 256 * j + 4 * lane);
        oacc[4 * j] += bflo(a.x); oacc[4 * j + 1] += bfhi(a.x); oacc[4 * j + 2] += bflo(a.y); oacc[4 * j + 3] += bfhi(a.y);
#pragma unroll
        for (int i = 0; i < 4; ++i) ss += oacc[4 * j + i] * oacc[4 * j + i]; }
    ss += swz_xor<1>(ss); ss += swz_xor<2>(ss); ss += swz_xor<4>(ss); ss += swz_xor<8>(ss); ss += swz_xor<16>(ss); ss += bperm(ss, lane ^ 32);
    const float rs3 = __builtin_amdgcn_rsqf(ss * (1.0f / D) + EPS);
#pragma unroll
    for (int j = 0; j < 4; ++j) { const f32x4 g = *(const f32x4*)(g_fin + 256 * j + 4 * lane); f32x4 ov;
#pragma unroll
        for (int i = 0; i < 4; ++i) ov[i] = oacc[4 * j + i] * rs3 * g[i];
        *(f32x4*)(orow + 256 * j + 4 * lane) = ov; }
}
#endif
__device__ __forceinline__ void p9_token_mx(Frame& F, int t, const float* g_ffn, const float* g_fin) {
    unsigned char* ws = F.ws; const int lane = pg8::fresh_lane();
    const unsigned char* EUV = ws + WS_EU;
    const __amdgpu_buffer_rsrc_t rs = __builtin_amdgcn_make_buffer_rsrc((void*)EUV, (short)0, 16384 * MX_ROW, 0x00020000);
    const bf16* xrow = (const bf16*)(ws + WS_X1B) + (size_t)t * D; float* orow = F.out + (size_t)t * D;
    const float rs2 = __builtin_amdgcn_rsqf(pg8::sum16((const float*)(ws + WS_ROWSS) + (size_t)t * 16) * (1.0f / D) + EPS);
    LAS unsigned char* wl = F.lds + F.wave * WAVE_LDS;
    LAS int* sid = (LAS int*)wl; LAS float* sgt = (LAS float*)(sid + 128); LAS unsigned char* h8 = wl + 1024;
    { const v4u a0 = *(const v4u*)(xrow + 16 * lane), a1 = *(const v4u*)(xrow + 16 * lane + 8); v4u o;
      const unsigned xs[8] = {a0.x, a0.y, a0.z, a0.w, a1.x, a1.y, a1.z, a1.w};
#pragma unroll
      for (int j = 0; j < 4; ++j) { const f32x4 g = *(const f32x4*)(g_ffn + 16 * lane + 4 * j);
          int p = __builtin_amdgcn_cvt_pk_fp8_f32(bflo(xs[2 * j]) * rs2 * g[0], bfhi(xs[2 * j]) * rs2 * g[1], 0, false);
          p = __builtin_amdgcn_cvt_pk_fp8_f32(bflo(xs[2 * j + 1]) * rs2 * g[2], bfhi(xs[2 * j + 1]) * rs2 * g[3], p, true); o[j] = (unsigned)p; }
      *(LAS v4u*)(h8 + 16 * lane) = o; }
    const int* IDX = (const int*)(ws + WS_IDX) + (size_t)t * 128; const float* GT = (const float*)(ws + WS_GATE) + (size_t)t * 128;
    { const int a0 = IDX[lane], b0 = IDX[64 + lane]; const float ga = GT[lane], gb = GT[64 + lane];
      const int kA = a0 >> 10, kB = b0 >> 10; const unsigned long long lt = (1ull << lane) - 1ull;
      int base = 0, rA = 0, rB = 0;
#pragma unroll
      for (int k = 0; k < 16; ++k) { const unsigned long long mA = __ballot(kA == k), mB = __ballot(kB == k); const int cA = __popcll(mA), cB = __popcll(mB);
          if (kA == k) rA = base + __popcll(mA & lt);
          if (kB == k) rB = base + cA + __popcll(mB & lt);
          base += cA + cB; }
      sid[rA] = a0; sid[rB] = b0; sgt[rA] = ga; sgt[rB] = gb;
      LDS_WAIT(); asm volatile("" ::: "memory"); }
    f32x2v o[8];
#pragma unroll
    for (int i = 0; i < 8; ++i) o[i] = (f32x2v){0.f, 0.f};
    AFrag A0, A1; VSlot V[16];
    int idc = sid[lane & 15];
    p9m_load_a(A0, EUV, idc, lane);
#pragma unroll
    for (int p = 0; p < 16; ++p) p9m_load_v(V[p], rs, __builtin_amdgcn_readlane(idc, p), lane);
#pragma unroll 1
    for (int b = 0; b < 8; b += 2) {
        const int id1 = sid[16 * (b + 1) + (lane & 15)];
        p9m_load_a(A1, EUV, id1, lane); asm volatile("" ::: "memory");
        p9m_batch(A0, V, h8, sgt, rs, b, id1, lane, o); asm volatile("" ::: "memory");
        const int b2 = (b + 2 < 8) ? b + 2 : 7;
        const int id2 = sid[16 * b2 + (lane & 15)];
        p9m_load_a(A0, EUV, id2, lane); asm volatile("" ::: "memory");
        p9m_batch(A1, V, h8, sgt, rs, b + 1, id2, lane, o); asm volatile("" ::: "memory");
    }
    LDS_WAIT(); asm volatile("" ::: "memory");
    float oacc[16];
#pragma unroll
    for (int k = 0; k < 8; ++k) { oacc[2 * k] = o[k].x; oacc[2 * k + 1] = o[k].y; }
    float ss = 0.f;
#pragma unroll
    for (int j = 0; j < 4; ++j) { const v2u a = *(const v2u*)(xrow + 256 * j + 4 * lane);
        oacc[4 * j] += bflo(a.x); oacc[4 * j + 1] += bfhi(a.x); oacc[4 * j + 2] += bflo(a.y); oacc[4 * j + 3] += bfhi(a.y);
#pragma unroll
        for (int i = 0; i < 4; ++i) ss += oacc[4 * j + i] * oacc[4 * j + i]; }
    ss += swz_xor<1>(ss); ss += swz_xor<2>(ss); ss += swz_xor<4>(ss); ss += swz_xor<8>(ss); ss += swz_xor<16>(ss); ss += bperm(ss, lane ^ 32);
    const float rs3 = __builtin_amdgcn_rsqf(ss * (1.0f / D) + EPS);
#pragma unroll
    for (int j = 0; j < 4; ++j) { const f32x4 g = *(const f32x4*)(g_fin + 256 * j + 4 * lane); f32x4 ov;
#pragma unroll
        for (int i = 0; i < 4; ++i) ov[i] = oacc[4 * j + i] * rs3 * g[i];
        *(f32x4*)(orow + 256 * j + 4 * lane) = ov; }
}
struct Rows8 { v4u u[8], v[8]; };
__device__ __forceinline__ void p9_load8(Rows8& R, const unsigned char* EU, const unsigned char* EV, const int (&e)[8], int lane) {
#pragma unroll
    for (int j = 0; j < 8; ++j) { R.u[j] = *(const v4u*)(EU + (size_t)e[j] * 1024 + 16 * lane); R.v[j] = *(const v4u*)(EV + (size_t)e[j] * 1024 + 16 * lane); }
}
__device__ __forceinline__ void p9_token_f8(Frame& F, int t, const float* g_ffn, const float* g_fin) {
    unsigned char* ws = F.ws; const int lane = pg8::fresh_lane(), hh = lane >> 5, q4 = (lane >> 4) & 1, q3 = (lane >> 3) & 1;
    const unsigned char* EU = ws + WS_EU; const unsigned char* EV = ws + WS_EV; const float* ISU = (const float*)(ws + WS_ESC); const float* ISV = ISU + 16384;
    const bf16* xrow = (const bf16*)(ws + WS_X1B) + (size_t)t * D; float* orow = F.out + (size_t)t * D;
    const float rs2 = __builtin_amdgcn_rsqf(pg8::sum16((const float*)(ws + WS_ROWSS) + (size_t)t * 16) * (1.0f / D) + EPS);
    float hn[16];
#pragma unroll
    for (int j = 0; j < 4; ++j) { const v2u a = *(const v2u*)(xrow + 256 * j + 4 * lane); const f32x4 g = *(const f32x4*)(g_ffn + 256 * j + 4 * lane);
        hn[4 * j] = bflo(a.x) * rs2 * g[0]; hn[4 * j + 1] = bfhi(a.x) * rs2 * g[1]; hn[4 * j + 2] = bflo(a.y) * rs2 * g[2]; hn[4 * j + 3] = bfhi(a.y) * rs2 * g[3]; }
    const int* IDX = (const int*)(ws + WS_IDX) + (size_t)t * 128; const float* GT = (const float*)(ws + WS_GATE) + (size_t)t * 128;
    int idA, idB; float suA, suB, gvA, gvB;
    { const int a0 = IDX[lane], b0 = IDX[64 + lane];
      const float sa = ISU[a0], sb = ISU[b0], ga = GT[lane] * ISV[a0], gb = GT[64 + lane] * ISV[b0];
      const int kA = a0 >> 10, kB = b0 >> 10; const unsigned long long lt = (1ull << lane) - 1ull;
      int base = 0, rA = 0, rB = 0;
#pragma unroll
      for (int k = 0; k < 16; ++k) { const unsigned long long mA = __ballot(kA == k), mB = __ballot(kB == k); const int cA = __popcll(mA), cB = __popcll(mB);
          if (kA == k) rA = base + __popcll(mA & lt);
          if (kB == k) rB = base + cA + __popcll(mB & lt);
          base += cA + cB; }
      LAS int* sid = (LAS int*)(F.lds + F.wave * WAVE_LDS); LAS float* ssu = (LAS float*)(sid + 128); LAS float* sgv = ssu + 128;
      sid[rA] = a0; sid[rB] = b0; ssu[rA] = sa; ssu[rB] = sb; sgv[rA] = ga; sgv[rB] = gb;
      LDS_WAIT(); asm volatile("" ::: "memory");
      idA = sid[lane]; idB = sid[64 + lane]; suA = ssu[lane]; suB = ssu[64 + lane]; gvA = sgv[lane]; gvB = sgv[64 + lane];
      LDS_WAIT(); asm volatile("" ::: "memory"); }
    float oacc[16];
#pragma unroll
    for (int i = 0; i < 16; ++i) oacc[i] = 0.f;
    const int jsel = 4 * hh + 2 * q4 + q3;
    Rows8 R;
    { int e[8];
#pragma unroll
      for (int j = 0; j < 8; ++j) e[j] = __builtin_amdgcn_readlane(idA, j);
      p9_load8(R, EU, EV, e, lane); }
    for (int bt = 0; bt < 16; ++bt) {
        Rows8 Rn;
        { const int nb = (bt + 1) & 15; int e[8];
#pragma unroll
          for (int j = 0; j < 8; ++j) { const int n = 8 * nb + j; e[j] = (nb < 8) ? __builtin_amdgcn_readlane(idA, n & 63) : __builtin_amdgcn_readlane(idB, n & 63); }
          p9_load8(Rn, EU, EV, e, lane); }
        float pd[8];
#pragma unroll
        for (int j = 0; j < 8; ++j) { float a = 0.f, b = 0.f;
#pragma unroll
            for (int d = 0; d < 4; ++d) { const f32x2v lo = __builtin_amdgcn_cvt_pk_f32_fp8((int)R.u[j][d], false), hi = __builtin_amdgcn_cvt_pk_f32_fp8((int)R.u[j][d], true);
                a += lo.x * hn[4 * d] + hi.x * hn[4 * d + 2]; b += lo.y * hn[4 * d + 1] + hi.y * hn[4 * d + 3]; }
            pd[j] = a + b; }
        float r4[4], r2[2];
#pragma unroll
        for (int i = 0; i < 4; ++i) { const float keep = hh ? pd[4 + i] : pd[i], send = hh ? pd[i] : pd[4 + i]; r4[i] = keep + __shfl_xor(send, 32); }
#pragma unroll
        for (int i = 0; i < 2; ++i) { const float keep = q4 ? r4[2 + i] : r4[i], send = q4 ? r4[i] : r4[2 + i]; r2[i] = keep + __shfl_xor(send, 16); }
        float v = (q3 ? r2[1] : r2[0]) + __shfl_xor(q3 ? r2[0] : r2[1], 8);
        v += __shfl_xor(v, 4); v += __shfl_xor(v, 2); v += __shfl_xor(v, 1);
        const int n = 8 * bt + jsel;
        const float su = (bt < 8) ? __shfl(suA, n & 63) : __shfl(suB, n & 63), gv = (bt < 8) ? __shfl(gvA, n & 63) : __shfl(gvB, n & 63);
        const float w = gv * gelu_erf(v * su);
#pragma unroll
        for (int j = 0; j < 8; ++j) { const float wj = rdl(w, 8 * j);
#pragma unroll
            for (int d = 0; d < 4; ++d) { const f32x2v lo = __builtin_amdgcn_cvt_pk_f32_fp8((int)R.v[j][d], false), hi = __builtin_amdgcn_cvt_pk_f32_fp8((int)R.v[j][d], true);
                oacc[4 * d] += wj * lo.x; oacc[4 * d + 1] += wj * lo.y; oacc[4 * d + 2] += wj * hi.x; oacc[4 * d + 3] += wj * hi.y; } }
        R = Rn;
    }
    asm volatile("" ::: "memory");
    float ss = 0.f;
#pragma unroll
    for (int j = 0; j < 4; ++j) { const v2u a = *(const v2u*)(xrow + 256 * j + 4 * lane);
        oacc[4 * j] += bflo(a.x); oacc[4 * j + 1] += bfhi(a.x); oacc[4 * j + 2] += bflo(a.y); oacc[4 * j + 3] += bfhi(a.y);
#pragma unroll
        for (int i = 0; i < 4; ++i) ss += oacc[4 * j + i] * oacc[4 * j + i]; }
    ss = wave_sum(ss);
    const float rs3 = __builtin_amdgcn_rsqf(ss * (1.0f / D) + EPS);
#pragma unroll
    for (int j = 0; j < 4; ++j) { const f32x4 g = *(const f32x4*)(g_fin + 256 * j + 4 * lane); f32x4 o;
#pragma unroll
        for (int i = 0; i < 4; ++i) o[i] = oacc[4 * j + i] * rs3 * g[i];
        *(f32x4*)(orow + 256 * j + 4 * lane) = o; }
}
struct Rows4 { v4u ua[4], ub[4], va[4], vb[4]; };
__device__ __forceinline__ void p9_load(Rows4& R, const bf16* EU, const bf16* EV, const int (&e)[4], int lane) {
#pragma unroll
    for (int j = 0; j < 4; ++j) { const bf16* up = EU + (size_t)e[j] * 1024 + lane * 8; const bf16* vp = EV + (size_t)e[j] * 1024 + lane * 8;
        R.ua[j] = *(const v4u*)up; R.ub[j] = *(const v4u*)(up + 512); R.va[j] = *(const v4u*)vp; R.vb[j] = *(const v4u*)(vp + 512); }
}
__device__ __forceinline__ void p9_token(Frame& F, int t, const float* g_ffn, const float* g_fin) {
    unsigned char* ws = F.ws; const int lane = pg8::fresh_lane(), hh = lane >> 5, q4 = (lane >> 4) & 1;
    const bf16* EU = (const bf16*)(ws + WS_EU); const bf16* EV = (const bf16*)(ws + WS_EV);
    const float* xrow = (const float*)(ws + WS_X1) + (size_t)t * D; float* orow = F.out + (size_t)t * D;
    const float rs2 = __builtin_amdgcn_rsqf(pg8::sum16((const float*)(ws + WS_ROWSS) + (size_t)t * 16) * (1.0f / D) + EPS);
    float x1[16];
    { const f32x4 a0 = *(const f32x4*)(xrow + lane * 8), a1 = *(const f32x4*)(xrow + lane * 8 + 4), b0 = *(const f32x4*)(xrow + 512 + lane * 8), b1 = *(const f32x4*)(xrow + 512 + lane * 8 + 4);
#pragma unroll
      for (int i = 0; i < 4; ++i) { x1[i] = a0[i]; x1[4 + i] = a1[i]; x1[8 + i] = b0[i]; x1[12 + i] = b1[i]; } }
    unsigned hn[8];
    { const f32x4 a0 = *(const f32x4*)(g_ffn + lane * 8), a1 = *(const f32x4*)(g_ffn + lane * 8 + 4), b0 = *(const f32x4*)(g_ffn + 512 + lane * 8), b1 = *(const f32x4*)(g_ffn + 512 + lane * 8 + 4);
      float g[16];
#pragma unroll
      for (int i = 0; i < 4; ++i) { g[i] = a0[i]; g[4 + i] = a1[i]; g[8 + i] = b0[i]; g[12 + i] = b1[i]; }
#pragma unroll
      for (int i = 0; i < 8; ++i) hn[i] = pk2(x1[2 * i] * rs2 * g[2 * i], x1[2 * i + 1] * rs2 * g[2 * i + 1]); }
    const int* IDX = (const int*)(ws + WS_IDX) + (size_t)t * 128; const float* GT = (const float*)(ws + WS_GATE) + (size_t)t * 128;
    const int idA = IDX[lane], idB = IDX[64 + lane]; const float gtA = GT[lane], gtB = GT[64 + lane];
    float oacc[16];
#pragma unroll
    for (int i = 0; i < 16; ++i) oacc[i] = 0.f;
    const int jsel = 2 * hh + q4;
    Rows4 R;
    { int e[4];
#pragma unroll
      for (int j = 0; j < 4; ++j) e[j] = __builtin_amdgcn_readlane(idA, j);
      p9_load(R, EU, EV, e, lane); }
#ifndef DBG_NBATCH
#define DBG_NBATCH 32
#endif
    for (int bt = 0; bt < DBG_NBATCH; ++bt) {
        Rows4 Rn;
        { const int nb = (bt + 1) & 31; int e[4];
#pragma unroll
          for (int j = 0; j < 4; ++j) { const int n = 4 * nb + j; e[j] = (nb < 16) ? __builtin_amdgcn_readlane(idA, n & 63) : __builtin_amdgcn_readlane(idB, n & 63); }
          p9_load(Rn, EU, EV, e, lane); }
        float pd[4];
#pragma unroll
        for (int j = 0; j < 4; ++j) { float a = 0.f, b = 0.f;
            a = dot2bf(R.ua[j].x, hn[0], a); b = dot2bf(R.ua[j].y, hn[1], b); a = dot2bf(R.ua[j].z, hn[2], a); b = dot2bf(R.ua[j].w, hn[3], b);
            a = dot2bf(R.ub[j].x, hn[4], a); b = dot2bf(R.ub[j].y, hn[5], b); a = dot2bf(R.ub[j].z, hn[6], a); b = dot2bf(R.ub[j].w, hn[7], b); pd[j] = a + b; }
        const float k0 = hh ? pd[2] : pd[0], k1 = hh ? pd[3] : pd[1], s0 = hh ? pd[0] : pd[2], s1 = hh ? pd[1] : pd[3];
        const float r0 = k0 + __shfl_xor(s0, 32), r1 = k1 + __shfl_xor(s1, 32);
        float v = (q4 ? r1 : r0) + __shfl_xor(q4 ? r0 : r1, 16);
        v += __shfl_xor(v, 8); v += __shfl_xor(v, 4); v += __shfl_xor(v, 2); v += __shfl_xor(v, 1);
        const int n = 4 * bt + jsel; const float gsel = (bt < 16) ? __shfl(gtA, n & 63) : __shfl(gtB, n & 63);
        const float w = gsel * gelu_erf(v);
        const float w0 = __builtin_bit_cast(float, __builtin_amdgcn_readlane(__builtin_bit_cast(int, w), 0)), w1 = __builtin_bit_cast(float, __builtin_amdgcn_readlane(__builtin_bit_cast(int, w), 16)),
                    w2 = __builtin_bit_cast(float, __builtin_amdgcn_readlane(__builtin_bit_cast(int, w), 32)), w3 = __builtin_bit_cast(float, __builtin_amdgcn_readlane(__builtin_bit_cast(int, w), 48));
        const float wj[4] = {w0, w1, w2, w3};
#pragma unroll
        for (int j = 0; j < 4; ++j) {
            const unsigned va[4] = {R.va[j].x, R.va[j].y, R.va[j].z, R.va[j].w}, vb[4] = {R.vb[j].x, R.vb[j].y, R.vb[j].z, R.vb[j].w};
#pragma unroll
            for (int i = 0; i < 4; ++i) { oacc[2 * i] += wj[j] * bflo(va[i]); oacc[2 * i + 1] += wj[j] * bfhi(va[i]); oacc[8 + 2 * i] += wj[j] * bflo(vb[i]); oacc[8 + 2 * i + 1] += wj[j] * bfhi(vb[i]); }
        }
        R = Rn;
    }
    float ss = 0.f;
#pragma unroll
    for (int i = 0; i < 16; ++i) { x1[i] += oacc[i]; ss += x1[i] * x1[i]; }
    ss = wave_sum(ss);
#ifdef DBG_CHK
    const float rs3 = __builtin_amdgcn_rsqf(ss * (1.0f / D) + EPS) * chk_scale(F);
#else
    const float rs3 = __builtin_amdgcn_rsqf(ss * (1.0f / D) + EPS);
#endif
    { const f32x4 a0 = *(const f32x4*)(g_fin + lane * 8), a1 = *(const f32x4*)(g_fin + lane * 8 + 4), b0 = *(const f32x4*)(g_fin + 512 + lane * 8), b1 = *(const f32x4*)(g_fin + 512 + lane * 8 + 4);
      f32x4 o0, o1, o2, o3;
#pragma unroll
      for (int i = 0; i < 4; ++i) { o0[i] = x1[i] * rs3 * a0[i]; o1[i] = x1[4 + i] * rs3 * a1[i]; o2[i] = x1[8 + i] * rs3 * b0[i]; o3[i] = x1[12 + i] * rs3 * b1[i]; }
      *(f32x4*)(orow + lane * 8) = o0; *(f32x4*)(orow + lane * 8 + 4) = o1; *(f32x4*)(orow + 512 + lane * 8) = o2; *(f32x4*)(orow + 512 + lane * 8 + 4) = o3; }
}

__device__ __forceinline__ void dbg_dump_bf16(Frame& F, const bf16* src, int ld, int c0, int n) {
    const int gt = F.vcu * (NWAVES * 64) + F.wave * 64 + pg8::fresh_lane(), ngt = F.G * NWAVES * 64;
    for (long i = gt; i < (long)T * n; i += ngt) { const long t = i / n; const int c = (int)(i % n); F.out[t * 1024 + c0 + c] = bf2f(src[t * ld + c]); }
}
__device__ __forceinline__ void dbg_dump_f32(Frame& F, const float* src, long n, long o0) {
    const int gt = F.vcu * (NWAVES * 64) + F.wave * 64 + pg8::fresh_lane(), ngt = F.G * NWAVES * 64;
    for (long i = gt; i < n; i += ngt) F.out[o0 + i] = src[i];
}
__global__ void __launch_bounds__(NWAVES * 64, 2) fwd_kernel(Args args) {
    extern __shared__ __attribute__((aligned(16))) unsigned char lds[];
    Frame F;
    F.lds = (LAS unsigned char*)lds;
    F.wave = __builtin_amdgcn_readfirstlane((int)threadIdx.x >> 6);
    F.G = gridDim.x; { const int bx = blockIdx.x; F.vcu = (F.G % 8 == 0) ? (bx % 8) * (F.G / 8) + bx / 8 : bx; }
    F.gw = F.vcu * NWAVES + F.wave; F.ngw = F.G * NWAVES;
    F.out = args.out; F.ws = args.ws;
    unsigned char* ws = args.ws;
    volatile LAS unsigned* MISC = (volatile LAS unsigned*)(F.lds + MISC_OFF);
    for (int u = threadIdx.x; u < 256; u += NWAVES * 64) MISC[u] = 0u;
    __syncthreads();
    gu32* ctl = (gu32*)(ws + WS_CTL);
    XcdBarrier bar; bar.bar = (unsigned*)(ctl + CW_BAR); bar.x = 0; bar.st = nullptr;
    if (N_LAUNCHES != PER_PHASE) bar = xcd_barrier_post((unsigned*)(ctl + CW_BAR), MISC + 8);
#ifdef PROBE_DUP
#define DUPN(k) (((PROBE_DUP >> (k)) & 1) ? 2 : 1)
#else
#define DUPN(k) 1
#endif
#define GRID_BAR() do { if (N_LAUNCHES != PER_PHASE) xcd_barrier(bar); } while (0)
    const int lo = args.ph_lo, hi = args.ph_hi;
#ifdef ONLY_PH
#define IN(k) ((k) == ONLY_PH)
#else
#define IN(k) (lo <= (k) && (k) < hi)
#endif
#define BOTH(k) (IN(k) && IN((k) + 1))
    bf16* const XB = (bf16*)(ws + WS_XB);
    float* const rowss = (float*)(ws + WS_ROWSS);

    if (IN(0)) { for (int rep = 0; rep < DUPN(0); ++rep) { p0_colmax(F, args); GRID_BAR(); p0_prologue(F, args); } if (BOTH(0)) GRID_BAR(); }
    if (IN(1)) for (int rep = 0; rep < DUPN(1); ++rep) {
        pg8::Gemm g{(const bf16*)(ws + WS_X8), (const bf16*)(ws + WS_WIN), T, NIN, D / 2}; pg8::StaticOrder S; S.init(T, NIN, F.G, (int)blockIdx.x);
        pg8::EpiInProj E{(const float*)(ws + WS_RFAC), (const float*)(ws + WS_SWR), (const float*)(ws + WS_LB), (bf16*)(ws + WS_Q), (bf16*)(ws + WS_LF), (bf16*)(ws + WS_KK), (bf16*)(ws + WS_V), (bf16*)(ws + WS_SG),
                         (bf16*)(ws + WS_CB), (bf16*)(ws + WS_U), (bf16*)(ws + WS_GA)};
        pg8::gemm_phase<pg8::EpiInProj, pg8::StaticOrder, true, true, false, true>(F.lds, g, S, E, F.wave);
        if (BOTH(1)) GRID_BAR();
    }
    if (IN(2)) { p2_phase(F, args.in[5]); if (BOTH(2)) GRID_BAR(); }
    if (IN(3)) { for (int rep = 0; rep < DUPN(3); ++rep) p3_phase(F); if (BOTH(3)) GRID_BAR(); }
    if (IN(4)) { const float* gain = args.in[4]; for (int rep = 0; rep < DUPN(4); ++rep) for (int u = F.gw; u < NUNIT; u += F.ngw) p4_unit(F, u, gain); if (BOTH(4)) GRID_BAR(); }
    if (IN(5)) for (int rep = 0; rep < DUPN(5); ++rep) {
        pg8::Gemm g{(const bf16*)F.out, (const bf16*)(ws + WS_PAB), T, D, D}; pg8::StaticOrder S; S.init(T, D, F.G, (int)blockIdx.x);
        pg8::EpiMerged E{(const bf16*)(ws + WS_GA), (bf16*)(ws + WS_MG)};
        pg8::gemm_phase<pg8::EpiMerged, pg8::StaticOrder, true, true>(F.lds, g, S, E, F.wave);
        if (BOTH(5)) GRID_BAR();
    }
    if (IN(6)) for (int rep = 0; rep < DUPN(6); ++rep) {
        pg8::Gemm g{(const bf16*)(ws + WS_MG), (const bf16*)(ws + WS_WO), T, D, D}; pg8::StaticOrder S; S.init(T, D, F.G, (int)blockIdx.x);
        pg8::EpiOut E{args.in[0], (float*)(ws + WS_X1), (bf16*)(ws + WS_X1B), rowss};
        pg8::gemm_phase<pg8::EpiOut, pg8::StaticOrder, true, true>(F.lds, g, S, E, F.wave);
        if (BOTH(6)) GRID_BAR();
    }
    if (IN(7)) for (int rep = 0; rep < DUPN(7); ++rep) {
        pg8::Gemm g{(const bf16*)(ws + WS_X1B), (const bf16*)(ws + WS_WQ), T, 2048, D}; pg8::StaticOrder S; S.init(T, 2048, F.G, (int)blockIdx.x);
        pg8::EpiQuery E{rowss, (bf16*)(ws + WS_QQ), EPS};
        pg8::gemm_phase<pg8::EpiQuery, pg8::StaticOrder, true, true>(F.lds, g, S, E, F.wave);
        if (BOTH(7)) GRID_BAR();
    }
    if (IN(8)) {
        const float* eu = args.in[13]; const float* ev = args.in[14]; const int ln = pg8::fresh_lane();
        int it = F.gw;
        for (int rep = 0; rep < DUPN(8); ++rep)
        for (int tile = F.vcu; tile < T / 32; tile += F.G) {
            p8_task(F, tile, F.wave);
            if (it + F.ngw < 16384) { cvt_expert_mx2(eu, ev, ws + WS_EU, it, it + F.ngw, ln); it += 2 * F.ngw; }
            else if (it < 16384) { cvt_expert_mx(eu, ev, ws + WS_EU, it, ln); it += F.ngw; }
        }
#pragma unroll 1
        for (; it < 16384; it += F.ngw) cvt_expert_mx(eu, ev, ws + WS_EU, it, ln);
        if (BOTH(8)) GRID_BAR();
    }
    if (IN(9)) { const float* g_ffn = args.in[9]; const float* g_fin = args.in[15];
        for (int rep = 0; rep < DUPN(9); ++rep)
#pragma unroll 1
        for (int g = F.gw; g < T / 4; g += F.ngw) p9_group_mx(F, g, g_ffn, g_fin);
    }
#undef IN
#undef BOTH
}

extern "C" void kernel_launch(void* const* d_in, const int* in_sizes, int n_in, void* d_out, int out_size, void* d_ws, size_t ws_size, hipStream_t stream) {
    static int grid = 0;
    if (grid == 0) {
        if (n_in != 16 || in_sizes[0] != T * D || out_size != T * D || ws_size < WS_END) { fprintf(stderr, "kernel_launch: unexpected shapes (n_in %d, in0 %d, out %d, ws %zu); nothing launched\n", n_in, n_in > 0 ? in_sizes[0] : -1, out_size, ws_size); grid = -1; return; }
        int dev = 0, cus = 0, per_cu = 0;
        if (hipGetDevice(&dev) != hipSuccess || hipDeviceGetAttribute(&cus, hipDeviceAttributeMultiprocessorCount, dev) != hipSuccess) { fprintf(stderr, "kernel_launch: device query failed\n"); grid = -1; return; }
        if (hipFuncSetAttribute((const void*)fwd_kernel, hipFuncAttributeMaxDynamicSharedMemorySize, LDS_BYTES) != hipSuccess) { fprintf(stderr, "kernel_launch: hipFuncSetAttribute failed\n"); grid = -1; return; }
        if (hipOccupancyMaxActiveBlocksPerMultiprocessor(&per_cu, (const void*)fwd_kernel, NWAVES * 64, LDS_BYTES) != hipSuccess || per_cu < 1)
            fprintf(stderr, "kernel_launch: note: occupancy query reports %d workgroups per CU\n", per_cu);
        (void)hipGetLastError();
        grid = cus;
    }
    if (grid < 0) return;
    if (hipMemsetAsync((char*)d_ws + WS_CTL, 0, CTL_ZERO_BYTES, stream) != hipSuccess) { fprintf(stderr, "kernel_launch: hipMemsetAsync failed\n"); return; }
    Args a{};
    for (int i = 0; i < 16; ++i) a.in[i] = (const float*)d_in[i];
    a.out = (float*)d_out; a.ws = (unsigned char*)d_ws;
    for (int li = 0; li < N_LAUNCHES; ++li) {
        a.ph_lo = (N_LAUNCHES == PER_PHASE) ? li : 0; a.ph_hi = (N_LAUNCHES == PER_PHASE) ? li + 1 : PER_PHASE; a.li = li;
#ifdef DBG_STOP
        if (li == DBG_STOP + 1) { a.ph_lo = 100; a.ph_hi = 101; }
        if (li > DBG_STOP + 1) break;
#endif
        hipLaunchKernelGGL(fwd_kernel, dim3(grid), dim3(NWAVES * 64), LDS_BYTES, stream, a);
#ifdef DBG_CHK
        if (N_LAUNCHES == PER_PHASE && (li == 1 || li == 4)) { Args c = a; c.ph_lo = 210 + li; c.ph_hi = 211 + li; hipLaunchKernelGGL(fwd_kernel, dim3(grid), dim3(NWAVES * 64), LDS_BYTES, stream, c); }
        if (N_LAUNCHES == PER_PHASE && (li == 0 || li == 1 || li == 2 || li == 5 || li == 6 || li == 7)) { Args c = a; c.ph_lo = 200 + li; c.ph_hi = 201 + li; hipLaunchKernelGGL(fwd_kernel, dim3(grid), dim3(NWAVES * 64), LDS_BYTES, stream, c); }
#endif
        const hipError_t le = hipPeekAtLastError();
        if (le != hipSuccess) { fprintf(stderr, "kernel_launch: launch %d failed: %s\n", li, hipGetErrorName(le)); break; }
    }
}
```

```cpp
#include <hip/hip_runtime.h>
#include <cstdio>
#include <cstdint>


#define DBG_ZYA 1.0f
#define DBG_ZYB 1.0f


#ifdef DBG_SWAPG
#define CHK_GA_ROW 4608
#define CHK_GB_ROW 3584
#else
#define CHK_GA_ROW 3584
#define CHK_GB_ROW 4608
#endif

#ifndef MK_N_LAUNCHES
#define MK_N_LAUNCHES 1
#endif
namespace pg8 {
#define PG8_LAS __attribute__((address_space(3)))
typedef unsigned short bf16_t;
typedef short bf16x8 __attribute__((ext_vector_type(8)));
typedef float f32x4 __attribute__((ext_vector_type(4)));
typedef int v4i_ __attribute__((ext_vector_type(4)));
typedef int v8i_ __attribute__((ext_vector_type(8)));
typedef unsigned u32x4 __attribute__((ext_vector_type(4)));
constexpr int BM = 256, BK = 64, HALF = 128, HTB = HALF * BK * 2  , STAGE_BYTES = 8 * HTB, NXCD = 8, WGM = 8;

__host__ __device__ __forceinline__ int lds_byte(int r, int c) { const int st = (r >> 4) * 2 + (c >> 5), rr = r & 15, cc = c & 31, ob = rr * 64 + cc * 2; return st * 1024 + (ob ^ (((ob >> 9) & 1) << 5)); }
__host__ __device__ __forceinline__ void stage_rc(int b, int& R, int& C) { const int st = b / 1024, sb = b % 1024, swz = sb ^ (((sb >> 9) & 1) << 5); R = (st >> 1) * 16 + swz / 64; C = (st & 1) * 32 + (swz % 64) / 2; }
__host__ __device__ __forceinline__ int perm32(int rho) { const int n = rho >> 4, i = rho & 15; return 8 * (i >> 2) + 4 * n + (i & 3); }

struct Unit { int pm, pn; };
struct Gemm { const bf16_t* A; const bf16_t* Bt; int M, N, K; };

struct StaticOrder {
    int nM, nN, nwg, G, c;
    __host__ __device__ void init(int M, int N, int G_, int c_) { nM = M / BM; nN = N / BM; nwg = nM * nN; G = G_; c = c_; }
    __host__ __device__ bool next(int i, Unit& u) const {
        if ((long)i * G + c >= nwg) return false;
#ifdef DBG_REV
        const int nr = (nwg - 1 - c) / G; const long L = (long)(nr - i) * G + c;
#else
        const long L = (long)i * G + c;
#endif
        int wgid = (int)L; { const int q = nwg / NXCD, r = nwg % NXCD, xcd = wgid % NXCD, off = wgid / NXCD; wgid = (xcd < r ? xcd * (q + 1) : r * (q + 1) + (xcd - r) * q) + off; }
        const int nig = WGM * nN, gid = wgid / nig, fm = gid * WGM, gsz = (nM - fm) < WGM ? (nM - fm) : WGM;
        u.pm = fm + ((wgid % nig) % gsz); u.pn = (wgid % nig) / gsz; return true;
    }
    __device__ __forceinline__ void a_ready(const Unit&) const {}
    __device__ __forceinline__ void done(const Unit&) const {}
};

__device__ __forceinline__ int fresh_lane() { int l; asm volatile("v_mbcnt_lo_u32_b32 %0, -1, 0\n\tv_mbcnt_hi_u32_b32 %0, -1, %0" : "=v"(l)); return l; }
__device__ __forceinline__ unsigned cvt_pk_bf16(float lo, float hi) { unsigned r; asm volatile("v_cvt_pk_bf16_f32 %0, %1, %2" : "=v"(r) : "v"(lo), "v"(hi)); return r; }
__device__ __forceinline__ float fexp(float x) { return __builtin_amdgcn_exp2f(x * 1.44269504089f); }
__device__ __forceinline__ float fsig(float x) { return __builtin_amdgcn_rcpf(1.0f + fexp(-x)); }
__device__ __forceinline__ float bflo(unsigned w) { return __builtin_bit_cast(float, w << 16); }
__device__ __forceinline__ float bfhi(unsigned w) { return __builtin_bit_cast(float, w & 0xffff0000u); }
__device__ __forceinline__ void st8(bf16_t* p, const float (&v)[8]) {
    u32x4 w; w.x = cvt_pk_bf16(v[0], v[1]); w.y = cvt_pk_bf16(v[2], v[3]); w.z = cvt_pk_bf16(v[4], v[5]); w.w = cvt_pk_bf16(v[6], v[7]); *(u32x4*)p = w; }
__device__ __forceinline__ void ld8(const bf16_t* p, float (&v)[8]) {
    const u32x4 w = *(const u32x4*)p; v[0] = bflo(w.x); v[1] = bfhi(w.x); v[2] = bflo(w.y); v[3] = bfhi(w.y); v[4] = bflo(w.z); v[5] = bfhi(w.z); v[6] = bflo(w.w); v[7] = bfhi(w.w); }

__device__ __forceinline__ float sum16(const float* p) {
    const f32x4 a = *(const f32x4*)p, b = *(const f32x4*)(p + 4), c = *(const f32x4*)(p + 8), d = *(const f32x4*)(p + 12);
    return (((a[0] + a[1]) + (a[2] + a[3])) + ((b[0] + b[1]) + (b[2] + b[3]))) + (((c[0] + c[1]) + (c[2] + c[3])) + ((d[0] + d[1]) + (d[2] + d[3]))); }
struct EpiInProj {
    static constexpr bool PERM = true, AFTER_DRAIN = false, MID = false;
    const float* rfac; const float* swr; const float* lb;
    bf16_t *Q, *LF, *KK, *V, *SG, *CB, *U, *GA;
    static __device__ __forceinline__ float af(const f32x4 v, int i) { const float f = v[i]; return (float)__builtin_bit_cast(int, f); }
    __device__ __forceinline__ void mid(f32x4 (&)[2][2][4][2], const Unit&, int, int, int, int) const {}
    template <int MODE> __device__ __forceinline__ void run(const f32x4 (&acc)[2][2][4][2], bf16_t* O, int ldo, int cbase, int gcol0, int row0, int cl) const {
        float lbv[2][8], swv[2][8];
#pragma unroll
        for (int bj = 0; bj < 2; ++bj)
#pragma unroll
            for (int i = 0; i < 8; ++i) { lbv[bj][i] = (MODE == 1) ? lb[cbase + bj * HALF + cl + i] : 0.f; swv[bj][i] = swr[gcol0 + bj * HALF + cl + i]; }
#pragma unroll
        for (int ai = 0; ai < 2; ++ai)
#pragma unroll
            for (int m = 0; m < 4; ++m) { const int r = row0 + ai * HALF + m * 16; const float rs = rfac[r];
#pragma unroll
                for (int bj = 0; bj < 2; ++bj) { float v[8];
#pragma unroll
                    for (int i = 0; i < 8; ++i) { float x = af(acc[ai][bj][m][i >> 2], i & 3) * (rs * swv[bj][i]);
                        if (MODE == 0) { v[i] = x * fsig(x) * 0.125f; }
                        else if (MODE == 1) { x = fminf(fmaxf(x, -30.f), 30.f); const float ex = fexp(-x), sg = __builtin_amdgcn_rcpf(1.0f + ex), om = ex * sg;
                            v[i] = (1.0f - lbv[bj][i]) * om; }
                        else if (MODE == 2) { v[i] = x; }
                        else if (MODE == 3) { v[i] = x * fsig(x); }
                        else { v[i] = fsig(x); } }
                    const size_t off = (size_t)r * ldo + cbase + bj * HALF + cl;
                    st8(O + off, v); } }
    }
    __device__ __forceinline__ void operator()(const f32x4 (&acc)[2][2][4][2], const Unit& u, int wr, int wc, int fr, int fq) const {
        const int pn = u.pn; int row0 = u.pm * BM + wr * 64 + fr, cl = wc * 32 + 8 * fq;
        asm volatile("" : "+v"(row0), "+v"(cl));
        if (pn < 2) run<0>(acc, Q, 512, pn * 256, pn * 256, row0, cl);
        else if (pn < 4) run<1>(acc, KK, 512, (pn - 2) * 256, pn * 256, row0, cl);
        else if (pn < 6) run<2>(acc, V, 512, (pn - 4) * 256, pn * 256, row0, cl);
        else if (pn < 8) run<3>(acc, SG, 512, (pn - 6) * 256, pn * 256, row0, cl);
        else if (pn < 10) run<2>(acc, CB, 512, (pn - 8) * 256, pn * 256, row0, cl);
        else if (pn < 14) {
            float s01[8];
#pragma unroll
            for (int i = 0; i < 8; ++i) s01[i] = swr[pn * 256 + cl + i] * swr[pn * 256 + HALF + cl + i];
#pragma unroll
            for (int ai = 0; ai < 2; ++ai)
#pragma unroll
                for (int m = 0; m < 4; ++m) { const int r = row0 + ai * HALF + m * 16; const float rs = rfac[r], rs2 = rs * rs; float v[8];
#pragma unroll
                    for (int i = 0; i < 8; ++i) v[i] = af(acc[ai][0][m][i >> 2], i & 3) * af(acc[ai][1][m][i >> 2], i & 3) * (rs2 * s01[i]);
                    st8(U + (size_t)r * 512 + (pn - 10) * 128 + cl, v); }
        }
        else {
            unsigned char* G8 = (unsigned char*)GA + (size_t)(u.pm * 8 + (pn - 14)) * 65536 + (size_t)((wr * 4 + wc) * 64 + fq * 16 + fr) * 16;
            float swv[2][8];
#pragma unroll
            for (int bj = 0; bj < 2; ++bj)
#pragma unroll
                for (int i = 0; i < 8; ++i) swv[bj][i] = swr[pn * 256 + bj * HALF + cl + i];
#pragma unroll
            for (int ai = 0; ai < 2; ++ai)
#pragma unroll
                for (int m = 0; m < 4; ++m) { const int r = row0 + ai * HALF + m * 16; const float rs = rfac[r]; unsigned w[4] = {0u, 0u, 0u, 0u};
#pragma unroll
                    for (int bj = 0; bj < 2; ++bj)
#pragma unroll
                        for (int i = 0; i < 8; ++i) { const float gq = fmaxf(fsig(af(acc[ai][bj][m][i >> 2], i & 3) * (rs * swv[bj][i])) * 255.0f + 0.5f, 1.0f); w[2 * bj + (i >> 2)] = __builtin_amdgcn_cvt_pk_u8_f32(gq, i & 3, w[2 * bj + (i >> 2)]); }
                    u32x4 o; o.x = w[0]; o.y = w[1]; o.z = w[2]; o.w = w[3]; *(u32x4*)(G8 + (ai * 4 + m) * 8192) = o; }
        }
    }
};
struct EpiMerged {
    static constexpr bool PERM = true, AFTER_DRAIN = false, MID = true;
    const bf16_t *GAB; bf16_t* MG;
    static __device__ __forceinline__ float ub(unsigned w, int k) { return (float)((w >> (8 * k)) & 0xffu); }
    __device__ __forceinline__ void mid(f32x4 (&acc)[2][2][4][2], const Unit& u, int wr, int wc, int fr, int fq) const {
        int lt = (wr * 4 + wc) * 64 + fq * 16 + fr; asm volatile("" : "+v"(lt));
        const unsigned char* Ga = (const unsigned char*)GAB + (size_t)(u.pm * 8 + u.pn) * 65536 + (size_t)lt * 16; const unsigned char* Gb = Ga + (size_t)4 * 65536;
#pragma unroll
        for (int ai = 0; ai < 2; ++ai)
#pragma unroll
            for (int m = 0; m < 4; ++m) { const u32x4 a = *(const u32x4*)(Ga + (ai * 4 + m) * 8192), b = *(const u32x4*)(Gb + (ai * 4 + m) * 8192);
                const unsigned aw[4] = {a.x, a.y, a.z, a.w}, bw[4] = {b.x, b.y, b.z, b.w};
#pragma unroll
                for (int bj = 0; bj < 2; ++bj)
#pragma unroll
                    for (int i = 0; i < 8; ++i) acc[ai][bj][m][i >> 2][i & 3] *= ub(aw[2 * bj + (i >> 2)], i & 3) * __builtin_amdgcn_rcpf(ub(bw[2 * bj + (i >> 2)], i & 3)); }
        asm volatile("" ::: "memory");
    }
    __device__ __forceinline__ void operator()(const f32x4 (&acc)[2][2][4][2], const Unit& u, int wr, int wc, int fr, int fq) const {
        int row0 = u.pm * BM + wr * 64 + fr, c0 = u.pn * BM + wc * 32 + 8 * fq;
        asm volatile("" : "+v"(row0), "+v"(c0));
        int lt = (wr * 4 + wc) * 64 + fq * 16 + fr; asm volatile("" : "+v"(lt));
        const unsigned char* Gb = (const unsigned char*)GAB + (size_t)(u.pm * 8 + 4 + u.pn) * 65536 + (size_t)lt * 16;
        u32x4 gbw[2][4];
#pragma unroll
        for (int ai = 0; ai < 2; ++ai)
#pragma unroll
            for (int m = 0; m < 4; ++m) gbw[ai][m] = *(const u32x4*)(Gb + (ai * 4 + m) * 8192);
#pragma unroll
        for (int ai = 0; ai < 2; ++ai)
#pragma unroll
            for (int m = 0; m < 4; ++m) { const size_t rr = (size_t)(row0 + ai * HALF + m * 16); const unsigned bw[4] = {gbw[ai][m].x, gbw[ai][m].y, gbw[ai][m].z, gbw[ai][m].w};
#pragma unroll
                for (int bj = 0; bj < 2; ++bj) { float v[8];
#pragma unroll
                    for (int i = 0; i < 8; ++i) v[i] = acc[ai][bj][m][i >> 2][i & 3] * (ub(bw[2 * bj + (i >> 2)], i & 3) * (1.0f / 255.0f));
                    st8(MG + rr * 1024 + c0 + bj * HALF, v); } }
    }
};
struct EpiOut {
    static constexpr bool PERM = true, AFTER_DRAIN = false, MID = false;
    const float* x; float* x1; bf16_t* x1b; float* rowss;
    __device__ __forceinline__ void mid(f32x4 (&)[2][2][4][2], const Unit&, int, int, int, int) const {}
    __device__ __forceinline__ void operator()(const f32x4 (&acc)[2][2][4][2], const Unit& u, int wr, int wc, int fr, int fq) const {
        int row0 = u.pm * BM + wr * 64 + fr, c0 = u.pn * BM + wc * 32 + 8 * fq;
        asm volatile("" : "+v"(row0), "+v"(c0));
#pragma unroll
        for (int ai = 0; ai < 2; ++ai)
#pragma unroll
            for (int m = 0; m < 4; ++m) { const int r = row0 + ai * HALF + m * 16; const size_t ro = (size_t)r * 1024 + c0; float ss = 0.f;
#pragma unroll
                for (int bj = 0; bj < 2; ++bj) { const f32x4 x0 = *(const f32x4*)(x + ro + bj * HALF), x1v = *(const f32x4*)(x + ro + bj * HALF + 4);
                    const f32x4 o0 = acc[ai][bj][m][0] + x0, o1 = acc[ai][bj][m][1] + x1v;
                    float v[8] = {o0[0], o0[1], o0[2], o0[3], o1[0], o1[1], o1[2], o1[3]};
#pragma unroll
                    for (int i = 0; i < 8; ++i) ss += v[i] * v[i];
                    st8(x1b + ro + bj * HALF, v); }
                ss += __shfl_xor(ss, 16); ss += __shfl_xor(ss, 32);
                if (fq == 0) rowss[(size_t)r * 16 + u.pn * 4 + wc] = ss; }
    }
};
struct EpiQuery {
    static constexpr bool PERM = true, AFTER_DRAIN = false, MID = false;
    const float* rowss; bf16_t* QQ; float eps;
    __device__ __forceinline__ void mid(f32x4 (&)[2][2][4][2], const Unit&, int, int, int, int) const {}
    __device__ __forceinline__ void operator()(const f32x4 (&acc)[2][2][4][2], const Unit& u, int wr, int wc, int fr, int fq) const {
        int row0 = u.pm * BM + wr * 64 + fr, c0 = u.pn * BM + wc * 32 + 8 * fq;
        asm volatile("" : "+v"(row0), "+v"(c0));
#pragma unroll
        for (int ai = 0; ai < 2; ++ai)
#pragma unroll
            for (int m = 0; m < 4; ++m) { const int r = row0 + ai * HALF + m * 16; const float rs = __builtin_amdgcn_rsqf(sum16(rowss + (size_t)r * 16) * (1.0f / 1024.0f) + eps);
#pragma unroll
                for (int bj = 0; bj < 2; ++bj) { float v[8];
#pragma unroll
                    for (int i = 0; i < 8; ++i) v[i] = acc[ai][bj][m][i >> 2][i & 3] * rs;
                    st8(QQ + (size_t)r * 2048 + c0 + bj * HALF, v); } }
    }
};

template <class Epi, class Sched, bool ALIGN_EPI = false, bool SP2 = false, bool FP8 = false, bool INT8 = false>
__device__ __forceinline__ void gemm_phase(PG8_LAS unsigned char* lds, const Gemm g, const Sched& S, const Epi& E, const int wid) {
    const int lane = fresh_lane(), tid = wid * 64 + lane, wr = wid >> 2, wc = wid & 3, fr = lane & 15, fq = lane >> 4;
    const int K = g.K, nt = K / BK;
    unsigned voffA[2], voffB[2];
#pragma unroll
    for (int i = 0; i < 2; ++i) { int R, C; stage_rc(tid * 16 + i * 8192, R, C); const int Rb = Epi::PERM ? ((R & ~31) + perm32(R & 31)) : R;
        voffA[i] = (unsigned)(R * K + C) * 2u; voffB[i] = (unsigned)(Rb * K + C) * 2u; }
    const size_t kstep = (size_t)(BK * 2);
    const size_t hstep = (size_t)HALF * K * 2;
    const size_t tstep = 2 * hstep;
    const unsigned ldsw = (unsigned)wid * 1024u;
    const int aoff = lds_byte(wr * 64 + fr, fq * 8), boff = lds_byte(wc * 32 + fr, fq * 8);
#define PG8_SA(b, h) (((b) * 2 + (h)) * HTB)
#define PG8_SB(b, h) ((4 + (b) * 2 + (h)) * HTB)
#define PG8_STAGE(bufoff, gbase, voff) do { _Pragma("unroll") for (int _i = 0; _i < 2; ++_i) \
        __builtin_amdgcn_global_load_lds((const unsigned*)((const char*)(gbase) + (voff)[_i]), (PG8_LAS unsigned*)(lds + (bufoff) + ldsw + _i * 8192), 16, 0, 0); } while (0)
#define PG8_LDA(dst, b, h) do { _Pragma("unroll") for (int m = 0; m < 4; ++m) _Pragma("unroll") for (int k = 0; k < 2; ++k) dst[m][k] = *(const PG8_LAS bf16x8*)(lds + PG8_SA(b, h) + aoff + m * 2048 + k * 1024); } while (0)
#define PG8_LDB(dst, b, h) do { _Pragma("unroll") for (int n = 0; n < 2; ++n) _Pragma("unroll") for (int k = 0; k < 2; ++k) dst[n][k] = *(const PG8_LAS bf16x8*)(lds + PG8_SB(b, h) + boff + n * 2048 + k * 1024); } while (0)
#define PG8_MMA(ai, bj, At, Bt) do { __builtin_amdgcn_s_setprio(1); \
        if constexpr (FP8) { _Pragma("unroll") for (int m = 0; m < 4; ++m) _Pragma("unroll") for (int n = 0; n < 2; ++n) { \
            const v4i_ b0_ = __builtin_bit_cast(v4i_, Bt[n][0]), b1_ = __builtin_bit_cast(v4i_, Bt[n][1]), a0_ = __builtin_bit_cast(v4i_, At[m][0]), a1_ = __builtin_bit_cast(v4i_, At[m][1]); \
            const v8i_ bb_ = {b0_[0], b0_[1], b0_[2], b0_[3], b1_[0], b1_[1], b1_[2], b1_[3]}, aa_ = {a0_[0], a0_[1], a0_[2], a0_[3], a1_[0], a1_[1], a1_[2], a1_[3]}; \
            asm("v_mfma_scale_f32_16x16x128_f8f6f4 %0, %1, %2, %0, %3, %4 op_sel_hi:[0,0,0]" : "+v"(acc[ai][bj][m][n]) : "v"(bb_), "v"(aa_), "v"(scw_), "v"(sca_)); } } \
        else if constexpr (INT8) { _Pragma("unroll") for (int m = 0; m < 4; ++m) _Pragma("unroll") for (int n = 0; n < 2; ++n) _Pragma("unroll") for (int k = 0; k < 2; ++k) \
            acc[ai][bj][m][n] = __builtin_bit_cast(f32x4, __builtin_amdgcn_mfma_i32_16x16x64_i8(__builtin_bit_cast(v4i_, Bt[n][k]), __builtin_bit_cast(v4i_, At[m][k]), __builtin_bit_cast(v4i_, acc[ai][bj][m][n]), 0, 0, 0)); } \
        else { _Pragma("unroll") for (int m = 0; m < 4; ++m) _Pragma("unroll") for (int n = 0; n < 2; ++n) _Pragma("unroll") for (int k = 0; k < 2; ++k) \
            acc[ai][bj][m][n] = __builtin_amdgcn_mfma_f32_16x16x32_bf16(Bt[n][k], At[m][k], acc[ai][bj][m][n], 0, 0, 0); } \
        __builtin_amdgcn_s_setprio(0); } while (0)
#define PG8_WAIT_V(n) asm volatile("s_waitcnt vmcnt(" #n ")" ::: "memory")
#define PG8_WAIT_L(n) asm volatile("s_waitcnt lgkmcnt(" #n ")" ::: "memory")
#define PG8_BAR __builtin_amdgcn_s_barrier()
#define PG8_SCHED __builtin_amdgcn_sched_barrier(0)
    Unit cur, nxt; int ui = 0;
    if (!S.next(0, cur)) return;
    int scw_ = 0x79797979, sca_ = 0x7f7f7f7f; if constexpr (FP8) asm volatile("" : "+v"(scw_), "+v"(sca_));
    f32x4 acc[2][2][4][2];
#pragma unroll
    for (int a = 0; a < 2; ++a)
#pragma unroll
        for (int b = 0; b < 2; ++b)
#pragma unroll
            for (int m = 0; m < 4; ++m)
#pragma unroll
                for (int n = 0; n < 2; ++n) acc[a][b][m][n] = (f32x4){0.f, 0.f, 0.f, 0.f};
    bf16x8 At[4][2], B0[2][2], B1[2][2];
    const char* cA = (const char*)g.A + (size_t)cur.pm * tstep; const char* cB = (const char*)g.Bt + (size_t)cur.pn * tstep;
    S.a_ready(cur);
    if constexpr (SP2) {
        PG8_STAGE(PG8_SB(0, 0), cB, voffB); PG8_STAGE(PG8_SB(0, 1), cB + hstep, voffB); PG8_STAGE(PG8_SA(0, 0), cA, voffA); PG8_STAGE(PG8_SA(0, 1), cA + hstep, voffA);
        if (wr == 1) PG8_BAR;
        PG8_WAIT_V(2); PG8_BAR;
        PG8_STAGE(PG8_SB(1, 0), cB + kstep, voffB); PG8_STAGE(PG8_SA(1, 0), cA + kstep, voffA); PG8_STAGE(PG8_SB(1, 1), cB + hstep + kstep, voffB);
        PG8_WAIT_V(6); PG8_BAR;
    } else {
        PG8_STAGE(PG8_SB(0, 0), cB, voffB); PG8_STAGE(PG8_SA(0, 0), cA, voffA); PG8_STAGE(PG8_SB(0, 1), cB + hstep, voffB); PG8_STAGE(PG8_SA(0, 1), cA + hstep, voffA);
        if (wr == 1) PG8_BAR;
        PG8_WAIT_V(4); PG8_BAR;
        PG8_STAGE(PG8_SB(1, 0), cB + kstep, voffB); PG8_STAGE(PG8_SA(1, 0), cA + kstep, voffA); PG8_STAGE(PG8_SB(1, 1), cB + hstep + kstep, voffB);
        PG8_WAIT_V(6); PG8_BAR;
    }
    for (;;) {
        const bool has_next = S.next(ui + 1, nxt);
        const char* nA = has_next ? (const char*)g.A + (size_t)nxt.pm * tstep : cA; const char* nB = has_next ? (const char*)g.Bt + (size_t)nxt.pn * tstep : cB;
#pragma unroll 1
        for (int t = 0; t < nt; t += 2) {
            if constexpr (Epi::MID) { if (t == (nt >> 1)) E.mid(acc, cur, wr, wc, fr, fq); }
            const bool last = (t == nt - 2);
            const char* a1 = cA + (size_t)(t + 1) * kstep;
            const char* a2 = last ? nA : cA + (size_t)(t + 2) * kstep; const char* b2 = last ? nB : cB + (size_t)(t + 2) * kstep;
            const char* a3 = a2 + kstep; const char* b3 = b2 + kstep;
            if (last && has_next) S.a_ready(nxt);
            if constexpr (SP2) {
            PG8_LDB(B0, 0, 0); PG8_LDB(B1, 0, 1); PG8_SCHED; PG8_LDA(At, 0, 0); PG8_STAGE(PG8_SA(1, 1), a1 + hstep, voffA);
            PG8_WAIT_V(8); PG8_WAIT_L(0); PG8_BAR; PG8_MMA(0, 0, At, B0); PG8_MMA(0, 1, At, B1); PG8_BAR; PG8_SCHED;
            PG8_LDA(At, 0, 1); PG8_STAGE(PG8_SB(0, 0), b2, voffB); PG8_STAGE(PG8_SB(0, 1), b2 + hstep, voffB); PG8_STAGE(PG8_SA(0, 0), a2, voffA);
            PG8_WAIT_V(8); PG8_WAIT_L(0); PG8_BAR; PG8_MMA(1, 0, At, B0); PG8_MMA(1, 1, At, B1); PG8_BAR; PG8_SCHED;
            PG8_LDB(B0, 1, 0); PG8_LDB(B1, 1, 1); PG8_SCHED; PG8_LDA(At, 1, 0); PG8_STAGE(PG8_SA(0, 1), a2 + hstep, voffA);
            PG8_WAIT_V(8); PG8_WAIT_L(0); PG8_BAR; PG8_MMA(0, 0, At, B0); PG8_MMA(0, 1, At, B1); PG8_BAR; PG8_SCHED;
            PG8_LDA(At, 1, 1); PG8_STAGE(PG8_SB(1, 0), b3, voffB); PG8_STAGE(PG8_SB(1, 1), b3 + hstep, voffB); PG8_STAGE(PG8_SA(1, 0), a3, voffA);
            PG8_WAIT_V(8); PG8_WAIT_L(0); PG8_BAR; PG8_MMA(1, 0, At, B0); PG8_MMA(1, 1, At, B1); PG8_BAR; PG8_SCHED;
            } else {
            PG8_LDB(B0, 0, 0); PG8_SCHED; PG8_LDA(At, 0, 0); PG8_STAGE(PG8_SA(1, 1), a1 + hstep, voffA);
            PG8_WAIT_L(8); PG8_BAR; PG8_WAIT_L(0); PG8_MMA(0, 0, At, B0); PG8_BAR; PG8_SCHED;
            PG8_LDB(B1, 0, 1); PG8_STAGE(PG8_SB(0, 0), b2, voffB);
            PG8_BAR; PG8_WAIT_L(0); PG8_MMA(0, 1, At, B1); PG8_BAR;
            PG8_LDA(At, 0, 1); PG8_STAGE(PG8_SA(0, 0), a2, voffA);
            PG8_BAR; PG8_WAIT_L(0); PG8_MMA(1, 0, At, B0); PG8_BAR; PG8_SCHED;
            PG8_STAGE(PG8_SB(0, 1), b2 + hstep, voffB);
            PG8_WAIT_V(6); PG8_BAR; PG8_MMA(1, 1, At, B1); PG8_BAR;
            PG8_LDB(B0, 1, 0); PG8_SCHED; PG8_LDA(At, 1, 0); PG8_STAGE(PG8_SA(0, 1), a2 + hstep, voffA);
            PG8_WAIT_L(8); PG8_BAR; PG8_WAIT_L(0); PG8_MMA(0, 0, At, B0); PG8_BAR; PG8_SCHED;
            PG8_LDB(B1, 1, 1); PG8_STAGE(PG8_SB(1, 0), b3, voffB);
            PG8_BAR; PG8_WAIT_L(0); PG8_MMA(0, 1, At, B1); PG8_BAR;
            PG8_LDA(At, 1, 1); PG8_STAGE(PG8_SA(1, 0), a3, voffA);
            PG8_BAR; PG8_WAIT_L(0); PG8_MMA(1, 0, At, B0); PG8_BAR; PG8_SCHED;
            PG8_STAGE(PG8_SB(1, 1), b3 + hstep, voffB);
            PG8_WAIT_V(6); PG8_BAR; PG8_MMA(1, 1, At, B1); PG8_BAR;
            }
        }
        if constexpr (FP8) asm volatile("s_nop 15\n\ts_nop 15\n\ts_nop 15" ::: "memory");
        if constexpr (ALIGN_EPI) { if (wr == 0) PG8_BAR; }
        if constexpr (!Epi::AFTER_DRAIN) { E(acc, cur, wr, wc, fr, fq); S.done(cur); }
        if (!has_next) break;
#pragma unroll
        for (int a = 0; a < 2; ++a)
#pragma unroll
            for (int b = 0; b < 2; ++b)
#pragma unroll
                for (int m = 0; m < 4; ++m)
#pragma unroll
                    for (int n = 0; n < 2; ++n) acc[a][b][m][n] = (f32x4){0.f, 0.f, 0.f, 0.f};
        cur = nxt; cA = nA; cB = nB; ++ui;
        if constexpr (ALIGN_EPI) { if (wr == 1) PG8_BAR; }
    }
    PG8_WAIT_V(0);
    if constexpr (!ALIGN_EPI) { if (wr == 0) PG8_BAR; }
    PG8_BAR;
    if constexpr (Epi::AFTER_DRAIN) { E.fused(acc, cur, wr, wc, fr, fq, lds, wid, lane); S.done(cur); }
#undef PG8_SA
#undef PG8_SB
#undef PG8_STAGE
#undef PG8_LDA
#undef PG8_LDB
#undef PG8_MMA
#undef PG8_WAIT_V
#undef PG8_WAIT_L
#undef PG8_BAR
#undef PG8_SCHED
}
}

constexpr int NWAVES = 8;
constexpr int N_LAUNCHES = MK_N_LAUNCHES;
constexpr int PER_PHASE = 10;
constexpr int T = 32768, D = 1024, SEQ = 4096, NIN = 5632, NUNIT = 4096;
constexpr float EPS = 1e-6f;
constexpr size_t MiB = 1u << 20;
constexpr size_t WS_CTL = 0, CTL_ZERO_BYTES = 1 * MiB;
constexpr size_t WS_WMAX = 64 * 1024;
constexpr size_t WS_SWR = 1 * MiB + 512 * 1024;
constexpr size_t WS_RFAC = 1 * MiB + 768 * 1024;
constexpr size_t WS_ROWSS = 4 * MiB;
constexpr size_t WS_RSTD1 = 1 * MiB;
constexpr size_t WS_LB = 1 * MiB + 256 * 1024;
constexpr size_t WS_DEC = 2 * MiB;
constexpr size_t WS_WIN = 8 * MiB, WS_PAB = 19 * MiB, WS_WO = 21 * MiB, WS_WQ = 23 * MiB, WS_KEYS = 27 * MiB;
constexpr size_t WS_GA = 32 * MiB, WS_GB = 96 * MiB;
constexpr size_t WS_Q = 160 * MiB, WS_LF = 192 * MiB, WS_KK = 224 * MiB, WS_V = 256 * MiB, WS_SG = 288 * MiB, WS_CB = 320 * MiB, WS_U = 352 * MiB;
constexpr size_t WS_XB = 384 * MiB;
constexpr size_t WS_LOC = 448 * MiB;
constexpr size_t WS_SPREV = 320 * MiB;
constexpr size_t WS_X1 = 32 * MiB;
constexpr size_t WS_MG = 160 * MiB;
constexpr size_t WS_X1B = 224 * MiB;
constexpr size_t WS_QQ = 288 * MiB;
constexpr size_t WS_IDX = 416 * MiB, WS_GATE = 432 * MiB;
constexpr size_t WS_EU = 160 * MiB, WS_EV = 176 * MiB;
constexpr size_t WS_ESC = 192 * MiB;
constexpr size_t WS_X8 = 448 * MiB;
constexpr size_t WS_W8G = 28 * MiB;
constexpr size_t WS_END = 480 * MiB;
constexpr int CW_BAR = 4096;
constexpr int RING_BYTES = 131072, WAVE_LDS = 18688, MISC_OFF = NWAVES * WAVE_LDS, LDS_BYTES = MISC_OFF + 1024;
static_assert(MISC_OFF >= RING_BYTES && LDS_BYTES <= 160 * 1024, "LDS map");

#define GAS __attribute__((address_space(1)))
#define LAS __attribute__((address_space(3)))
typedef unsigned short bf16;
typedef unsigned v4u __attribute__((ext_vector_type(4)));
typedef unsigned v2u __attribute__((ext_vector_type(2)));
typedef float f32x4 __attribute__((ext_vector_type(4)));
typedef float f32x16 __attribute__((ext_vector_type(16)));
typedef short bf16x8 __attribute__((ext_vector_type(8)));
typedef __bf16 bf16x2_t __attribute__((ext_vector_type(2)));
typedef GAS unsigned gu32;
#define RLX_AGENT __ATOMIC_RELAXED, __HIP_MEMORY_SCOPE_AGENT
#define LDS_WAIT() asm volatile("s_waitcnt lgkmcnt(0)" ::: "memory")
#define VM_WAIT() asm volatile("s_waitcnt vmcnt(0)" ::: "memory")
#define MFMA32(a, b, c) __builtin_amdgcn_mfma_f32_32x32x16_bf16((a), (b), (c), 0, 0, 0)
using pg8::cvt_pk_bf16; using pg8::fexp; using pg8::fsig; using pg8::bflo; using pg8::bfhi;
__device__ __forceinline__ int crow(int reg, int h) { return (reg & 3) + 8 * (reg >> 2) + 4 * h; }

#define XB_TMO      128
#define XB_XCNT(j)  (256  + 64 * (j))
#define XB_XSUB(j)  (1280 + 64 * (j))
#define XB_XGEN(j)  (2304 + 64 * (j))
#define XB_TOP      3328
#define XB_TOPGEN   3392
#define XCD_BAR_WORDS 3456
#define XB_SPIN_CAP (1u << 18)
__device__ __forceinline__ unsigned xb_ld(unsigned* p)              { return __hip_atomic_load(p, __ATOMIC_RELAXED, __HIP_MEMORY_SCOPE_AGENT); }
__device__ __forceinline__ unsigned xb_add(unsigned* p, unsigned v) { return __hip_atomic_fetch_add(p, v, __ATOMIC_RELAXED, __HIP_MEMORY_SCOPE_AGENT); }
__device__ __forceinline__ unsigned xb_xcc_id() { return (unsigned)__builtin_amdgcn_s_getreg((3 << 11) | 20) & 0xFu; }
#define XB_SPIN(cond, bar) do { unsigned _sp = 0; while (cond) { __builtin_amdgcn_s_sleep(1); \
    if ((++_sp & 255u) == 0u) { if (xb_ld(&(bar)[XB_TMO])) break; if (_sp > XB_SPIN_CAP) { atomicAdd(&(bar)[XB_TMO], 1u); break; } } } } while (0)
struct XcdBarrier { unsigned* bar; unsigned x; volatile LAS unsigned* st; };
__device__ __forceinline__ XcdBarrier xcd_barrier_post(unsigned* bar, volatile LAS unsigned* st) {
    XcdBarrier b; b.bar = bar; b.x = xb_xcc_id(); b.st = st;
    if (threadIdx.x == 0) (void)xb_add(&bar[XB_XCNT(b.x)], 1u);
    return b;
}
__device__ __forceinline__ void xcd_barrier_complete(unsigned* bar, unsigned x, unsigned& nloc, unsigned& nx) {
    const unsigned G = gridDim.x * gridDim.y * gridDim.z;
    unsigned sum, cnt, mine, sp = 0u;
    for (;;) {
        sum = 0u; cnt = 0u; mine = 0u;
#pragma unroll
        for (unsigned j = 0; j < 16; ++j) { const unsigned c = xb_ld(&bar[XB_XCNT(j)]); sum += c; cnt += (c > 0u) ? 1u : 0u; mine = (j == x) ? c : mine; }
        if (sum == G) break;
        __builtin_amdgcn_s_sleep(1);
        if ((++sp & 255u) == 0u) { if (xb_ld(&bar[XB_TMO])) break; if (sp > XB_SPIN_CAP) { atomicAdd(&bar[XB_TMO], 1u); break; } }
    }
    nloc = mine > 0u ? mine : 1u; nx = cnt > 0u ? cnt : 1u;
}
__device__ __forceinline__ void xcd_barrier(const XcdBarrier& b) {
    asm volatile("s_waitcnt vmcnt(0)" ::: "memory");
    __syncthreads();
    if (threadIdx.x == 0) {
        unsigned* bar = b.bar;
        __builtin_amdgcn_s_waitcnt(0);
        unsigned nloc = b.st[0], nx = b.st[1];
        if (nloc == 0u) { xcd_barrier_complete(bar, b.x, nloc, nx); b.st[0] = nloc; b.st[1] = nx; }
        const unsigned old = xb_add(&bar[XB_XSUB(b.x)], 1u);
        const unsigned gen = old / nloc;
        if (old + 1u == (gen + 1u) * nloc) {
            __builtin_amdgcn_fence(__ATOMIC_RELEASE, "agent");
            asm volatile("s_waitcnt vmcnt(0)" ::: "memory");
            const unsigned og = xb_add(&bar[XB_TOP], 1u);
            const unsigned tg = og / nx;
            if (og + 1u == (tg + 1u) * nx) xb_add(&bar[XB_TOPGEN], 1u);
            else XB_SPIN(xb_ld(&bar[XB_TOPGEN]) == tg, bar);
            __builtin_amdgcn_fence(__ATOMIC_ACQUIRE, "agent");
            xb_add(&bar[XB_XGEN(b.x)], 1u);
            asm volatile("s_waitcnt vmcnt(0)" ::: "memory");
        } else {
            XB_SPIN(xb_ld(&bar[XB_XGEN(b.x)]) == gen, bar);
            __builtin_amdgcn_fence(__ATOMIC_ACQUIRE, "agent");
            asm volatile("s_waitcnt vmcnt(0)" ::: "memory");
        }
    }
    __syncthreads();
}

struct Args { const float* in[16]; float* out; unsigned char* ws; int ph_lo, ph_hi, li, pad; };
struct Frame {
    LAS unsigned char* lds;
    int wave;
    int vcu, G;
    int gw, ngw;
    float* out; unsigned char* ws;
};
__device__ __forceinline__ float wave_sum(float v) {
#pragma unroll
    for (int o = 1; o < 64; o <<= 1) v += __shfl_xor(v, o);
    return v;
}
__device__ __forceinline__ unsigned f2bf(float f) { unsigned u = __builtin_bit_cast(unsigned, f); return (u + 0x7fffu + ((u >> 16) & 1u)) >> 16; }
__device__ __forceinline__ unsigned pk2(float lo, float hi) { return cvt_pk_bf16(lo, hi); }
__device__ __forceinline__ float bf2f(bf16 h) { return __builtin_bit_cast(float, (unsigned)h << 16); }

__device__ __forceinline__ int win_dst_row(int n) {
    if (n >= 2560 && n < 3072) { const int j = (n - 2560) >> 7, r = (n - 2560) & 127; return 2560 + 256 * j + r; }
    if (n >= 3072 && n < 3584) { const int j = (n - 3072) >> 7, r = (n - 3072) & 127; return 2560 + 256 * j + 128 + r; }
#ifdef DBG_SWAPG
    if (n >= 3584 && n < 4608) return n + 1024;
    if (n >= 4608) return n - 1024;
#endif
    return n;
}
__device__ __forceinline__ void p0_transpose_item(const float* W, int K, int N, const float* gain, bf16* WT, int ldwt, int koff, bool perm, LAS float* scr, int item, int lane, unsigned char* W8 = nullptr, const void* W8q_max = nullptr, float* W8q_swr = nullptr) {
    const int nblk = N / 32, kb = item / nblk, nb = item % nblk, k0 = 64 * kb, n0 = 32 * nb;
    { float wv[32];
#pragma unroll
      for (int i = 0; i < 32; ++i) wv[i] = W[(size_t)(k0 + 2 * i + (lane >> 5)) * N + n0 + (lane & 31)];
#pragma unroll
      for (int i = 0; i < 32; ++i) { const int kk = 2 * i + (lane >> 5); float v = wv[i]; if (gain) v *= gain[k0 + kk]; scr[kk * 33 + (lane & 31)] = v; } }
    LDS_WAIT(); asm volatile("" ::: "memory");
    const int c = lane & 7, d0 = perm ? win_dst_row(n0) : n0;
    if (W8 != nullptr) {
        const unsigned* wmx = (const unsigned*)W8q_max; float* swr = W8q_swr;
#pragma unroll
        for (int j = 0; j < 4; ++j) { const int n = (lane >> 3) + 8 * j; const LAS float* s = scr + (8 * c) * 33 + n;
            const float mx = fmaxf(__builtin_bit_cast(float, wmx[n0 + n]), 1e-30f), inv = 127.0f / mx;
            unsigned lo = 0u, hi = 0u;
#pragma unroll
            for (int i = 0; i < 4; ++i) { lo |= ((unsigned)__float2int_rn(s[i * 33] * inv) & 0xffu) << (8 * i); hi |= ((unsigned)__float2int_rn(s[(4 + i) * 33] * inv) & 0xffu) << (8 * i); }
            v2u o; o.x = lo; o.y = hi; *(GAS v2u*)(W8 + (size_t)(d0 + n) * 1024 + k0 + 8 * c) = o;
            if (c == 0 && kb == 0) swr[d0 + n] = mx * (1.0f / 127.0f); }
        LDS_WAIT(); asm volatile("" ::: "memory");
        return;
    }
#pragma unroll
    for (int j = 0; j < 4; ++j) { const int n = (lane >> 3) + 8 * j; const LAS float* s = scr + (8 * c) * 33 + n;
        v4u o; o.x = pk2(s[0 * 33], s[1 * 33]); o.y = pk2(s[2 * 33], s[3 * 33]); o.z = pk2(s[4 * 33], s[5 * 33]); o.w = pk2(s[6 * 33], s[7 * 33]);
        *(GAS v4u*)(WT + (size_t)(d0 + n) * ldwt + koff + k0 + 8 * c) = o; }
    LDS_WAIT(); asm volatile("" ::: "memory");
}
__device__ __forceinline__ void cvt512(const float* src, bf16* dst, size_t item, int lane) {
    const f32x4 a = *(const f32x4*)(src + item * 512 + lane * 8), b = *(const f32x4*)(src + item * 512 + lane * 8 + 4);
    v4u o; o.x = pk2(a[0], a[1]); o.y = pk2(a[2], a[3]); o.z = pk2(b[0], b[1]); o.w = pk2(b[2], b[3]);
    *(v4u*)(dst + item * 512 + lane * 8) = o;
}
__device__ __forceinline__ void p0_win_item(const float* W, const float* gain, unsigned char* W8, float* swr, LAS unsigned char* lds, int wave, int nb, int lane) {
    const int n0 = 32 * nb, kw = 128 * wave; float wv[64];
#pragma unroll
    for (int i = 0; i < 64; ++i) wv[i] = W[(size_t)(kw + 2 * i + (lane >> 5)) * NIN + n0 + (lane & 31)];
    float m = 0.f;
#pragma unroll
    for (int i = 0; i < 64; ++i) { wv[i] *= gain[kw + 2 * i + (lane >> 5)]; m = fmaxf(m, fabsf(wv[i])); }
    m = fmaxf(m, __shfl_xor(m, 32));
    LAS float* cm = (LAS float*)(lds + 12288);
    if (lane < 32) cm[wave * 32 + lane] = m;
    __syncthreads();
    LAS float* scr = (LAS float*)(lds + wave * 16384);
    const int c = lane & 7, d0 = win_dst_row(n0);
    float inv[4], mxs[4];
#pragma unroll
    for (int j = 0; j < 4; ++j) { const int n = (lane >> 3) + 8 * j; float mx = cm[n];
#pragma unroll
        for (int w = 1; w < 8; ++w) mx = fmaxf(mx, cm[w * 32 + n]);
        mx = fmaxf(mx, 1e-30f); inv[j] = 127.0f / mx; mxs[j] = mx * (1.0f / 127.0f); }
#pragma unroll
    for (int h = 0; h < 2; ++h) {
#pragma unroll
        for (int i = 0; i < 32; ++i) scr[(2 * i + (lane >> 5)) * 33 + (lane & 31)] = wv[32 * h + i];
        LDS_WAIT(); asm volatile("" ::: "memory");
#pragma unroll
        for (int j = 0; j < 4; ++j) { const int n = (lane >> 3) + 8 * j; const LAS float* sp = scr + (8 * c) * 33 + n;
            unsigned lo = 0u, hi = 0u;
#pragma unroll
            for (int i = 0; i < 4; ++i) { lo |= ((unsigned)__float2int_rn(sp[i * 33] * inv[j]) & 0xffu) << (8 * i); hi |= ((unsigned)__float2int_rn(sp[(4 + i) * 33] * inv[j]) & 0xffu) << (8 * i); }
            v2u o; o.x = lo; o.y = hi; *(GAS v2u*)(W8 + (size_t)(d0 + n) * 1024 + kw + 64 * h + 8 * c) = o; }
        LDS_WAIT(); asm volatile("" ::: "memory");
    }
    if (wave == 0 && c == 0) {
#pragma unroll
        for (int j = 0; j < 4; ++j) swr[d0 + (lane >> 3) + 8 * j] = mxs[j]; }
    __syncthreads();
}
__device__ __forceinline__ void p0_colmax(Frame& F, const Args& A) {
    const float *g_mix = A.in[1], *w_in = A.in[2]; unsigned* wmx = (unsigned*)(F.ws + WS_WMAX); const int lane = pg8::fresh_lane();
    for (int item = F.gw; item < 16 * 176; item += F.ngw) {
        const int kb = item / 176, nb = item % 176, k0 = 64 * kb, n0 = 32 * nb; float wv[32];
#pragma unroll
        for (int i = 0; i < 32; ++i) wv[i] = w_in[(size_t)(k0 + 2 * i + (lane >> 5)) * NIN + n0 + (lane & 31)];
        float m = 0.f;
#pragma unroll
        for (int i = 0; i < 32; ++i) m = fmaxf(m, fabsf(wv[i] * g_mix[k0 + 2 * i + (lane >> 5)]));
        m = fmaxf(m, __shfl_xor(m, 32));
        if (lane < 32) atomicMax(wmx + n0 + lane, __builtin_bit_cast(unsigned, m));
    }
}
__device__ __forceinline__ void p0_prologue(Frame& F, const Args& A) {
    const float *x = A.in[0], *g_mix = A.in[1], *w_in = A.in[2], *lb_log = A.in[3], *w_pa = A.in[6], *w_pb = A.in[7], *w_o = A.in[8], *g_ffn = A.in[9], *w_q = A.in[10],
                *k1 = A.in[11], *k2 = A.in[12];
    unsigned char* ws = F.ws; const int lane_ = pg8::fresh_lane();
    LAS float* scr = (LAS float*)(F.lds + F.wave * 16384);
    constexpr int I_P = 8 * 32, I_O = 16 * 32, I_Q = 16 * 64, NITEMS = 2 * I_P + I_O + I_Q;
    for (int nb = F.vcu; nb < NIN / 32; nb += F.G) p0_win_item(w_in, g_mix, ws + WS_WIN, (float*)(ws + WS_SWR), F.lds, F.wave, nb, lane_);
    for (int it = F.gw; it < NITEMS; it += F.ngw) {
        int r = it;
        if (r < I_P) { p0_transpose_item(w_pa, 512, 1024, nullptr, (bf16*)(ws + WS_PAB), 1024, 0, false, scr, r, lane_); continue; } r -= I_P;
        if (r < I_P) { p0_transpose_item(w_pb, 512, 1024, nullptr, (bf16*)(ws + WS_PAB), 1024, 512, false, scr, r, lane_); continue; } r -= I_P;
        if (r < I_O) { p0_transpose_item(w_o, 1024, 1024, nullptr, (bf16*)(ws + WS_WO), 1024, 0, false, scr, r, lane_); continue; } r -= I_O;
        p0_transpose_item(w_q, 1024, 2048, g_ffn, (bf16*)(ws + WS_WQ), 1024, 0, false, scr, r, lane_);
    }
    for (int it = F.gw; it < 512; it += F.ngw) { if (it < 256) cvt512(k1, (bf16*)(ws + WS_KEYS), it, lane_); else cvt512(k2, (bf16*)(ws + WS_KEYS) + 131072, it - 256, lane_); }
    float* rstd1 = (float*)(ws + WS_RSTD1);
    for (int m0 = F.gw; m0 < T; m0 += 2 * F.ngw) {
        f32x4 v[2][4];
#pragma unroll
        for (int h = 0; h < 2; ++h) { const f32x4* xr = (const f32x4*)(x + (size_t)((h && m0 + F.ngw >= T) ? m0 : m0 + h * F.ngw) * D) + lane_;
#pragma unroll
            for (int j = 0; j < 4; ++j) v[h][j] = xr[64 * j]; }
#pragma unroll
        for (int h = 0; h < 2; ++h) { const int m = (h && m0 + F.ngw >= T) ? m0 : m0 + h * F.ngw; float s = 0.f, mx = 0.f;
#pragma unroll
            for (int j = 0; j < 4; ++j) { s += (v[h][j][0] * v[h][j][0] + v[h][j][1] * v[h][j][1]) + (v[h][j][2] * v[h][j][2] + v[h][j][3] * v[h][j][3]);
                mx = fmaxf(mx, fmaxf(fmaxf(fabsf(v[h][j][0]), fabsf(v[h][j][1])), fmaxf(fabsf(v[h][j][2]), fabsf(v[h][j][3])))); }
            s = wave_sum(s);
#pragma unroll
            for (int o = 1; o < 64; o <<= 1) mx = fmaxf(mx, __shfl_xor(mx, o));
            mx = fmaxf(mx, 1e-30f); const float qinv = 127.0f / mx;
            if (lane_ == 0) { const float rs_ = __builtin_amdgcn_rsqf(s * (1.0f / D) + EPS); rstd1[m] = rs_; ((float*)(ws + WS_RFAC))[m] = rs_ * mx * (1.0f / 127.0f); }
            unsigned* q8 = (unsigned*)(ws + WS_X8 + (size_t)m * D) + lane_;
#pragma unroll
            for (int j = 0; j < 4; ++j)
                q8[64 * j] = ((unsigned)__float2int_rn(v[h][j][0] * qinv) & 0xffu) | (((unsigned)__float2int_rn(v[h][j][1] * qinv) & 0xffu) << 8) | (((unsigned)__float2int_rn(v[h][j][2] * qinv) & 0xffu) << 16) | ((unsigned)__float2int_rn(v[h][j][3] * qinv) << 24);
        }
    }
    if (F.gw == 0) { float* lb = (float*)(ws + WS_LB);
        for (int j = lane_; j < 512; j += 64) { const float a = lb_log[j], b = lb_log[512 + j]; lb[j] = 1.0f / (1.0f + expf(b - a)); } }
}

#define P2_SCATTER(REG, SRC) { _Pragma("unroll") for (int p = 0; p < 8; ++p) { LAS unsigned char* dst_ = (REG) + (8 * cc) * 144 + cc * 16 + 2 * (rr + 8 * p); const unsigned w_[4] = {SRC[p].x, SRC[p].y, SRC[p].z, SRC[p].w}; \
        _Pragma("unroll") for (int i = 0; i < 4; ++i) { *(LAS bf16*)(dst_ + (2 * i) * 144) = (bf16)(w_[i] & 0xffffu); *(LAS bf16*)(dst_ + (2 * i + 1) * 144) = (bf16)(w_[i] >> 16); } } }
#define P2_ROWLOAD(REG, W) { _Pragma("unroll") for (int j = 0; j < 8; ++j) { const v4u o_ = *(LAS v4u*)((REG) + lane * 144 + rr * 16 + j * 16); W[4 * j] = o_.x; W[4 * j + 1] = o_.y; W[4 * j + 2] = o_.z; W[4 * j + 3] = o_.w; } }
#define P2_ROWSTORE(REG, W) { _Pragma("unroll") for (int j = 0; j < 8; ++j) { v4u o_; o_.x = W[4 * j]; o_.y = W[4 * j + 1]; o_.z = W[4 * j + 2]; o_.w = W[4 * j + 3]; *(LAS v4u*)((REG) + lane * 144 + rr * 16 + j * 16) = o_; } }
#define P2_GATHER_STORE(REG, GP) { int ro_ = rr; asm volatile("" : "+v"(ro_));     \
    _Pragma("unroll") for (int p = 0; p < 8; ++p) { const LAS unsigned char* src_ = (REG) + (8 * cc) * 144 + cc * 16 + 2 * (ro_ + 8 * p); unsigned e_[8]; \
        _Pragma("unroll") for (int i = 0; i < 8; ++i) e_[i] = (unsigned)*(const LAS bf16*)(src_ + i * 144); \
        v4u o_; o_.x = e_[0] | (e_[1] << 16); o_.y = e_[2] | (e_[3] << 16); o_.z = e_[4] | (e_[5] << 16); o_.w = e_[6] | (e_[7] << 16); *(v4u*)((GP) + (size_t)(ro_ + 8 * p) * 512) = o_; if (p & 1) asm volatile("" ::: "memory"); } }
__device__ __forceinline__ void p2_unit(Frame& F, int unit) {
    unsigned char* ws = F.ws; const int lane = pg8::fresh_lane(), rr = lane >> 3, cc = lane & 7;
    const int bh = unit >> 6, c = unit & 63, bb = bh >> 3, h = bh & 7; const size_t t0 = (size_t)bb * SEQ + c * 64; const int cb0 = h * 64;
    bf16* Qg = (bf16*)(ws + WS_Q) + t0 * 512 + cb0 + 8 * cc; bf16* Kg = (bf16*)(ws + WS_KK) + t0 * 512 + cb0 + 8 * cc; const bf16* Vg = (const bf16*)(ws + WS_V) + t0 * 512 + cb0 + 8 * cc;
    LAS unsigned char* wl = F.lds + F.wave * WAVE_LDS; LAS unsigned char* KH = wl; LAS unsigned char* VT = wl + 9344;
    v4u kw[8], qw[8];
#pragma unroll
    for (int p = 0; p < 8; ++p) { kw[p] = *(const v4u*)(Kg + (size_t)(rr + 8 * p) * 512); qw[p] = *(const v4u*)(Qg + (size_t)(rr + 8 * p) * 512); }
    P2_SCATTER(KH, kw) P2_SCATTER(VT, qw)
    LDS_WAIT(); asm volatile("" ::: "memory");
    unsigned kr[32]; P2_ROWLOAD(KH, kr)
    LDS_WAIT(); asm volatile("" ::: "memory");
    float b[64];
    { float run = 0.f;
#pragma unroll
      for (int t = 0; t < 64; ++t) { const float kt = (t & 1) ? bfhi(kr[t >> 1]) : bflo(kr[t >> 1]); run += __builtin_amdgcn_logf(1.0f - kt) * 0.69314718056f; b[t] = run; } }
    const float blast = b[63];
    ((float*)(ws + WS_DEC))[unit * 64 + lane] = fexp(blast);
    { unsigned w[32];
#pragma unroll
      for (int t = 0; t < 64; t += 2) w[t >> 1] = pk2(bflo(kr[t >> 1]) * fexp(-b[t]), bfhi(kr[t >> 1]) * fexp(-b[t + 1]));
      P2_ROWSTORE(KH, w) }
    LDS_WAIT(); asm volatile("" ::: "memory");
    P2_GATHER_STORE(KH, Kg)
    LDS_WAIT(); asm volatile("" ::: "memory");
    { unsigned w[32];
#pragma unroll
      for (int t = 0; t < 64; t += 2) w[t >> 1] = pk2(bflo(kr[t >> 1]) * fexp(blast - b[t]), bfhi(kr[t >> 1]) * fexp(blast - b[t + 1]));
      P2_ROWSTORE(KH, w) }
    { unsigned w[32]; P2_ROWLOAD(VT, w)
      LDS_WAIT(); asm volatile("" ::: "memory");
#pragma unroll
      for (int t = 0; t < 64; t += 2) w[t >> 1] = pk2(bflo(w[t >> 1]) * fexp(b[t]), bfhi(w[t >> 1]) * fexp(b[t + 1]));
      P2_ROWSTORE(VT, w) }
    LDS_WAIT(); asm volatile("" ::: "memory");
    P2_GATHER_STORE(VT, Qg)
    LDS_WAIT(); asm volatile("" ::: "memory");
    { v4u vw[8]; int ro = rr; asm volatile("" : "+v"(ro));
#pragma unroll
      for (int p = 0; p < 8; ++p) vw[p] = *(const v4u*)(Vg + (size_t)(ro + 8 * p) * 512);
      P2_SCATTER(VT, vw) }
    LDS_WAIT(); asm volatile("" ::: "memory");
    const int r = lane & 31, hh = lane >> 5;
    f32x16 acc[2][2];
#pragma unroll
    for (int i = 0; i < 2; ++i)
#pragma unroll
        for (int j = 0; j < 2; ++j)
#pragma unroll
            for (int k = 0; k < 16; ++k) acc[i][j][k] = 0.f;
#pragma unroll
    for (int ks = 0; ks < 4; ++ks) {
        bf16x8 a[2], bq[2];
#pragma unroll
        for (int i = 0; i < 2; ++i) { const int ra = (32 * i + r) * 144 + (4 * i + (r >> 3)) * 16 + (16 * ks + 8 * hh) * 2; a[i] = *(const LAS bf16x8*)(VT + ra); bq[i] = *(const LAS bf16x8*)(KH + ra); }
#pragma unroll
        for (int i = 0; i < 2; ++i)
#pragma unroll
            for (int j = 0; j < 2; ++j) acc[i][j] = MFMA32(a[i], bq[j], acc[i][j]);
    }
    LDS_WAIT(); asm volatile("" ::: "memory");
    { LAS float* OL = (LAS float*)wl;
#pragma unroll
      for (int i = 0; i < 2; ++i)
#pragma unroll
          for (int j = 0; j < 2; ++j)
#pragma unroll
              for (int k = 0; k < 16; ++k) OL[(32 * i + crow(k, hh)) * 68 + 32 * j + r] = acc[i][j][k];
      LDS_WAIT(); asm volatile("" ::: "memory");
      bf16* LOC = (bf16*)(ws + WS_LOC) + (size_t)unit * 4096 + 8 * cc; int ro = rr; asm volatile("" : "+v"(ro));
#pragma unroll
      for (int p = 0; p < 8; ++p) { const int e = ro + 8 * p; const f32x4 v0 = *(LAS f32x4*)(OL + e * 68 + 8 * cc), v1 = *(LAS f32x4*)(OL + e * 68 + 8 * cc + 4);
          v4u o; o.x = pk2(v0[0], v0[1]); o.y = pk2(v0[2], v0[3]); o.z = pk2(v1[0], v1[1]); o.w = pk2(v1[2], v1[3]); *(v4u*)(LOC + e * 64) = o; } }
    LDS_WAIT(); asm volatile("" ::: "memory");
}
__device__ __forceinline__ void p2_phase(Frame& F, const float* cw) {
    for (int u = F.gw; u < NUNIT; u += F.ngw) p2_unit(F, u);
    unsigned char* ws = F.ws;
    const bf16* CB = (const bf16*)(ws + WS_CB); const bf16* U = (const bf16*)(ws + WS_U); bf16* YAB = (bf16*)F.out;
    const int gt = F.vcu * (NWAVES * 64) + F.wave * 64 + pg8::fresh_lane(), ngt = F.G * NWAVES * 64;
    for (int i = gt; i < (T / 16) * 64; i += ngt) {
        const int t0 = (i >> 6) * 16, j0 = (i & 63) * 8;
        float w0[8], w1[8], w2[8];
        { const f32x4 a0 = *(const f32x4*)(cw + j0), a1 = *(const f32x4*)(cw + j0 + 4), b0 = *(const f32x4*)(cw + 512 + j0), b1 = *(const f32x4*)(cw + 512 + j0 + 4), c0 = *(const f32x4*)(cw + 1024 + j0), c1 = *(const f32x4*)(cw + 1024 + j0 + 4);
#pragma unroll
          for (int k = 0; k < 4; ++k) { w0[k] = a0[k]; w0[4 + k] = a1[k]; w1[k] = b0[k]; w1[4 + k] = b1[k]; w2[k] = c0[k]; w2[4 + k] = c1[k]; } }
        float um2[8], um1[8];
        if ((t0 & (SEQ - 1)) != 0) { pg8::ld8(U + (size_t)(t0 - 2) * 512 + j0, um2); pg8::ld8(U + (size_t)(t0 - 1) * 512 + j0, um1); }
        else {
#pragma unroll
            for (int k = 0; k < 8; ++k) { um2[k] = 0.f; um1[k] = 0.f; } }
#pragma unroll 1
        for (int tt = 0; tt < 16; tt += 4) {
            pg8::u32x4 uw[4], cbw[4];
#pragma unroll
            for (int q = 0; q < 4; ++q) { uw[q] = *(const pg8::u32x4*)(U + (size_t)(t0 + tt + q) * 512 + j0); cbw[q] = *(const pg8::u32x4*)(CB + (size_t)(t0 + tt + q) * 512 + j0); }
#pragma unroll
            for (int q = 0; q < 4; ++q) {
                const float u0[8] = {bflo(uw[q].x), bfhi(uw[q].x), bflo(uw[q].y), bfhi(uw[q].y), bflo(uw[q].z), bfhi(uw[q].z), bflo(uw[q].w), bfhi(uw[q].w)};
                const float cbv[8] = {bflo(cbw[q].x), bfhi(cbw[q].x), bflo(cbw[q].y), bfhi(cbw[q].y), bflo(cbw[q].z), bfhi(cbw[q].z), bflo(cbw[q].w), bfhi(cbw[q].w)};
                float y[8];
#pragma unroll
                for (int k = 0; k < 8; ++k) { y[k] = DBG_ZYB * cbv[k] * (w0[k] * um2[k] + w1[k] * um1[k] + w2[k] * u0[k]); um2[k] = um1[k]; um1[k] = u0[k]; }
                pg8::st8(YAB + (size_t)(t0 + tt + q) * 1024 + 512 + j0, y); }
        }
    }
}

__device__ __forceinline__ void p3_phase(Frame& F) {
    unsigned char* ws = F.ws; const bf16* LOC = (const bf16*)(ws + WS_LOC); bf16* SP = (bf16*)(ws + WS_SPREV); const float* DEC = (const float*)(ws + WS_DEC);
    const int gt = F.vcu * (NWAVES * 64) + F.wave * 64 + pg8::fresh_lane(), ngt = F.G * NWAVES * 64;
    for (int i = gt; i < 64 * 4096; i += ngt) {
        const int bh = i >> 12, ed = i & 4095, d = ed & 63; float st = 0.f;
        for (int c0 = 0; c0 < 64; c0 += 8) { float lv[8], dv[8];
#pragma unroll
            for (int k = 0; k < 8; ++k) { lv[k] = bf2f(LOC[(size_t)(bh * 64 + c0 + k) * 4096 + ed]); dv[k] = DEC[(bh * 64 + c0 + k) * 64 + d]; }
#pragma unroll
            for (int k = 0; k < 8; ++k) { SP[(size_t)(bh * 64 + c0 + k) * 4096 + ed] = (bf16)f2bf(st); st = dv[k] * st + lv[k]; } }
    }
}

template <int M> __device__ __forceinline__ float p4_swz(float v) { return __builtin_bit_cast(float, __builtin_amdgcn_ds_swizzle(__builtin_bit_cast(int, v), 0x1f | (M << 10))); }
__device__ __forceinline__ void p4_unit(Frame& F, int unit, const float* gain) {
    unsigned char* ws = F.ws; const int lane = pg8::fresh_lane(), r = lane & 31, hh = lane >> 5;
    const int bh = unit >> 6, c = unit & 63, bb = bh >> 3, h = bh & 7; const size_t t0 = (size_t)bb * SEQ + c * 64; const int cb0 = h * 64;
    const bf16* Qt = (const bf16*)(ws + WS_Q) + t0 * 512 + cb0; const bf16* Kt = (const bf16*)(ws + WS_KK) + t0 * 512 + cb0;
    const bf16* Vp = (const bf16*)(ws + WS_V) + t0 * 512 + cb0 + lane; const bf16* SPu = (const bf16*)(ws + WS_SPREV) + (size_t)unit * 4096;
    LAS unsigned char* wl = F.lds + F.wave * WAVE_LDS; LAS unsigned char* PL = wl; LAS unsigned char* VT = wl + 9216;
    bf16x8 qa[2][4], kb[2][4], spf[2][4];
    { const bf16* Vt = (const bf16*)(ws + WS_V) + t0 * 512 + cb0 + 8 * (lane & 7);
      v4u pv[8];
#pragma unroll
      for (int p = 0; p < 8; ++p) pv[p] = *(const v4u*)(Vt + (size_t)((lane >> 3) + 8 * p) * 512);
#pragma unroll
      for (int i = 0; i < 2; ++i)
#pragma unroll
          for (int ks = 0; ks < 4; ++ks) { qa[i][ks] = *(const bf16x8*)(Qt + (size_t)(32 * i + r) * 512 + 16 * ks + 8 * hh); kb[i][ks] = *(const bf16x8*)(Kt + (size_t)(32 * i + r) * 512 + 16 * ks + 8 * hh); }
#pragma unroll
      for (int jj = 0; jj < 2; ++jj)
#pragma unroll
          for (int ks = 0; ks < 4; ++ks) spf[jj][ks] = *(const bf16x8*)(SPu + (32 * jj + r) * 64 + 16 * ks + 8 * hh);
#pragma unroll
      for (int p = 0; p < 8; ++p) { const int t = (lane >> 3) + 8 * p; LAS unsigned char* dst = VT + (8 * (lane & 7)) * 144 + 2 * t; const unsigned w[4] = {pv[p].x, pv[p].y, pv[p].z, pv[p].w};
#pragma unroll
          for (int i = 0; i < 4; ++i) { *(LAS bf16*)(dst + (2 * i) * 144) = (bf16)(w[i] & 0xffffu); *(LAS bf16*)(dst + (2 * i + 1) * 144) = (bf16)(w[i] >> 16); } } }
    asm volatile("" ::: "memory");
    {
        f32x16 sc[3];
#pragma unroll
        for (int k = 0; k < 16; ++k) { sc[0][k] = 0.f; sc[1][k] = 0.f; sc[2][k] = 0.f; }
#pragma unroll
        for (int ks = 0; ks < 4; ++ks) { sc[0] = MFMA32(qa[0][ks], kb[0][ks], sc[0]); sc[1] = MFMA32(qa[1][ks], kb[0][ks], sc[1]); sc[2] = MFMA32(qa[1][ks], kb[1][ks], sc[2]); }
#pragma unroll
        for (int k = 0; k < 16; ++k) { const int tr = crow(k, hh);
            *(LAS bf16*)(PL + tr * 144 + r * 2) = (bf16)f2bf(r <= tr ? sc[0][k] : 0.f);
            *(LAS bf16*)(PL + (32 + tr) * 144 + r * 2) = (bf16)f2bf(sc[1][k]);
            *(LAS bf16*)(PL + (32 + tr) * 144 + (32 + r) * 2) = (bf16)f2bf(r <= tr ? sc[2][k] : 0.f); }
    }
    asm volatile("" ::: "memory");
    f32x16 o[2][2];
#pragma unroll
    for (int i = 0; i < 2; ++i)
#pragma unroll
        for (int j = 0; j < 2; ++j)
#pragma unroll
            for (int k = 0; k < 16; ++k) o[i][j][k] = 0.f;
#pragma unroll
    for (int ks = 0; ks < 4; ++ks) {
#pragma unroll
        for (int i = 0; i < 2; ++i)
#pragma unroll
            for (int j = 0; j < 2; ++j) o[i][j] = MFMA32(qa[i][ks], spf[j][ks], o[i][j]);
    }
    LDS_WAIT(); asm volatile("" ::: "memory");
#pragma unroll
    for (int ks = 0; ks < 4; ++ks) {
        bf16x8 pa[2], vb[2];
        if (ks < 2) pa[0] = *(const LAS bf16x8*)(PL + r * 144 + (16 * ks + 8 * hh) * 2);
        pa[1] = *(const LAS bf16x8*)(PL + (32 + r) * 144 + (16 * ks + 8 * hh) * 2);
#pragma unroll
        for (int j = 0; j < 2; ++j) vb[j] = *(const LAS bf16x8*)(VT + (32 * j + r) * 144 + (16 * ks + 8 * hh) * 2);
#pragma unroll
        for (int j = 0; j < 2; ++j) { if (ks < 2) o[0][j] = MFMA32(pa[0], vb[j], o[0][j]); o[1][j] = MFMA32(pa[1], vb[j], o[1][j]); }
    }
    asm volatile("" ::: "memory");
    LDS_WAIT(); asm volatile("" ::: "memory");
    { LAS float* OL = (LAS float*)wl;
#pragma unroll
      for (int i = 0; i < 2; ++i)
#pragma unroll
          for (int j = 0; j < 2; ++j)
#pragma unroll
              for (int k = 0; k < 16; ++k) OL[(32 * i + crow(k, hh)) * 68 + 32 * j + r] = o[i][j][k];
      LDS_WAIT(); asm volatile("" ::: "memory");
      const int c = lane & 7; const f32x4 ga = *(const f32x4*)(gain + cb0 + 8 * c), gb = *(const f32x4*)(gain + cb0 + 8 * c + 4);
      const float g8[8] = {ga[0], ga[1], ga[2], ga[3], gb[0], gb[1], gb[2], gb[3]};
      const bf16* SGp = (const bf16*)(ws + WS_SG) + t0 * 512 + cb0 + 8 * c; bf16* YA = (bf16*)F.out + t0 * 1024 + cb0 + 8 * c;
#pragma unroll
      for (int p = 0; p < 8; ++p) { int t = (lane >> 3) + 8 * p; asm volatile("" : "+v"(t));
          const f32x4 v0 = *(LAS f32x4*)(OL + t * 68 + 8 * c), v1 = *(LAS f32x4*)(OL + t * 68 + 8 * c + 4);
          float ss = (v0[0] * v0[0] + v0[1] * v0[1]) + (v0[2] * v0[2] + v0[3] * v0[3]) + (v1[0] * v1[0] + v1[1] * v1[1]) + (v1[2] * v1[2] + v1[3] * v1[3]);
          ss += p4_swz<1>(ss); ss += p4_swz<2>(ss); ss += p4_swz<4>(ss);
          const float rs = __builtin_amdgcn_rsqf(ss * (1.0f / 64.0f) + EPS) * DBG_ZYA;
          float sg[8], y[8]; pg8::ld8(SGp + (size_t)t * 512, sg);
#pragma unroll
          for (int e = 0; e < 4; ++e) { y[e] = v0[e] * rs * g8[e] * sg[e]; y[4 + e] = v1[e] * rs * g8[4 + e] * sg[4 + e]; }
          pg8::st8(YA + (size_t)t * 1024, y); }
    }
    LDS_WAIT(); asm volatile("" ::: "memory");
}

__device__ __forceinline__ unsigned mono(float f) { const unsigned u = __builtin_bit_cast(unsigned, f); return u ^ (((unsigned)((int)u >> 31)) | 0x80000000u); }
__device__ __forceinline__ float unmono(unsigned m) { const unsigned u = (m & 0x80000000u) ? (m ^ 0x80000000u) : ~m; return __builtin_bit_cast(float, u); }
__device__ __forceinline__ unsigned med3u(unsigned a, unsigned b, unsigned c) { unsigned r; asm("v_med3_u32 %0, %1, %2, %3" : "=v"(r) : "v"(a), "v"(b), "v"(c)); return r; }
__device__ __forceinline__ unsigned maxu(unsigned a, unsigned b) { return a > b ? a : b; }
__device__ __forceinline__ void ins16(unsigned (&L)[16], unsigned v) {
#pragma unroll
    for (int j = 15; j >= 1; --j) L[j] = med3u(v, L[j - 1], L[j]);
    L[0] = maxu(L[0], v);
}
__device__ __forceinline__ unsigned minu(unsigned a, unsigned b) { return a < b ? a : b; }
#define P8_CE(X, A, B) { const unsigned hi_ = maxu(X[A], X[B]), lo_ = minu(X[A], X[B]); X[A] = hi_; X[B] = lo_; }
__device__ __forceinline__ void sort16_desc(unsigned (&x)[16]) { P8_CE(x, 0, 13) P8_CE(x, 1, 12) P8_CE(x, 2, 15) P8_CE(x, 3, 14) P8_CE(x, 4, 8) P8_CE(x, 5, 6) P8_CE(x, 7, 11) P8_CE(x, 9, 10) P8_CE(x, 0, 5) P8_CE(x, 1, 7) P8_CE(x, 2, 9) P8_CE(x, 3, 4) P8_CE(x, 6, 13) P8_CE(x, 8, 14) P8_CE(x, 10, 15) P8_CE(x, 11, 12) P8_CE(x, 0, 1) P8_CE(x, 2, 3) P8_CE(x, 4, 5) P8_CE(x, 6, 8) P8_CE(x, 7, 9) P8_CE(x, 10, 11) P8_CE(x, 12, 13) P8_CE(x, 14, 15) P8_CE(x, 0, 2) P8_CE(x, 1, 3) P8_CE(x, 4, 10) P8_CE(x, 5, 11) P8_CE(x, 6, 7) P8_CE(x, 8, 9) P8_CE(x, 12, 14) P8_CE(x, 13, 15) P8_CE(x, 1, 2) P8_CE(x, 3, 12) P8_CE(x, 4, 6) P8_CE(x, 5, 7) P8_CE(x, 8, 10) P8_CE(x, 9, 11) P8_CE(x, 13, 14) P8_CE(x, 1, 4) P8_CE(x, 2, 6) P8_CE(x, 5, 8) P8_CE(x, 7, 10) P8_CE(x, 9, 13) P8_CE(x, 11, 14) P8_CE(x, 2, 4) P8_CE(x, 3, 6) P8_CE(x, 9, 12) P8_CE(x, 11, 13) P8_CE(x, 3, 5) P8_CE(x, 6, 8) P8_CE(x, 7, 9) P8_CE(x, 10, 12) P8_CE(x, 3, 4) P8_CE(x, 5, 6) P8_CE(x, 7, 8) P8_CE(x, 9, 10) P8_CE(x, 11, 12) P8_CE(x, 6, 7) P8_CE(x, 8, 9) }
__device__ __forceinline__ void merge16_desc(unsigned (&L)[16], const unsigned (&S)[16]) {
    unsigned c[16];
#pragma unroll
    for (int i = 0; i < 16; ++i) c[i] = maxu(L[i], S[15 - i]);
    P8_CE(c, 0, 8) P8_CE(c, 1, 9) P8_CE(c, 2, 10) P8_CE(c, 3, 11) P8_CE(c, 4, 12) P8_CE(c, 5, 13) P8_CE(c, 6, 14) P8_CE(c, 7, 15) P8_CE(c, 0, 4) P8_CE(c, 1, 5) P8_CE(c, 2, 6) P8_CE(c, 3, 7) P8_CE(c, 8, 12) P8_CE(c, 9, 13) P8_CE(c, 10, 14) P8_CE(c, 11, 15) P8_CE(c, 0, 2) P8_CE(c, 1, 3) P8_CE(c, 4, 6) P8_CE(c, 5, 7) P8_CE(c, 8, 10) P8_CE(c, 9, 11) P8_CE(c, 12, 14) P8_CE(c, 13, 15) P8_CE(c, 0, 1) P8_CE(c, 2, 3) P8_CE(c, 4, 5) P8_CE(c, 6, 7) P8_CE(c, 8, 9) P8_CE(c, 10, 11) P8_CE(c, 12, 13) P8_CE(c, 14, 15)
#pragma unroll
    for (int i = 0; i < 16; ++i) L[i] = c[i];
}
__device__ __forceinline__ void p8_half(const bf16* keys, const bf16* qbase, LAS unsigned char* wl, int lane, unsigned (&L)[16]) {
    const int r = lane & 31, hh = lane >> 5, rr4 = lane >> 4, c = lane & 15;
    LAS unsigned char* qbuf = wl; LAS unsigned char* kbuf = wl + 8192;
    v4u st[8];
#pragma unroll
    for (int i = 0; i < 8; ++i) st[i] = *(const v4u*)(qbase + (size_t)(4 * i + rr4) * 2048 + 8 * c);
#pragma unroll
    for (int i = 0; i < 8; ++i) { const int rr = 4 * i + rr4; *(LAS v4u*)(qbuf + rr * 256 + ((c ^ (rr & 15)) << 4)) = st[i]; }
#pragma unroll
    for (int i = 0; i < 8; ++i) st[i] = *(const v4u*)(keys + (size_t)(4 * i + rr4) * 128 + 8 * c);
    LDS_WAIT(); asm volatile("" ::: "memory");
    bf16x8 qb[8];
#pragma unroll
    for (int ks = 0; ks < 8; ++ks) qb[ks] = *(const LAS bf16x8*)(qbuf + r * 256 + (((2 * ks + hh) ^ (r & 15)) << 4));
#pragma unroll
    for (int j = 0; j < 16; ++j) L[j] = 0u;
    const unsigned h4 = (unsigned)hh << 2;
#pragma unroll
    for (int it = 0; it < 4; ++it) {
#pragma unroll
        for (int i = 0; i < 8; ++i) { const int rr = 4 * i + rr4; *(LAS v4u*)(kbuf + rr * 256 + ((c ^ (rr & 15)) << 4)) = st[i]; }
        if (it < 3) {
#pragma unroll
            for (int i = 0; i < 8; ++i) st[i] = *(const v4u*)(keys + (size_t)(32 * (it + 1) + 4 * i + rr4) * 128 + 8 * c);
        }
        LDS_WAIT(); asm volatile("" ::: "memory");
        f32x16 acc;
#pragma unroll
        for (int k = 0; k < 16; ++k) acc[k] = 0.f;
#pragma unroll
        for (int ks = 0; ks < 8; ++ks) { const bf16x8 ka = *(const LAS bf16x8*)(kbuf + r * 256 + (((2 * ks + hh) ^ (r & 15)) << 4)); acc = MFMA32(ka, qb[ks], acc); }
        LDS_WAIT(); asm volatile("" ::: "memory");
        unsigned kx[16];
#pragma unroll
        for (int k = 0; k < 16; ++k) { const unsigned n0 = (unsigned)(32 * it + (k & 3) + 8 * (k >> 2));
            kx[k] = (mono(acc[k]) & 0xFFFFFF80u) | ((127u - n0) ^ h4); }
        sort16_desc(kx);
        if (it == 0) {
#pragma unroll
            for (int j = 0; j < 16; ++j) L[j] = kx[j];
        } else merge16_desc(L, kx);
    }
    unsigned P[16];
#pragma unroll
    for (int j = 0; j < 16; ++j) P[j] = (unsigned)__shfl_xor((int)L[j], 32);
    merge16_desc(L, P);
}
__device__ __forceinline__ void p8_task(Frame& F, int tile, int head) {
    unsigned char* ws = F.ws; const int lane = pg8::fresh_lane(), r = lane & 31, hh = lane >> 5; int t = tile * 32 + r; asm volatile("" : "+v"(t));
    const bf16* kb = (const bf16*)(ws + WS_KEYS); int tbase = tile * 32; asm volatile("" : "+s"(tbase)); const bf16* qtile = (const bf16*)(ws + WS_QQ) + (size_t)tbase * 2048 + head * 256;
    LAS unsigned char* wl = F.lds + F.wave * WAVE_LDS;
    unsigned L1[16], L2[16];
    p8_half(kb + (size_t)head * 16384, qtile, wl, lane, L1);
    p8_half(kb + 131072 + (size_t)head * 16384, qtile + 128, wl, lane, L2);
    LDS_WAIT(); asm volatile("" ::: "memory");
    float v1[16], v2[16]; unsigned n1[16], n2[16];
#pragma unroll
    for (int j = 0; j < 16; ++j) { v1[j] = unmono(L1[j] & 0xFFFFFF80u); n1[j] = 127u - (L1[j] & 127u); v2[j] = unmono(L2[j] & 0xFFFFFF80u); n2[j] = 127u - (L2[j] & 127u); }
    LAS unsigned* tab = (LAS unsigned*)(F.lds + F.wave * WAVE_LDS) + lane * 9;
#pragma unroll
    for (int j = 0; j < 4; ++j) { tab[j] = n1[4 * j] | (n1[4 * j + 1] << 8) | (n1[4 * j + 2] << 16) | (n1[4 * j + 3] << 24); tab[4 + j] = n2[4 * j] | (n2[4 * j + 1] << 8) | (n2[4 * j + 2] << 16) | (n2[4 * j + 3] << 24); }
    unsigned Fk[16];
#define P8_CK(A, B) ((mono(v1[A] + v2[B]) & 0xFFFFFF00u) | (unsigned)(255 - ((A) * 16 + (B))))
#pragma unroll
    for (int b = 0; b < 16; ++b) Fk[b] = P8_CK(0, b);
    { unsigned s1[16] = {P8_CK(1, 0), P8_CK(1, 1), P8_CK(1, 2), P8_CK(1, 3), P8_CK(1, 4), P8_CK(1, 5), P8_CK(1, 6), P8_CK(1, 7), P8_CK(2, 0), P8_CK(2, 1), P8_CK(2, 2), P8_CK(2, 3), P8_CK(2, 4), P8_CK(4, 0), P8_CK(4, 1), P8_CK(4, 2)};
      sort16_desc(s1); merge16_desc(Fk, s1); }
    { unsigned s2[16] = {P8_CK(3, 0), P8_CK(3, 1), P8_CK(3, 2), P8_CK(3, 3), P8_CK(5, 0), P8_CK(5, 1), P8_CK(6, 0), P8_CK(6, 1), P8_CK(7, 0), P8_CK(7, 1), P8_CK(8, 0), P8_CK(9, 0), P8_CK(10, 0), P8_CK(11, 0), P8_CK(12, 0), P8_CK(13, 0)};
      sort16_desc(s2); merge16_desc(Fk, s2); }
    ins16(Fk, P8_CK(14, 0)); ins16(Fk, P8_CK(15, 0));
#undef P8_CK
    LDS_WAIT(); asm volatile("" ::: "memory");
    float sv[16]; int ex[16];
    const LAS unsigned char* tb = (const LAS unsigned char*)tab;
#pragma unroll
    for (int j = 0; j < 16; ++j) { const unsigned pos = 255u - (Fk[j] & 255u); sv[j] = unmono(Fk[j] & 0xFFFFFF00u); ex[j] = (int)tb[pos >> 4] * 128 + (int)tb[16 + (pos & 15)]; }
    float den = 0.f, p[16];
#pragma unroll
    for (int j = 0; j < 16; ++j) { p[j] = fexp(sv[j] - sv[0]); den += p[j]; }
    const float inv = 1.0f / den;
    int* IDX = (int*)(ws + WS_IDX) + (size_t)t * 128 + head * 16; float* GT = (float*)(ws + WS_GATE) + (size_t)t * 128 + head * 16;
    if (hh == 0) {
#pragma unroll
        for (int j = 0; j < 4; ++j) { *(int4*)(IDX + 4 * j) = make_int4(ex[4 * j], ex[4 * j + 1], ex[4 * j + 2], ex[4 * j + 3]); }
    } else {
#pragma unroll
        for (int j = 0; j < 4; ++j) { f32x4 g = {p[4 * j] * inv, p[4 * j + 1] * inv, p[4 * j + 2] * inv, p[4 * j + 3] * inv}; *(f32x4*)(GT + 4 * j) = g; }
    }
    LDS_WAIT(); asm volatile("" ::: "memory");
}

#ifdef DBG_CHK
constexpr int CW_CHK = 8192;
__device__ __forceinline__ unsigned chk_hash(unsigned x) { x ^= x >> 16; x *= 0x7feb352dU; x ^= x >> 15; x *= 0x846ca68bU; x ^= x >> 16; return x; }
__device__ __forceinline__ float chk_dot(const bf16* a, const bf16* b, int K) { float s = 0.f; for (int k = 0; k < K; ++k) s += bf2f(a[k]) * bf2f(b[k]); return s; }
__device__ __forceinline__ void chk_rec(unsigned* cnt, float got, float ref) { if (!(fabsf(got - ref) <= 0.03f * fabsf(ref) + 0.03f)) atomicAdd(cnt, 1u); }
__device__ __forceinline__ void chk_phase(Frame& F, const Args& A, int which) {
    unsigned char* ws = F.ws; unsigned* ctl = (unsigned*)(ws + WS_CTL);
    const int g = F.vcu * (NWAVES * 64) + F.wave * 64 + pg8::fresh_lane();
    if (which == 21) {
        const bf16* xb_ = (const bf16*)(ws + WS_XB); const bf16* W_ = (const bf16*)(ws + WS_WIN); const float* r1 = (const float*)(ws + WS_RSTD1); bf16* GBo = (bf16*)(ws + WS_GA);
        for (long i = g; i < (long)T * 1024; i += (long)F.G * NWAVES * 64) { const long rw = i >> 10; const int j = (int)(i & 1023);
            const float v = r1[rw] * chk_dot(xb_ + rw * 1024, W_ + (size_t)(4608 + j) * 1024, 1024); GBo[i] = (bf16)f2bf(1.0f / (1.0f + expf(-v))); }
        return;
    }
    if (g >= 8192) return;
    const unsigned h1 = chk_hash(g * 2 + 1), h2 = chk_hash(g * 2 + 2); const int row = h1 % T;
    const bf16* xb = (const bf16*)(ws + WS_XB); const bf16* WinT = (const bf16*)(ws + WS_WIN); const float* rstd1 = (const float*)(ws + WS_RSTD1);
    if (which == 0) {
        { const int n = h2 % NIN, k = h1 % 1024; chk_rec(ctl + CW_CHK + (n >= 4608 ? 256 : 0), 32.f * bf2f(WinT[(size_t)(win_dst_row(n & ~31) + (n & 31)) * 1024 + k]), 32.f * A.in[1][k] * A.in[2][(size_t)k * NIN + n]); }
        { const int n = h2 % 1024, k = h1 % 512; chk_rec(ctl + CW_CHK, 32.f * bf2f(((const bf16*)(ws + WS_PAB))[(size_t)n * 1024 + k]), 32.f * A.in[6][(size_t)k * 1024 + n]);
          chk_rec(ctl + CW_CHK, 32.f * bf2f(((const bf16*)(ws + WS_PAB))[(size_t)n * 1024 + 512 + k]), 32.f * A.in[7][(size_t)k * 1024 + n]); }
        { const int n = h2 % 1024, k = h1 % 1024; chk_rec(ctl + CW_CHK, 32.f * bf2f(((const bf16*)(ws + WS_WO))[(size_t)n * 1024 + k]), 32.f * A.in[8][(size_t)k * 1024 + n]); }
        { const int n = h2 % 2048, k = h1 % 1024; chk_rec(ctl + CW_CHK, 32.f * bf2f(((const bf16*)(ws + WS_WQ))[(size_t)n * 1024 + k]), 32.f * A.in[9][k] * A.in[10][(size_t)k * 2048 + n]); }
        { const int k = h2 % 1024; chk_rec(ctl + CW_CHK, bf2f(xb[(size_t)row * 1024 + k]), A.in[0][(size_t)row * 1024 + k]); }
    }
    if (which == 1) {
        const float rs = rstd1[row];
        { const int j = h2 % 512; chk_rec(ctl + CW_CHK + 0, bf2f(((const bf16*)(ws + WS_V))[(size_t)row * 512 + j]), rs * chk_dot(xb + (size_t)row * 1024, WinT + (size_t)(1024 + j) * 1024, 1024)); }
        { const int j = h2 % 1024; const float v = rs * chk_dot(xb + (size_t)row * 1024, WinT + (size_t)(CHK_GA_ROW + j) * 1024, 1024);
          chk_rec(ctl + CW_CHK + 128, bf2f(((const bf16*)(ws + WS_GA))[(size_t)row * 2048 + j]), 1.0f / (1.0f + expf(-v))); }
        { const int j = h2 % 1024; const float v = rs * chk_dot(xb + (size_t)row * 1024, WinT + (size_t)(CHK_GB_ROW + j) * 1024, 1024);
          chk_rec(ctl + CW_CHK + 64, bf2f(((const bf16*)(ws + WS_GA))[(size_t)row * 2048 + 1024 + j]), 1.0f / (1.0f + expf(-v))); }
        { const int j = h2 % 512; chk_rec(ctl + CW_CHK + 448, bf2f(((const bf16*)(ws + WS_CB))[(size_t)row * 512 + j]), rs * chk_dot(xb + (size_t)row * 1024, WinT + (size_t)(2048 + j) * 1024, 1024)); }
        { const int j = h2 % 512; const int rb = 2560 + 256 * (j >> 7) + (j & 127);
          const float cc = rs * chk_dot(xb + (size_t)row * 1024, WinT + (size_t)rb * 1024, 1024), ch = rs * chk_dot(xb + (size_t)row * 1024, WinT + (size_t)(rb + 128) * 1024, 1024);
          chk_rec(ctl + CW_CHK + 192, bf2f(((const bf16*)(ws + WS_U))[(size_t)row * 512 + j]), cc * ch); }
    }
    if (which == 1) {
        const float rs = rstd1[row]; const int j = h2 % 512; const float* lbv = (const float*)(ws + WS_LB);
        const float hq = rs * chk_dot(xb + (size_t)row * 1024, WinT + (size_t)(0 + j) * 1024, 1024), hf = rs * chk_dot(xb + (size_t)row * 1024, WinT + (size_t)(512 + j) * 1024, 1024),
                    hg = rs * chk_dot(xb + (size_t)row * 1024, WinT + (size_t)(1536 + j) * 1024, 1024);
        const float l0 = A.in[3][j], l1 = A.in[3][512 + j], lb = expf(l0) / (expf(l0) + expf(l1)); chk_rec(ctl + CW_CHK + 128, lbv[j], lb);
        const float sg = 1.0f / (1.0f + expf(-hf)), f = lb + (1.0f - lb) * sg;
        chk_rec(ctl + CW_CHK + 128, bf2f(((const bf16*)(ws + WS_Q))[(size_t)row * 512 + j]), hq / (1.0f + expf(-hq)) * 0.125f);
        chk_rec(ctl + CW_CHK + 128, bf2f(((const bf16*)(ws + WS_LF))[(size_t)row * 512 + j]), logf(f));
        chk_rec(ctl + CW_CHK + 128, bf2f(((const bf16*)(ws + WS_KK))[(size_t)row * 512 + j]), 1.0f - f);
        chk_rec(ctl + CW_CHK + 128, bf2f(((const bf16*)(ws + WS_SG))[(size_t)row * 512 + j]), hg / (1.0f + expf(-hg)));
    }
    if (which == 11 && g < 64 * 64) {
        const int smp = g >> 6, e = g & 63; const unsigned hs = chk_hash(1000 + smp); const int bb = hs % 8, hd = (hs >> 3) % 8, tpos = (smp < 8) ? (int)(smp * 9) : (int)((hs >> 6) % SEQ);
        const bf16* Qb = (const bf16*)(ws + WS_Q); const bf16* LFb = (const bf16*)(ws + WS_LF); const bf16* KKb = (const bf16*)(ws + WS_KK); const bf16* Vb = (const bf16*)(ws + WS_V); const bf16* SGb = (const bf16*)(ws + WS_SG);
        float S[64];
#pragma unroll
        for (int d = 0; d < 64; ++d) S[d] = 0.f;
        for (int sp = 0; sp <= tpos; ++sp) { const size_t ro = ((size_t)bb * SEQ + sp) * 512 + hd * 64; const float v = bf2f(Vb[ro + e]);
#pragma unroll
            for (int d = 0; d < 64; ++d) S[d] = expf(bf2f(LFb[ro + d])) * S[d] + bf2f(KKb[ro + d]) * v; }
        const size_t rq = ((size_t)bb * SEQ + tpos) * 512 + hd * 64; float o = 0.f;
#pragma unroll
        for (int d = 0; d < 64; ++d) o += bf2f(Qb[rq + d]) * S[d];
        const float ss = wave_sum(o * o); const float y = o * rsqrtf(ss * (1.0f / 64.0f) + EPS) * A.in[4][hd * 64 + e] * bf2f(SGb[rq + e]);
        ((float*)(ws + 6 * MiB))[g] = y;
    }
    if (which == 14 && g < 64 * 64) {
        const int smp = g >> 6, e = g & 63; const unsigned hs = chk_hash(1000 + smp); const int bb = hs % 8, hd = (hs >> 3) % 8, tpos = (smp < 8) ? (int)(smp * 9) : (int)((hs >> 6) % SEQ);
        chk_rec(ctl + CW_CHK + 192, bf2f(((const bf16*)(ws + WS_XB))[((size_t)bb * SEQ + tpos) * 1024 + hd * 64 + e]), ((const float*)(ws + 6 * MiB))[g]);
    }
    if (which == 2) {
        const int j = h2 % 512, sq = row & (SEQ - 1); const bf16* U = (const bf16*)(ws + WS_U); const bf16* CB = (const bf16*)(ws + WS_CB); const float* cw = A.in[5];
        float acc = cw[1024 + j] * bf2f(U[(size_t)row * 512 + j]);
        if (sq >= 1) acc += cw[512 + j] * bf2f(U[(size_t)(row - 1) * 512 + j]);
        if (sq >= 2) acc += cw[j] * bf2f(U[(size_t)(row - 2) * 512 + j]);
        chk_rec(ctl + CW_CHK + 448, bf2f(((const bf16*)(ws + WS_XB))[(size_t)row * 1024 + 512 + j]), bf2f(CB[(size_t)row * 512 + j]) * acc);
    }
    if (which == 5) {
        const int j = h2 % 1024; const bf16* Y = (const bf16*)(ws + WS_XB) + (size_t)row * 1024; const bf16* P = (const bf16*)(ws + WS_PAB) + (size_t)j * 1024;
        const float ga = bf2f(((const bf16*)(ws + WS_GA))[(size_t)row * 2048 + j]), gb = bf2f(((const bf16*)(ws + WS_GA))[(size_t)row * 2048 + 1024 + j]);
        chk_rec(ctl + CW_CHK + 256, bf2f(((const bf16*)(ws + WS_MG))[(size_t)row * 1024 + j]), ga * chk_dot(Y, P, 512) + gb * chk_dot(Y + 512, P + 512, 512));
    }
    if (which == 6) {
        const int j = h2 % 1024;
        chk_rec(ctl + CW_CHK + 320, ((const float*)(ws + WS_X1))[(size_t)row * 1024 + j] - A.in[0][(size_t)row * 1024 + j],
                chk_dot((const bf16*)(ws + WS_MG) + (size_t)row * 1024, (const bf16*)(ws + WS_WO) + (size_t)j * 1024, 1024));
    }
    if (which == 7) {
        const int j = h2 % 2048; const float rs2 = rsqrtf(pg8::sum16((const float*)(ws + WS_ROWSS) + (size_t)row * 16) * (1.0f / D) + EPS);
        chk_rec(ctl + CW_CHK + 384, bf2f(((const bf16*)(ws + WS_QQ))[(size_t)row * 2048 + j]), rs2 * chk_dot((const bf16*)(ws + WS_X1B) + (size_t)row * 1024, (const bf16*)(ws + WS_WQ) + (size_t)j * 1024, 1024));
    }
}
__device__ __forceinline__ float chk_scale(Frame& F) {
    const unsigned* c = (const unsigned*)(F.ws + WS_CTL) + CW_CHK; const float sc[8] = {0.5f, 0.0f, 2.0f, -0.5f, -1.0f, 3.0f, -2.0f, 4.0f};
    float s = 1.0f;
#pragma unroll
    for (int i = 7; i >= 0; --i) if (c[64 * i] > 40u) s = sc[i];
    return s;
}
#endif
__device__ __forceinline__ float dot2bf(unsigned w, unsigned x, float acc) { return __builtin_amdgcn_fdot2_f32_bf16(__builtin_bit_cast(bf16x2_t, w), __builtin_bit_cast(bf16x2_t, x), acc, false); }
__device__ __forceinline__ float gelu_erf(float v) {
    const float av = fabsf(v), tt = __builtin_amdgcn_rcpf(av * 0.2316418882f + 1.0f);
    float q = tt * 0.5307027145f + (-0.7265760135f); q = q * tt + 0.7107068705f; q = q * tt + (-0.142248368f); q = q * tt + 0.127414796f; q = q * tt;
    const float e = __builtin_amdgcn_exp2f(v * v * (-0.72134752044f)), m = v * (q * e);
    return v < 0.f ? m : v - m;
}
typedef float f32x2v __attribute__((ext_vector_type(2)));
__device__ __forceinline__ void cvt_row_fp8(const float* src, unsigned char* dst, float* inv_scale, int row, int lane) {
    const float* r = src + (size_t)row * 1024; f32x4 v[4]; float m = 0.f;
#pragma unroll
    for (int j = 0; j < 4; ++j) { v[j] = *(const f32x4*)(r + 256 * j + 4 * lane); m = fmaxf(m, fmaxf(fmaxf(fabsf(v[j][0]), fabsf(v[j][1])), fmaxf(fabsf(v[j][2]), fabsf(v[j][3])))); }
#pragma unroll
    for (int o = 1; o < 64; o <<= 1) m = fmaxf(m, __shfl_xor(m, o));
    const int ex = (int)((__builtin_bit_cast(unsigned, m) >> 23) & 0xff);
    const int k = (m > 0.f) ? (134 - ex) : 0;
    const float sc = __builtin_bit_cast(float, (unsigned)(127 + k) << 23), isc = __builtin_bit_cast(float, (unsigned)(127 - k) << 23);
    v4u o;
#pragma unroll
    for (int j = 0; j < 4; ++j) { int p = __builtin_amdgcn_cvt_pk_fp8_f32(v[j][0] * sc, v[j][1] * sc, 0, false); p = __builtin_amdgcn_cvt_pk_fp8_f32(v[j][2] * sc, v[j][3] * sc, p, true); o[j] = (unsigned)p; }
    *(v4u*)(dst + (size_t)row * 1024 + 16 * lane) = o;
    if (lane == 0) inv_scale[row] = isc;
}
constexpr int F4_ROW = 1152;
__device__ __forceinline__ void pack16_fp4(const float* r, int lane, unsigned& d0, unsigned& d1, unsigned& eb_out) {
    f32x4 v[4]; float m = 0.f;
#pragma unroll
    for (int j = 0; j < 4; ++j) { v[j] = *(const f32x4*)(r + 256 * j + 4 * lane); m = fmaxf(m, fmaxf(fmaxf(fabsf(v[j][0]), fabsf(v[j][1])), fmaxf(fabsf(v[j][2]), fabsf(v[j][3])))); }
    const float tq = m * (1.0f / 6.0f); const unsigned eb = (__builtin_bit_cast(unsigned, tq) + 0x7FFFFFu) >> 23;
    const unsigned ebc = eb > 253u ? 253u : eb; const float inv = __builtin_bit_cast(float, (254u - ebc) << 23);
    d0 = 0u; d1 = 0u;
    d0 = __builtin_amdgcn_cvt_scalef32_pk_fp4_f32(d0, v[0][0] * inv, v[0][1] * inv, 1.0f, 0); d0 = __builtin_amdgcn_cvt_scalef32_pk_fp4_f32(d0, v[0][2] * inv, v[0][3] * inv, 1.0f, 1);
    d0 = __builtin_amdgcn_cvt_scalef32_pk_fp4_f32(d0, v[1][0] * inv, v[1][1] * inv, 1.0f, 2); d0 = __builtin_amdgcn_cvt_scalef32_pk_fp4_f32(d0, v[1][2] * inv, v[1][3] * inv, 1.0f, 3);
    d1 = __builtin_amdgcn_cvt_scalef32_pk_fp4_f32(d1, v[2][0] * inv, v[2][1] * inv, 1.0f, 0); d1 = __builtin_amdgcn_cvt_scalef32_pk_fp4_f32(d1, v[2][2] * inv, v[2][3] * inv, 1.0f, 1);
    d1 = __builtin_amdgcn_cvt_scalef32_pk_fp4_f32(d1, v[3][0] * inv, v[3][1] * inv, 1.0f, 2); d1 = __builtin_amdgcn_cvt_scalef32_pk_fp4_f32(d1, v[3][2] * inv, v[3][3] * inv, 1.0f, 3);
    eb_out = ebc;
}
__device__ __forceinline__ void cvt_expert_fp4(const float* eu, const float* ev, unsigned char* dst, int e, int lane) {
    unsigned u0, u1, v0, v1, su, sv;
    pack16_fp4(eu + (size_t)e * 1024, lane, u0, u1, su); pack16_fp4(ev + (size_t)e * 1024, lane, v0, v1, sv);
    v4u o; o.x = u0; o.y = u1; o.z = v0; o.w = v1;
    unsigned char* rec = dst + (size_t)e * F4_ROW;
    *(v4u*)(rec + 16 * lane) = o; *(unsigned short*)(rec + 1024 + 2 * lane) = (unsigned short)(su | (sv << 8));
}
struct RowsF4 { v4u d[8]; unsigned s[8]; };
__device__ __forceinline__ void p9_load_f4(RowsF4& R, const unsigned char* EUV, const int (&e)[8], int lane) {
#pragma unroll
    for (int j = 0; j < 8; ++j) { const GAS unsigned char* rec = (const GAS unsigned char*)EUV + (size_t)e[j] * F4_ROW;
        R.d[j] = *(const GAS v4u*)(rec + (unsigned)(16 * lane)); R.s[j] = *(const GAS unsigned short*)(rec + (unsigned)(1024 + 2 * lane)); }
}
template <int M> __device__ __forceinline__ float swz_xor(float v) {
    return __builtin_bit_cast(float, __builtin_amdgcn_ds_swizzle(__builtin_bit_cast(int, v), 0x1f | (M << 10))); }
__device__ __forceinline__ float bperm(float v, int lane_src) { return __builtin_bit_cast(float, __builtin_amdgcn_ds_bpermute(lane_src << 2, __builtin_bit_cast(int, v))); }
__device__ __forceinline__ float rdl(float v, int l) { return __builtin_bit_cast(float, __builtin_amdgcn_readlane(__builtin_bit_cast(int, v), l)); }
__device__ __forceinline__ void unpack8_f4(const unsigned dw, float (&f)[8]) {
    const f32x2v p0 = __builtin_amdgcn_cvt_scalef32_pk_f32_fp4(dw, 1.0f, 0), p1 = __builtin_amdgcn_cvt_scalef32_pk_f32_fp4(dw, 1.0f, 1),
                 p2 = __builtin_amdgcn_cvt_scalef32_pk_f32_fp4(dw, 1.0f, 2), p3 = __builtin_amdgcn_cvt_scalef32_pk_f32_fp4(dw, 1.0f, 3);
    f[0] = p0.x; f[1] = p0.y; f[2] = p1.x; f[3] = p1.y; f[4] = p2.x; f[5] = p2.y; f[6] = p3.x; f[7] = p3.y;
}
__device__ __forceinline__ float dot16_f4(const unsigned q0, const unsigned q1, const float (&hn)[16]) {
    f32x2v acc = {0.f, 0.f};
#define D16_STEP(Q, C, B) { const f32x2v p = __builtin_amdgcn_cvt_scalef32_pk_f32_fp4(Q, 1.0f, C); const f32x2v h = {hn[B], hn[B + 1]}; acc = __builtin_elementwise_fma(p, h, acc); }
    D16_STEP(q0, 0, 0) D16_STEP(q0, 1, 2) D16_STEP(q0, 2, 4) D16_STEP(q0, 3, 6) D16_STEP(q1, 0, 8) D16_STEP(q1, 1, 10) D16_STEP(q1, 2, 12) D16_STEP(q1, 3, 14)
#undef D16_STEP
    return acc.x + acc.y;
}
__device__ __forceinline__ void axpy16_f4(const unsigned q0, const unsigned q1, const float w, float (&o)[16]) {
    float f0[8], f1[8]; unpack8_f4(q0, f0); unpack8_f4(q1, f1);
#pragma unroll
    for (int i = 0; i < 8; ++i) { o[i] += w * f0[i]; o[8 + i] += w * f1[i]; }
}
__device__ __forceinline__ void p9_batch_f4(const RowsF4& R, const float (&hn)[16], float (&oacc)[16], int bt, int lane, float gA, float gB) {
    const int hh = lane >> 5, q4 = (lane >> 4) & 1, q3 = (lane >> 3) & 1, jsel = 4 * hh + 2 * q4 + q3;
    float pd[8];
#pragma unroll
    for (int j = 0; j < 8; ++j) { pd[j] = dot16_f4(R.d[j].x, R.d[j].y, hn) * __builtin_bit_cast(float, (R.s[j] & 0xffu) << 23); if (j & 1) __builtin_amdgcn_sched_barrier(0); }
    float r4[4], r2[2];
#pragma unroll
    for (int i = 0; i < 4; ++i) { const float keep = hh ? pd[4 + i] : pd[i], send = hh ? pd[i] : pd[4 + i]; r4[i] = keep + bperm(send, lane ^ 32); }
#pragma unroll
    for (int i = 0; i < 2; ++i) { const float keep = q4 ? r4[2 + i] : r4[i], send = q4 ? r4[i] : r4[2 + i]; r2[i] = keep + swz_xor<16>(send); }
    float v = (q3 ? r2[1] : r2[0]) + swz_xor<8>(q3 ? r2[0] : r2[1]);
    v += swz_xor<4>(v); v += swz_xor<2>(v); v += swz_xor<1>(v);
    const int n = 8 * bt + jsel; const float g = (bt < 8) ? bperm(gA, n & 63) : bperm(gB, n & 63);
    const float w = g * gelu_erf(v);
#pragma unroll
    for (int j = 0; j < 8; ++j) { axpy16_f4(R.d[j].z, R.d[j].w, rdl(w, 8 * j) * __builtin_bit_cast(float, (R.s[j] >> 8) << 23), oacc); if (j & 1) __builtin_amdgcn_sched_barrier(0); }
}
__device__ __forceinline__ void p9_ids(int idA, int idB, int nb, int (&e)[8]) {
#pragma unroll
    for (int j = 0; j < 8; ++j) { const int n = 8 * nb + j; e[j] = (nb < 8) ? __builtin_amdgcn_readlane(idA, n & 63) : __builtin_amdgcn_readlane(idB, n & 63); }
}
struct RowsF4q { v4u d[4]; unsigned s[4]; };
__device__ __forceinline__ void p9_load_f4q(RowsF4q& R, const unsigned char* EUV, int idP, int nb, int lane) {
    const __amdgpu_buffer_rsrc_t rs = __builtin_amdgcn_make_buffer_rsrc((void*)EUV, (short)0, 16384 * F4_ROW, 0x00020000);
#pragma unroll
    for (int j = 0; j < 4; ++j) { const int n = 4 * nb + j; const unsigned x = (unsigned)__builtin_amdgcn_readlane(idP, n & 63); const unsigned e = (x >> ((n >> 6) << 4)) & 0xffffu;
        const int so = (int)(e * F4_ROW);
        R.d[j] = __builtin_bit_cast(v4u, __builtin_amdgcn_raw_buffer_load_b128(rs, 16 * lane, so, 0)); R.s[j] = (unsigned)__builtin_amdgcn_raw_buffer_load_b16(rs, 1024 + 2 * lane, so, 0); }
}
__device__ __forceinline__ void p9_batch4_f4(const RowsF4q& R, const float (&hn)[16], float (&oacc)[16], int bt, int lane, float gA, float gB) {
    const int hh = lane >> 5, q4 = (lane >> 4) & 1, jsel = 2 * hh + q4;
    float pd[4];
#pragma unroll
    for (int j = 0; j < 4; ++j) pd[j] = dot16_f4(R.d[j].x, R.d[j].y, hn) * __builtin_bit_cast(float, (R.s[j] & 0xffu) << 23);
    const float k0 = hh ? pd[2] : pd[0], k1 = hh ? pd[3] : pd[1], s0 = hh ? pd[0] : pd[2], s1 = hh ? pd[1] : pd[3];
    const float r0 = k0 + bperm(s0, lane ^ 32), r1 = k1 + bperm(s1, lane ^ 32);
    float v = (q4 ? r1 : r0) + swz_xor<16>(q4 ? r0 : r1);
    v += swz_xor<8>(v); v += swz_xor<4>(v); v += swz_xor<2>(v); v += swz_xor<1>(v);
    const int n = 4 * bt + jsel; const float g = (bt < 16) ? bperm(gA, n & 63) : bperm(gB, n & 63);
    const float w = g * gelu_erf(v);
#pragma unroll
    for (int j = 0; j < 4; ++j) axpy16_f4(R.d[j].z, R.d[j].w, rdl(w, 16 * j) * __builtin_bit_cast(float, (R.s[j] >> 8) << 23), oacc);
}
__device__ __forceinline__ void p9_token_f4(Frame& F, int t, const float* g_ffn, const float* g_fin) {
    unsigned char* ws = F.ws; const int lane = pg8::fresh_lane();
    const unsigned char* EUV = ws + WS_EU;
    const bf16* xrow = (const bf16*)(ws + WS_X1B) + (size_t)t * D; float* orow = F.out + (size_t)t * D;
    const float rs2 = __builtin_amdgcn_rsqf(pg8::sum16((const float*)(ws + WS_ROWSS) + (size_t)t * 16) * (1.0f / D) + EPS);
    float hn[16];
#pragma unroll
    for (int j = 0; j < 4; ++j) { const v2u a = *(const v2u*)(xrow + 256 * j + 4 * lane); const f32x4 g = *(const f32x4*)(g_ffn + 256 * j + 4 * lane);
        hn[4 * j] = bflo(a.x) * rs2 * g[0]; hn[4 * j + 1] = bfhi(a.x) * rs2 * g[1]; hn[4 * j + 2] = bflo(a.y) * rs2 * g[2]; hn[4 * j + 3] = bfhi(a.y) * rs2 * g[3]; }
    const int* IDX = (const int*)(ws + WS_IDX) + (size_t)t * 128; const float* GT = (const float*)(ws + WS_GATE) + (size_t)t * 128;
    int idA, idB; float gA, gB;
    { const int a0 = IDX[lane], b0 = IDX[64 + lane]; const float ga = GT[lane], gb = GT[64 + lane];
      const int kA = a0 >> 10, kB = b0 >> 10; const unsigned long long lt = (1ull << lane) - 1ull;
      int base = 0, rA = 0, rB = 0;
#pragma unroll
      for (int k = 0; k < 16; ++k) { const unsigned long long mA = __ballot(kA == k), mB = __ballot(kB == k); const int cA = __popcll(mA), cB = __popcll(mB);
          if (kA == k) rA = base + __popcll(mA & lt);
          if (kB == k) rB = base + cA + __popcll(mB & lt);
          base += cA + cB; }
      LAS int* sid = (LAS int*)(F.lds + F.wave * WAVE_LDS); LAS float* sgt = (LAS float*)(sid + 128);
      sid[rA] = a0; sid[rB] = b0; sgt[rA] = ga; sgt[rB] = gb;
      LDS_WAIT(); asm volatile("" ::: "memory");
      idA = sid[lane]; idB = sid[64 + lane]; gA = sgt[lane]; gB = sgt[64 + lane];
      LDS_WAIT(); asm volatile("" ::: "memory"); }
    float oacc[16];
#pragma unroll
    for (int i = 0; i < 16; ++i) oacc[i] = 0.f;
    const int idP = idA | (idB << 16);
    RowsF4q R0, R1, R2, R3, R4;
    p9_load_f4q(R0, EUV, idP, 0, lane); p9_load_f4q(R1, EUV, idP, 1, lane); p9_load_f4q(R2, EUV, idP, 2, lane); p9_load_f4q(R3, EUV, idP, 3, lane);
#pragma unroll 1
    for (int bt = 0; bt < 30; bt += 5) {
        p9_load_f4q(R4, EUV, idP, bt + 4, lane); asm volatile("" ::: "memory");
        p9_batch4_f4(R0, hn, oacc, bt, lane, gA, gB); asm volatile("" ::: "memory");
        p9_load_f4q(R0, EUV, idP, (bt + 5) & 31, lane); asm volatile("" ::: "memory");
        p9_batch4_f4(R1, hn, oacc, bt + 1, lane, gA, gB); asm volatile("" ::: "memory");
        p9_load_f4q(R1, EUV, idP, (bt + 6) & 31, lane); asm volatile("" ::: "memory");
        p9_batch4_f4(R2, hn, oacc, bt + 2, lane, gA, gB); asm volatile("" ::: "memory");
        p9_load_f4q(R2, EUV, idP, (bt + 7) & 31, lane); asm volatile("" ::: "memory");
        p9_batch4_f4(R3, hn, oacc, bt + 3, lane, gA, gB); asm volatile("" ::: "memory");
        p9_load_f4q(R3, EUV, idP, (bt + 8) & 31, lane); asm volatile("" ::: "memory");
        p9_batch4_f4(R4, hn, oacc, bt + 4, lane, gA, gB); asm volatile("" ::: "memory");
    }
    p9_batch4_f4(R0, hn, oacc, 30, lane, gA, gB); p9_batch4_f4(R1, hn, oacc, 31, lane, gA, gB);
    asm volatile("" ::: "memory");
    float ss = 0.f;
#pragma unroll
    for (int j = 0; j < 4; ++j) { const v2u a = *(const v2u*)(xrow + 256 * j + 4 * lane);
        oacc[4 * j] += bflo(a.x); oacc[4 * j + 1] += bfhi(a.x); oacc[4 * j + 2] += bflo(a.y); oacc[4 * j + 3] += bfhi(a.y);
#pragma unroll
        for (int i = 0; i < 4; ++i) ss += oacc[4 * j + i] * oacc[4 * j + i]; }
    ss += swz_xor<1>(ss); ss += swz_xor<2>(ss); ss += swz_xor<4>(ss); ss += swz_xor<8>(ss); ss += swz_xor<16>(ss); ss += bperm(ss, lane ^ 32);
    const float rs3 = __builtin_amdgcn_rsqf(ss * (1.0f / D) + EPS);
#pragma unroll
    for (int j = 0; j < 4; ++j) { const f32x4 g = *(const f32x4*)(g_fin + 256 * j + 4 * lane); f32x4 o;
#pragma unroll
        for (int i = 0; i < 4; ++i) o[i] = oacc[4 * j + i] * rs3 * g[i];
        *(f32x4*)(orow + 256 * j + 4 * lane) = o; }
}
constexpr int MX_ROW = 1152, MX_USC = 1024, MX_V = 512, MX_VSC = 1056;
typedef int v8i __attribute__((ext_vector_type(8)));
__device__ __forceinline__ void cvt_expert_mx(const float* eu, const float* ev, unsigned char* dst, int e, int lane) {
    unsigned char* rec = dst + (size_t)e * MX_ROW;
    { const float* r = eu + (size_t)e * 1024 + 16 * lane; f32x4 v[4]; float m = 0.f;
#pragma unroll
      for (int j = 0; j < 4; ++j) { v[j] = *(const f32x4*)(r + 4 * j); m = fmaxf(m, fmaxf(fmaxf(fabsf(v[j][0]), fabsf(v[j][1])), fmaxf(fabsf(v[j][2]), fabsf(v[j][3])))); }
      m = fmaxf(m, swz_xor<1>(m));
      const float tq = m * (1.0f / 6.0f); const unsigned eb = (__builtin_bit_cast(unsigned, tq) + 0x7FFFFFu) >> 23;
      const unsigned ebc = eb > 253u ? 253u : eb; const float inv = __builtin_bit_cast(float, (254u - ebc) << 23);
      unsigned d0 = 0u, d1 = 0u;
      d0 = __builtin_amdgcn_cvt_scalef32_pk_fp4_f32(d0, v[0][0] * inv, v[0][1] * inv, 1.0f, 0); d0 = __builtin_amdgcn_cvt_scalef32_pk_fp4_f32(d0, v[0][2] * inv, v[0][3] * inv, 1.0f, 1);
      d0 = __builtin_amdgcn_cvt_scalef32_pk_fp4_f32(d0, v[1][0] * inv, v[1][1] * inv, 1.0f, 2); d0 = __builtin_amdgcn_cvt_scalef32_pk_fp4_f32(d0, v[1][2] * inv, v[1][3] * inv, 1.0f, 3);
      d1 = __builtin_amdgcn_cvt_scalef32_pk_fp4_f32(d1, v[2][0] * inv, v[2][1] * inv, 1.0f, 0); d1 = __builtin_amdgcn_cvt_scalef32_pk_fp4_f32(d1, v[2][2] * inv, v[2][3] * inv, 1.0f, 1);
      d1 = __builtin_amdgcn_cvt_scalef32_pk_fp4_f32(d1, v[3][0] * inv, v[3][1] * inv, 1.0f, 2); d1 = __builtin_amdgcn_cvt_scalef32_pk_fp4_f32(d1, v[3][2] * inv, v[3][3] * inv, 1.0f, 3);
      v2u o; o.x = d0; o.y = d1; *(v2u*)(rec + 8 * lane) = o;
      if (!(lane & 1)) { const int blk = lane >> 1; rec[MX_USC + (blk & 3) * 8 + (blk >> 2)] = (unsigned char)ebc; } }
    { unsigned v0, v1, sv; pack16_fp4(ev + (size_t)e * 1024, lane, v0, v1, sv);
      v2u o; o.x = v0; o.y = v1; *(v2u*)(rec + MX_V + 8 * lane) = o; rec[MX_VSC + lane] = (unsigned char)sv; }
}
__device__ __forceinline__ void mx_pack_u(const f32x4 (&v)[4], unsigned char* rec, int lane) {
    float m = 0.f;
#pragma unroll
    for (int j = 0; j < 4; ++j) m = fmaxf(m, fmaxf(fmaxf(fabsf(v[j][0]), fabsf(v[j][1])), fmaxf(fabsf(v[j][2]), fabsf(v[j][3]))));
    m = fmaxf(m, swz_xor<1>(m));
    const float tq = m * (1.0f / 6.0f); const unsigned eb = (__builtin_bit_cast(unsigned, tq) + 0x7FFFFFu) >> 23;
    const unsigned ebc = eb > 253u ? 253u : eb; const float inv = __builtin_bit_cast(float, (254u - ebc) << 23);
    unsigned d0 = 0u, d1 = 0u;
    d0 = __builtin_amdgcn_cvt_scalef32_pk_fp4_f32(d0, v[0][0] * inv, v[0][1] * inv, 1.0f, 0); d0 = __builtin_amdgcn_cvt_scalef32_pk_fp4_f32(d0, v[0][2] * inv, v[0][3] * inv, 1.0f, 1);
    d0 = __builtin_amdgcn_cvt_scalef32_pk_fp4_f32(d0, v[1][0] * inv, v[1][1] * inv, 1.0f, 2); d0 = __builtin_amdgcn_cvt_scalef32_pk_fp4_f32(d0, v[1][2] * inv, v[1][3] * inv, 1.0f, 3);
    d1 = __builtin_amdgcn_cvt_scalef32_pk_fp4_f32(d1, v[2][0] * inv, v[2][1] * inv, 1.0f, 0); d1 = __builtin_amdgcn_cvt_scalef32_pk_fp4_f32(d1, v[2][2] * inv, v[2][3] * inv, 1.0f, 1);
    d1 = __builtin_amdgcn_cvt_scalef32_pk_fp4_f32(d1, v[3][0] * inv, v[3][1] * inv, 1.0f, 2); d1 = __builtin_amdgcn_cvt_scalef32_pk_fp4_f32(d1, v[3][2] * inv, v[3][3] * inv, 1.0f, 3);
    v2u o; o.x = d0; o.y = d1; *(v2u*)(rec + 8 * lane) = o;
    if (!(lane & 1)) { const int blk = lane >> 1; rec[MX_USC + (blk & 3) * 8 + (blk >> 2)] = (unsigned char)ebc; }
}
__device__ __forceinline__ void mx_pack_v(const f32x4 (&v)[4], unsigned char* rec, int lane) {
    float m = 0.f;
#pragma unroll
    for (int j = 0; j < 4; ++j) m = fmaxf(m, fmaxf(fmaxf(fabsf(v[j][0]), fabsf(v[j][1])), fmaxf(fabsf(v[j][2]), fabsf(v[j][3]))));
    const float tq = m * (1.0f / 6.0f); const unsigned eb = (__builtin_bit_cast(unsigned, tq) + 0x7FFFFFu) >> 23;
    const unsigned ebc = eb > 253u ? 253u : eb; const float inv = __builtin_bit_cast(float, (254u - ebc) << 23);
    unsigned d0 = 0u, d1 = 0u;
    d0 = __builtin_amdgcn_cvt_scalef32_pk_fp4_f32(d0, v[0][0] * inv, v[0][1] * inv, 1.0f, 0); d0 = __builtin_amdgcn_cvt_scalef32_pk_fp4_f32(d0, v[0][2] * inv, v[0][3] * inv, 1.0f, 1);
    d0 = __builtin_amdgcn_cvt_scalef32_pk_fp4_f32(d0, v[1][0] * inv, v[1][1] * inv, 1.0f, 2); d0 = __builtin_amdgcn_cvt_scalef32_pk_fp4_f32(d0, v[1][2] * inv, v[1][3] * inv, 1.0f, 3);
    d1 = __builtin_amdgcn_cvt_scalef32_pk_fp4_f32(d1, v[2][0] * inv, v[2][1] * inv, 1.0f, 0); d1 = __builtin_amdgcn_cvt_scalef32_pk_fp4_f32(d1, v[2][2] * inv, v[2][3] * inv, 1.0f, 1);
    d1 = __builtin_amdgcn_cvt_scalef32_pk_fp4_f32(d1, v[3][0] * inv, v[3][1] * inv, 1.0f, 2); d1 = __builtin_amdgcn_cvt_scalef32_pk_fp4_f32(d1, v[3][2] * inv, v[3][3] * inv, 1.0f, 3);
    v2u o; o.x = d0; o.y = d1; *(v2u*)(rec + MX_V + 8 * lane) = o; rec[MX_VSC + lane] = (unsigned char)ebc;
}
__device__ __forceinline__ void cvt_expert_mx2(const float* eu, const float* ev, unsigned char* dst, int e0, int e1, int lane) {
    f32x4 ua[4], va[4], ub[4], vb[4];
#pragma unroll
    for (int j = 0; j < 4; ++j) { ua[j] = *(const f32x4*)(eu + (size_t)e0 * 1024 + 16 * lane + 4 * j); va[j] = *(const f32x4*)(ev + (size_t)e0 * 1024 + 256 * j + 4 * lane);
                                  ub[j] = *(const f32x4*)(eu + (size_t)e1 * 1024 + 16 * lane + 4 * j); vb[j] = *(const f32x4*)(ev + (size_t)e1 * 1024 + 256 * j + 4 * lane); }
    mx_pack_u(ua, dst + (size_t)e0 * MX_ROW, lane); mx_pack_v(va, dst + (size_t)e0 * MX_ROW, lane);
    mx_pack_u(ub, dst + (size_t)e1 * MX_ROW, lane); mx_pack_v(vb, dst + (size_t)e1 * MX_ROW, lane);
}
struct AFrag { v4u a[8]; v2u sc; };
__device__ __forceinline__ void p9m_load_a(AFrag& A, const unsigned char* EUV, int id, int lane) {
    const GAS unsigned char* rec = (const GAS unsigned char*)EUV + (size_t)id * MX_ROW + (unsigned)((lane >> 4) * 8);
    A.sc = *(const GAS v2u*)(rec + MX_USC);
    const GAS unsigned char* ra = rec + (unsigned)((lane >> 4) * 8);
#pragma unroll
    for (int s = 0; s < 8; ++s) A.a[s] = *(const GAS v4u*)(ra + 64 * s);
}
struct VSlot { v2u d; unsigned s; };
__device__ __forceinline__ void p9m_load_v(VSlot& V, __amdgpu_buffer_rsrc_t rs, int e, int lane) {
    const int so = e * MX_ROW;
    V.d = __builtin_bit_cast(v2u, __builtin_amdgcn_raw_buffer_load_b64(rs, MX_V + 8 * lane, so, 0)); V.s = (unsigned)__builtin_amdgcn_raw_buffer_load_b8(rs, MX_VSC + lane, so, 0);
}
__device__ __forceinline__ void p9m_axpy(const VSlot& V, const float c, f32x2v (&o)[8]) {
    const float sc = __builtin_bit_cast(float, V.s << 23); const f32x2v cc = {c, c};
#define AX_STEP(K) { o[K] = __builtin_elementwise_fma(__builtin_amdgcn_cvt_scalef32_pk_f32_fp4(V.d.x, sc, K), cc, o[K]); o[4 + K] = __builtin_elementwise_fma(__builtin_amdgcn_cvt_scalef32_pk_f32_fp4(V.d.y, sc, K), cc, o[4 + K]); }
    AX_STEP(0) AX_STEP(1) AX_STEP(2) AX_STEP(3)
#undef AX_STEP
}
__device__ __forceinline__ f32x4 p9m_dots(const AFrag& A, LAS unsigned char* h8, int lane) {
    f32x4 d0 = {0.f, 0.f, 0.f, 0.f}, d1 = {0.f, 0.f, 0.f, 0.f};
    LAS unsigned char* hb = h8 + (lane >> 4) * 16;
#define P9M_STEP(S, ACC) { const v4u b0 = *(LAS v4u*)(hb + 128 * (S)), b1 = *(LAS v4u*)(hb + 128 * (S) + 64); \
        const v8i a8 = {(int)A.a[S].x, (int)A.a[S].y, (int)A.a[S].z, (int)A.a[S].w, 0, 0, 0, 0}; const v8i b8 = {(int)b0.x, (int)b0.y, (int)b0.z, (int)b0.w, (int)b1.x, (int)b1.y, (int)b1.z, (int)b1.w}; \
        ACC = __builtin_amdgcn_mfma_scale_f32_16x16x128_f8f6f4(a8, b8, ACC, 4, 0, (S) & 3, (int)((S) < 4 ? A.sc.x : A.sc.y), 0, 0x7f7f7f7f); }
    P9M_STEP(0, d0) P9M_STEP(1, d1) P9M_STEP(2, d0) P9M_STEP(3, d1) P9M_STEP(4, d0) P9M_STEP(5, d1) P9M_STEP(6, d0) P9M_STEP(7, d1)
#undef P9M_STEP
    return d0 + d1;
}
__device__ __forceinline__ void p9m_batch(const AFrag& A, VSlot (&V)[16], LAS unsigned char* h8, LAS float* sgt, __amdgpu_buffer_rsrc_t rs, int b, int idn, int lane, f32x2v (&o)[8]) {
    const f32x4 dd = p9m_dots(A, h8, lane);
    const f32x4 gt = *(LAS f32x4*)(sgt + 16 * b + 4 * (lane >> 4));
    float c[4];
#pragma unroll
    for (int r = 0; r < 4; ++r) c[r] = gt[r] * gelu_erf(dd[r]);
#pragma unroll
    for (int p = 0; p < 16; ++p) {
        p9m_axpy(V[p], rdl(c[p & 3], 16 * (p >> 2)), o);
        p9m_load_v(V[p], rs, __builtin_amdgcn_readlane(idn, p), lane);
    }
}
constexpr int G_HSTR = 1040;
struct BFrag { v4u b[16]; };
__device__ __forceinline__ void p9g_load_b(BFrag& B, LAS unsigned char* h8, int lane) {
    LAS unsigned char* hb = h8 + (lane & 3) * G_HSTR + (lane >> 4) * 16;
#pragma unroll
    for (int s = 0; s < 8; ++s) { B.b[2 * s] = *(LAS v4u*)(hb + 128 * s); B.b[2 * s + 1] = *(LAS v4u*)(hb + 128 * s + 64); }
}
__device__ __forceinline__ f32x4 p9g_dots(const AFrag& A, const BFrag& B, int lane) {
    f32x4 d0 = {0.f, 0.f, 0.f, 0.f}, d1 = {0.f, 0.f, 0.f, 0.f};
#define P9G_STEP(S, ACC) { const v4u b0 = B.b[2 * (S)], b1 = B.b[2 * (S) + 1]; \
        const v8i a8 = {(int)A.a[S].x, (int)A.a[S].y, (int)A.a[S].z, (int)A.a[S].w, 0, 0, 0, 0}; const v8i b8 = {(int)b0.x, (int)b0.y, (int)b0.z, (int)b0.w, (int)b1.x, (int)b1.y, (int)b1.z, (int)b1.w}; \
        ACC = __builtin_amdgcn_mfma_scale_f32_16x16x128_f8f6f4(a8, b8, ACC, 4, 0, (S) & 3, (int)((S) < 4 ? A.sc.x : A.sc.y), 0, 0x7f7f7f7f); }
    P9G_STEP(0, d0) P9G_STEP(1, d1) P9G_STEP(2, d0) P9G_STEP(3, d1) P9G_STEP(4, d0) P9G_STEP(5, d1) P9G_STEP(6, d0) P9G_STEP(7, d1)
#undef P9G_STEP
    return d0 + d1;
}
typedef unsigned v4s __attribute__((ext_vector_type(4)));
__device__ __forceinline__ void p9g_issue_a(AFrag& A, v4s rsrc, unsigned voa, unsigned vos) {
#define LD_A(S) asm volatile("buffer_load_dwordx4 %0, %1, %2, 0 offen offset:" #S : "=v"(A.a[(S) / 64]) : "v"(voa), "s"(rsrc));
    LD_A(0) LD_A(64) LD_A(128) LD_A(192) LD_A(256) LD_A(320) LD_A(384) LD_A(448)
#undef LD_A
    asm volatile("buffer_load_dwordx2 %0, %1, %2, 0 offen offset:1024" : "=v"(A.sc) : "v"(vos), "s"(rsrc));
}
constexpr int G_ABUF = 8448, G_APAIR = 1040;
__device__ __forceinline__ void p9g_issue_a_lds(AFrag& A, v4s rsrc, unsigned vos, LAS int* idsrc, unsigned abase, unsigned l16) {
    int idj[8];
#pragma unroll
    for (int j = 0; j < 8; ++j) idj[j] = idsrc[(j >> 1) * 128 + 2 * (j & 1)];
    LDS_WAIT();
#define LD_AL(J) { const unsigned vo_ = (unsigned)idj[J] * MX_ROW + l16; const unsigned m0_ = abase + (unsigned)(J) * G_APAIR; \
        asm volatile("s_mov_b32 m0, %0\n\ts_nop 0\n\tbuffer_load_dwordx4 %1, %2, 0 offen lds" :: "s"(m0_), "v"(vo_), "s"(rsrc) : "m0", "memory"); }
    LD_AL(0) LD_AL(1) LD_AL(2) LD_AL(3) LD_AL(4) LD_AL(5) LD_AL(6) LD_AL(7)
#undef LD_AL
    asm volatile("buffer_load_dwordx2 %0, %1, %2, 0 offen offset:1024" : "=v"(A.sc) : "v"(vos), "s"(rsrc));
}
__device__ __forceinline__ void p9g_issue_v(VSlot& V, v4s rsrc, int so, unsigned vov, unsigned vob) {
    asm volatile("buffer_load_dwordx2 %0, %1, %2, %3 offen offset:512" : "=v"(V.d) : "v"(vov), "s"(rsrc), "s"(so));
    asm volatile("buffer_load_ubyte %0, %1, %2, %3 offen offset:1056" : "=v"(V.s) : "v"(vob), "s"(rsrc), "s"(so));
}
#define P9G_WAIT_A(N, A) asm volatile("s_waitcnt vmcnt(" #N ")" : "+v"(A.a[0]), "+v"(A.a[1]), "+v"(A.a[2]), "+v"(A.a[3]), "+v"(A.a[4]), "+v"(A.a[5]), "+v"(A.a[6]), "+v"(A.a[7]), "+v"(A.sc))
#define P9G_WAIT_V(N, V) asm volatile("s_waitcnt vmcnt(" #N ")" : "+v"(V.d), "+v"(V.s))
template <bool PF> __device__ __forceinline__ void p9g_batch(AFrag& A, VSlot (&V)[16], const BFrag& B, LAS float* sgtl, v4s rsrc, int b, int idn, int lane,
                                                            f32x2v (&o0)[8], f32x2v (&o1)[8], f32x2v (&o2)[8], f32x2v (&o3)[8], LAS unsigned char* afr, LAS int* idsrc, unsigned abase) {
    if (PF) asm volatile("s_waitcnt vmcnt(32)" : "+v"(A.sc) :: "memory"); else asm volatile("s_waitcnt vmcnt(0)" : "+v"(A.sc) :: "memory");
#pragma unroll
    for (int s_ = 0; s_ < 8; ++s_) A.a[s_] = *(LAS v4u*)(afr + 64 * s_);
    const f32x4 dd = p9g_dots(A, B, lane);
    if (PF) { const unsigned rowo = (unsigned)idn * MX_ROW + (unsigned)((lane >> 4) * 8); p9g_issue_a_lds(A, rsrc, rowo, idsrc + 4 * (b + 1), abase, 16u * (unsigned)(lane & 31)); }
    const f32x4 gt = *(LAS f32x4*)(sgtl + 4 * b);
    float c[4];
#pragma unroll
    for (int r = 0; r < 4; ++r) c[r] = gt[r] * gelu_erf(dd[r]);
    const unsigned vov = 8u * (unsigned)lane, vob = (unsigned)lane;
#define P9G_PAIR(P, O) { if (PF) P9G_WAIT_V(39, V[P]); else P9G_WAIT_V(0, V[P]); p9m_axpy(V[P], rdl(c[(P) & 3], 17 * ((P) >> 2)), O); \
        if (PF) p9g_issue_v(V[P], rsrc, __builtin_amdgcn_readlane(idn, P) * MX_ROW, vov, vob); }
    P9G_PAIR(0, o0) P9G_PAIR(1, o0) P9G_PAIR(2, o0) P9G_PAIR(3, o0) P9G_PAIR(4, o1) P9G_PAIR(5, o1) P9G_PAIR(6, o1) P9G_PAIR(7, o1)
    P9G_PAIR(8, o2) P9G_PAIR(9, o2) P9G_PAIR(10, o2) P9G_PAIR(11, o2) P9G_PAIR(12, o3) P9G_PAIR(13, o3) P9G_PAIR(14, o3) P9G_PAIR(15, o3)
#undef P9G_PAIR
}
__device__ __forceinline__ void p9_group_mx(Frame& F, int g, const float* g_ffn, const float* g_fin) {
    unsigned char* ws = F.ws; const int lane = pg8::fresh_lane();
    const unsigned char* EUV = ws + WS_EU;
    const __amdgpu_buffer_rsrc_t rs = __builtin_amdgcn_make_buffer_rsrc((void*)EUV, (short)0, 16384 * MX_ROW, 0x00020000);
    LAS unsigned char* wl = F.lds + F.wave * WAVE_LDS;
    LAS int* sid = (LAS int*)wl; LAS float* sgt = (LAS float*)(wl + 2048); LAS unsigned char* h8 = wl + 4096;
    v4u xa0[4], xa1[4]; f32x4 rq[4][4]; int ia[4], ib[4]; float gav[4], gbv[4];
#pragma unroll
    for (int tk = 0; tk < 4; ++tk) { const int t = 4 * g + tk;
        const bf16* xrow = (const bf16*)(ws + WS_X1B) + (size_t)t * D; xa0[tk] = *(const v4u*)(xrow + 16 * lane); xa1[tk] = *(const v4u*)(xrow + 16 * lane + 8);
        const float* rp = (const float*)(ws + WS_ROWSS) + (size_t)t * 16;
#pragma unroll
        for (int i = 0; i < 4; ++i) rq[tk][i] = *(const f32x4*)(rp + 4 * i);
        const int* IDX = (const int*)(ws + WS_IDX) + (size_t)t * 128; const float* GT = (const float*)(ws + WS_GATE) + (size_t)t * 128;
        ia[tk] = IDX[lane]; ib[tk] = IDX[64 + lane]; gav[tk] = GT[lane]; gbv[tk] = GT[64 + lane]; }
    f32x4 ggv[4];
#pragma unroll
    for (int j = 0; j < 4; ++j) ggv[j] = *(const f32x4*)(g_ffn + 16 * lane + 4 * j);
#pragma unroll
    for (int tk = 0; tk < 4; ++tk) {
        const f32x4 qa = rq[tk][0], qb = rq[tk][1], qc = rq[tk][2], qd = rq[tk][3];
        const float rs2 = __builtin_amdgcn_rsqf(((((qa[0] + qa[1]) + (qa[2] + qa[3])) + ((qb[0] + qb[1]) + (qb[2] + qb[3]))) + (((qc[0] + qc[1]) + (qc[2] + qc[3])) + ((qd[0] + qd[1]) + (qd[2] + qd[3])))) * (1.0f / D) + EPS);
        { const v4u a0 = xa0[tk], a1 = xa1[tk]; v4u o;
          const unsigned xs[8] = {a0.x, a0.y, a0.z, a0.w, a1.x, a1.y, a1.z, a1.w};
#pragma unroll
          for (int j = 0; j < 4; ++j) { const f32x4 gg = ggv[j];
              int p = __builtin_amdgcn_cvt_pk_fp8_f32(bflo(xs[2 * j]) * rs2 * gg[0], bfhi(xs[2 * j]) * rs2 * gg[1], 0, false);
              p = __builtin_amdgcn_cvt_pk_fp8_f32(bflo(xs[2 * j + 1]) * rs2 * gg[2], bfhi(xs[2 * j + 1]) * rs2 * gg[3], p, true); o[j] = (unsigned)p; }
          *(LAS v4u*)(h8 + tk * G_HSTR + 16 * lane) = o; }
        { const int a0 = ia[tk], b0 = ib[tk]; const float ga = gav[tk], gb = gbv[tk];
            const int kA = (int)(((unsigned)a0 * 2654435761u) >> 28), kB = (int)(((unsigned)b0 * 2654435761u) >> 28);
          int base = 0, rA = 0, rB = 0;
#pragma unroll
          for (int k = 0; k < 16; ++k) { const unsigned long long mA = __ballot(kA == k), mB = __ballot(kB == k); const int cA = __popcll(mA), cB = __popcll(mB);
              const int pA = (int)__builtin_amdgcn_mbcnt_hi((unsigned)(mA >> 32), __builtin_amdgcn_mbcnt_lo((unsigned)mA, 0u)), pB = (int)__builtin_amdgcn_mbcnt_hi((unsigned)(mB >> 32), __builtin_amdgcn_mbcnt_lo((unsigned)mB, 0u));
              if (kA == k) rA = base + pA;
              if (kB == k) rB = base + cA + pB;
              base += cA + cB; }
          sid[tk * 128 + rA] = a0; sid[tk * 128 + rB] = b0; sgt[tk * 128 + rA] = ga; sgt[tk * 128 + rB] = gb; }
    }
    LDS_WAIT(); asm volatile("" ::: "memory");
    f32x2v o0[8], o1[8], o2[8], o3[8];
#pragma unroll
    for (int i = 0; i < 8; ++i) { o0[i] = (f32x2v){0.f, 0.f}; o1[i] = o0[i]; o2[i] = o0[i]; o3[i] = o0[i]; }
    AFrag A; VSlot V[16]; BFrag B; p9g_load_b(B, h8, lane);
    LAS int* sidl = sid + ((lane & 15) >> 2) * 128 + (lane & 3);
    LAS float* sgtl = sgt + (lane >> 4) * 128;
    v4s rsrc; { const unsigned long long ba = (unsigned long long)EUV; rsrc.x = (unsigned)__builtin_amdgcn_readfirstlane((int)(unsigned)ba); rsrc.y = (unsigned)__builtin_amdgcn_readfirstlane((int)(unsigned)(ba >> 32)) & 0xffffu; rsrc.z = 16384u * MX_ROW; rsrc.w = 0x00020000u; }
    LAS unsigned char* afr = wl + G_ABUF + ((lane & 15) >> 1) * G_APAIR + (lane & 1) * 512 + (lane >> 4) * 16;
    LAS int* idsrc = sid + (lane >> 5);
    const unsigned abase = (unsigned)__builtin_amdgcn_readfirstlane((int)(unsigned)(unsigned long long)(wl + G_ABUF));
    { const int idc = sidl[0];
      const unsigned rowo = (unsigned)idc * MX_ROW + (unsigned)((lane >> 4) * 8); p9g_issue_a_lds(A, rsrc, rowo, idsrc, abase, 16u * (unsigned)(lane & 31));
#pragma unroll
      for (int p = 0; p < 16; ++p) p9g_issue_v(V[p], rsrc, __builtin_amdgcn_readlane(idc, p) * MX_ROW, 8u * (unsigned)lane, (unsigned)lane); }
#pragma unroll 1
    for (int b = 0; b < 31; ++b) {
        const int idn = sidl[4 * (b + 1)];
        p9g_batch<true>(A, V, B, sgtl, rsrc, b, idn, lane, o0, o1, o2, o3, afr, idsrc, abase);
    }
    p9g_batch<false>(A, V, B, sgtl, rsrc, 31, 0, lane, o0, o1, o2, o3, afr, idsrc, abase);
    LDS_WAIT(); asm volatile("" ::: "memory");
    f32x4 gfin[4]; v2u xr[4][4];
#pragma unroll
    for (int j = 0; j < 4; ++j) gfin[j] = *(const f32x4*)(g_fin + 256 * j + 4 * lane);
#pragma unroll
    for (int tk = 0; tk < 4; ++tk) { const bf16* xrow = (const bf16*)(ws + WS_X1B) + (size_t)(4 * g + tk) * D;
#pragma unroll
        for (int j = 0; j < 4; ++j) xr[tk][j] = *(const v2u*)(xrow + 256 * j + 4 * lane); }
#define P9G_EPI(TK, O) { float* orow = F.out + (size_t)(4 * g + (TK)) * D; \
        float oacc[16]; _Pragma("unroll") for (int k = 0; k < 8; ++k) { oacc[2 * k] = O[k].x; oacc[2 * k + 1] = O[k].y; } \
        float ss = 0.f; \
        _Pragma("unroll") for (int j = 0; j < 4; ++j) { const v2u a = xr[TK][j]; \
            oacc[4 * j] += bflo(a.x); oacc[4 * j + 1] += bfhi(a.x); oacc[4 * j + 2] += bflo(a.y); oacc[4 * j + 3] += bfhi(a.y); \
            _Pragma("unroll") for (int i = 0; i < 4; ++i) ss += oacc[4 * j + i] * oacc[4 * j + i]; } \
        ss += swz_xor<1>(ss); ss += swz_xor<2>(ss); ss += swz_xor<4>(ss); ss += swz_xor<8>(ss); ss += swz_xor<16>(ss); ss += bperm(ss, lane ^ 32); \
        const float rs3 = __builtin_amdgcn_rsqf(ss * (1.0f / D) + EPS); \
        _Pragma("unroll") for (int j = 0; j < 4; ++j) { const f32x4 gg = gfin[j]; f32x4 ov; \
            _Pragma("unroll") for (int i = 0; i < 4; ++i) ov[i] = oacc[4 * j + i] * rs3 * gg[i]; \
            *(f32x4*)(orow + 256 * j + 4 * lane) = ov; } }
    P9G_EPI(0, o0) P9G_EPI(1, o1) P9G_EPI(2, o2) P9G_EPI(3, o3)
#undef P9G_EPI
}
#ifdef DBG_P9
__device__ __forceinline__ void p9_token_dbg(Frame& F, int t, const float* g_ffn, const float* g_fin) {
    unsigned char* ws = F.ws; const int lane = pg8::fresh_lane();
    const unsigned char* EUV = ws + WS_EU;
    const __amdgpu_buffer_rsrc_t rs = __builtin_amdgcn_make_buffer_rsrc((void*)EUV, (short)0, 16384 * MX_ROW, 0x00020000);
    const bf16* xrow = (const bf16*)(ws + WS_X1B) + (size_t)t * D; float* orow = F.out + (size_t)t * D;
    const float rs2 = __builtin_amdgcn_rsqf(pg8::sum16((const float*)(ws + WS_ROWSS) + (size_t)t * 16) * (1.0f / D) + EPS);
    LAS unsigned char* wl = F.lds + F.wave * WAVE_LDS;
    LAS int* sid = (LAS int*)wl; LAS float* sgt = (LAS float*)(sid + 128); LAS unsigned char* h8 = wl + 1024;
    { const v4u a0 = *(const v4u*)(xrow + 16 * lane), a1 = *(const v4u*)(xrow + 16 * lane + 8); v4u o;
      const unsigned xs[8] = {a0.x, a0.y, a0.z, a0.w, a1.x, a1.y, a1.z, a1.w};
#pragma unroll
      for (int j = 0; j < 4; ++j) { const f32x4 g = *(const f32x4*)(g_ffn + 16 * lane + 4 * j);
          int p = __builtin_amdgcn_cvt_pk_fp8_f32(bflo(xs[2 * j]) * rs2 * g[0], bfhi(xs[2 * j]) * rs2 * g[1], 0, false);
          p = __builtin_amdgcn_cvt_pk_fp8_f32(bflo(xs[2 * j + 1]) * rs2 * g[2], bfhi(xs[2 * j + 1]) * rs2 * g[3], p, true); o[j] = (unsigned)p; }
      *(LAS v4u*)(h8 + 16 * lane) = o; }
    const int* IDX = (const int*)(ws + WS_IDX) + (size_t)t * 128; const float* GT = (const float*)(ws + WS_GATE) + (size_t)t * 128;
    sid[lane] = IDX[lane]; sid[64 + lane] = IDX[64 + lane]; sgt[lane] = GT[lane]; sgt[64 + lane] = GT[64 + lane];
    LDS_WAIT(); asm volatile("" ::: "memory");
    f32x2v o[8];
#pragma unroll
    for (int i = 0; i < 8; ++i) o[i] = (f32x2v){0.f, 0.f};
#pragma unroll 1
    for (int b = 0; b < 8; ++b) {
        const int idc = sid[16 * b + (lane & 15)];
        f32x4 dd = {0.f, 0.f, 0.f, 0.f};
#if DBG_P9 == 2
        { AFrag A; p9m_load_a(A, EUV, idc, lane); dd = p9m_dots(A, h8, lane); }
#else
#pragma unroll 1
        for (int i = 0; i < 16; ++i) { const int e = __builtin_amdgcn_readlane(idc, i); const unsigned char* rec = EUV + (size_t)e * MX_ROW;
            const v2u uu = *(const v2u*)(rec + 8 * lane); const int blk = lane >> 1; const unsigned sb = rec[MX_USC + (blk & 3) * 8 + (blk >> 2)];
            const v4u hh = *(LAS v4u*)(h8 + 16 * lane);
            float f0[8], f1[8]; unpack8_f4(uu.x, f0); unpack8_f4(uu.y, f1); float acc = 0.f;
#define DBG_ACC(HW, F, O4) { const f32x2v lo = __builtin_amdgcn_cvt_pk_f32_fp8((int)(HW), false), hi = __builtin_amdgcn_cvt_pk_f32_fp8((int)(HW), true); acc += F[O4] * lo.x + F[O4 + 1] * lo.y + F[O4 + 2] * hi.x + F[O4 + 3] * hi.y; }
            DBG_ACC(hh.x, f0, 0) DBG_ACC(hh.y, f0, 4) DBG_ACC(hh.z, f1, 0) DBG_ACC(hh.w, f1, 4)
#undef DBG_ACC
            acc *= __builtin_bit_cast(float, sb << 23);
            acc += swz_xor<1>(acc); acc += swz_xor<2>(acc); acc += swz_xor<4>(acc); acc += swz_xor<8>(acc); acc += swz_xor<16>(acc); acc += bperm(acc, lane ^ 32);
            if ((lane >> 4) == (i >> 2)) { if ((i & 3) == 0) dd[0] = acc; if ((i & 3) == 1) dd[1] = acc; if ((i & 3) == 2) dd[2] = acc; if ((i & 3) == 3) dd[3] = acc; } }
#endif
        const f32x4 gt = *(LAS f32x4*)(sgt + 16 * b + 4 * (lane >> 4));
        float c[4];
#pragma unroll
        for (int r = 0; r < 4; ++r) c[r] = gt[r] * gelu_erf(dd[r]);
#pragma unroll 1
        for (int p = 0; p < 16; ++p) { VSlot V; p9m_load_v(V, rs, __builtin_amdgcn_readlane(idc, p), lane);
            const float cs = (p & 3) == 0 ? c[0] : (p & 3) == 1 ? c[1] : (p & 3) == 2 ? c[2] : c[3];
            p9m_axpy(V, rdl(cs, 16 * (p >> 2)), o); }
    }
    LDS_WAIT(); asm volatile("" ::: "memory");
    float oacc[16];
#pragma unroll
    for (int k = 0; k < 8; ++k) { oacc[2 * k] = o[k].x; oacc[2 * k + 1] = o[k].y; }
    float ss = 0.f;
#pragma unroll
    for (int j = 0; j < 4; ++j) { const v2u a = *(const v2u*)(xrow + 256 * j + 4 * lane);
        oacc[4 * j] += bflo(a.x); oacc[4 * j + 1] += bfhi(a.x); oacc[4 * j + 2] += bflo(a.y); oacc[4 * j + 3] += bfhi(a.y);
#pragma unroll
        for (int i = 0; i < 4; ++i) ss += oacc[4 * j + i] * oacc[4 * j + i]; }
    ss += swz_xor<1>(ss); ss += swz_xor<2>(ss); ss += swz_xor<4>(ss); ss += swz_xor<8>(ss); ss += swz_xor<16>(ss); ss += bperm(ss, lane ^ 32);
    const float rs3 = __builtin_amdgcn_rsqf(ss * (1.0f / D) + EPS);
#pragma unroll
    for (int j = 0; j < 4; ++j) { const f32x4 g = *(const f32x4*)(g_fin + 256 * j + 4 * lane); f32x4 ov;
#pragma unroll
        for (int i = 0; i < 4; ++i) ov[i] = oacc[4 * j + i] * rs3 * g[i];
        *(f32x4*)(orow + 256 * j + 4 * lane) = ov; }
}
#endif
__device__ __forceinline__ void p9_token_mx(Frame& F, int t, const float* g_ffn, const float* g_fin) {
    unsigned char* ws = F.ws; const int lane = pg8::fresh_lane();
    const unsigned char* EUV = ws + WS_EU;
    const __amdgpu_buffer_rsrc_t rs = __builtin_amdgcn_make_buffer_rsrc((void*)EUV, (short)0, 16384 * MX_ROW, 0x00020000);
    const bf16* xrow = (const bf16*)(ws + WS_X1B) + (size_t)t * D; float* orow = F.out + (size_t)t * D;
    const float rs2 = __builtin_amdgcn_rsqf(pg8::sum16((const float*)(ws + WS_ROWSS) + (size_t)t * 16) * (1.0f / D) + EPS);
    LAS unsigned char* wl = F.lds + F.wave * WAVE_LDS;
    LAS int* sid = (LAS int*)wl; LAS float* sgt = (LAS float*)(sid + 128); LAS unsigned char* h8 = wl + 1024;
    { const v4u a0 = *(const v4u*)(xrow + 16 * lane), a1 = *(const v4u*)(xrow + 16 * lane + 8); v4u o;
      const unsigned xs[8] = {a0.x, a0.y, a0.z, a0.w, a1.x, a1.y, a1.z, a1.w};
#pragma unroll
      for (int j = 0; j < 4; ++j) { const f32x4 g = *(const f32x4*)(g_ffn + 16 * lane + 4 * j);
          int p = __builtin_amdgcn_cvt_pk_fp8_f32(bflo(xs[2 * j]) * rs2 * g[0], bfhi(xs[2 * j]) * rs2 * g[1], 0, false);
          p = __builtin_amdgcn_cvt_pk_fp8_f32(bflo(xs[2 * j + 1]) * rs2 * g[2], bfhi(xs[2 * j + 1]) * rs2 * g[3], p, true); o[j] = (unsigned)p; }
      *(LAS v4u*)(h8 + 16 * lane) = o; }
    const int* IDX = (const int*)(ws + WS_IDX) + (size_t)t * 128; const float* GT = (const float*)(ws + WS_GATE) + (size_t)t * 128;
    { const int a0 = IDX[lane], b0 = IDX[64 + lane]; const float ga = GT[lane], gb = GT[64 + lane];
      const int kA = a0 >> 10, kB = b0 >> 10; const unsigned long long lt = (1ull << lane) - 1ull;
      int base = 0, rA = 0, rB = 0;
#pragma unroll
      for (int k = 0; k < 16; ++k) { const unsigned long long mA = __ballot(kA == k), mB = __ballot(kB == k); const int cA = __popcll(mA), cB = __popcll(mB);
          if (kA == k) rA = base + __popcll(mA & lt);
          if (kB == k) rB = base + cA + __popcll(mB & lt);
          base += cA + cB; }
      sid[rA] = a0; sid[rB] = b0; sgt[rA] = ga; sgt[rB] = gb;
      LDS_WAIT(); asm volatile("" ::: "memory"); }
    f32x2v o[8];
#pragma unroll
    for (int i = 0; i < 8; ++i) o[i] = (f32x2v){0.f, 0.f};
    AFrag A0, A1; VSlot V[16];
    int idc = sid[lane & 15];
    p9m_load_a(A0, EUV, idc, lane);
#pragma unroll
    for (int p = 0; p < 16; ++p) p9m_load_v(V[p], rs, __builtin_amdgcn_readlane(idc, p), lane);
#pragma unroll 1
    for (int b = 0; b < 8; b += 2) {
        const int id1 = sid[16 * (b + 1) + (lane & 15)];
        p9m_load_a(A1, EUV, id1, lane); asm volatile("" ::: "memory");
        p9m_batch(A0, V, h8, sgt, rs, b, id1, lane, o); asm volatile("" ::: "memory");
        const int b2 = (b + 2 < 8) ? b + 2 : 7;
        const int id2 = sid[16 * b2 + (lane & 15)];
        p9m_load_a(A0, EUV, id2, lane); asm volatile("" ::: "memory");
        p9m_batch(A1, V, h8, sgt, rs, b + 1, id2, lane, o); asm volatile("" ::: "memory");
    }
    LDS_WAIT(); asm volatile("" ::: "memory");
    float oacc[16];
#pragma unroll
    for (int k = 0; k < 8; ++k) { oacc[2 * k] = o[k].x; oacc[2 * k + 1] = o[k].y; }
    float ss = 0.f;
#pragma unroll
    for (int j = 0; j < 4; ++j) { const v2u a = *(const v2u*)(xrow + 256 * j + 4 * lane);
        oacc[4 * j] += bflo(a.x); oacc[4 * j + 1] += bfhi(a.x); oacc[4 * j + 2] += bflo(a.y); oacc[4 * j + 3] += bfhi(a.y);
#pragma unroll
        for (int i = 0; i < 4; ++i) ss += oacc[4 * j + i] * oacc[4 * j + i]; }
    ss += swz_xor<1>(ss); ss += swz_xor<2>(ss); ss += swz_xor<4>(ss); ss += swz_xor<8>(ss); ss += swz_xor<16>(ss); ss += bperm(ss, lane ^ 32);
    const float rs3 = __builtin_amdgcn_rsqf(ss * (1.0f / D) + EPS);
#pragma unroll
    for (int j = 0; j < 4; ++j) { const f32x4 g = *(const f32x4*)(g_fin + 256 * j + 4 * lane); f32x4 ov;
#pragma unroll
        for (int i = 0; i < 4; ++i) ov[i] = oacc[4 * j + i] * rs3 * g[i];
        *(f32x4*)(orow + 256 * j + 4 * lane) = ov; }
}
struct Rows8 { v4u u[8], v[8]; };
__device__ __forceinline__ void p9_load8(Rows8& R, const unsigned char* EU, const unsigned char* EV, const int (&e)[8], int lane) {
#pragma unroll
    for (int j = 0; j < 8; ++j) { R.u[j] = *(const v4u*)(EU + (size_t)e[j] * 1024 + 16 * lane); R.v[j] = *(const v4u*)(EV + (size_t)e[j] * 1024 + 16 * lane); }
}
__device__ __forceinline__ void p9_token_f8(Frame& F, int t, const float* g_ffn, const float* g_fin) {
    unsigned char* ws = F.ws; const int lane = pg8::fresh_lane(), hh = lane >> 5, q4 = (lane >> 4) & 1, q3 = (lane >> 3) & 1;
    const unsigned char* EU = ws + WS_EU; const unsigned char* EV = ws + WS_EV; const float* ISU = (const float*)(ws + WS_ESC); const float* ISV = ISU + 16384;
    const bf16* xrow = (const bf16*)(ws + WS_X1B) + (size_t)t * D; float* orow = F.out + (size_t)t * D;
    const float rs2 = __builtin_amdgcn_rsqf(pg8::sum16((const float*)(ws + WS_ROWSS) + (size_t)t * 16) * (1.0f / D) + EPS);
    float hn[16];
#pragma unroll
    for (int j = 0; j < 4; ++j) { const v2u a = *(const v2u*)(xrow + 256 * j + 4 * lane); const f32x4 g = *(const f32x4*)(g_ffn + 256 * j + 4 * lane);
        hn[4 * j] = bflo(a.x) * rs2 * g[0]; hn[4 * j + 1] = bfhi(a.x) * rs2 * g[1]; hn[4 * j + 2] = bflo(a.y) * rs2 * g[2]; hn[4 * j + 3] = bfhi(a.y) * rs2 * g[3]; }
    const int* IDX = (const int*)(ws + WS_IDX) + (size_t)t * 128; const float* GT = (const float*)(ws + WS_GATE) + (size_t)t * 128;
    int idA, idB; float suA, suB, gvA, gvB;
    { const int a0 = IDX[lane], b0 = IDX[64 + lane];
      const float sa = ISU[a0], sb = ISU[b0], ga = GT[lane] * ISV[a0], gb = GT[64 + lane] * ISV[b0];
      const int kA = a0 >> 10, kB = b0 >> 10; const unsigned long long lt = (1ull << lane) - 1ull;
      int base = 0, rA = 0, rB = 0;
#pragma unroll
      for (int k = 0; k < 16; ++k) { const unsigned long long mA = __ballot(kA == k), mB = __ballot(kB == k); const int cA = __popcll(mA), cB = __popcll(mB);
          if (kA == k) rA = base + __popcll(mA & lt);
          if (kB == k) rB = base + cA + __popcll(mB & lt);
          base += cA + cB; }
      LAS int* sid = (LAS int*)(F.lds + F.wave * WAVE_LDS); LAS float* ssu = (LAS float*)(sid + 128); LAS float* sgv = ssu + 128;
      sid[rA] = a0; sid[rB] = b0; ssu[rA] = sa; ssu[rB] = sb; sgv[rA] = ga; sgv[rB] = gb;
      LDS_WAIT(); asm volatile("" ::: "memory");
      idA = sid[lane]; idB = sid[64 + lane]; suA = ssu[lane]; suB = ssu[64 + lane]; gvA = sgv[lane]; gvB = sgv[64 + lane];
      LDS_WAIT(); asm volatile("" ::: "memory"); }
    float oacc[16];
#pragma unroll
    for (int i = 0; i < 16; ++i) oacc[i] = 0.f;
    const int jsel = 4 * hh + 2 * q4 + q3;
    Rows8 R;
    { int e[8];
#pragma unroll
      for (int j = 0; j < 8; ++j) e[j] = __builtin_amdgcn_readlane(idA, j);
      p9_load8(R, EU, EV, e, lane); }
    for (int bt = 0; bt < 16; ++bt) {
        Rows8 Rn;
        { const int nb = (bt + 1) & 15; int e[8];
#pragma unroll
          for (int j = 0; j < 8; ++j) { const int n = 8 * nb + j; e[j] = (nb < 8) ? __builtin_amdgcn_readlane(idA, n & 63) : __builtin_amdgcn_readlane(idB, n & 63); }
          p9_load8(Rn, EU, EV, e, lane); }
        float pd[8];
#pragma unroll
        for (int j = 0; j < 8; ++j) { float a = 0.f, b = 0.f;
#pragma unroll
            for (int d = 0; d < 4; ++d) { const f32x2v lo = __builtin_amdgcn_cvt_pk_f32_fp8((int)R.u[j][d], false), hi = __builtin_amdgcn_cvt_pk_f32_fp8((int)R.u[j][d], true);
                a += lo.x * hn[4 * d] + hi.x * hn[4 * d + 2]; b += lo.y * hn[4 * d + 1] + hi.y * hn[4 * d + 3]; }
            pd[j] = a + b; }
        float r4[4], r2[2];
#pragma unroll
        for (int i = 0; i < 4; ++i) { const float keep = hh ? pd[4 + i] : pd[i], send = hh ? pd[i] : pd[4 + i]; r4[i] = keep + __shfl_xor(send, 32); }
#pragma unroll
        for (int i = 0; i < 2; ++i) { const float keep = q4 ? r4[2 + i] : r4[i], send = q4 ? r4[i] : r4[2 + i]; r2[i] = keep + __shfl_xor(send, 16); }
        float v = (q3 ? r2[1] : r2[0]) + __shfl_xor(q3 ? r2[0] : r2[1], 8);
        v += __shfl_xor(v, 4); v += __shfl_xor(v, 2); v += __shfl_xor(v, 1);
        const int n = 8 * bt + jsel;
        const float su = (bt < 8) ? __shfl(suA, n & 63) : __shfl(suB, n & 63), gv = (bt < 8) ? __shfl(gvA, n & 63) : __shfl(gvB, n & 63);
        const float w = gv * gelu_erf(v * su);
#pragma unroll
        for (int j = 0; j < 8; ++j) { const float wj = rdl(w, 8 * j);
#pragma unroll
            for (int d = 0; d < 4; ++d) { const f32x2v lo = __builtin_amdgcn_cvt_pk_f32_fp8((int)R.v[j][d], false), hi = __builtin_amdgcn_cvt_pk_f32_fp8((int)R.v[j][d], true);
                oacc[4 * d] += wj * lo.x; oacc[4 * d + 1] += wj * lo.y; oacc[4 * d + 2] += wj * hi.x; oacc[4 * d + 3] += wj * hi.y; } }
        R = Rn;
    }
    asm volatile("" ::: "memory");
    float ss = 0.f;
#pragma unroll
    for (int j = 0; j < 4; ++j) { const v2u a = *(const v2u*)(xrow + 256 * j + 4 * lane);
        oacc[4 * j] += bflo(a.x); oacc[4 * j + 1] += bfhi(a.x); oacc[4 * j + 2] += bflo(a.y); oacc[4 * j + 3] += bfhi(a.y);
#pragma unroll
        for (int i = 0; i < 4; ++i) ss += oacc[4 * j + i] * oacc[4 * j + i]; }
    ss = wave_sum(ss);
    const float rs3 = __builtin_amdgcn_rsqf(ss * (1.0f / D) + EPS);
#pragma unroll
    for (int j = 0; j < 4; ++j) { const f32x4 g = *(const f32x4*)(g_fin + 256 * j + 4 * lane); f32x4 o;
#pragma unroll
        for (int i = 0; i < 4; ++i) o[i] = oacc[4 * j + i] * rs3 * g[i];
        *(f32x4*)(orow + 256 * j + 4 * lane) = o; }
}
struct Rows4 { v4u ua[4], ub[4], va[4], vb[4]; };
__device__ __forceinline__ void p9_load(Rows4& R, const bf16* EU, const bf16* EV, const int (&e)[4], int lane) {
#pragma unroll
    for (int j = 0; j < 4; ++j) { const bf16* up = EU + (size_t)e[j] * 1024 + lane * 8; const bf16* vp = EV + (size_t)e[j] * 1024 + lane * 8;
        R.ua[j] = *(const v4u*)up; R.ub[j] = *(const v4u*)(up + 512); R.va[j] = *(const v4u*)vp; R.vb[j] = *(const v4u*)(vp + 512); }
}
__device__ __forceinline__ void p9_token(Frame& F, int t, const float* g_ffn, const float* g_fin) {
    unsigned char* ws = F.ws; const int lane = pg8::fresh_lane(), hh = lane >> 5, q4 = (lane >> 4) & 1;
    const bf16* EU = (const bf16*)(ws + WS_EU); const bf16* EV = (const bf16*)(ws + WS_EV);
    const float* xrow = (const float*)(ws + WS_X1) + (size_t)t * D; float* orow = F.out + (size_t)t * D;
    const float rs2 = __builtin_amdgcn_rsqf(pg8::sum16((const float*)(ws + WS_ROWSS) + (size_t)t * 16) * (1.0f / D) + EPS);
    float x1[16];
    { const f32x4 a0 = *(const f32x4*)(xrow + lane * 8), a1 = *(const f32x4*)(xrow + lane * 8 + 4), b0 = *(const f32x4*)(xrow + 512 + lane * 8), b1 = *(const f32x4*)(xrow + 512 + lane * 8 + 4);
#pragma unroll
      for (int i = 0; i < 4; ++i) { x1[i] = a0[i]; x1[4 + i] = a1[i]; x1[8 + i] = b0[i]; x1[12 + i] = b1[i]; } }
    unsigned hn[8];
    { const f32x4 a0 = *(const f32x4*)(g_ffn + lane * 8), a1 = *(const f32x4*)(g_ffn + lane * 8 + 4), b0 = *(const f32x4*)(g_ffn + 512 + lane * 8), b1 = *(const f32x4*)(g_ffn + 512 + lane * 8 + 4);
      float g[16];
#pragma unroll
      for (int i = 0; i < 4; ++i) { g[i] = a0[i]; g[4 + i] = a1[i]; g[8 + i] = b0[i]; g[12 + i] = b1[i]; }
#pragma unroll
      for (int i = 0; i < 8; ++i) hn[i] = pk2(x1[2 * i] * rs2 * g[2 * i], x1[2 * i + 1] * rs2 * g[2 * i + 1]); }
    const int* IDX = (const int*)(ws + WS_IDX) + (size_t)t * 128; const float* GT = (const float*)(ws + WS_GATE) + (size_t)t * 128;
    const int idA = IDX[lane], idB = IDX[64 + lane]; const float gtA = GT[lane], gtB = GT[64 + lane];
    float oacc[16];
#pragma unroll
    for (int i = 0; i < 16; ++i) oacc[i] = 0.f;
    const int jsel = 2 * hh + q4;
    Rows4 R;
    { int e[4];
#pragma unroll
      for (int j = 0; j < 4; ++j) e[j] = __builtin_amdgcn_readlane(idA, j);
      p9_load(R, EU, EV, e, lane); }
#ifndef DBG_NBATCH
#define DBG_NBATCH 32
#endif
    for (int bt = 0; bt < DBG_NBATCH; ++bt) {
        Rows4 Rn;
        { const int nb = (bt + 1) & 31; int e[4];
#pragma unroll
          for (int j = 0; j < 4; ++j) { const int n = 4 * nb + j; e[j] = (nb < 16) ? __builtin_amdgcn_readlane(idA, n & 63) : __builtin_amdgcn_readlane(idB, n & 63); }
          p9_load(Rn, EU, EV, e, lane); }
        float pd[4];
#pragma unroll
        for (int j = 0; j < 4; ++j) { float a = 0.f, b = 0.f;
            a = dot2bf(R.ua[j].x, hn[0], a); b = dot2bf(R.ua[j].y, hn[1], b); a = dot2bf(R.ua[j].z, hn[2], a); b = dot2bf(R.ua[j].w, hn[3], b);
            a = dot2bf(R.ub[j].x, hn[4], a); b = dot2bf(R.ub[j].y, hn[5], b); a = dot2bf(R.ub[j].z, hn[6], a); b = dot2bf(R.ub[j].w, hn[7], b); pd[j] = a + b; }
        const float k0 = hh ? pd[2] : pd[0], k1 = hh ? pd[3] : pd[1], s0 = hh ? pd[0] : pd[2], s1 = hh ? pd[1] : pd[3];
        const float r0 = k0 + __shfl_xor(s0, 32), r1 = k1 + __shfl_xor(s1, 32);
        float v = (q4 ? r1 : r0) + __shfl_xor(q4 ? r0 : r1, 16);
        v += __shfl_xor(v, 8); v += __shfl_xor(v, 4); v += __shfl_xor(v, 2); v += __shfl_xor(v, 1);
        const int n = 4 * bt + jsel; const float gsel = (bt < 16) ? __shfl(gtA, n & 63) : __shfl(gtB, n & 63);
        const float w = gsel * gelu_erf(v);
        const float w0 = __builtin_bit_cast(float, __builtin_amdgcn_readlane(__builtin_bit_cast(int, w), 0)), w1 = __builtin_bit_cast(float, __builtin_amdgcn_readlane(__builtin_bit_cast(int, w), 16)),
                    w2 = __builtin_bit_cast(float, __builtin_amdgcn_readlane(__builtin_bit_cast(int, w), 32)), w3 = __builtin_bit_cast(float, __builtin_amdgcn_readlane(__builtin_bit_cast(int, w), 48));
        const float wj[4] = {w0, w1, w2, w3};
#pragma unroll
        for (int j = 0; j < 4; ++j) {
            const unsigned va[4] = {R.va[j].x, R.va[j].y, R.va[j].z, R.va[j].w}, vb[4] = {R.vb[j].x, R.vb[j].y, R.vb[j].z, R.vb[j].w};
#pragma unroll
            for (int i = 0; i < 4; ++i) { oacc[2 * i] += wj[j] * bflo(va[i]); oacc[2 * i + 1] += wj[j] * bfhi(va[i]); oacc[8 + 2 * i] += wj[j] * bflo(vb[i]); oacc[8 + 2 * i + 1] += wj[j] * bfhi(vb[i]); }
        }
        R = Rn;
    }
    float ss = 0.f;
#pragma unroll
    for (int i = 0; i < 16; ++i) { x1[i] += oacc[i]; ss += x1[i] * x1[i]; }
    ss = wave_sum(ss);
#ifdef DBG_CHK
    const float rs3 = __builtin_amdgcn_rsqf(ss * (1.0f / D) + EPS) * chk_scale(F);
#else
    const float rs3 = __builtin_amdgcn_rsqf(ss * (1.0f / D) + EPS);
#endif
    { const f32x4 a0 = *(const f32x4*)(g_fin + lane * 8), a1 = *(const f32x4*)(g_fin + lane * 8 + 4), b0 = *(const f32x4*)(g_fin + 512 + lane * 8), b1 = *(const f32x4*)(g_fin + 512 + lane * 8 + 4);
      f32x4 o0, o1, o2, o3;
#pragma unroll
      for (int i = 0; i < 4; ++i) { o0[i] = x1[i] * rs3 * a0[i]; o1[i] = x1[4 + i] * rs3 * a1[i]; o2[i] = x1[8 + i] * rs3 * b0[i]; o3[i] = x1[12 + i] * rs3 * b1[i]; }
      *(f32x4*)(orow + lane * 8) = o0; *(f32x4*)(orow + lane * 8 + 4) = o1; *(f32x4*)(orow + 512 + lane * 8) = o2; *(f32x4*)(orow + 512 + lane * 8 + 4) = o3; }
}

__device__ __forceinline__ void dbg_dump_bf16(Frame& F, const bf16* src, int ld, int c0, int n) {
    const int gt = F.vcu * (NWAVES * 64) + F.wave * 64 + pg8::fresh_lane(), ngt = F.G * NWAVES * 64;
    for (long i = gt; i < (long)T * n; i += ngt) { const long t = i / n; const int c = (int)(i % n); F.out[t * 1024 + c0 + c] = bf2f(src[t * ld + c]); }
}
__device__ __forceinline__ void dbg_dump_f32(Frame& F, const float* src, long n, long o0) {
    const int gt = F.vcu * (NWAVES * 64) + F.wave * 64 + pg8::fresh_lane(), ngt = F.G * NWAVES * 64;
    for (long i = gt; i < n; i += ngt) F.out[o0 + i] = src[i];
}
__global__ void __launch_bounds__(NWAVES * 64, 2) fwd_kernel(Args args) {
    extern __shared__ __attribute__((aligned(16))) unsigned char lds[];
    Frame F;
    F.lds = (LAS unsigned char*)lds;
    F.wave = __builtin_amdgcn_readfirstlane((int)threadIdx.x >> 6);
    F.G = gridDim.x; { const int bx = blockIdx.x; F.vcu = (F.G % 8 == 0) ? (bx % 8) * (F.G / 8) + bx / 8 : bx; }
    F.gw = F.vcu * NWAVES + F.wave; F.ngw = F.G * NWAVES;
    F.out = args.out; F.ws = args.ws;
    unsigned char* ws = args.ws;
    volatile LAS unsigned* MISC = (volatile LAS unsigned*)(F.lds + MISC_OFF);
    for (int u = threadIdx.x; u < 256; u += NWAVES * 64) MISC[u] = 0u;
    __syncthreads();
    gu32* ctl = (gu32*)(ws + WS_CTL);
    XcdBarrier bar; bar.bar = (unsigned*)(ctl + CW_BAR); bar.x = 0; bar.st = nullptr;
    if (N_LAUNCHES != PER_PHASE) bar = xcd_barrier_post((unsigned*)(ctl + CW_BAR), MISC + 8);
#ifdef PROBE_DUP
#define DUPN(k) (((PROBE_DUP >> (k)) & 1) ? 2 : 1)
#else
#define DUPN(k) 1
#endif
#define GRID_BAR() do { if (N_LAUNCHES != PER_PHASE) xcd_barrier(bar); } while (0)
    const int lo = args.ph_lo, hi = args.ph_hi;
#ifdef ONLY_PH
#define IN(k) ((k) == ONLY_PH)
#else
#define IN(k) (lo <= (k) && (k) < hi)
#endif
#define BOTH(k) (IN(k) && IN((k) + 1))
    bf16* const XB = (bf16*)(ws + WS_XB);
    float* const rowss = (float*)(ws + WS_ROWSS);

    if (IN(0)) { for (int rep = 0; rep < DUPN(0); ++rep) p0_prologue(F, args); if (BOTH(0)) GRID_BAR(); }
    if (IN(1)) for (int rep = 0; rep < DUPN(1); ++rep) {
        pg8::Gemm g{(const bf16*)(ws + WS_X8), (const bf16*)(ws + WS_WIN), T, NIN, D / 2}; pg8::StaticOrder S; S.init(T, NIN, F.G, (int)blockIdx.x);
        pg8::EpiInProj E{(const float*)(ws + WS_RFAC), (const float*)(ws + WS_SWR), (const float*)(ws + WS_LB), (bf16*)(ws + WS_Q), (bf16*)(ws + WS_LF), (bf16*)(ws + WS_KK), (bf16*)(ws + WS_V), (bf16*)(ws + WS_SG),
                         (bf16*)(ws + WS_CB), (bf16*)(ws + WS_U), (bf16*)(ws + WS_GA)};
        pg8::gemm_phase<pg8::EpiInProj, pg8::StaticOrder, true, true, false, true>(F.lds, g, S, E, F.wave);
        if (BOTH(1)) GRID_BAR();
    }
    if (IN(2)) { p2_phase(F, args.in[5]); if (BOTH(2)) GRID_BAR(); }
    if (IN(3)) { for (int rep = 0; rep < DUPN(3); ++rep) p3_phase(F); if (BOTH(3)) GRID_BAR(); }
    if (IN(4)) { const float* gain = args.in[4]; for (int rep = 0; rep < DUPN(4); ++rep) for (int u = F.gw; u < NUNIT; u += F.ngw) p4_unit(F, u, gain); if (BOTH(4)) GRID_BAR(); }
    if (IN(5)) for (int rep = 0; rep < DUPN(5); ++rep) {
        pg8::Gemm g{(const bf16*)F.out, (const bf16*)(ws + WS_PAB), T, D, D}; pg8::StaticOrder S; S.init(T, D, F.G, (int)blockIdx.x);
        pg8::EpiMerged E{(const bf16*)(ws + WS_GA), (bf16*)(ws + WS_MG)};
        pg8::gemm_phase<pg8::EpiMerged, pg8::StaticOrder, true, true>(F.lds, g, S, E, F.wave);
        if (BOTH(5)) GRID_BAR();
    }
    if (IN(6)) for (int rep = 0; rep < DUPN(6); ++rep) {
        pg8::Gemm g{(const bf16*)(ws + WS_MG), (const bf16*)(ws + WS_WO), T, D, D}; pg8::StaticOrder S; S.init(T, D, F.G, (int)blockIdx.x);
        pg8::EpiOut E{args.in[0], (float*)(ws + WS_X1), (bf16*)(ws + WS_X1B), rowss};
        pg8::gemm_phase<pg8::EpiOut, pg8::StaticOrder, true, true>(F.lds, g, S, E, F.wave);
        if (BOTH(6)) GRID_BAR();
    }
    if (IN(7)) for (int rep = 0; rep < DUPN(7); ++rep) {
        pg8::Gemm g{(const bf16*)(ws + WS_X1B), (const bf16*)(ws + WS_WQ), T, 2048, D}; pg8::StaticOrder S; S.init(T, 2048, F.G, (int)blockIdx.x);
        pg8::EpiQuery E{rowss, (bf16*)(ws + WS_QQ), EPS};
        pg8::gemm_phase<pg8::EpiQuery, pg8::StaticOrder, true, true>(F.lds, g, S, E, F.wave);
        if (BOTH(7)) GRID_BAR();
    }
    if (IN(8)) {
        const float* eu = args.in[13]; const float* ev = args.in[14]; const int ln = pg8::fresh_lane();
        int it = F.gw;
        for (int rep = 0; rep < DUPN(8); ++rep)
        for (int tile = F.vcu; tile < T / 32; tile += F.G) {
            p8_task(F, tile, F.wave);
            if (it + F.ngw < 16384) { cvt_expert_mx2(eu, ev, ws + WS_EU, it, it + F.ngw, ln); it += 2 * F.ngw; }
            else if (it < 16384) { cvt_expert_mx(eu, ev, ws + WS_EU, it, ln); it += F.ngw; }
        }
#pragma unroll 1
        for (; it < 16384; it += F.ngw) cvt_expert_mx(eu, ev, ws + WS_EU, it, ln);
        if (BOTH(8)) GRID_BAR();
    }
    if (IN(9)) { const float* g_ffn = args.in[9]; const float* g_fin = args.in[15];
        for (int rep = 0; rep < DUPN(9); ++rep)
#pragma unroll 1
        for (int g = F.gw; g < T / 4; g += F.ngw) p9_group_mx(F, g, g_ffn, g_fin);
    }
#undef IN
#undef BOTH
}

extern "C" void kernel_launch(void* const* d_in, const int* in_sizes, int n_in, void* d_out, int out_size, void* d_ws, size_t ws_size, hipStream_t stream) {
    static int grid = 0;
    if (grid == 0) {
        if (n_in != 16 || in_sizes[0] != T * D || out_size != T * D || ws_size < WS_END) { fprintf(stderr, "kernel_launch: unexpected shapes (n_in %d, in0 %d, out %d, ws %zu); nothing launched\n", n_in, n_in > 0 ? in_sizes[0] : -1, out_size, ws_size); grid = -1; return; }
        int dev = 0, cus = 0, per_cu = 0;
        if (hipGetDevice(&dev) != hipSuccess || hipDeviceGetAttribute(&cus, hipDeviceAttributeMultiprocessorCount, dev) != hipSuccess) { fprintf(stderr, "kernel_launch: device query failed\n"); grid = -1; return; }
        if (hipFuncSetAttribute((const void*)fwd_kernel, hipFuncAttributeMaxDynamicSharedMemorySize, LDS_BYTES) != hipSuccess) { fprintf(stderr, "kernel_launch: hipFuncSetAttribute failed\n"); grid = -1; return; }
        if (hipOccupancyMaxActiveBlocksPerMultiprocessor(&per_cu, (const void*)fwd_kernel, NWAVES * 64, LDS_BYTES) != hipSuccess || per_cu < 1)
            fprintf(stderr, "kernel_launch: note: occupancy query reports %d workgroups per CU\n", per_cu);
        (void)hipGetLastError();
        grid = cus;
    }
    if (grid < 0) return;
    if (hipMemsetAsync((char*)d_ws + WS_CTL, 0, CTL_ZERO_BYTES, stream) != hipSuccess) { fprintf(stderr, "kernel_launch: hipMemsetAsync failed\n"); return; }
    Args a{};
    for (int i = 0; i < 16; ++i) a.in[i] = (const float*)d_in[i];
    a.out = (float*)d_out; a.ws = (unsigned char*)d_ws;
    for (int li = 0; li < N_LAUNCHES; ++li) {
        a.ph_lo = (N_LAUNCHES == PER_PHASE) ? li : 0; a.ph_hi = (N_LAUNCHES == PER_PHASE) ? li + 1 : PER_PHASE; a.li = li;
#ifdef DBG_STOP
        if (li == DBG_STOP + 1) { a.ph_lo = 100; a.ph_hi = 101; }
        if (li > DBG_STOP + 1) break;
#endif
        hipLaunchKernelGGL(fwd_kernel, dim3(grid), dim3(NWAVES * 64), LDS_BYTES, stream, a);
#ifdef DBG_CHK
        if (N_LAUNCHES == PER_PHASE && (li == 1 || li == 4)) { Args c = a; c.ph_lo = 210 + li; c.ph_hi = 211 + li; hipLaunchKernelGGL(fwd_kernel, dim3(grid), dim3(NWAVES * 64), LDS_BYTES, stream, c); }
        if (N_LAUNCHES == PER_PHASE && (li == 0 || li == 1 || li == 2 || li == 5 || li == 6 || li == 7)) { Args c = a; c.ph_lo = 200 + li; c.ph_hi = 201 + li; hipLaunchKernelGGL(fwd_kernel, dim3(grid), dim3(NWAVES * 64), LDS_BYTES, stream, c); }
#endif
        const hipError_t le = hipPeekAtLastError();
        if (le != hipSuccess) { fprintf(stderr, "kernel_launch: launch %d failed: %s\n", li, hipGetErrorName(le)); break; }
    }
}
```
